# Optimizing an MI355X kernel written in HIP

```python
import jax, jax.numpy as jnp
from jax import lax
import numpy as np

D_MODEL = 1024
BATCH = 8
SEQ = 2048
DEPTH = 2

POOL_WINDOWS = (2, 4, 8, 16)
POOL_GROUPS = len(POOL_WINDOWS)
POOL_GROUP_DIM = D_MODEL // 8
POOL_WIDTH = POOL_GROUPS * POOL_GROUP_DIM
HGRN_HEAD_DIM = 128
HGRN_HEADS = D_MODEL // HGRN_HEAD_DIM
HGRN_WIDTH = HGRN_HEADS * HGRN_HEAD_DIM
CHUNK = 64
NORM_EPS = 1e-6
IN_SIZES = (POOL_WIDTH, POOL_WIDTH, HGRN_WIDTH, HGRN_WIDTH, HGRN_WIDTH, HGRN_WIDTH, D_MODEL, D_MODEL)
IN_WIDTH = sum(IN_SIZES)

kernel_name = "hybrid_pool_hgrn2_gated_block"


def rms_norm(x, g):
    xf = x.astype(jnp.float32)
    y = xf * lax.rsqrt(jnp.mean(xf * xf, axis=-1, keepdims=True) + NORM_EPS)
    return (y * g.astype(jnp.float32)).astype(x.dtype)


def multiscale_pool(u):
    b, s, _ = u.shape
    uf = u.astype(jnp.float32)
    csum = lax.cumsum(uf, axis=1)
    pos = jnp.arange(s, dtype=jnp.float32) + 1.0
    outs = []
    for gi, w in enumerate(POOL_WINDOWS):
        sl = slice(gi * POOL_GROUP_DIM, (gi + 1) * POOL_GROUP_DIM)
        cg = csum[:, :, sl]
        prev = jnp.pad(cg, ((0, 0), (w, 0), (0, 0)))[:, :s]
        count = jnp.minimum(pos, float(w))[None, :, None]
        outs.append((cg - prev) / count - uf[:, :, sl])
    return jnp.stack(outs, axis=2)


def _hgrn2_chunk_step(state, inp):
    q, k, v, logf = inp
    cum = jnp.cumsum(logf, axis=2)
    o_inter = jnp.einsum('bhtk,bhkv->bhtv', q * jnp.exp(cum), state)
    c = q.shape[2]
    causal = jnp.tril(jnp.ones((c, c), dtype=bool))[:, :, None]
    diff = cum[:, :, :, None, :] - cum[:, :, None, :, :]
    decay = jnp.where(causal, jnp.exp(jnp.minimum(diff, 0.0)), 0.0)
    scores = jnp.sum(q[:, :, :, None, :] * k[:, :, None, :, :] * decay, axis=-1)
    o = o_inter + jnp.einsum('bhts,bhsv->bhtv', scores, v)
    last = cum[:, :, -1:, :]
    new_state = (jnp.exp(last[:, :, 0, :])[..., None] * state
                 + jnp.einsum('bhsk,bhsv->bhkv', k * jnp.exp(last - cum), v))
    return new_state, o


def hgrn2(q, k, v, logf):
    b, s, h, dk = q.shape
    n = s // CHUNK

    def to_chunks(t):
        return t.reshape(b, n, CHUNK, h, t.shape[-1]).transpose(1, 0, 3, 2, 4)

    state0 = jnp.zeros((b, h, dk, v.shape[-1]), jnp.float32)
    _, o = lax.scan(_hgrn2_chunk_step, state0,
                    (to_chunks(q), to_chunks(k), to_chunks(v), to_chunks(logf)))
    return o.transpose(1, 0, 3, 2, 4).reshape(b, s, h, v.shape[-1])


def setup_inputs(seed: int = 0) -> dict:
    key = jax.random.key(seed)
    ks = jax.random.split(key, 16)
    L, D = DEPTH, D_MODEL
    nrm = jax.random.normal
    return {
        "x": nrm(ks[0], (BATCH, SEQ, D), jnp.float32),
        "c": nrm(ks[1], (BATCH, D), jnp.float32),
        "w_ada": nrm(ks[2], (L, D, 3 * D), jnp.float32) * (0.5 * D ** -0.5),
        "b_ada": nrm(ks[3], (L, 3 * D), jnp.float32) * 0.02,
        "g_pre": 1.0 + 0.02 * nrm(ks[4], (L, D), jnp.float32),
        "g_post": 1.0 + 0.02 * nrm(ks[5], (L, D), jnp.float32),
        "w_in": nrm(ks[6], (L, D, IN_WIDTH), jnp.float32) * D ** -0.5,
        "pool_w": nrm(ks[7], (L, POOL_GROUPS, POOL_GROUP_DIM, POOL_GROUP_DIM), jnp.float32) * POOL_GROUP_DIM ** -0.5,
        "pool_scale": 1.0 + 0.02 * nrm(ks[8], (L, POOL_WIDTH), jnp.float32),
        "lb_logits": nrm(ks[9], (L, HGRN_WIDTH), jnp.float32),
        "hgrn_norm_g": 1.0 + 0.02 * nrm(ks[10], (L, HGRN_HEAD_DIM), jnp.float32),
        "w_pool_o": nrm(ks[11], (L, POOL_WIDTH, D), jnp.float32) * POOL_WIDTH ** -0.5,
        "w_hgrn_o": nrm(ks[12], (L, HGRN_WIDTH, D), jnp.float32) * HGRN_WIDTH ** -0.5,
        "w_out": nrm(ks[13], (L, D, D), jnp.float32) * D ** -0.5,
    }


def reference(x, c, w_ada, b_ada, g_pre, g_post, w_in, pool_w, pool_scale, lb_logits,
              hgrn_norm_g, w_pool_o, w_hgrn_o, w_out):
    b, s, d = x.shape
    p = jax.nn.softmax(lb_logits.astype(jnp.float32), axis=0)
    lower_bounds = jnp.cumsum(p, axis=0) - p[0:1]
    split_idx = np.cumsum(IN_SIZES)[:-1].tolist()
    c_act = jax.nn.silu(c)
    for l in range(DEPTH):
        ada = c_act @ w_ada[l] + b_ada[l]
        shift, scale, gate = jnp.split(ada[:, None, :], 3, axis=-1)
        h = rms_norm(x, g_pre[l]) * (1.0 + scale) + shift
        (pv, pg, hq, hf, hi, hg, mg_pool, mg_hgrn) = jnp.split(h @ w_in[l], split_idx, axis=-1)

        pooled = multiscale_pool(pv)
        pooled = jnp.einsum('bsgc,gcd->bsgd', pooled, pool_w[l].astype(jnp.float32))
        pooled = pooled.reshape(b, s, POOL_WIDTH) * pool_scale[l]
        branch_a = (pooled.astype(x.dtype) * jax.nn.silu(pg)) @ w_pool_o[l]

        shp = (b, s, HGRN_HEADS, HGRN_HEAD_DIM)
        lb = jnp.clip(lower_bounds[l], 0.0, 1.0).reshape(HGRN_HEADS, HGRN_HEAD_DIM)
        zf = hf.astype(jnp.float32).reshape(shp)
        f = lb + (1.0 - lb) * jax.nn.sigmoid(zf)
        logf = jnp.log(jnp.maximum(f, 1e-30))
        k = 1.0 - f
        q = jax.nn.silu(hq.astype(jnp.float32)).reshape(shp)
        v = hi.astype(jnp.float32).reshape(shp)
        o = hgrn2(q, k, v, logf)
        o = rms_norm(o, hgrn_norm_g[l]).astype(x.dtype).reshape(b, s, HGRN_WIDTH)
        branch_b = (o * jax.nn.silu(hg)) @ w_hgrn_o[l]

        merged = jax.nn.sigmoid(mg_pool) * branch_a + jax.nn.sigmoid(mg_hgrn) * branch_b
        y = merged @ w_out[l]
        x = x + gate * rms_norm(y, g_post[l])
    return x
```

```cpp
#include <hip/hip_runtime.h>
#include <hip/hip_cooperative_groups.h>
#include <cstdio>
#include <cstdint>
namespace cg = cooperative_groups;
namespace pg8 {
#define PG8_LAS __attribute__((address_space(3)))
typedef unsigned short bf16_t;
typedef short bf16x8 __attribute__((ext_vector_type(8)));
typedef float f32x4 __attribute__((ext_vector_type(4)));
typedef unsigned u32x4 __attribute__((ext_vector_type(4)));
constexpr int BM = 256, BK = 64, HALF = 128, HTB = HALF * BK * 2  , STAGE_BYTES = 8 * HTB, NXCD = 8, WGM = 8;

__host__ __device__ __forceinline__ int lds_byte(int r, int c) { const int st = (r >> 4) * 2 + (c >> 5), rr = r & 15, cc = c & 31, ob = rr * 64 + cc * 2; return st * 1024 + (ob ^ (((ob >> 9) & 1) << 5)); }
__host__ __device__ __forceinline__ void stage_rc(int b, int& R, int& C) { const int st = b / 1024, sb = b % 1024, swz = sb ^ (((sb >> 9) & 1) << 5); R = (st >> 1) * 16 + swz / 64; C = (st & 1) * 32 + (swz % 64) / 2; }
__host__ __device__ __forceinline__ int perm32(int rho) { const int n = rho >> 4, i = rho & 15; return 8 * (i >> 2) + 4 * n + (i & 3); }

struct Unit { int pm, pn; };
struct Gemm { const bf16_t* A; const bf16_t* Bt; int M, N, K; };

struct StaticOrder {
    int nM, nN, nwg, G, c;
    __host__ __device__ void init(int M, int N, int G_, int c_) { nM = M / BM; nN = N / BM; nwg = nM * nN; G = G_; c = c_; }
    __host__ __device__ bool next(int i, Unit& u) const {
        const long L = (long)i * G + c; if (L >= nwg) return false;
        int wgid = (int)L; { const int q = nwg / NXCD, r = nwg % NXCD, xcd = wgid % NXCD, off = wgid / NXCD; wgid = (xcd < r ? xcd * (q + 1) : r * (q + 1) + (xcd - r) * q) + off; }
        const int nig = WGM * nN, gid = wgid / nig, fm = gid * WGM, gsz = (nM - fm) < WGM ? (nM - fm) : WGM;
        u.pm = fm + ((wgid % nig) % gsz); u.pn = (wgid % nig) / gsz; return true;
    }
    __device__ __forceinline__ void a_ready(const Unit&) const {}
    __device__ __forceinline__ void done(const Unit&) const {}
};
__device__ __forceinline__ unsigned cvt_pk_bf16(float lo, float hi) { unsigned r; asm volatile("v_cvt_pk_bf16_f32 %0, %1, %2" : "=v"(r) : "v"(lo), "v"(hi)); return r; }
template <class Epi, class Sched, bool ALIGN_EPI = false, bool SP2 = false>
__device__ __forceinline__ void gemm_phase(PG8_LAS unsigned char* lds, const Gemm g, const Sched& S, const Epi& E) {
    int tid_l = threadIdx.x; asm volatile("" : "+v"(tid_l));
    const int tid = tid_l, wid = __builtin_amdgcn_readfirstlane(tid >> 6), lane = tid & 63, wr = wid >> 2, wc = wid & 3, fr = lane & 15, fq = lane >> 4;
    const int K = g.K, nt = K / BK;
    unsigned voffA[2], voffB[2];
#pragma unroll
    for (int i = 0; i < 2; ++i) { int R, C; stage_rc(tid * 16 + i * 8192, R, C); const int Rb = Epi::PERM ? ((R & ~31) + perm32(R & 31)) : R;
        voffA[i] = (unsigned)(R * K + C) * 2u; voffB[i] = (unsigned)(Rb * K + C) * 2u; }
    const size_t kstep = (size_t)(BK * 2);
    const size_t hstep = (size_t)HALF * K * 2;
    const size_t tstep = 2 * hstep;
    const unsigned ldsw = (unsigned)wid * 1024u;
    const int aoff = lds_byte(wr * 64 + fr, fq * 8), boff = lds_byte(wc * 32 + fr, fq * 8);
#define PG8_SA(b, h) (((b) * 2 + (h)) * HTB)
#define PG8_SB(b, h) ((4 + (b) * 2 + (h)) * HTB)
#define PG8_STAGE(bufoff, gbase, voff) do { _Pragma("unroll") for (int _i = 0; _i < 2; ++_i) \
        __builtin_amdgcn_global_load_lds((const unsigned*)((const char*)(gbase) + (voff)[_i]), (PG8_LAS unsigned*)(lds + (bufoff) + ldsw + _i * 8192), 16, 0, 0); } while (0)
#define PG8_LDA(dst, b, h) do { _Pragma("unroll") for (int m = 0; m < 4; ++m) _Pragma("unroll") for (int k = 0; k < 2; ++k) dst[m][k] = *(const PG8_LAS bf16x8*)(lds + PG8_SA(b, h) + aoff + m * 2048 + k * 1024); } while (0)
#define PG8_LDB(dst, b, h) do { _Pragma("unroll") for (int n = 0; n < 2; ++n) _Pragma("unroll") for (int k = 0; k < 2; ++k) dst[n][k] = *(const PG8_LAS bf16x8*)(lds + PG8_SB(b, h) + boff + n * 2048 + k * 1024); } while (0)
#define PG8_MMA(ai, bj, At, Bt) do { __builtin_amdgcn_s_setprio(1); _Pragma("unroll") for (int m = 0; m < 4; ++m) _Pragma("unroll") for (int n = 0; n < 2; ++n) _Pragma("unroll") for (int k = 0; k < 2; ++k) \
        acc[ai][bj][m][n] = __builtin_amdgcn_mfma_f32_16x16x32_bf16(Bt[n][k], At[m][k], acc[ai][bj][m][n], 0, 0, 0); __builtin_amdgcn_s_setprio(0); } while (0)
#define PG8_WAIT_V(n) asm volatile("s_waitcnt vmcnt(" #n ")" ::: "memory")
#define PG8_WAIT_L(n) asm volatile("s_waitcnt lgkmcnt(" #n ")" ::: "memory")
#define PG8_BAR __builtin_amdgcn_s_barrier()
#define PG8_SCHED __builtin_amdgcn_sched_barrier(0)
    Unit cur, nxt; int ui = 0;
    if (!S.next(0, cur)) return;
    f32x4 acc[2][2][4][2];
#pragma unroll
    for (int a = 0; a < 2; ++a)
#pragma unroll
        for (int b = 0; b < 2; ++b)
#pragma unroll
            for (int m = 0; m < 4; ++m)
#pragma unroll
                for (int n = 0; n < 2; ++n) acc[a][b][m][n] = (f32x4){0.f, 0.f, 0.f, 0.f};
    bf16x8 At[4][2], B0[2][2], B1[2][2];
    const char* cA = (const char*)g.A + (size_t)cur.pm * tstep; const char* cB = (const char*)g.Bt + (size_t)cur.pn * tstep;
    S.a_ready(cur);
    if constexpr (SP2) {
        PG8_STAGE(PG8_SB(0, 0), cB, voffB); PG8_STAGE(PG8_SB(0, 1), cB + hstep, voffB); PG8_STAGE(PG8_SA(0, 0), cA, voffA); PG8_STAGE(PG8_SA(0, 1), cA + hstep, voffA);
        if (wr == 1) PG8_BAR;
        PG8_WAIT_V(2); PG8_BAR;
        PG8_STAGE(PG8_SB(1, 0), cB + kstep, voffB); PG8_STAGE(PG8_SA(1, 0), cA + kstep, voffA); PG8_STAGE(PG8_SB(1, 1), cB + hstep + kstep, voffB);
        PG8_WAIT_V(6); PG8_BAR;
    } else {
        PG8_STAGE(PG8_SB(0, 0), cB, voffB); PG8_STAGE(PG8_SA(0, 0), cA, voffA); PG8_STAGE(PG8_SB(0, 1), cB + hstep, voffB); PG8_STAGE(PG8_SA(0, 1), cA + hstep, voffA);
        if (wr == 1) PG8_BAR;
        PG8_WAIT_V(4); PG8_BAR;
        PG8_STAGE(PG8_SB(1, 0), cB + kstep, voffB); PG8_STAGE(PG8_SA(1, 0), cA + kstep, voffA); PG8_STAGE(PG8_SB(1, 1), cB + hstep + kstep, voffB);
        PG8_WAIT_V(6); PG8_BAR;
    }
    for (;;) {
        const bool has_next = S.next(ui + 1, nxt);
        const char* nA = has_next ? (const char*)g.A + (size_t)nxt.pm * tstep : cA; const char* nB = has_next ? (const char*)g.Bt + (size_t)nxt.pn * tstep : cB;
        for (int t = 0; t < nt; t += 2) {
            const bool last = (t == nt - 2);
            const char* a1 = cA + (size_t)(t + 1) * kstep;
            const char* a2 = last ? nA : cA + (size_t)(t + 2) * kstep; const char* b2 = last ? nB : cB + (size_t)(t + 2) * kstep;
            const char* a3 = a2 + kstep; const char* b3 = b2 + kstep;
            if (last && has_next) S.a_ready(nxt);
            if constexpr (SP2) {
            PG8_LDB(B0, 0, 0); PG8_LDB(B1, 0, 1); PG8_SCHED; PG8_LDA(At, 0, 0); PG8_STAGE(PG8_SA(1, 1), a1 + hstep, voffA);
            PG8_WAIT_V(8); PG8_WAIT_L(0); PG8_BAR; PG8_MMA(0, 0, At, B0); PG8_MMA(0, 1, At, B1); PG8_BAR; PG8_SCHED;
            PG8_LDA(At, 0, 1); PG8_STAGE(PG8_SB(0, 0), b2, voffB); PG8_STAGE(PG8_SB(0, 1), b2 + hstep, voffB); PG8_STAGE(PG8_SA(0, 0), a2, voffA);
            PG8_WAIT_V(8); PG8_WAIT_L(0); PG8_BAR; PG8_MMA(1, 0, At, B0); PG8_MMA(1, 1, At, B1); PG8_BAR; PG8_SCHED;
            PG8_LDB(B0, 1, 0); PG8_LDB(B1, 1, 1); PG8_SCHED; PG8_LDA(At, 1, 0); PG8_STAGE(PG8_SA(0, 1), a2 + hstep, voffA);
            PG8_WAIT_V(8); PG8_WAIT_L(0); PG8_BAR; PG8_MMA(0, 0, At, B0); PG8_MMA(0, 1, At, B1); PG8_BAR; PG8_SCHED;
            PG8_LDA(At, 1, 1); PG8_STAGE(PG8_SB(1, 0), b3, voffB); PG8_STAGE(PG8_SB(1, 1), b3 + hstep, voffB); PG8_STAGE(PG8_SA(1, 0), a3, voffA);
            PG8_WAIT_V(8); PG8_WAIT_L(0); PG8_BAR; PG8_MMA(1, 0, At, B0); PG8_MMA(1, 1, At, B1); PG8_BAR; PG8_SCHED;
            } else {
            PG8_LDB(B0, 0, 0); PG8_SCHED; PG8_LDA(At, 0, 0); PG8_STAGE(PG8_SA(1, 1), a1 + hstep, voffA);
            PG8_WAIT_L(8); PG8_BAR; PG8_WAIT_L(0); PG8_MMA(0, 0, At, B0); PG8_BAR; PG8_SCHED;
            PG8_LDB(B1, 0, 1); PG8_STAGE(PG8_SB(0, 0), b2, voffB);
            PG8_BAR; PG8_WAIT_L(0); PG8_MMA(0, 1, At, B1); PG8_BAR;
            PG8_LDA(At, 0, 1); PG8_STAGE(PG8_SA(0, 0), a2, voffA);
            PG8_BAR; PG8_WAIT_L(0); PG8_MMA(1, 0, At, B0); PG8_BAR; PG8_SCHED;
            PG8_STAGE(PG8_SB(0, 1), b2 + hstep, voffB);
            PG8_WAIT_V(6); PG8_BAR; PG8_MMA(1, 1, At, B1); PG8_BAR;
            PG8_LDB(B0, 1, 0); PG8_SCHED; PG8_LDA(At, 1, 0); PG8_STAGE(PG8_SA(0, 1), a2 + hstep, voffA);
            PG8_WAIT_L(8); PG8_BAR; PG8_WAIT_L(0); PG8_MMA(0, 0, At, B0); PG8_BAR; PG8_SCHED;
            PG8_LDB(B1, 1, 1); PG8_STAGE(PG8_SB(1, 0), b3, voffB);
            PG8_BAR; PG8_WAIT_L(0); PG8_MMA(0, 1, At, B1); PG8_BAR;
            PG8_LDA(At, 1, 1); PG8_STAGE(PG8_SA(1, 0), a3, voffA);
            PG8_BAR; PG8_WAIT_L(0); PG8_MMA(1, 0, At, B0); PG8_BAR; PG8_SCHED;
            PG8_STAGE(PG8_SB(1, 1), b3 + hstep, voffB);
            PG8_WAIT_V(6); PG8_BAR; PG8_MMA(1, 1, At, B1); PG8_BAR;
            }
        }
        if constexpr (ALIGN_EPI) { if (wr == 0) PG8_BAR; }
        if constexpr (!Epi::AFTER_DRAIN) { E(acc, cur, wr, wc, fr, fq); S.done(cur); }
        if (!has_next) break;
#pragma unroll
        for (int a = 0; a < 2; ++a)
#pragma unroll
            for (int b = 0; b < 2; ++b)
#pragma unroll
                for (int m = 0; m < 4; ++m)
#pragma unroll
                    for (int n = 0; n < 2; ++n) acc[a][b][m][n] = (f32x4){0.f, 0.f, 0.f, 0.f};
        cur = nxt; cA = nA; cB = nB; ++ui;
        if constexpr (ALIGN_EPI) { if (wr == 1) PG8_BAR; }
    }
    PG8_WAIT_V(0);
    if constexpr (!ALIGN_EPI) { if (wr == 0) PG8_BAR; }
    PG8_BAR;
    if constexpr (Epi::AFTER_DRAIN) { E.fused(acc, cur, wr, wc, fr, fq, lds, wid, lane); S.done(cur); }
#undef PG8_SA
#undef PG8_SB
#undef PG8_STAGE
#undef PG8_LDA
#undef PG8_LDB
#undef PG8_MMA
#undef PG8_WAIT_V
#undef PG8_WAIT_L
#undef PG8_BAR
#undef PG8_SCHED
}
}

constexpr int NB = 8, SEQ = 2048, D = 1024, M = NB * SEQ, NL = 2, INW = 7168, NIN = 5120;
constexpr float EPS = 1e-6f;
#define LAS __attribute__((address_space(3)))
typedef unsigned short bf16_t;
typedef short bf16x8 __attribute__((ext_vector_type(8)));
typedef float f32x4 __attribute__((ext_vector_type(4)));
typedef float f32x2 __attribute__((ext_vector_type(2)));
typedef unsigned u32x4 __attribute__((ext_vector_type(4)));
typedef unsigned u32x2 __attribute__((ext_vector_type(2)));
typedef __bf16 bf2_t __attribute__((ext_vector_type(2)));
typedef _Float16 h2_t __attribute__((ext_vector_type(2)));

constexpr size_t MiB = 1u << 20;
constexpr size_t WS_ADA = 0;
constexpr size_t WS_LB = 256 * 1024;
constexpr size_t WS_POOLWT = 512 * 1024;
constexpr size_t WS_WIN = 1 * MiB;
constexpr size_t WS_WPO = 29 * MiB;
constexpr size_t WS_WHO = 31 * MiB;
constexpr size_t WS_WOUT = 35 * MiB;
constexpr size_t WS_H = 40 * MiB;
constexpr size_t WS_PV = 72 * MiB;
constexpr size_t WS_PG = 88 * MiB;
constexpr size_t WS_Q = 104 * MiB;
constexpr size_t WS_LF = 136 * MiB;
constexpr size_t WS_V = 168 * MiB;
constexpr size_t WS_HG = 200 * MiB;
constexpr size_t WS_END = 232 * MiB;
constexpr int LDS_BYTES = 147456;

__device__ __forceinline__ unsigned pk_bf16(float lo, float hi) { bf2_t r = __builtin_convertvector((f32x2){lo, hi}, bf2_t); return __builtin_bit_cast(unsigned, r); }
__device__ __forceinline__ unsigned pk_f16(float lo, float hi) { h2_t r = __builtin_convertvector((f32x2){lo, hi}, h2_t); return __builtin_bit_cast(unsigned, r); }
__device__ __forceinline__ float bf_lo(unsigned w) { return __uint_as_float(w << 16); }
__device__ __forceinline__ float bf_hi(unsigned w) { return __uint_as_float(w & 0xffff0000u); }
__device__ __forceinline__ float h_lo(unsigned w) { h2_t r = __builtin_bit_cast(h2_t, w); return (float)r.x; }
__device__ __forceinline__ float h_hi(unsigned w) { h2_t r = __builtin_bit_cast(h2_t, w); return (float)r.y; }
__device__ __forceinline__ float sigmoid_f(float x) { return __builtin_amdgcn_rcpf(1.f + __expf(-x)); }
__device__ __forceinline__ float silu_f(float x) { return x * sigmoid_f(x); }
__device__ __forceinline__ float wave_sum(float v) {
#pragma unroll
    for (int o = 1; o < 64; o <<= 1) v += __shfl_xor(v, o);
    return v;
}
#define MFMA16(a, b, c) __builtin_amdgcn_mfma_f32_16x16x32_bf16((a), (b), (c), 0, 0, 0)

__device__ __forceinline__ void p0_transpose_item(const float* W, int K, int N, bf16_t* WT, LAS float* scr, int item, int lane) {
    const int nblk = N / 32, kb = item / nblk, nb = item % nblk, k0 = 64 * kb, n0 = 32 * nb;
#pragma unroll 8
    for (int i = 0; i < 32; ++i) { const int kk = 2 * i + (lane >> 5); scr[kk * 33 + (lane & 31)] = W[(size_t)(k0 + kk) * N + n0 + (lane & 31)]; }
    asm volatile("s_waitcnt lgkmcnt(0)" ::: "memory");
    const int c = lane & 7;
#pragma unroll
    for (int j = 0; j < 4; ++j) { const int n = (lane >> 3) + 8 * j; const LAS float* s = scr + (8 * c) * 33 + n;
        u32x4 o; o.x = pk_bf16(s[0 * 33], s[1 * 33]); o.y = pk_bf16(s[2 * 33], s[3 * 33]); o.z = pk_bf16(s[4 * 33], s[5 * 33]); o.w = pk_bf16(s[6 * 33], s[7 * 33]);
        *(u32x4*)(WT + (size_t)(n0 + n) * K + k0 + 8 * c) = o; }
    asm volatile("s_waitcnt lgkmcnt(0)" ::: "memory");
}

struct Params {
    const float *x, *c, *w_ada, *b_ada, *g_pre, *g_post, *w_in, *pool_w, *pool_scale, *lb_logits, *hgrn_norm_g, *w_pool_o, *w_hgrn_o, *w_out;
    float* out; unsigned char* ws;
};

__device__ __forceinline__ void p0_prologue(const Params& p, LAS unsigned char* lds) {
    const int tid = threadIdx.x, lane = tid & 63, wave = tid >> 6, blk = blockIdx.x, G = gridDim.x;
    float* ADA = (float*)(p.ws + WS_ADA);
    LAS float* cact = (LAS float*)(lds + 73728);
    LAS float* red = (LAS float*)(lds + 73728 + 32768);
    for (int job = blk; job < 192; job += G) {
        for (int i = tid; i < NB * D; i += 512) cact[i] = silu_f(p.c[i]);
        __syncthreads();
        const int l = job / 96, j0 = (job % 96) * 32, j = tid & 31, ks = tid >> 5;
        const float* w = p.w_ada + ((size_t)l * D + ks * 64) * 3072 + j0 + j;
        float a0 = 0.f, a1 = 0.f, a2 = 0.f, a3 = 0.f, a4 = 0.f, a5 = 0.f, a6 = 0.f, a7 = 0.f;
#pragma unroll 8
        for (int d = 0; d < 64; ++d) { const float wv = w[(size_t)d * 3072]; const LAS float* cc = cact + ks * 64 + d;
            a0 += cc[0] * wv; a1 += cc[1024] * wv; a2 += cc[2048] * wv; a3 += cc[3072] * wv; a4 += cc[4096] * wv; a5 += cc[5120] * wv; a6 += cc[6144] * wv; a7 += cc[7168] * wv; }
        LAS float* rr = red + (ks * 8) * 32 + j;
        rr[0] = a0; rr[32] = a1; rr[64] = a2; rr[96] = a3; rr[128] = a4; rr[160] = a5; rr[192] = a6; rr[224] = a7;
        __syncthreads();
        if (tid < 256) { const int b = tid >> 5; float s = p.b_ada[l * 3072 + j0 + j];
#pragma unroll
            for (int k2 = 0; k2 < 16; ++k2) s += red[(k2 * 8 + b) * 32 + j];
            ADA[(size_t)(l * NB + b) * 3072 + j0 + j] = s; }
        __syncthreads();
    }
    if (blk == G - 1) { float* LB = (float*)(p.ws + WS_LB);
        for (int j = tid; j < 1024; j += 512) { const float l0 = p.lb_logits[j], l1 = p.lb_logits[1024 + j], mx = fmaxf(l0, l1), e0 = __expf(l0 - mx), e1 = __expf(l1 - mx);
            const float p0 = e0 / (e0 + e1), p1 = e1 / (e0 + e1); const float c1 = (p0 + p1) - p0;
            LB[j] = 0.f; LB[1024 + j] = fminf(fmaxf(c1, 0.f), 1.f); } }
    LAS float* scr = (LAS float*)(lds + wave * 8448);
    constexpr int I_IN = (D / 64) * (INW / 32), I_PO = (512 / 64) * (D / 32), I_HO = (D / 64) * (D / 32), I_OUT = I_HO, I_PW = 4 * 8, I_LAYER = I_IN + I_PO + I_HO + I_OUT + I_PW;
    bf16_t* WinT = (bf16_t*)(p.ws + WS_WIN); bf16_t* WpoT = (bf16_t*)(p.ws + WS_WPO); bf16_t* WhoT = (bf16_t*)(p.ws + WS_WHO); bf16_t* WoutT = (bf16_t*)(p.ws + WS_WOUT); bf16_t* PoolWT = (bf16_t*)(p.ws + WS_POOLWT);
    for (int it = blk * 8 + wave; it < NL * I_LAYER; it += G * 8) {
        int r = it; const int l = r / I_LAYER; r -= l * I_LAYER;
        if (r < I_IN) { p0_transpose_item(p.w_in + (size_t)l * D * INW, D, INW, WinT + (size_t)l * INW * D, scr, r, lane); continue; } r -= I_IN;
        if (r < I_PO) { p0_transpose_item(p.w_pool_o + (size_t)l * 512 * D, 512, D, WpoT + (size_t)l * D * 512, scr, r, lane); continue; } r -= I_PO;
        if (r < I_HO) { p0_transpose_item(p.w_hgrn_o + (size_t)l * D * D, D, D, WhoT + (size_t)l * D * D, scr, r, lane); continue; } r -= I_HO;
        if (r < I_OUT) { p0_transpose_item(p.w_out + (size_t)l * D * D, D, D, WoutT + (size_t)l * D * D, scr, r, lane); continue; } r -= I_OUT;
        { const int g = r >> 3; r &= 7; p0_transpose_item(p.pool_w + (size_t)(l * 4 + g) * 16384, 128, 128, PoolWT + (size_t)(l * 4 + g) * 16384, scr, r, lane); }
    }
}

template <bool HAS_PREV, bool MAKE_H>
__device__ __forceinline__ void p1_rows(const float* xprev, const bf16_t* Y, const float* ada_prev, const float* gpost, float* xout, const float* gpre, const float* ada_cur, bf16_t* H) {
    int tid_l = threadIdx.x; asm volatile("" : "+v"(tid_l));
    const int lane = tid_l & 63, wave = tid_l >> 6;
    for (int m = blockIdx.x * 8 + wave; m < M; m += gridDim.x * 8) {
        const int b = m >> 11;
        f32x4 v[4];
        const f32x4* xr = (const f32x4*)(xprev + (size_t)m * D) + lane;
#pragma unroll
        for (int j = 0; j < 4; ++j) v[j] = xr[64 * j];
        if (HAS_PREV) {
            const u32x2* yr = (const u32x2*)(Y + (size_t)m * D) + lane; f32x4 y[4]; float ss = 0.f;
#pragma unroll
            for (int j = 0; j < 4; ++j) { const u32x2 w = yr[64 * j]; y[j] = (f32x4){bf_lo(w.x), bf_hi(w.x), bf_lo(w.y), bf_hi(w.y)}; ss += (y[j].x * y[j].x + y[j].y * y[j].y) + (y[j].z * y[j].z + y[j].w * y[j].w); }
            const float rstd = rsqrtf(wave_sum(ss) * (1.f / D) + EPS);
            const f32x4* gp = (const f32x4*)gpost + lane; const f32x4* gt = (const f32x4*)(ada_prev + (size_t)b * 3072 + 2048) + lane;
            f32x4* xo = (f32x4*)(xout + (size_t)m * D) + lane;
#pragma unroll
            for (int j = 0; j < 4; ++j) { v[j] = v[j] + gt[64 * j] * (y[j] * rstd * gp[64 * j]); xo[64 * j] = v[j]; }
        }
        if (MAKE_H) {
            float ss = 0.f;
#pragma unroll
            for (int j = 0; j < 4; ++j) ss += (v[j].x * v[j].x + v[j].y * v[j].y) + (v[j].z * v[j].z + v[j].w * v[j].w);
            const float rstd = rsqrtf(wave_sum(ss) * (1.f / D) + EPS);
            const f32x4* gp = (const f32x4*)gpre + lane; const f32x4* sh = (const f32x4*)(ada_cur + (size_t)b * 3072) + lane; const f32x4* sc = (const f32x4*)(ada_cur + (size_t)b * 3072 + 1024) + lane;
            u32x2* ho = (u32x2*)(H + (size_t)m * D) + lane;
#pragma unroll
            for (int j = 0; j < 4; ++j) { const f32x4 hv = (v[j] * rstd * gp[64 * j]) * (sc[64 * j] + 1.f) + sh[64 * j]; u32x2 w; w.x = pk_bf16(hv.x, hv.y); w.y = pk_bf16(hv.z, hv.w); ho[64 * j] = w; }
        }
    }
}

struct EpiU {
    static constexpr bool PERM = true, AFTER_DRAIN = false;
    unsigned char* ws; const float* lb; int mode;
    __device__ __forceinline__ void operator()(const f32x4 (&acc)[2][2][4][2], const pg8::Unit& u, int wr, int wc, int fr, int fq) const {
        const int pn = u.pn; const int row0 = u.pm * 256 + wr * 64 + fr;
        size_t boff; int ld = 1024, colt = pn * 256, op;
        if (mode == 0) {
            if (pn < 2) { boff = WS_PV; ld = 512; op = 0; }
            else if (pn < 4) { boff = WS_PG; ld = 512; colt = (pn - 2) * 256; op = 1; }
            else if (pn < 8) { boff = WS_Q; colt = (pn - 4) * 256; op = 1; }
            else if (pn < 12) { boff = WS_LF; colt = (pn - 8) * 256; op = 2; }
            else if (pn < 16) { boff = WS_V; colt = (pn - 12) * 256; op = 0; }
            else { boff = WS_HG; colt = (pn - 16) * 256; op = 1; }
        } else if (mode == 1) { boff = WS_Q; op = 3; }
        else if (mode == 2) { boff = WS_LF; op = 4; }
        else if (mode == 3) { boff = WS_LF; op = 5; }
        else { boff = WS_V; op = 0; }
        bf16_t* base = (bf16_t*)(ws + boff); const bf16_t* Gp = (const bf16_t*)(ws + WS_Q);
        const int col0 = colt + wc * 32 + 8 * fq;
        f32x4 lbv[2][2];
#pragma unroll
        for (int bj = 0; bj < 2; ++bj) { lbv[bj][0] = (f32x4){0.f, 0.f, 0.f, 0.f}; lbv[bj][1] = lbv[bj][0]; }
        if (op == 2) {
#pragma unroll
            for (int bj = 0; bj < 2; ++bj) { lbv[bj][0] = *(const f32x4*)(lb + col0 + bj * 128); lbv[bj][1] = *(const f32x4*)(lb + col0 + bj * 128 + 4); } }
#pragma unroll
        for (int ai = 0; ai < 2; ++ai)
#pragma unroll
            for (int m = 0; m < 4; ++m) { const size_t off = (size_t)(row0 + ai * 128 + m * 16) * ld + col0;
#pragma unroll
                for (int bj = 0; bj < 2; ++bj) { f32x4 v0 = acc[ai][bj][m][0], v1 = acc[ai][bj][m][1];
                    if (op == 1) {
#pragma unroll
                        for (int j = 0; j < 4; ++j) { v0[j] = silu_f(v0[j]); v1[j] = silu_f(v1[j]); }
                    } else if (op == 2) {
#pragma unroll
                        for (int j = 0; j < 4; ++j) { const float l0 = lbv[bj][0][j], l1 = lbv[bj][1][j];
                            v0[j] = __logf(fmaxf(l0 + (1.f - l0) * sigmoid_f(v0[j]), 1e-30f)); v1[j] = __logf(fmaxf(l1 + (1.f - l1) * sigmoid_f(v1[j]), 1e-30f)); }
                    } else if (op == 3) {
#pragma unroll
                        for (int j = 0; j < 4; ++j) { v0[j] = sigmoid_f(v0[j]); v1[j] = sigmoid_f(v1[j]); }
                    } else if (op >= 4) { const u32x4 g = *(const u32x4*)(Gp + off + bj * 128);
                        v0 = v0 * (f32x4){bf_lo(g.x), bf_hi(g.x), bf_lo(g.y), bf_hi(g.y)}; v1 = v1 * (f32x4){bf_lo(g.z), bf_hi(g.z), bf_lo(g.w), bf_hi(g.w)};
                        if (op == 5) { const u32x4 t = *(const u32x4*)(base + off + bj * 128);
                            v0 = v0 + (f32x4){bf_lo(t.x), bf_hi(t.x), bf_lo(t.y), bf_hi(t.y)}; v1 = v1 + (f32x4){bf_lo(t.z), bf_hi(t.z), bf_lo(t.w), bf_hi(t.w)}; } }
                    u32x4 w;
                    if (op == 2) { w.x = pk_f16(v0[0], v0[1]); w.y = pk_f16(v0[2], v0[3]); w.z = pk_f16(v1[0], v1[1]); w.w = pk_f16(v1[2], v1[3]); }
                    else { w.x = pk_bf16(v0[0], v0[1]); w.y = pk_bf16(v0[2], v0[3]); w.z = pk_bf16(v1[0], v1[1]); w.w = pk_bf16(v1[2], v1[3]); }
                    *(u32x4*)(base + off + bj * 128) = w; } }
    }
};

constexpr int AP_STRIDE = 136;
template <int W>
__device__ __forceinline__ void pool_item(const bf16_t* PV, bf16_t* PG, const bf16_t* PoolWT_g, const float* pscale_g, int m0, int g, LAS unsigned char* lds) {
    int tid_l = threadIdx.x; asm volatile("" : "+v"(tid_l));
    const int tid = tid_l, lane = tid & 63, wv = tid >> 6, r = lane & 15, q = lane >> 4;
    const int pos0 = (m0 & (SEQ - 1)) + wv * 8;
    const bf16_t* src = PV + (size_t)(m0 + wv * 8) * 512 + g * 128 + 2 * lane;
    float r0[W + 7], r1[W + 7];
#pragma unroll
    for (int i = 0; i < W + 7; ++i) { const int pp = pos0 - (W - 1) + i; unsigned w = 0u; if (pp >= 0) w = *(const unsigned*)(src + (ptrdiff_t)(i - (W - 1)) * 512); r0[i] = bf_lo(w); r1[i] = bf_hi(w); }
    float s0 = 0.f, s1 = 0.f;
#pragma unroll
    for (int i = 0; i < W - 1; ++i) { s0 += r0[i]; s1 += r1[i]; }
    LAS bf16_t* AP = (LAS bf16_t*)lds;
#pragma unroll
    for (int i = 0; i < 8; ++i) { s0 += r0[W - 1 + i]; s1 += r1[W - 1 + i];
        const int pos = pos0 + i; const float inv = 1.f / (float)(pos + 1 < W ? pos + 1 : W);
        *(LAS unsigned*)(AP + (wv * 8 + i) * AP_STRIDE + 2 * lane) = pk_bf16(s0 * inv - r0[W - 1 + i], s1 * inv - r1[W - 1 + i]);
        s0 -= r0[i]; s1 -= r1[i]; }
    __syncthreads();
    f32x4 o[4];
#pragma unroll
    for (int mt = 0; mt < 4; ++mt) o[mt] = (f32x4){0.f, 0.f, 0.f, 0.f};
#pragma unroll
    for (int ks = 0; ks < 4; ++ks) { const bf16x8 wf = *(const bf16x8*)(PoolWT_g + (16 * wv + r) * 128 + ks * 32 + q * 8);
#pragma unroll
        for (int mt = 0; mt < 4; ++mt) { const bf16x8 af = *(const LAS bf16x8*)(AP + (mt * 16 + r) * AP_STRIDE + ks * 32 + q * 8); o[mt] = MFMA16(wf, af, o[mt]); } }
    const f32x4 sc = *(const f32x4*)(pscale_g + 16 * wv + q * 4);
#pragma unroll
    for (int mt = 0; mt < 4; ++mt) { bf16_t* pp = PG + (size_t)(m0 + mt * 16 + r) * 512 + g * 128 + 16 * wv + q * 4;
        const u32x2 gw = *(const u32x2*)pp; const f32x4 ov = o[mt] * sc * (f32x4){bf_lo(gw.x), bf_hi(gw.x), bf_lo(gw.y), bf_hi(gw.y)};
        u32x2 w; w.x = pk_bf16(ov.x, ov.y); w.y = pk_bf16(ov.z, ov.w); *(u32x2*)pp = w; }
    __syncthreads();
}

constexpr int HQ_STR = 136, HK_STR = 72;
constexpr int L_QH = 0, L_QT = 17408, L_KT = 34816, L_KHT = 52224, L_VT = 70656, L_P = 89088, L_TOT = 98304, L_DEC = 102400, L_SSQ = 102912;
__device__ __forceinline__ void hgrn_item(const bf16_t* Qg, const bf16_t* LFg, const bf16_t* Vg, bf16_t* HGg, const float* gnorm, int b, int h, LAS unsigned char* lds) {
    int tid_l = threadIdx.x; asm volatile("" : "+v"(tid_l));
    const int tid = tid_l, lane = tid & 63, wv = __builtin_amdgcn_readfirstlane(tid >> 6), r = lane & 15, q = lane >> 4;
    LAS bf16_t* QH = (LAS bf16_t*)(lds + L_QH); LAS bf16_t* QT = (LAS bf16_t*)(lds + L_QT); LAS bf16_t* KT = (LAS bf16_t*)(lds + L_KT);
    LAS bf16_t* KHT = (LAS bf16_t*)(lds + L_KHT); LAS bf16_t* VT = (LAS bf16_t*)(lds + L_VT); LAS bf16_t* Pm = (LAS bf16_t*)(lds + L_P);
    LAS float* TOT = (LAS float*)(lds + L_TOT); LAS float* DEC = (LAS float*)(lds + L_DEC); LAS float* SSQ = (LAS float*)(lds + L_SSQ);
    f32x4 S[8];
#pragma unroll
    for (int kt = 0; kt < 8; ++kt) S[kt] = (f32x4){0.f, 0.f, 0.f, 0.f};
    const f32x4 g4 = *(const f32x4*)(gnorm + 16 * wv + q * 4);
    const size_t cb = (size_t)h * 128;
    unsigned q2[8], lf2[8], v2[8];
    { const size_t rb = ((size_t)b * SEQ + wv * 8) * 1024 + cb + 2 * lane;
#pragma unroll
      for (int i = 0; i < 8; ++i) { q2[i] = *(const unsigned*)(Qg + rb + (size_t)i * 1024); lf2[i] = *(const unsigned*)(LFg + rb + (size_t)i * 1024); v2[i] = *(const unsigned*)(Vg + rb + (size_t)i * 1024); } }
    const int ti = wv >> 1;
#pragma unroll 1
    for (int n = 0; n < SEQ / 64; ++n) {
        const size_t m0 = (size_t)b * SEQ + n * 64;
        float c0[8], c1[8], k0[8], k1[8]; float run0 = 0.f, run1 = 0.f;
#pragma unroll
        for (int i = 0; i < 8; ++i) { const float a0 = h_lo(lf2[i]), a1 = h_hi(lf2[i]); run0 += a0; run1 += a1; c0[i] = run0; c1[i] = run1; k0[i] = 1.f - __expf(a0); k1[i] = 1.f - __expf(a1); }
        *(LAS f32x2*)(TOT + wv * 128 + 2 * lane) = (f32x2){run0, run1};
        { u32x4 lo, hi;
          lo.x = (v2[0] & 0xffffu) | (v2[1] << 16); lo.y = (v2[2] & 0xffffu) | (v2[3] << 16); lo.z = (v2[4] & 0xffffu) | (v2[5] << 16); lo.w = (v2[6] & 0xffffu) | (v2[7] << 16);
          hi.x = (v2[0] >> 16) | (v2[1] & 0xffff0000u); hi.y = (v2[2] >> 16) | (v2[3] & 0xffff0000u); hi.z = (v2[4] >> 16) | (v2[5] & 0xffff0000u); hi.w = (v2[6] >> 16) | (v2[7] & 0xffff0000u);
          *(LAS u32x4*)(VT + (2 * lane) * HK_STR + wv * 8) = lo; *(LAS u32x4*)(VT + (2 * lane + 1) * HK_STR + wv * 8) = hi; }
        __syncthreads();
        float pre0 = 0.f, pre1 = 0.f, last0 = 0.f, last1 = 0.f;
#pragma unroll
        for (int w = 0; w < 8; ++w) { const f32x2 t = *(const LAS f32x2*)(TOT + w * 128 + 2 * lane); last0 += t.x; last1 += t.y; if (w < wv) { pre0 += t.x; pre1 += t.y; } }
        if (wv == 0) *(LAS f32x2*)(DEC + 2 * lane) = (f32x2){__expf(last0), __expf(last1)};
        const float sc0 = __expf(fminf(-0.5f * last0, 60.f)), sc1 = __expf(fminf(-0.5f * last1, 60.f));
        { float kh0[8], kh1[8];
#pragma unroll
          for (int i = 0; i < 8; ++i) { const float cum0 = pre0 + c0[i], cum1 = pre1 + c1[i];
              const float qh0 = bf_lo(q2[i]) * __expf(cum0), qh1 = bf_hi(q2[i]) * __expf(cum1);
              kh0[i] = k0[i] * __expf(last0 - cum0); kh1[i] = k1[i] * __expf(last1 - cum1);
              const int t = wv * 8 + i;
              *(LAS unsigned*)(QH + t * HQ_STR + 2 * lane) = pk_bf16(qh0, qh1);
              *(LAS unsigned*)(QT + t * HQ_STR + 2 * lane) = pk_bf16(qh0 * sc0, qh1 * sc1);
              *(LAS unsigned*)(KT + t * HQ_STR + 2 * lane) = pk_bf16(kh0[i] * sc0, kh1[i] * sc1); }
          u32x4 a, c; a.x = pk_bf16(kh0[0], kh0[1]); a.y = pk_bf16(kh0[2], kh0[3]); a.z = pk_bf16(kh0[4], kh0[5]); a.w = pk_bf16(kh0[6], kh0[7]);
          c.x = pk_bf16(kh1[0], kh1[1]); c.y = pk_bf16(kh1[2], kh1[3]); c.z = pk_bf16(kh1[4], kh1[5]); c.w = pk_bf16(kh1[6], kh1[7]);
          *(LAS u32x4*)(KHT + (2 * lane) * HK_STR + wv * 8) = a; *(LAS u32x4*)(KHT + (2 * lane + 1) * HK_STR + wv * 8) = c; }
        if (n + 1 < SEQ / 64) { const size_t rb = (m0 + 64 + wv * 8) * 1024 + cb + 2 * lane;
#pragma unroll
            for (int i = 0; i < 8; ++i) { q2[i] = *(const unsigned*)(Qg + rb + (size_t)i * 1024); lf2[i] = *(const unsigned*)(LFg + rb + (size_t)i * 1024); v2[i] = *(const unsigned*)(Vg + rb + (size_t)i * 1024); } }
        u32x2 hgv[4];
#pragma unroll
        for (int mt = 0; mt < 4; ++mt) hgv[mt] = *(const u32x2*)(HGg + (m0 + mt * 16 + r) * 1024 + cb + 16 * wv + q * 4);
        __syncthreads();
#pragma unroll
        for (int jj = 0; jj < 2; ++jj) { const int tj = 2 * (wv & 1) + jj; f32x4 sc = (f32x4){0.f, 0.f, 0.f, 0.f};
            if (tj <= ti) {
#pragma unroll
                for (int ks = 0; ks < 4; ++ks) { const bf16x8 kf = *(const LAS bf16x8*)(KT + (tj * 16 + r) * HQ_STR + ks * 32 + q * 8); const bf16x8 qf = *(const LAS bf16x8*)(QT + (ti * 16 + r) * HQ_STR + ks * 32 + q * 8); sc = MFMA16(kf, qf, sc); } }
            const int t = ti * 16 + r, s0 = tj * 16 + q * 4;
#pragma unroll
            for (int j = 0; j < 4; ++j) sc[j] = (s0 + j <= t) ? sc[j] : 0.f;
            u32x2 w; w.x = pk_bf16(sc[0], sc[1]); w.y = pk_bf16(sc[2], sc[3]);
            *(LAS u32x2*)(Pm + t * HK_STR + s0) = w; }
        f32x4 o[4];
#pragma unroll
        for (int mt = 0; mt < 4; ++mt) o[mt] = (f32x4){0.f, 0.f, 0.f, 0.f};
#pragma unroll
        for (int a = 0; a < 4; ++a) { u32x4 sp; sp.x = pk_bf16(S[2 * a][0], S[2 * a][1]); sp.y = pk_bf16(S[2 * a][2], S[2 * a][3]); sp.z = pk_bf16(S[2 * a + 1][0], S[2 * a + 1][1]); sp.w = pk_bf16(S[2 * a + 1][2], S[2 * a + 1][3]);
            const bf16x8 sf = __builtin_bit_cast(bf16x8, sp);
#pragma unroll
            for (int mt = 0; mt < 4; ++mt) { const u32x2 lo = *(const LAS u32x2*)(QH + (mt * 16 + r) * HQ_STR + 32 * a + q * 4), hi = *(const LAS u32x2*)(QH + (mt * 16 + r) * HQ_STR + 32 * a + 16 + q * 4);
                const bf16x8 qf = __builtin_bit_cast(bf16x8, (u32x4){lo.x, lo.y, hi.x, hi.y}); o[mt] = MFMA16(sf, qf, o[mt]); } }
        __syncthreads();
        bf16x8 vf[2];
#pragma unroll
        for (int ks = 0; ks < 2; ++ks) vf[ks] = *(const LAS bf16x8*)(VT + (16 * wv + r) * HK_STR + ks * 32 + q * 8);
#pragma unroll
        for (int mt = 0; mt < 4; ++mt) { const bf16x8 p0 = *(const LAS bf16x8*)(Pm + (mt * 16 + r) * HK_STR + q * 8); o[mt] = MFMA16(vf[0], p0, o[mt]);
            if (mt >= 2) { const bf16x8 p1 = *(const LAS bf16x8*)(Pm + (mt * 16 + r) * HK_STR + 32 + q * 8); o[mt] = MFMA16(vf[1], p1, o[mt]); } }
#pragma unroll
        for (int kt = 0; kt < 8; ++kt) { const f32x4 dec = *(const LAS f32x4*)(DEC + kt * 16 + q * 4); S[kt] = S[kt] * dec;
#pragma unroll
            for (int ks = 0; ks < 2; ++ks) { const bf16x8 kf = *(const LAS bf16x8*)(KHT + (kt * 16 + r) * HK_STR + ks * 32 + q * 8); S[kt] = MFMA16(kf, vf[ks], S[kt]); } }
#pragma unroll
        for (int mt = 0; mt < 4; ++mt) { float ss = (o[mt].x * o[mt].x + o[mt].y * o[mt].y) + (o[mt].z * o[mt].z + o[mt].w * o[mt].w); ss += __shfl_xor(ss, 16); ss += __shfl_xor(ss, 32);
            if (q == 0) SSQ[wv * 64 + mt * 16 + r] = ss; }
        __syncthreads();
#pragma unroll
        for (int mt = 0; mt < 4; ++mt) { float tot = 0.f;
#pragma unroll
            for (int w = 0; w < 8; ++w) tot += SSQ[w * 64 + mt * 16 + r];
            const float rstd = rsqrtf(tot * (1.f / 128.f) + EPS);
            const f32x4 ov = o[mt] * rstd * g4 * (f32x4){bf_lo(hgv[mt].x), bf_hi(hgv[mt].x), bf_lo(hgv[mt].y), bf_hi(hgv[mt].y)};
            u32x2 w; w.x = pk_bf16(ov.x, ov.y); w.y = pk_bf16(ov.z, ov.w);
            *(u32x2*)(HGg + (m0 + mt * 16 + r) * 1024 + cb + 16 * wv + q * 4) = w; }
    }
    __syncthreads();
}

__global__ void __launch_bounds__(512, 2) fwd_megakernel(Params p) {
    extern __shared__ __attribute__((aligned(16))) unsigned char lds_raw[];
    LAS unsigned char* lds = (LAS unsigned char*)lds_raw;
    cg::grid_group grid = cg::this_grid();
    const int G = gridDim.x, blk = blockIdx.x;
    unsigned char* ws = p.ws;
    float* ADA = (float*)(ws + WS_ADA);
    bf16_t* H = (bf16_t*)(ws + WS_H); bf16_t* PV = (bf16_t*)(ws + WS_PV); bf16_t* PG = (bf16_t*)(ws + WS_PG); bf16_t* Q = (bf16_t*)(ws + WS_Q);
    bf16_t* LF = (bf16_t*)(ws + WS_LF); bf16_t* V = (bf16_t*)(ws + WS_V); bf16_t* HG = (bf16_t*)(ws + WS_HG);
    bf16_t* GATE = Q; bf16_t* MERGED = LF; bf16_t* Y = V;

#ifndef SKIP_P0
    p0_prologue(p, lds);
#endif
    grid.sync();
#pragma unroll 1
    for (int l = 0; l < NL; ++l) {
#ifndef SKIP_P1
        if (l == 0) p1_rows<false, true>(p.x, nullptr, nullptr, nullptr, nullptr, p.g_pre, ADA, H);
        else p1_rows<true, true>(p.x, Y, ADA + (size_t)(l - 1) * NB * 3072, p.g_post + (size_t)(l - 1) * D, p.out, p.g_pre + (size_t)l * D, ADA + (size_t)l * NB * 3072, H);
#endif
        grid.sync();
#pragma unroll 1
        for (int s = 0; s < 6; ++s) {
            const bf16_t* WinT = (const bf16_t*)(ws + WS_WIN) + (size_t)l * INW * D;
            pg8::Gemm g; g.M = M; g.N = D; g.K = D; int mode;
            if (s == 0) { g.A = H; g.Bt = WinT; g.N = NIN; mode = 0; }
            else if (s == 1) { g.A = H; g.Bt = WinT + (size_t)5120 * D; mode = 1; }
            else if (s == 2) { g.A = PG; g.Bt = (const bf16_t*)(ws + WS_WPO) + (size_t)l * D * 512; g.K = 512; mode = 2; }
            else if (s == 3) { g.A = H; g.Bt = WinT + (size_t)6144 * D; mode = 1; }
            else if (s == 4) { g.A = HG; g.Bt = (const bf16_t*)(ws + WS_WHO) + (size_t)l * D * D; mode = 3; }
            else { g.A = MERGED; g.Bt = (const bf16_t*)(ws + WS_WOUT) + (size_t)l * D * D; mode = 4; }
            pg8::StaticOrder S; S.init(M, g.N, G, blk);
            EpiU E{ws, (const float*)(ws + WS_LB) + l * 1024, mode};
            pg8::gemm_phase<EpiU, pg8::StaticOrder, true, true>(lds, g, S, E);
            if (s == 0) {
                grid.sync();
#ifndef SKIP_P3
                const int nh = NB * 8;
                if (blk < nh && G > nh) hgrn_item(Q, LF, V, HG, p.hgrn_norm_g + l * 128, blk >> 3, blk & 7, lds);
                else {
                    const int first = (G > nh) ? blk - nh : blk, step = (G > nh) ? G - nh : G, total = (G > nh) ? 1024 : 1024 + nh;
                    for (int it = first; it < total; it += step) {
                        if (it >= 1024) { const int bh = it - 1024; hgrn_item(Q, LF, V, HG, p.hgrn_norm_g + l * 128, bh >> 3, bh & 7, lds); continue; }
                        const int gq = it & 3, m0 = (it >> 2) * 64;
                        const bf16_t* pw = (const bf16_t*)(ws + WS_POOLWT) + (size_t)(l * 4 + gq) * 16384; const float* ps = p.pool_scale + l * 512 + gq * 128;
                        if (gq == 0) pool_item<2>(PV, PG, pw, ps, m0, gq, lds); else if (gq == 1) pool_item<4>(PV, PG, pw, ps, m0, gq, lds);
                        else if (gq == 2) pool_item<8>(PV, PG, pw, ps, m0, gq, lds); else pool_item<16>(PV, PG, pw, ps, m0, gq, lds);
                    } }
#endif
                grid.sync();
            } else if (s >= 4) grid.sync();
        }
    }
    p1_rows<true, false>(p.out, Y, ADA + (size_t)(NL - 1) * NB * 3072, p.g_post + (size_t)(NL - 1) * D, p.out, nullptr, nullptr, nullptr);
}

extern "C" void kernel_launch(void* const* d_in, const int* in_sizes, int n_in, void* d_out, int out_size, void* d_ws, size_t ws_size, hipStream_t stream) {
    static int grid_blocks = 0;
    if (grid_blocks == 0) {
        if (n_in != 14 || out_size != M * D || ws_size < WS_END) { fprintf(stderr, "kernel_launch: unexpected problem (n_in %d out %d ws %zu)\n", n_in, out_size, ws_size); grid_blocks = -1; return; }
        int dev = 0, cus = 0, per_cu = 0;
        (void)hipGetDevice(&dev);
        (void)hipDeviceGetAttribute(&cus, hipDeviceAttributeMultiprocessorCount, dev);
        (void)hipFuncSetAttribute((const void*)fwd_megakernel, hipFuncAttributeMaxDynamicSharedMemorySize, LDS_BYTES);
        (void)hipOccupancyMaxActiveBlocksPerMultiprocessor(&per_cu, (const void*)fwd_megakernel, 512, LDS_BYTES);
        if (per_cu < 1) { fprintf(stderr, "kernel_launch: occupancy query says %d blocks per CU\n", per_cu); grid_blocks = -1; return; }
        grid_blocks = cus;
    }
    if (grid_blocks < 0) return;
    Params p{};
    p.x = (const float*)d_in[0]; p.c = (const float*)d_in[1]; p.w_ada = (const float*)d_in[2]; p.b_ada = (const float*)d_in[3]; p.g_pre = (const float*)d_in[4]; p.g_post = (const float*)d_in[5];
    p.w_in = (const float*)d_in[6]; p.pool_w = (const float*)d_in[7]; p.pool_scale = (const float*)d_in[8]; p.lb_logits = (const float*)d_in[9]; p.hgrn_norm_g = (const float*)d_in[10];
    p.w_pool_o = (const float*)d_in[11]; p.w_hgrn_o = (const float*)d_in[12]; p.w_out = (const float*)d_in[13];
    p.out = (float*)d_out; p.ws = (unsigned char*)d_ws;
    void* args[] = {&p};
    hipError_t e = hipLaunchCooperativeKernel((const void*)fwd_megakernel, dim3(grid_blocks), dim3(512), args, LDS_BYTES, stream);
    if (e != hipSuccess) fprintf(stderr, "cooperative launch failed: %s (grid %d)\n", hipGetErrorString(e), grid_blocks);
}
```

```cpp
#define PG8_ALIGN_SEL true
#define USE_CG_SYNC 1
#include <hip/hip_runtime.h>
#include <hip/hip_cooperative_groups.h>
#include <cstdio>
#include <cstdint>
namespace cg = cooperative_groups;
#define LAS __attribute__((address_space(3)))
namespace pg8 {
#define PG8_LAS __attribute__((address_space(3)))
typedef unsigned short bf16_t;
typedef short bf16x8 __attribute__((ext_vector_type(8)));
typedef float f32x4 __attribute__((ext_vector_type(4)));
typedef unsigned u32x4 __attribute__((ext_vector_type(4)));
constexpr int BM = 256, BK = 64, HALF = 128, HTB = HALF * BK * 2  , STAGE_BYTES = 8 * HTB, NXCD = 8, WGM = 8;

__host__ __device__ __forceinline__ int lds_byte(int r, int c) { const int st = (r >> 4) * 2 + (c >> 5), rr = r & 15, cc = c & 31, ob = rr * 64 + cc * 2; return st * 1024 + (ob ^ (((ob >> 9) & 1) << 5)); }
__host__ __device__ __forceinline__ void stage_rc(int b, int& R, int& C) { const int st = b / 1024, sb = b % 1024, swz = sb ^ (((sb >> 9) & 1) << 5); R = (st >> 1) * 16 + swz / 64; C = (st & 1) * 32 + (swz % 64) / 2; }
__host__ __device__ __forceinline__ int perm32(int rho) { const int n = rho >> 4, i = rho & 15; return 8 * (i >> 2) + 4 * n + (i & 3); }

struct Unit { int pm, pn; const unsigned short* A; const unsigned short* Bt; int mode; };
struct Gemm { const bf16_t* A; const bf16_t* Bt; int M, N, K; };

struct StaticOrder {
    int nM, nN, nwg, G, c, dup;
    const unsigned short *A0, *B0, *A2, *B2; int mode0, mode2;
    __host__ __device__ void init(int M, int N, int G_, int c_) { nM = M / BM; nN = N / BM; nwg = nM * nN; G = G_; c = c_; dup = 0; A0 = B0 = A2 = B2 = nullptr; mode0 = mode2 = 0; }
    __host__ __device__ bool next(int i, Unit& u) const {
        if (dup > 0 && i >= dup) return false;
        const long L = (dup > 0) ? (long)c : (long)i * G + c; if (L >= nwg) return false;
        int wgid = (int)L; { const int q = nwg / NXCD, r = nwg % NXCD, xcd = wgid % NXCD, off = wgid / NXCD; wgid = (xcd < r ? xcd * (q + 1) : r * (q + 1) + (xcd - r) * q) + off; }
        const int nig = WGM * nN, gid = wgid / nig, fm = gid * WGM, gsz = (nM - fm) < WGM ? (nM - fm) : WGM;
        u.pm = fm + ((wgid % nig) % gsz); u.pn = (wgid % nig) / gsz + ((dup > 0 && i == 1) ? nN : 0);
        const bool third = (dup > 0 && i == 2);
        u.A = third ? A2 : A0; u.Bt = third ? B2 : B0; u.mode = third ? mode2 : mode0; return true;
    }
    __device__ __forceinline__ void a_ready(const Unit&) const {}
    __device__ __forceinline__ void done(const Unit&) const {}
};
__device__ __forceinline__ unsigned cvt_pk_bf16(float lo, float hi) { unsigned r; asm volatile("v_cvt_pk_bf16_f32 %0, %1, %2" : "=v"(r) : "v"(lo), "v"(hi)); return r; }
template <class Epi, class Sched, bool ALIGN_EPI = false, bool SP2 = false>
__device__ __forceinline__ void gemm_phase(PG8_LAS unsigned char* lds, const Gemm g, const Sched& S, const Epi& E) {
    int tid_l = threadIdx.x; asm volatile("" : "+v"(tid_l));
    const int tid = tid_l, wid = __builtin_amdgcn_readfirstlane(tid >> 6), lane = tid & 63, wr = wid >> 2, wc = wid & 3, fr = lane & 15, fq = lane >> 4;
    const int K = g.K, nt = K / BK;
    unsigned voffA[2], voffB[2];
#pragma unroll
    for (int i = 0; i < 2; ++i) { int R, C; stage_rc(tid * 16 + i * 8192, R, C); const int Rb = Epi::PERM ? ((R & ~31) + perm32(R & 31)) : R;
        voffA[i] = (unsigned)(R * K + C) * 2u; voffB[i] = (unsigned)(Rb * K + C) * 2u; }
    const size_t kstep = (size_t)(BK * 2);
    const size_t hstep = (size_t)HALF * K * 2;
    const size_t tstep = 2 * hstep;
    const unsigned ldsw = (unsigned)wid * 1024u;
    const int aoff = lds_byte(wr * 64 + fr, fq * 8), boff = lds_byte(wc * 32 + fr, fq * 8);
#define PG8_SA(b, h) (((b) * 2 + (h)) * HTB)
#define PG8_SB(b, h) ((4 + (b) * 2 + (h)) * HTB)
#define PG8_STAGE(bufoff, gbase, voff) do { _Pragma("unroll") for (int _i = 0; _i < 2; ++_i) \
        __builtin_amdgcn_global_load_lds((const unsigned*)((const char*)(gbase) + (voff)[_i]), (PG8_LAS unsigned*)(lds + (bufoff) + ldsw + _i * 8192), 16, 0, 0); } while (0)
#define PG8_LDA(dst, b, h) do { _Pragma("unroll") for (int m = 0; m < 4; ++m) _Pragma("unroll") for (int k = 0; k < 2; ++k) dst[m][k] = *(const PG8_LAS bf16x8*)(lds + PG8_SA(b, h) + aoff + m * 2048 + k * 1024); } while (0)
#define PG8_LDB(dst, b, h) do { _Pragma("unroll") for (int n = 0; n < 2; ++n) _Pragma("unroll") for (int k = 0; k < 2; ++k) dst[n][k] = *(const PG8_LAS bf16x8*)(lds + PG8_SB(b, h) + boff + n * 2048 + k * 1024); } while (0)
#define PG8_MMA(ai, bj, At, Bt) do { __builtin_amdgcn_s_setprio(1); _Pragma("unroll") for (int m = 0; m < 4; ++m) _Pragma("unroll") for (int n = 0; n < 2; ++n) _Pragma("unroll") for (int k = 0; k < 2; ++k) \
        acc[ai][bj][m][n] = __builtin_amdgcn_mfma_f32_16x16x32_bf16(Bt[n][k], At[m][k], acc[ai][bj][m][n], 0, 0, 0); __builtin_amdgcn_s_setprio(0); } while (0)
#define PG8_WAIT_V(n) asm volatile("s_waitcnt vmcnt(" #n ")" ::: "memory")
#define PG8_WAIT_L(n) asm volatile("s_waitcnt lgkmcnt(" #n ")" ::: "memory")
#define PG8_BAR __builtin_amdgcn_s_barrier()
#define PG8_SCHED __builtin_amdgcn_sched_barrier(0)
    Unit cur, nxt; int ui = 0;
    if (!S.next(0, cur)) return;
    f32x4 acc[2][2][4][2];
#pragma unroll
    for (int a = 0; a < 2; ++a)
#pragma unroll
        for (int b = 0; b < 2; ++b)
#pragma unroll
            for (int m = 0; m < 4; ++m)
#pragma unroll
                for (int n = 0; n < 2; ++n) acc[a][b][m][n] = (f32x4){0.f, 0.f, 0.f, 0.f};
    bf16x8 At[4][2], B0[2][2], B1[2][2];
    const char* cA = (const char*)cur.A + (size_t)cur.pm * tstep; const char* cB = (const char*)cur.Bt + (size_t)cur.pn * tstep;
    S.a_ready(cur);
    if constexpr (SP2) {
        PG8_STAGE(PG8_SB(0, 0), cB, voffB); PG8_STAGE(PG8_SB(0, 1), cB + hstep, voffB); PG8_STAGE(PG8_SA(0, 0), cA, voffA); PG8_STAGE(PG8_SA(0, 1), cA + hstep, voffA);
        if (wr == 1) PG8_BAR;
        PG8_WAIT_V(2); PG8_BAR;
        PG8_STAGE(PG8_SB(1, 0), cB + kstep, voffB); PG8_STAGE(PG8_SA(1, 0), cA + kstep, voffA); PG8_STAGE(PG8_SB(1, 1), cB + hstep + kstep, voffB);
        PG8_WAIT_V(6); PG8_BAR;
    } else {
        PG8_STAGE(PG8_SB(0, 0), cB, voffB); PG8_STAGE(PG8_SA(0, 0), cA, voffA); PG8_STAGE(PG8_SB(0, 1), cB + hstep, voffB); PG8_STAGE(PG8_SA(0, 1), cA + hstep, voffA);
        if (wr == 1) PG8_BAR;
        PG8_WAIT_V(4); PG8_BAR;
        PG8_STAGE(PG8_SB(1, 0), cB + kstep, voffB); PG8_STAGE(PG8_SA(1, 0), cA + kstep, voffA); PG8_STAGE(PG8_SB(1, 1), cB + hstep + kstep, voffB);
        PG8_WAIT_V(6); PG8_BAR;
    }
    for (;;) {
        const bool has_next = S.next(ui + 1, nxt);
        const char* nA = has_next ? (const char*)nxt.A + (size_t)nxt.pm * tstep : cA; const char* nB = has_next ? (const char*)nxt.Bt + (size_t)nxt.pn * tstep : cB;
        for (int t = 0; t < nt; t += 2) {
            const bool last = (t == nt - 2);
            const char* a1 = cA + (size_t)(t + 1) * kstep;
            const char* a2 = last ? nA : cA + (size_t)(t + 2) * kstep; const char* b2 = last ? nB : cB + (size_t)(t + 2) * kstep;
            const char* a3 = a2 + kstep; const char* b3 = b2 + kstep;
            if (last && has_next) S.a_ready(nxt);
            if constexpr (SP2) {
            PG8_LDB(B0, 0, 0); PG8_LDB(B1, 0, 1); PG8_SCHED; PG8_LDA(At, 0, 0); PG8_STAGE(PG8_SA(1, 1), a1 + hstep, voffA);
            PG8_WAIT_V(8); PG8_WAIT_L(0); PG8_BAR; PG8_MMA(0, 0, At, B0); PG8_MMA(0, 1, At, B1); PG8_BAR; PG8_SCHED;
            PG8_LDA(At, 0, 1); PG8_STAGE(PG8_SB(0, 0), b2, voffB); PG8_STAGE(PG8_SB(0, 1), b2 + hstep, voffB); PG8_STAGE(PG8_SA(0, 0), a2, voffA);
            PG8_WAIT_V(8); PG8_WAIT_L(0); PG8_BAR; PG8_MMA(1, 0, At, B0); PG8_MMA(1, 1, At, B1); PG8_BAR; PG8_SCHED;
            PG8_LDB(B0, 1, 0); PG8_LDB(B1, 1, 1); PG8_SCHED; PG8_LDA(At, 1, 0); PG8_STAGE(PG8_SA(0, 1), a2 + hstep, voffA);
            PG8_WAIT_V(8); PG8_WAIT_L(0); PG8_BAR; PG8_MMA(0, 0, At, B0); PG8_MMA(0, 1, At, B1); PG8_BAR; PG8_SCHED;
            PG8_LDA(At, 1, 1); PG8_STAGE(PG8_SB(1, 0), b3, voffB); PG8_STAGE(PG8_SB(1, 1), b3 + hstep, voffB); PG8_STAGE(PG8_SA(1, 0), a3, voffA);
            PG8_WAIT_V(8); PG8_WAIT_L(0); PG8_BAR; PG8_MMA(1, 0, At, B0); PG8_MMA(1, 1, At, B1); PG8_BAR; PG8_SCHED;
            } else {
            PG8_LDB(B0, 0, 0); PG8_SCHED; PG8_LDA(At, 0, 0); PG8_STAGE(PG8_SA(1, 1), a1 + hstep, voffA);
            PG8_WAIT_L(8); PG8_BAR; PG8_WAIT_L(0); PG8_MMA(0, 0, At, B0); PG8_BAR; PG8_SCHED;
            PG8_LDB(B1, 0, 1); PG8_STAGE(PG8_SB(0, 0), b2, voffB);
            PG8_BAR; PG8_WAIT_L(0); PG8_MMA(0, 1, At, B1); PG8_BAR;
            PG8_LDA(At, 0, 1); PG8_STAGE(PG8_SA(0, 0), a2, voffA);
            PG8_BAR; PG8_WAIT_L(0); PG8_MMA(1, 0, At, B0); PG8_BAR; PG8_SCHED;
            PG8_STAGE(PG8_SB(0, 1), b2 + hstep, voffB);
            PG8_WAIT_V(6); PG8_BAR; PG8_MMA(1, 1, At, B1); PG8_BAR;
            PG8_LDB(B0, 1, 0); PG8_SCHED; PG8_LDA(At, 1, 0); PG8_STAGE(PG8_SA(0, 1), a2 + hstep, voffA);
            PG8_WAIT_L(8); PG8_BAR; PG8_WAIT_L(0); PG8_MMA(0, 0, At, B0); PG8_BAR; PG8_SCHED;
            PG8_LDB(B1, 1, 1); PG8_STAGE(PG8_SB(1, 0), b3, voffB);
            PG8_BAR; PG8_WAIT_L(0); PG8_MMA(0, 1, At, B1); PG8_BAR;
            PG8_LDA(At, 1, 1); PG8_STAGE(PG8_SA(1, 0), a3, voffA);
            PG8_BAR; PG8_WAIT_L(0); PG8_MMA(1, 0, At, B0); PG8_BAR; PG8_SCHED;
            PG8_STAGE(PG8_SB(1, 1), b3 + hstep, voffB);
            PG8_WAIT_V(6); PG8_BAR; PG8_MMA(1, 1, At, B1); PG8_BAR;
            }
        }
        if constexpr (ALIGN_EPI) { if (wr == 0) PG8_BAR; }
        if constexpr (!Epi::AFTER_DRAIN) { E(acc, cur, wr, wc, fr, fq); S.done(cur); }
        if (!has_next) break;
#pragma unroll
        for (int a = 0; a < 2; ++a)
#pragma unroll
            for (int b = 0; b < 2; ++b)
#pragma unroll
                for (int m = 0; m < 4; ++m)
#pragma unroll
                    for (int n = 0; n < 2; ++n) acc[a][b][m][n] = (f32x4){0.f, 0.f, 0.f, 0.f};
        cur = nxt; cA = nA; cB = nB; ++ui;
        if constexpr (ALIGN_EPI) { if (wr == 1) PG8_BAR; }
    }
    PG8_WAIT_V(0);
    if constexpr (!ALIGN_EPI) { if (wr == 0) PG8_BAR; }
    PG8_BAR;
    if constexpr (Epi::AFTER_DRAIN) { E.fused(acc, cur, wr, wc, fr, fq, lds, wid, lane); S.done(cur); }
#undef PG8_SA
#undef PG8_SB
#undef PG8_STAGE
#undef PG8_LDA
#undef PG8_LDB
#undef PG8_MMA
#undef PG8_WAIT_V
#undef PG8_WAIT_L
#undef PG8_BAR
#undef PG8_SCHED
}
}
#define XB_TMO      128
#define XB_XCNT(j)  (256  + 64 * (j))
#define XB_XSUB(j)  (1280 + 64 * (j))
#define XB_XGEN(j)  (2304 + 64 * (j))
#define XB_TOP      3328
#define XB_TOPGEN   3392
#define XCD_BAR_WORDS 3456
#define XB_SPIN_CAP (1u << 18)

__device__ __forceinline__ unsigned xb_ld(unsigned* p)              { return __hip_atomic_load(p, __ATOMIC_RELAXED, __HIP_MEMORY_SCOPE_AGENT); }
__device__ __forceinline__ unsigned xb_add(unsigned* p, unsigned v) { return __hip_atomic_fetch_add(p, v, __ATOMIC_RELAXED, __HIP_MEMORY_SCOPE_AGENT); }
__device__ __forceinline__ unsigned xb_xcc_id() { return (unsigned)__builtin_amdgcn_s_getreg((3 << 11) | 20) & 0xFu; }
#define XB_SPIN(cond, bar) do { unsigned _sp = 0; while (cond) { __builtin_amdgcn_s_sleep(1); \
    if ((++_sp & 255u) == 0u) { if (xb_ld(&(bar)[XB_TMO])) break; if (_sp > XB_SPIN_CAP) { atomicAdd(&(bar)[XB_TMO], 1u); break; } } } } while (0)

struct XcdBarrier {
    unsigned* bar; unsigned x;
    volatile LAS unsigned* st;
};

__device__ __forceinline__ XcdBarrier xcd_barrier_post(unsigned* bar, volatile LAS unsigned* st) {
    XcdBarrier b; b.bar = bar; b.x = xb_xcc_id(); b.st = st;
    if (threadIdx.x == 0) (void)xb_add(&bar[XB_XCNT(b.x)], 1u);
    return b;
}
__device__ __forceinline__ void xcd_barrier_complete(unsigned* bar, unsigned x, unsigned& nloc, unsigned& nx) {
    const unsigned G = gridDim.x * gridDim.y * gridDim.z;
    unsigned sum, cnt, mine, sp = 0u;
    for (;;) {
        sum = 0u; cnt = 0u; mine = 0u;
#pragma unroll
        for (unsigned j = 0; j < 16; ++j) { const unsigned c = xb_ld(&bar[XB_XCNT(j)]); sum += c; cnt += (c > 0u) ? 1u : 0u; mine = (j == x) ? c : mine; }
        if (sum == G) break;
        __builtin_amdgcn_s_sleep(1);
        if ((++sp & 255u) == 0u) { if (xb_ld(&bar[XB_TMO])) break; if (sp > XB_SPIN_CAP) { atomicAdd(&bar[XB_TMO], 1u); break; } }
    }
    nloc = mine > 0u ? mine : 1u; nx = cnt > 0u ? cnt : 1u;
}

__device__ __forceinline__ void xcd_barrier(const XcdBarrier& b) {
    asm volatile("s_waitcnt vmcnt(0)" ::: "memory");
    __syncthreads();
    if (threadIdx.x == 0) {
        unsigned* bar = b.bar;
        __builtin_amdgcn_s_waitcnt(0);
        unsigned nloc = b.st[0], nx = b.st[1];
        if (nloc == 0u) { xcd_barrier_complete(bar, b.x, nloc, nx); b.st[0] = nloc; b.st[1] = nx; }
        const unsigned old = xb_add(&bar[XB_XSUB(b.x)], 1u);
        const unsigned gen = old / nloc;
        if (old + 1u == (gen + 1u) * nloc) {
            __builtin_amdgcn_fence(__ATOMIC_RELEASE, "agent");
            asm volatile("s_waitcnt vmcnt(0)" ::: "memory");
            const unsigned og = xb_add(&bar[XB_TOP], 1u);
            const unsigned tg = og / nx;
            if (og + 1u == (tg + 1u) * nx) xb_add(&bar[XB_TOPGEN], 1u);
            else XB_SPIN(xb_ld(&bar[XB_TOPGEN]) == tg, bar);
            __builtin_amdgcn_fence(__ATOMIC_ACQUIRE, "agent");
            xb_add(&bar[XB_XGEN(b.x)], 1u);
            asm volatile("s_waitcnt vmcnt(0)" ::: "memory");
        } else {
            XB_SPIN(xb_ld(&bar[XB_XGEN(b.x)]) == gen, bar);
            __builtin_amdgcn_fence(__ATOMIC_ACQUIRE, "agent");
            asm volatile("s_waitcnt vmcnt(0)" ::: "memory");
        }
    }
    __syncthreads();
}


constexpr int NB = 8, SEQ = 2048, D = 1024, M = NB * SEQ, NL = 2, INW = 7168, NIN = 5120;
constexpr float EPS = 1e-6f;
#define LAS __attribute__((address_space(3)))
typedef unsigned short bf16_t;
typedef short bf16x8 __attribute__((ext_vector_type(8)));
typedef float f32x4 __attribute__((ext_vector_type(4)));
typedef float f32x2 __attribute__((ext_vector_type(2)));
typedef unsigned u32x4 __attribute__((ext_vector_type(4)));
typedef unsigned u32x2 __attribute__((ext_vector_type(2)));
typedef __bf16 bf2_t __attribute__((ext_vector_type(2)));
typedef _Float16 h2_t __attribute__((ext_vector_type(2)));

constexpr size_t MiB = 1u << 20;
constexpr size_t WS_ADA = 0;
constexpr size_t WS_LB = 256 * 1024;
constexpr size_t WS_POOLWT = 512 * 1024;
constexpr size_t WS_WIN = 1 * MiB;
constexpr size_t WS_WPO = 29 * MiB;
constexpr size_t WS_WHO = 31 * MiB;
constexpr size_t WS_WOUT = 35 * MiB;
constexpr size_t WS_H = 40 * MiB;
constexpr size_t WS_PV = 72 * MiB;
constexpr size_t WS_PG = 88 * MiB;
constexpr size_t WS_Q = 104 * MiB;
constexpr size_t WS_LF = 136 * MiB;
constexpr size_t WS_V = 168 * MiB;
constexpr size_t WS_HG = 200 * MiB;
constexpr size_t WS_P = 232 * MiB;
constexpr size_t WS_DEC = 248 * MiB;
constexpr size_t WS_BAR = 250 * MiB;
constexpr size_t WS_DSEG = 251 * MiB;
constexpr size_t WS_END = 253 * MiB;
constexpr int LDS_BYTES = 147456, LDS_BARW = 147392;

__device__ __forceinline__ unsigned pk_bf16(float lo, float hi) { bf2_t r = __builtin_convertvector((f32x2){lo, hi}, bf2_t); return __builtin_bit_cast(unsigned, r); }
__device__ __forceinline__ unsigned pk_f16(float lo, float hi) { h2_t r = __builtin_convertvector((f32x2){lo, hi}, h2_t); return __builtin_bit_cast(unsigned, r); }
__device__ __forceinline__ float bf_lo(unsigned w) { return __uint_as_float(w << 16); }
__device__ __forceinline__ float bf_hi(unsigned w) { return __uint_as_float(w & 0xffff0000u); }
__device__ __forceinline__ float h_lo(unsigned w) { h2_t r = __builtin_bit_cast(h2_t, w); return (float)r.x; }
__device__ __forceinline__ float h_hi(unsigned w) { h2_t r = __builtin_bit_cast(h2_t, w); return (float)r.y; }
__device__ __forceinline__ float sigmoid_f(float x) { return __builtin_amdgcn_rcpf(1.f + __expf(-x)); }
__device__ __forceinline__ float silu_f(float x) { return x * sigmoid_f(x); }
__device__ __forceinline__ float dpp_f(float v, const int ctrl_unused) { return v; }
#define DPP_ADD(v, ctrl) ((v) + __builtin_bit_cast(float, __builtin_amdgcn_update_dpp(0, __builtin_bit_cast(int, (v)), (ctrl), 0xf, 0xf, true)))
__device__ __forceinline__ float wave_sum(float v) {
    v = DPP_ADD(v, 0xB1);
    v = DPP_ADD(v, 0x4E);
    v = DPP_ADD(v, 0x124);
    v = DPP_ADD(v, 0x128);
    return (__builtin_amdgcn_readlane(v, 0) + __builtin_amdgcn_readlane(v, 16)) + (__builtin_amdgcn_readlane(v, 32) + __builtin_amdgcn_readlane(v, 48));
}
#define LBAR() do { asm volatile("s_waitcnt lgkmcnt(0)" ::: "memory"); __builtin_amdgcn_s_barrier(); asm volatile("" ::: "memory"); } while (0)
#define MFMA16(a, b, c) __builtin_amdgcn_mfma_f32_16x16x32_bf16((a), (b), (c), 0, 0, 0)

__device__ __forceinline__ void p0_transpose_item(const float* W, int K, int N, bf16_t* WT, LAS float* scr, int item, int lane) {
    const int nblk = N / 32, kb = item / nblk, nb = item % nblk, k0 = 64 * kb, n0 = 32 * nb;
#pragma unroll
    for (int i = 0; i < 32; ++i) { const int kk = 2 * i + (lane >> 5); scr[kk * 33 + (lane & 31)] = W[(size_t)(k0 + kk) * N + n0 + (lane & 31)]; }
    asm volatile("s_waitcnt lgkmcnt(0)" ::: "memory");
    const int c = lane & 7;
#pragma unroll
    for (int j = 0; j < 4; ++j) { const int n = (lane >> 3) + 8 * j; const LAS float* s = scr + (8 * c) * 33 + n;
        u32x4 o; o.x = pk_bf16(s[0 * 33], s[1 * 33]); o.y = pk_bf16(s[2 * 33], s[3 * 33]); o.z = pk_bf16(s[4 * 33], s[5 * 33]); o.w = pk_bf16(s[6 * 33], s[7 * 33]);
        *(u32x4*)(WT + (size_t)(n0 + n) * K + k0 + 8 * c) = o; }
    asm volatile("s_waitcnt lgkmcnt(0)" ::: "memory");
}

struct Params {
    const float *x, *c, *w_ada, *b_ada, *g_pre, *g_post, *w_in, *pool_w, *pool_scale, *lb_logits, *hgrn_norm_g, *w_pool_o, *w_hgrn_o, *w_out;
    float* out; unsigned char* ws;
};

__device__ __forceinline__ void p0_prologue(const Params& p, LAS unsigned char* lds) {
    const int tid = threadIdx.x, lane = tid & 63, wave = tid >> 6, blk = blockIdx.x, G = gridDim.x;
    float* ADA = (float*)(p.ws + WS_ADA);
    LAS float* cact = (LAS float*)(lds + 73728);
    LAS float* red = (LAS float*)(lds + 73728 + 32768);
    for (int job = blk; job < 192; job += G) {
        for (int i = tid; i < NB * D; i += 512) cact[i] = silu_f(p.c[i]);
        __syncthreads();
        const int l = job / 96, j0 = (job % 96) * 32, j = tid & 31, ks = tid >> 5;
        const float* w = p.w_ada + ((size_t)l * D + ks * 64) * 3072 + j0 + j;
        float a0 = 0.f, a1 = 0.f, a2 = 0.f, a3 = 0.f, a4 = 0.f, a5 = 0.f, a6 = 0.f, a7 = 0.f;
#pragma unroll 32
        for (int d = 0; d < 64; ++d) { const float wv = w[(size_t)d * 3072]; const LAS float* cc = cact + ks * 64 + d;
            a0 += cc[0] * wv; a1 += cc[1024] * wv; a2 += cc[2048] * wv; a3 += cc[3072] * wv; a4 += cc[4096] * wv; a5 += cc[5120] * wv; a6 += cc[6144] * wv; a7 += cc[7168] * wv; }
        LAS float* rr = red + (ks * 8) * 32 + j;
        rr[0] = a0; rr[32] = a1; rr[64] = a2; rr[96] = a3; rr[128] = a4; rr[160] = a5; rr[192] = a6; rr[224] = a7;
        __syncthreads();
        if (tid < 256) { const int b = tid >> 5; float s = p.b_ada[l * 3072 + j0 + j];
#pragma unroll
            for (int k2 = 0; k2 < 16; ++k2) s += red[(k2 * 8 + b) * 32 + j];
            ADA[(size_t)(l * NB + b) * 3072 + j0 + j] = s; }
        __syncthreads();
    }
    if (blk == G - 1) { float* LB = (float*)(p.ws + WS_LB);
        for (int j = tid; j < 1024; j += 512) { const float l0 = p.lb_logits[j], l1 = p.lb_logits[1024 + j], mx = fmaxf(l0, l1), e0 = __expf(l0 - mx), e1 = __expf(l1 - mx);
            const float p0 = e0 / (e0 + e1), p1 = e1 / (e0 + e1); const float c1 = (p0 + p1) - p0;
            LB[j] = 0.f; LB[1024 + j] = fminf(fmaxf(c1, 0.f), 1.f); } }
    LAS float* scr = (LAS float*)(lds + wave * 8448);
    constexpr int I_IN = (D / 64) * (INW / 32), I_PO = (512 / 64) * (D / 32), I_HO = (D / 64) * (D / 32), I_OUT = I_HO, I_PW = 4 * 8, I_LAYER = I_IN + I_PO + I_HO + I_OUT + I_PW;
    bf16_t* WinT = (bf16_t*)(p.ws + WS_WIN); bf16_t* WpoT = (bf16_t*)(p.ws + WS_WPO); bf16_t* WhoT = (bf16_t*)(p.ws + WS_WHO); bf16_t* WoutT = (bf16_t*)(p.ws + WS_WOUT); bf16_t* PoolWT = (bf16_t*)(p.ws + WS_POOLWT);
    for (int it = blk * 8 + wave; it < NL * I_LAYER; it += G * 8) {
        int r = it; const int l = r / I_LAYER; r -= l * I_LAYER;
        if (r < I_IN) { p0_transpose_item(p.w_in + (size_t)l * D * INW, D, INW, WinT + (size_t)l * INW * D, scr, r, lane); continue; } r -= I_IN;
        if (r < I_PO) { p0_transpose_item(p.w_pool_o + (size_t)l * 512 * D, 512, D, WpoT + (size_t)l * D * 512, scr, r, lane); continue; } r -= I_PO;
        if (r < I_HO) { p0_transpose_item(p.w_hgrn_o + (size_t)l * D * D, D, D, WhoT + (size_t)l * D * D, scr, r, lane); continue; } r -= I_HO;
        if (r < I_OUT) { p0_transpose_item(p.w_out + (size_t)l * D * D, D, D, WoutT + (size_t)l * D * D, scr, r, lane); continue; } r -= I_OUT;
        { const int g = r >> 3; r &= 7; p0_transpose_item(p.pool_w + (size_t)(l * 4 + g) * 16384, 128, 128, PoolWT + (size_t)(l * 4 + g) * 16384, scr, r, lane); }
    }
}

template <bool HAS_PREV, bool MAKE_H>
__device__ __forceinline__ void p1_rows(const float* xprev, const bf16_t* Y, const float* ada_prev, const float* gpost, float* xout, const float* gpre, const float* ada_cur, bf16_t* H) {
    int tid_l = threadIdx.x; asm volatile("" : "+v"(tid_l));
    const int lane = tid_l & 63, wave = tid_l >> 6;
    const int NW = gridDim.x * 8, rpw = (M + NW - 1) / NW, gw = blockIdx.x * 8 + wave;
    const int mbeg = gw * rpw, mend = (mbeg + rpw < M) ? mbeg + rpw : M;
    if (mbeg >= mend) return;
    f32x4 ga[4], hm[4], hs[4];
    int bcur = -1;
    f32x4 vn[4]; u32x2 yn[4];
#pragma unroll
    for (int j = 0; j < 4; ++j) { vn[j] = ((const f32x4*)(xprev + (size_t)mbeg * D) + lane)[64 * j]; if (HAS_PREV) yn[j] = ((const u32x2*)(Y + (size_t)mbeg * D) + lane)[64 * j]; else yn[j] = (u32x2){0u, 0u}; }
    for (int m = mbeg; m < mend; ++m) {
        const int b = m >> 11;
        if (b != bcur) { bcur = b;
#pragma unroll
            for (int j = 0; j < 4; ++j) {
                if (HAS_PREV) ga[j] = ((const f32x4*)(ada_prev + (size_t)b * 3072 + 2048) + lane)[64 * j] * ((const f32x4*)gpost + lane)[64 * j]; else ga[j] = (f32x4){0.f, 0.f, 0.f, 0.f};
                if (MAKE_H) { hm[j] = ((const f32x4*)gpre + lane)[64 * j] * (((const f32x4*)(ada_cur + (size_t)b * 3072 + 1024) + lane)[64 * j] + 1.f); hs[j] = ((const f32x4*)(ada_cur + (size_t)b * 3072) + lane)[64 * j]; }
                else { hm[j] = (f32x4){0.f, 0.f, 0.f, 0.f}; hs[j] = hm[j]; } } }
        f32x4 v[4]; u32x2 yw[4];
#pragma unroll
        for (int j = 0; j < 4; ++j) { v[j] = vn[j]; yw[j] = yn[j]; }
        { const int mn = (m + 1 < mend) ? m + 1 : m;
#pragma unroll
          for (int j = 0; j < 4; ++j) { vn[j] = ((const f32x4*)(xprev + (size_t)mn * D) + lane)[64 * j]; if (HAS_PREV) yn[j] = ((const u32x2*)(Y + (size_t)mn * D) + lane)[64 * j]; } }
        if (HAS_PREV) {
            f32x4 y[4]; float ss = 0.f;
#pragma unroll
            for (int j = 0; j < 4; ++j) { y[j] = (f32x4){bf_lo(yw[j].x), bf_hi(yw[j].x), bf_lo(yw[j].y), bf_hi(yw[j].y)}; ss += (y[j].x * y[j].x + y[j].y * y[j].y) + (y[j].z * y[j].z + y[j].w * y[j].w); }
            const float rstd = rsqrtf(wave_sum(ss) * (1.f / D) + EPS);
            f32x4* xo = (f32x4*)(xout + (size_t)m * D) + lane;
#pragma unroll
            for (int j = 0; j < 4; ++j) { v[j] = v[j] + ga[j] * (y[j] * rstd); xo[64 * j] = v[j]; }
        }
        if (MAKE_H) {
            float ss = 0.f;
#pragma unroll
            for (int j = 0; j < 4; ++j) ss += (v[j].x * v[j].x + v[j].y * v[j].y) + (v[j].z * v[j].z + v[j].w * v[j].w);
            const float rstd = rsqrtf(wave_sum(ss) * (1.f / D) + EPS);
            u32x2* ho = (u32x2*)(H + (size_t)m * D) + lane;
#pragma unroll
            for (int j = 0; j < 4; ++j) { const f32x4 hv = (v[j] * rstd) * hm[j] + hs[j]; u32x2 w; w.x = pk_bf16(hv.x, hv.y); w.y = pk_bf16(hv.z, hv.w); ho[64 * j] = w; }
        }
    }
}

struct EpiU {
    static constexpr bool PERM = true, AFTER_DRAIN = false;
    unsigned char* ws;
    __device__ __forceinline__ void operator()(const f32x4 (&acc)[2][2][4][2], const pg8::Unit& u, int wr, int wc, int fr, int fq) const {
        const int pn = u.pn, mode = u.mode; const int row0 = u.pm * 256 + wr * 64 + fr;
        size_t boff; int ld = 1024, colt = pn * 256, op;
        if (mode == 0) {
            if (pn < 2) { boff = WS_PV; ld = 512; op = 0; }
            else if (pn < 4) { boff = WS_PG; ld = 512; colt = (pn - 2) * 256; op = 0; }
            else if (pn < 8) { boff = WS_Q; colt = (pn - 4) * 256; op = 0; }
            else if (pn < 12) { boff = WS_LF; colt = (pn - 8) * 256; op = 2; }
            else if (pn < 16) { boff = WS_V; colt = (pn - 12) * 256; op = 0; }
            else { boff = WS_HG; colt = (pn - 16) * 256; op = 0; }
        } else if (mode == 1) { boff = (pn < 4) ? WS_Q : WS_V; colt = (pn & 3) * 256; op = 3; }
        else if (mode == 2) { boff = WS_LF; op = 4; }
        else if (mode == 3) { boff = WS_LF; op = 5; }
        else { boff = WS_V; op = 0; }
        bf16_t* base = (bf16_t*)(ws + boff); const bf16_t* Gp = (const bf16_t*)(ws + (mode == 2 ? WS_V : WS_Q));
        const int col0 = colt + wc * 32 + 8 * fq;
#pragma unroll
        for (int ai = 0; ai < 2; ++ai) {
            u32x4 gq[4][2], tq[4][2];
#pragma unroll
            for (int m = 0; m < 4; ++m)
#pragma unroll
                for (int bj = 0; bj < 2; ++bj) { gq[m][bj] = (u32x4){0u, 0u, 0u, 0u}; tq[m][bj] = gq[m][bj]; }
            if (op >= 4) {
#pragma unroll
                for (int m = 0; m < 4; ++m)
#pragma unroll
                    for (int bj = 0; bj < 2; ++bj) gq[m][bj] = *(const u32x4*)(Gp + (size_t)(row0 + ai * 128 + m * 16) * ld + col0 + bj * 128);
                if (op == 5) {
#pragma unroll
                    for (int m = 0; m < 4; ++m)
#pragma unroll
                        for (int bj = 0; bj < 2; ++bj) tq[m][bj] = *(const u32x4*)(base + (size_t)(row0 + ai * 128 + m * 16) * ld + col0 + bj * 128); }
            }
            asm volatile("" ::: "memory");
#pragma unroll
            for (int m = 0; m < 4; ++m) { const size_t off = (size_t)(row0 + ai * 128 + m * 16) * ld + col0;
#pragma unroll
                for (int bj = 0; bj < 2; ++bj) { f32x4 v0 = acc[ai][bj][m][0], v1 = acc[ai][bj][m][1];
                    if (op == 1) {
#pragma unroll
                        for (int j = 0; j < 4; ++j) { v0[j] = silu_f(v0[j]); v1[j] = silu_f(v1[j]); }
                    } else if (op == 3) {
#pragma unroll
                        for (int j = 0; j < 4; ++j) { v0[j] = sigmoid_f(v0[j]); v1[j] = sigmoid_f(v1[j]); }
                    } else if (op >= 4) { const u32x4 g = gq[m][bj];
                        v0 = v0 * (f32x4){bf_lo(g.x), bf_hi(g.x), bf_lo(g.y), bf_hi(g.y)}; v1 = v1 * (f32x4){bf_lo(g.z), bf_hi(g.z), bf_lo(g.w), bf_hi(g.w)};
                        if (op == 5) { const u32x4 t = tq[m][bj];
                            v0 = v0 + (f32x4){bf_lo(t.x), bf_hi(t.x), bf_lo(t.y), bf_hi(t.y)}; v1 = v1 + (f32x4){bf_lo(t.z), bf_hi(t.z), bf_lo(t.w), bf_hi(t.w)}; } }
                    u32x4 w;
                    if (op == 2) { w.x = pk_f16(v0[0], v0[1]); w.y = pk_f16(v0[2], v0[3]); w.z = pk_f16(v1[0], v1[1]); w.w = pk_f16(v1[2], v1[3]); }
                    else { w.x = pk_bf16(v0[0], v0[1]); w.y = pk_bf16(v0[2], v0[3]); w.z = pk_bf16(v1[0], v1[1]); w.w = pk_bf16(v1[2], v1[3]); }
                    *(u32x4*)(base + off + bj * 128) = w; } }
        }
    }
};

constexpr int AP_STRIDE = 136;
template <int W>
__device__ __forceinline__ void pool_item(const bf16_t* PV, bf16_t* PG, const bf16_t* PoolWT_g, const float* pscale_g, int m0, int g, LAS unsigned char* lds) {
    int tid_l = threadIdx.x; asm volatile("" : "+v"(tid_l));
    const int tid = tid_l, lane = tid & 63, wv = tid >> 6, r = lane & 15, q = lane >> 4;
    const int pos0 = (m0 & (SEQ - 1)) + wv * 8;
    const bf16_t* src = PV + (size_t)(m0 + wv * 8) * 512 + g * 128 + 2 * lane;
    float r0[W + 7], r1[W + 7];
#pragma unroll
    for (int i = 0; i < W + 7; ++i) { const int pp = pos0 - (W - 1) + i; unsigned w = 0u; if (pp >= 0) w = *(const unsigned*)(src + (ptrdiff_t)(i - (W - 1)) * 512); r0[i] = bf_lo(w); r1[i] = bf_hi(w); }
    bf16x8 wf[4]; u32x2 gw[4];
#pragma unroll
    for (int ks = 0; ks < 4; ++ks) wf[ks] = *(const bf16x8*)(PoolWT_g + (16 * wv + r) * 128 + ks * 32 + q * 8);
#pragma unroll
    for (int mt = 0; mt < 4; ++mt) gw[mt] = *(const u32x2*)(PG + (size_t)(m0 + mt * 16 + r) * 512 + g * 128 + 16 * wv + q * 4);
    const f32x4 sc = *(const f32x4*)(pscale_g + 16 * wv + q * 4);
    float s0 = 0.f, s1 = 0.f;
#pragma unroll
    for (int i = 0; i < W - 1; ++i) { s0 += r0[i]; s1 += r1[i]; }
    LAS bf16_t* AP = (LAS bf16_t*)lds;
    __syncthreads();
#pragma unroll
    for (int i = 0; i < 8; ++i) { s0 += r0[W - 1 + i]; s1 += r1[W - 1 + i];
        const int pos = pos0 + i; const float inv = 1.f / (float)(pos + 1 < W ? pos + 1 : W);
        *(LAS unsigned*)(AP + (wv * 8 + i) * AP_STRIDE + 2 * lane) = pk_bf16(s0 * inv - r0[W - 1 + i], s1 * inv - r1[W - 1 + i]);
        s0 -= r0[i]; s1 -= r1[i]; }
    __syncthreads();
    f32x4 o[4];
#pragma unroll
    for (int mt = 0; mt < 4; ++mt) o[mt] = (f32x4){0.f, 0.f, 0.f, 0.f};
    bf16x8 af[16];
#pragma unroll
    for (int ks = 0; ks < 4; ++ks)
#pragma unroll
        for (int mt = 0; mt < 4; ++mt) af[ks * 4 + mt] = *(const LAS bf16x8*)(AP + (mt * 16 + r) * AP_STRIDE + ks * 32 + q * 8);
    __builtin_amdgcn_sched_barrier(0);
#pragma unroll
    for (int ks = 0; ks < 4; ++ks)
#pragma unroll
        for (int mt = 0; mt < 4; ++mt) o[mt] = MFMA16(wf[ks], af[ks * 4 + mt], o[mt]);
#pragma unroll
    for (int mt = 0; mt < 4; ++mt) { bf16_t* pp = PG + (size_t)(m0 + mt * 16 + r) * 512 + g * 128 + 16 * wv + q * 4;
        const f32x4 ov = o[mt] * sc * (f32x4){silu_f(bf_lo(gw[mt].x)), silu_f(bf_hi(gw[mt].x)), silu_f(bf_lo(gw[mt].y)), silu_f(bf_hi(gw[mt].y))};
        u32x2 w; w.x = pk_bf16(ov.x, ov.y); w.y = pk_bf16(ov.z, ov.w); *(u32x2*)pp = w; }
}

constexpr int HQ_STR = 136, HK_STR = 72;
__device__ __forceinline__ void prep_items(bf16_t* Qg, bf16_t* LFg, bf16_t* Pg, float* DECg, const float* lbl, int first, int step, int total, LAS unsigned char* lds) {
    int tid_l = threadIdx.x; asm volatile("" : "+v"(tid_l));
    const int tid = tid_l, lane = tid & 63, wv = __builtin_amdgcn_readfirstlane(tid >> 6), r = lane & 15, q = lane >> 4;
    LAS bf16_t* QT = (LAS bf16_t*)(lds); LAS bf16_t* KT = (LAS bf16_t*)(lds + 17408); LAS float* TOT = (LAS float*)(lds + 34816);
    unsigned q2[8], lf2[8], qn[8], lfn[8];
    if (first < total) { const int bh = first >> 5, n = first & 31; const size_t rb = ((size_t)(bh >> 3) * SEQ + n * 64 + wv * 8) * 1024 + (size_t)(bh & 7) * 128 + 2 * lane;
#pragma unroll
        for (int i = 0; i < 8; ++i) { qn[i] = *(const unsigned*)(Qg + rb + (size_t)i * 1024); lfn[i] = *(const unsigned*)(LFg + rb + (size_t)i * 1024); } }
#pragma unroll 1
    for (int item = first; item < total; item += step) {
        const int bh = item >> 5, n = item & 31;
        const size_t rb = ((size_t)(bh >> 3) * SEQ + n * 64 + wv * 8) * 1024 + (size_t)(bh & 7) * 128 + 2 * lane;
#pragma unroll
        for (int i = 0; i < 8; ++i) { q2[i] = qn[i]; lf2[i] = lfn[i]; }
        const f32x2 lbp = *(const f32x2*)(lbl + (bh & 7) * 128 + 2 * lane); const float lb0 = lbp.x, lb1 = lbp.y;
        { const int inext = (item + step < total) ? item + step : item; const int bh2 = inext >> 5, n2 = inext & 31; const size_t rb2 = ((size_t)(bh2 >> 3) * SEQ + n2 * 64 + wv * 8) * 1024 + (size_t)(bh2 & 7) * 128 + 2 * lane;
#pragma unroll
            for (int i = 0; i < 8; ++i) { qn[i] = *(const unsigned*)(Qg + rb2 + (size_t)i * 1024); lfn[i] = *(const unsigned*)(LFg + rb2 + (size_t)i * 1024); } }
        float f0[8], f1[8]; float run0 = 0.f, run1 = 0.f;
#pragma unroll
        for (int i = 0; i < 8; ++i) { const float z0 = h_lo(lf2[i]), z1 = h_hi(lf2[i]);
            f0[i] = fmaxf(lb0 + (1.f - lb0) * sigmoid_f(z0), 1e-30f); f1[i] = fmaxf(lb1 + (1.f - lb1) * sigmoid_f(z1), 1e-30f); run0 += __logf(f0[i]); run1 += __logf(f1[i]); }
        *(LAS f32x2*)(TOT + wv * 128 + 2 * lane) = (f32x2){run0, run1};
        LBAR();
        float pre0 = 0.f, pre1 = 0.f, last0 = 0.f, last1 = 0.f;
#pragma unroll
        for (int w = 0; w < 8; ++w) { const f32x2 t = *(const LAS f32x2*)(TOT + w * 128 + 2 * lane); last0 += t.x; last1 += t.y; if (w < wv) { pre0 += t.x; pre1 += t.y; } }
        if (wv == 0) *(f32x2*)(DECg + (size_t)item * 128 + 2 * lane) = (f32x2){__expf(last0), __expf(last1)};
        const float sc0 = __expf(fminf(-0.5f * last0, 60.f)), sc1 = __expf(fminf(-0.5f * last1, 60.f));
        float pf0 = __expf(pre0), pf1 = __expf(pre1), sf0 = __expf(last0 - pre0 - run0), sf1 = __expf(last1 - pre1 - run1);
        float kh0[8], kh1[8];
#pragma unroll
        for (int i = 7; i >= 0; --i) { kh0[i] = (1.f - f0[i]) * sf0; kh1[i] = (1.f - f1[i]) * sf1; sf0 *= f0[i]; sf1 *= f1[i]; }
#pragma unroll
        for (int i = 0; i < 8; ++i) { pf0 *= f0[i]; pf1 *= f1[i];
            const float qh0 = silu_f(bf_lo(q2[i])) * pf0, qh1 = silu_f(bf_hi(q2[i])) * pf1; const int t = wv * 8 + i;
            *(unsigned*)(Qg + rb + (size_t)i * 1024) = pk_bf16(qh0, qh1);
            *(unsigned*)(LFg + rb + (size_t)i * 1024) = pk_bf16(kh0[i], kh1[i]);
            *(LAS unsigned*)(QT + t * HQ_STR + 2 * lane) = pk_bf16(qh0 * sc0, qh1 * sc1);
            *(LAS unsigned*)(KT + t * HQ_STR + 2 * lane) = pk_bf16(kh0[i] * sc0, kh1[i] * sc1); }
        LBAR();
        const int ti = wv >> 1;
        { bf16x8 qf[4], kf[2][4];
#pragma unroll
          for (int ks = 0; ks < 4; ++ks) { qf[ks] = *(const LAS bf16x8*)(QT + (ti * 16 + r) * HQ_STR + ks * 32 + q * 8);
              kf[0][ks] = *(const LAS bf16x8*)(KT + ((2 * (wv & 1)) * 16 + r) * HQ_STR + ks * 32 + q * 8); kf[1][ks] = *(const LAS bf16x8*)(KT + ((2 * (wv & 1) + 1) * 16 + r) * HQ_STR + ks * 32 + q * 8); }
          __builtin_amdgcn_sched_barrier(0);
#pragma unroll
          for (int jj = 0; jj < 2; ++jj) { const int tj = 2 * (wv & 1) + jj; f32x4 sc = (f32x4){0.f, 0.f, 0.f, 0.f};
              if (tj <= ti) {
#pragma unroll
                  for (int ks = 0; ks < 4; ++ks) sc = MFMA16(kf[jj][ks], qf[ks], sc); }
              const int t = ti * 16 + r, s0 = tj * 16 + q * 4;
#pragma unroll
              for (int j = 0; j < 4; ++j) sc[j] = (s0 + j <= t) ? sc[j] : 0.f;
              u32x2 w; w.x = pk_bf16(sc[0], sc[1]); w.y = pk_bf16(sc[2], sc[3]);
              *(u32x2*)(Pg + (size_t)item * 4096 + t * 64 + s0) = w; } }
    }
    __syncthreads();
}

constexpr int SB_QH = 0, SB_KHT = 17408, SB_VT = 35840, SB_P = 54272, SB_DEC = 63488, SB_SSQ = 64000, SB_SIZE = 66048;
struct ScanRegs { unsigned q2[8], k2[8], v2[8]; u32x4 pr; f32x4 dc; u32x2 hg[4]; f32x4 o[4]; };
__device__ __forceinline__ void scan_load(ScanRegs& R, const bf16_t* Qg, const bf16_t* Kg, const bf16_t* Vg, const bf16_t* Pg, const float* DECg, int bh, int n, size_t mb, size_t cb, int tid, int lane, int wv) {
    R.pr = *(const u32x4*)(Pg + (size_t)(bh * 32 + n) * 4096 + tid * 8);
    R.dc = *(const f32x4*)(DECg + (size_t)(bh * 32 + n) * 128 + (tid & 31) * 4);
    const size_t rb = (mb + (size_t)n * 64 + wv * 8) * 1024 + cb + 2 * lane;
#pragma unroll
    for (int i = 0; i < 8; ++i) { R.q2[i] = *(const unsigned*)(Qg + rb + (size_t)i * 1024); R.k2[i] = *(const unsigned*)(Kg + rb + (size_t)i * 1024); R.v2[i] = *(const unsigned*)(Vg + rb + (size_t)i * 1024); }
    asm volatile("" ::: "memory");
}
__device__ __forceinline__ void scan_chunk(ScanRegs& X, ScanRegs& Y, f32x4 (&S)[8], const f32x4 g4, int n, const bf16_t* Qg, const bf16_t* Kg, const bf16_t* Vg, const bf16_t* Pg, const float* DECg, bf16_t* HGg,
                                           int bh, size_t mb, size_t cb, int tid, int lane, int wv, int r, int q, LAS unsigned char* lds, bool dry) {
    constexpr int NCH = SEQ / 64;
    LAS unsigned char* B = lds + (n & 1) * SB_SIZE;
    const size_t m0 = mb + (size_t)n * 64;
    if (n < NCH) {
        LAS bf16_t* QH = (LAS bf16_t*)(B + SB_QH); LAS bf16_t* KHT = (LAS bf16_t*)(B + SB_KHT); LAS bf16_t* VT = (LAS bf16_t*)(B + SB_VT); LAS bf16_t* Pm = (LAS bf16_t*)(B + SB_P);
#pragma unroll
        for (int i = 0; i < 8; ++i) *(LAS unsigned*)(QH + (wv * 8 + i) * HQ_STR + 2 * lane) = X.q2[i];
        { u32x4 lo, hi; const unsigned* k2 = X.k2;
          lo.x = (k2[0] & 0xffffu) | (k2[1] << 16); lo.y = (k2[2] & 0xffffu) | (k2[3] << 16); lo.z = (k2[4] & 0xffffu) | (k2[5] << 16); lo.w = (k2[6] & 0xffffu) | (k2[7] << 16);
          hi.x = (k2[0] >> 16) | (k2[1] & 0xffff0000u); hi.y = (k2[2] >> 16) | (k2[3] & 0xffff0000u); hi.z = (k2[4] >> 16) | (k2[5] & 0xffff0000u); hi.w = (k2[6] >> 16) | (k2[7] & 0xffff0000u);
          *(LAS u32x4*)(KHT + (2 * lane) * HK_STR + wv * 8) = lo; *(LAS u32x4*)(KHT + (2 * lane + 1) * HK_STR + wv * 8) = hi; }
        { u32x4 lo, hi; const unsigned* v2 = X.v2;
          lo.x = (v2[0] & 0xffffu) | (v2[1] << 16); lo.y = (v2[2] & 0xffffu) | (v2[3] << 16); lo.z = (v2[4] & 0xffffu) | (v2[5] << 16); lo.w = (v2[6] & 0xffffu) | (v2[7] << 16);
          hi.x = (v2[0] >> 16) | (v2[1] & 0xffff0000u); hi.y = (v2[2] >> 16) | (v2[3] & 0xffff0000u); hi.z = (v2[4] >> 16) | (v2[5] & 0xffff0000u); hi.w = (v2[6] >> 16) | (v2[7] & 0xffff0000u);
          *(LAS u32x4*)(VT + (2 * lane) * HK_STR + wv * 8) = lo; *(LAS u32x4*)(VT + (2 * lane + 1) * HK_STR + wv * 8) = hi; }
        *(LAS u32x4*)(Pm + (tid >> 3) * HK_STR + (tid & 7) * 8) = X.pr;
        if (tid < 32) *(LAS f32x4*)((LAS float*)(B + SB_DEC) + tid * 4) = X.dc;
#pragma unroll
        for (int mt = 0; mt < 4; ++mt) X.hg[mt] = *(const u32x2*)(HGg + (m0 + mt * 16 + r) * 1024 + cb + 16 * wv + q * 4);
        scan_load(X, Qg, Kg, Vg, Pg, DECg, bh, (n + 2 < NCH) ? n + 2 : NCH - 1, mb, cb, tid, lane, wv);
    }
    LBAR();
    {
        const LAS float* SSQ = (const LAS float*)(lds + ((n - 1) & 1) * SB_SIZE + SB_SSQ);
#pragma unroll
        for (int mt = 0; mt < 4; ++mt) { float tot = 0.f;
#pragma unroll
            for (int w = 0; w < 8; ++w) tot += SSQ[w * 64 + mt * 16 + r];
            const float rstd = rsqrtf(tot * (1.f / 128.f) + EPS);
            const f32x4 ov = Y.o[mt] * rstd * g4 * (f32x4){bf_lo(Y.hg[mt].x), bf_hi(Y.hg[mt].x), bf_lo(Y.hg[mt].y), bf_hi(Y.hg[mt].y)};
            u32x2 w; w.x = pk_bf16(ov.x, ov.y); w.y = pk_bf16(ov.z, ov.w);
            if (n > 0 && (!dry || rstd == 12345.678f)) *(u32x2*)(HGg + (m0 - 64 + mt * 16 + r) * 1024 + cb + 16 * wv + q * 4) = w; }
    }
    if (n < NCH) {
        const LAS bf16_t* QH = (const LAS bf16_t*)(B + SB_QH); const LAS bf16_t* KHT = (const LAS bf16_t*)(B + SB_KHT); const LAS bf16_t* VT = (const LAS bf16_t*)(B + SB_VT); const LAS bf16_t* Pm = (const LAS bf16_t*)(B + SB_P);
        const LAS float* DEC = (const LAS float*)(B + SB_DEC); LAS float* SSQ = (LAS float*)(B + SB_SSQ);
#define SCHED_FENCE() __builtin_amdgcn_sched_barrier(0)
#define QFRAG(a, mt) __builtin_bit_cast(bf16x8, (u32x4){(*(const LAS u32x2*)(QH + ((mt) * 16 + r) * HQ_STR + 32 * (a) + q * 4)).x, (*(const LAS u32x2*)(QH + ((mt) * 16 + r) * HQ_STR + 32 * (a) + q * 4)).y, \
                                                        (*(const LAS u32x2*)(QH + ((mt) * 16 + r) * HQ_STR + 32 * (a) + 16 + q * 4)).x, (*(const LAS u32x2*)(QH + ((mt) * 16 + r) * HQ_STR + 32 * (a) + 16 + q * 4)).y})
#define SFRAG(a) __builtin_bit_cast(bf16x8, (u32x4){pk_bf16(S[2 * (a)][0], S[2 * (a)][1]), pk_bf16(S[2 * (a)][2], S[2 * (a)][3]), pk_bf16(S[2 * (a) + 1][0], S[2 * (a) + 1][1]), pk_bf16(S[2 * (a) + 1][2], S[2 * (a) + 1][3])})
        f32x4 o[4];
#pragma unroll
        for (int mt = 0; mt < 4; ++mt) o[mt] = (f32x4){0.f, 0.f, 0.f, 0.f};
        bf16x8 qa[8], qb[8];
#pragma unroll
        for (int mt = 0; mt < 4; ++mt) { qa[mt] = QFRAG(0, mt); qa[4 + mt] = QFRAG(1, mt); }
        SCHED_FENCE();
#pragma unroll
        for (int mt = 0; mt < 4; ++mt) { qb[mt] = QFRAG(2, mt); qb[4 + mt] = QFRAG(3, mt); }
        { const bf16x8 s0 = SFRAG(0), s1 = SFRAG(1);
#pragma unroll
          for (int mt = 0; mt < 4; ++mt) o[mt] = MFMA16(s0, qa[mt], o[mt]);
#pragma unroll
          for (int mt = 0; mt < 4; ++mt) o[mt] = MFMA16(s1, qa[4 + mt], o[mt]); }
        SCHED_FENCE();
        bf16x8 vf[2], pf[6];
#pragma unroll
        for (int ks = 0; ks < 2; ++ks) vf[ks] = *(const LAS bf16x8*)(VT + (16 * wv + r) * HK_STR + ks * 32 + q * 8);
#pragma unroll
        for (int mt = 0; mt < 4; ++mt) pf[mt] = *(const LAS bf16x8*)(Pm + (mt * 16 + r) * HK_STR + q * 8);
        pf[4] = *(const LAS bf16x8*)(Pm + (2 * 16 + r) * HK_STR + 32 + q * 8); pf[5] = *(const LAS bf16x8*)(Pm + (3 * 16 + r) * HK_STR + 32 + q * 8);
        { const bf16x8 s2 = SFRAG(2), s3 = SFRAG(3);
#pragma unroll
          for (int mt = 0; mt < 4; ++mt) o[mt] = MFMA16(s2, qb[mt], o[mt]);
#pragma unroll
          for (int mt = 0; mt < 4; ++mt) o[mt] = MFMA16(s3, qb[4 + mt], o[mt]); }
        SCHED_FENCE();
        f32x4 deca[4], decb[4]; bf16x8 kfa[8], kfb[8];
#pragma unroll
        for (int kt = 0; kt < 4; ++kt) { deca[kt] = *(const LAS f32x4*)(DEC + kt * 16 + q * 4); kfa[2 * kt] = *(const LAS bf16x8*)(KHT + (kt * 16 + r) * HK_STR + q * 8); kfa[2 * kt + 1] = *(const LAS bf16x8*)(KHT + (kt * 16 + r) * HK_STR + 32 + q * 8); }
#pragma unroll
        for (int mt = 0; mt < 4; ++mt) o[mt] = MFMA16(vf[0], pf[mt], o[mt]);
        o[2] = MFMA16(vf[1], pf[4], o[2]); o[3] = MFMA16(vf[1], pf[5], o[3]);
        SCHED_FENCE();
#pragma unroll
        for (int kt = 4; kt < 8; ++kt) { decb[kt - 4] = *(const LAS f32x4*)(DEC + kt * 16 + q * 4); kfb[2 * (kt - 4)] = *(const LAS bf16x8*)(KHT + (kt * 16 + r) * HK_STR + q * 8); kfb[2 * (kt - 4) + 1] = *(const LAS bf16x8*)(KHT + (kt * 16 + r) * HK_STR + 32 + q * 8); }
#pragma unroll
        for (int kt = 0; kt < 4; ++kt) { S[kt] = S[kt] * deca[kt]; S[kt] = MFMA16(kfa[2 * kt], vf[0], S[kt]); S[kt] = MFMA16(kfa[2 * kt + 1], vf[1], S[kt]); }
        SCHED_FENCE();
#pragma unroll
        for (int kt = 4; kt < 8; ++kt) { S[kt] = S[kt] * decb[kt - 4]; S[kt] = MFMA16(kfb[2 * (kt - 4)], vf[0], S[kt]); S[kt] = MFMA16(kfb[2 * (kt - 4) + 1], vf[1], S[kt]); }
        float ss[4];
#pragma unroll
        for (int mt = 0; mt < 4; ++mt) { ss[mt] = (o[mt].x * o[mt].x + o[mt].y * o[mt].y) + (o[mt].z * o[mt].z + o[mt].w * o[mt].w); X.o[mt] = o[mt]; }
        float t16[4];
#pragma unroll
        for (int mt = 0; mt < 4; ++mt) t16[mt] = __shfl_xor(ss[mt], 16);
        SCHED_FENCE();
#pragma unroll
        for (int mt = 0; mt < 4; ++mt) ss[mt] += t16[mt];
#pragma unroll
        for (int mt = 0; mt < 4; ++mt) t16[mt] = __shfl_xor(ss[mt], 32);
        SCHED_FENCE();
#pragma unroll
        for (int mt = 0; mt < 4; ++mt) { ss[mt] += t16[mt]; if (q == 0) SSQ[wv * 64 + mt * 16 + r] = ss[mt]; }
#undef QFRAG
#undef SFRAG
    }
}
__device__ __forceinline__ void scan_item(const bf16_t* Qg, const bf16_t* Kg, const bf16_t* Vg, const bf16_t* Pg, const float* DECg, bf16_t* HGg, const float* gnorm, int bh, LAS unsigned char* lds, bool dry = false) {
    int tid_l = threadIdx.x; asm volatile("" : "+v"(tid_l));
    const int tid = tid_l, lane = tid & 63, wv = __builtin_amdgcn_readfirstlane(tid >> 6), r = lane & 15, q = lane >> 4;
    f32x4 S[8];
#pragma unroll
    for (int kt = 0; kt < 8; ++kt) S[kt] = (f32x4){0.f, 0.f, 0.f, 0.f};
    const f32x4 g4 = *(const f32x4*)(gnorm + 16 * wv + q * 4);
    const size_t cb = (size_t)(bh & 7) * 128, mb = (size_t)(bh >> 3) * SEQ;
    ScanRegs X, Y;
    X.dc = (f32x4){0.f, 0.f, 0.f, 0.f}; Y.dc = X.dc;
#pragma unroll
    for (int mt = 0; mt < 4; ++mt) { X.o[mt] = (f32x4){0.f, 0.f, 0.f, 0.f}; Y.o[mt] = X.o[mt]; X.hg[mt] = (u32x2){0u, 0u}; Y.hg[mt] = X.hg[mt]; }
    asm volatile("" ::: "memory");
    scan_load(X, Qg, Kg, Vg, Pg, DECg, bh, 0, mb, cb, tid, lane, wv);
    scan_load(Y, Qg, Kg, Vg, Pg, DECg, bh, 1, mb, cb, tid, lane, wv);
#pragma unroll 1
    for (int n = 0; n < SEQ / 64; n += 2) {
        scan_chunk(X, Y, S, g4, n, Qg, Kg, Vg, Pg, DECg, HGg, bh, mb, cb, tid, lane, wv, r, q, lds, dry);
        scan_chunk(Y, X, S, g4, n + 1, Qg, Kg, Vg, Pg, DECg, HGg, bh, mb, cb, tid, lane, wv, r, q, lds, dry);
    }
    scan_chunk(X, Y, S, g4, SEQ / 64, Qg, Kg, Vg, Pg, DECg, HGg, bh, mb, cb, tid, lane, wv, r, q, lds, dry);
    __syncthreads();
}

constexpr int NSEG = 4, CPS = (SEQ / 64) / NSEG;
struct Scan1Regs { unsigned q2[8], k2[8], v2[8]; u32x4 pr; f32x4 dc; };
__device__ __forceinline__ void scan1_load(Scan1Regs& R, const bf16_t* Qg, const bf16_t* Kg, const bf16_t* Vg, const bf16_t* Pg, const float* DECg, int bh, int n, size_t mb, size_t cb, int tid, int lane, int wv) {
    R.pr = *(const u32x4*)(Pg + (size_t)(bh * 32 + n) * 4096 + tid * 8);
    R.dc = *(const f32x4*)(DECg + (size_t)(bh * 32 + n) * 128 + (tid & 31) * 4);
    const size_t rb = (mb + (size_t)n * 64 + wv * 8) * 1024 + cb + 2 * lane;
#pragma unroll
    for (int i = 0; i < 8; ++i) { R.q2[i] = *(const unsigned*)(Qg + rb + (size_t)i * 1024); R.k2[i] = *(const unsigned*)(Kg + rb + (size_t)i * 1024); R.v2[i] = *(const unsigned*)(Vg + rb + (size_t)i * 1024); }
    asm volatile("" ::: "memory");
}
#define SCHED_FENCE() __builtin_amdgcn_sched_barrier(0)
#define QFRAG(a, mt) __builtin_bit_cast(bf16x8, (u32x4){(*(const LAS u32x2*)(QH + ((mt) * 16 + r) * HQ_STR + 32 * (a) + q * 4)).x, (*(const LAS u32x2*)(QH + ((mt) * 16 + r) * HQ_STR + 32 * (a) + q * 4)).y, \
                                                        (*(const LAS u32x2*)(QH + ((mt) * 16 + r) * HQ_STR + 32 * (a) + 16 + q * 4)).x, (*(const LAS u32x2*)(QH + ((mt) * 16 + r) * HQ_STR + 32 * (a) + 16 + q * 4)).y})
#define SFRAG(a) __builtin_bit_cast(bf16x8, (u32x4){pk_bf16(S[2 * (a)][0], S[2 * (a)][1]), pk_bf16(S[2 * (a)][2], S[2 * (a)][3]), pk_bf16(S[2 * (a) + 1][0], S[2 * (a) + 1][1]), pk_bf16(S[2 * (a) + 1][2], S[2 * (a) + 1][3])})
__device__ __forceinline__ void scan1_chunk(Scan1Regs& X, f32x4 (&S)[8], int n, int nlast, const bf16_t* Qg, const bf16_t* Kg, bf16_t* Vg, const bf16_t* Pg, const float* DECg,
                                            int bh, size_t mb, size_t cb, int tid, int lane, int wv, int r, int q, LAS unsigned char* lds) {
    LAS unsigned char* B = lds + (n & 1) * SB_SIZE;
    const size_t m0 = mb + (size_t)n * 64;
    LAS bf16_t* QH = (LAS bf16_t*)(B + SB_QH); LAS bf16_t* KHT = (LAS bf16_t*)(B + SB_KHT); LAS bf16_t* VT = (LAS bf16_t*)(B + SB_VT); LAS bf16_t* Pm = (LAS bf16_t*)(B + SB_P);
    const LAS float* DEC = (const LAS float*)(B + SB_DEC);
#pragma unroll
    for (int i = 0; i < 8; ++i) *(LAS unsigned*)(QH + (wv * 8 + i) * HQ_STR + 2 * lane) = X.q2[i];
    { u32x4 lo, hi; const unsigned* k2 = X.k2;
      lo.x = (k2[0] & 0xffffu) | (k2[1] << 16); lo.y = (k2[2] & 0xffffu) | (k2[3] << 16); lo.z = (k2[4] & 0xffffu) | (k2[5] << 16); lo.w = (k2[6] & 0xffffu) | (k2[7] << 16);
      hi.x = (k2[0] >> 16) | (k2[1] & 0xffff0000u); hi.y = (k2[2] >> 16) | (k2[3] & 0xffff0000u); hi.z = (k2[4] >> 16) | (k2[5] & 0xffff0000u); hi.w = (k2[6] >> 16) | (k2[7] & 0xffff0000u);
      *(LAS u32x4*)(KHT + (2 * lane) * HK_STR + wv * 8) = lo; *(LAS u32x4*)(KHT + (2 * lane + 1) * HK_STR + wv * 8) = hi; }
    { u32x4 lo, hi; const unsigned* v2 = X.v2;
      lo.x = (v2[0] & 0xffffu) | (v2[1] << 16); lo.y = (v2[2] & 0xffffu) | (v2[3] << 16); lo.z = (v2[4] & 0xffffu) | (v2[5] << 16); lo.w = (v2[6] & 0xffffu) | (v2[7] << 16);
      hi.x = (v2[0] >> 16) | (v2[1] & 0xffff0000u); hi.y = (v2[2] >> 16) | (v2[3] & 0xffff0000u); hi.z = (v2[4] >> 16) | (v2[5] & 0xffff0000u); hi.w = (v2[6] >> 16) | (v2[7] & 0xffff0000u);
      *(LAS u32x4*)(VT + (2 * lane) * HK_STR + wv * 8) = lo; *(LAS u32x4*)(VT + (2 * lane + 1) * HK_STR + wv * 8) = hi; }
    *(LAS u32x4*)(Pm + (tid >> 3) * HK_STR + (tid & 7) * 8) = X.pr;
    if (tid < 32) *(LAS f32x4*)((LAS float*)(B + SB_DEC) + tid * 4) = X.dc;
    scan1_load(X, Qg, Kg, Vg, Pg, DECg, bh, (n + 2 <= nlast) ? n + 2 : nlast, mb, cb, tid, lane, wv);
    LBAR();
    f32x4 o[4];
#pragma unroll
    for (int mt = 0; mt < 4; ++mt) o[mt] = (f32x4){0.f, 0.f, 0.f, 0.f};
    bf16x8 qa[8], qb[8];
#pragma unroll
    for (int mt = 0; mt < 4; ++mt) { qa[mt] = QFRAG(0, mt); qa[4 + mt] = QFRAG(1, mt); }
    SCHED_FENCE();
#pragma unroll
    for (int mt = 0; mt < 4; ++mt) { qb[mt] = QFRAG(2, mt); qb[4 + mt] = QFRAG(3, mt); }
    { const bf16x8 s0 = SFRAG(0), s1 = SFRAG(1);
#pragma unroll
      for (int mt = 0; mt < 4; ++mt) o[mt] = MFMA16(s0, qa[mt], o[mt]);
#pragma unroll
      for (int mt = 0; mt < 4; ++mt) o[mt] = MFMA16(s1, qa[4 + mt], o[mt]); }
    SCHED_FENCE();
    bf16x8 vf[2], pf[6];
#pragma unroll
    for (int ks = 0; ks < 2; ++ks) vf[ks] = *(const LAS bf16x8*)(VT + (16 * wv + r) * HK_STR + ks * 32 + q * 8);
#pragma unroll
    for (int mt = 0; mt < 4; ++mt) pf[mt] = *(const LAS bf16x8*)(Pm + (mt * 16 + r) * HK_STR + q * 8);
    pf[4] = *(const LAS bf16x8*)(Pm + (2 * 16 + r) * HK_STR + 32 + q * 8); pf[5] = *(const LAS bf16x8*)(Pm + (3 * 16 + r) * HK_STR + 32 + q * 8);
    { const bf16x8 s2 = SFRAG(2), s3 = SFRAG(3);
#pragma unroll
      for (int mt = 0; mt < 4; ++mt) o[mt] = MFMA16(s2, qb[mt], o[mt]);
#pragma unroll
      for (int mt = 0; mt < 4; ++mt) o[mt] = MFMA16(s3, qb[4 + mt], o[mt]); }
    SCHED_FENCE();
    f32x4 deca[4], decb[4]; bf16x8 kfa[8], kfb[8];
#pragma unroll
    for (int kt = 0; kt < 4; ++kt) { deca[kt] = *(const LAS f32x4*)(DEC + kt * 16 + q * 4); kfa[2 * kt] = *(const LAS bf16x8*)(KHT + (kt * 16 + r) * HK_STR + q * 8); kfa[2 * kt + 1] = *(const LAS bf16x8*)(KHT + (kt * 16 + r) * HK_STR + 32 + q * 8); }
#pragma unroll
    for (int mt = 0; mt < 4; ++mt) o[mt] = MFMA16(vf[0], pf[mt], o[mt]);
    o[2] = MFMA16(vf[1], pf[4], o[2]); o[3] = MFMA16(vf[1], pf[5], o[3]);
    SCHED_FENCE();
#pragma unroll
    for (int kt = 4; kt < 8; ++kt) { decb[kt - 4] = *(const LAS f32x4*)(DEC + kt * 16 + q * 4); kfb[2 * (kt - 4)] = *(const LAS bf16x8*)(KHT + (kt * 16 + r) * HK_STR + q * 8); kfb[2 * (kt - 4) + 1] = *(const LAS bf16x8*)(KHT + (kt * 16 + r) * HK_STR + 32 + q * 8); }
#pragma unroll
    for (int kt = 0; kt < 4; ++kt) { S[kt] = S[kt] * deca[kt]; S[kt] = MFMA16(kfa[2 * kt], vf[0], S[kt]); S[kt] = MFMA16(kfa[2 * kt + 1], vf[1], S[kt]); }
    SCHED_FENCE();
#pragma unroll
    for (int kt = 4; kt < 8; ++kt) { S[kt] = S[kt] * decb[kt - 4]; S[kt] = MFMA16(kfb[2 * (kt - 4)], vf[0], S[kt]); S[kt] = MFMA16(kfb[2 * (kt - 4) + 1], vf[1], S[kt]); }
#pragma unroll
    for (int mt = 0; mt < 4; ++mt) { u32x2 w; w.x = pk_bf16(o[mt].x, o[mt].y); w.y = pk_bf16(o[mt].z, o[mt].w);
        *(u32x2*)(Vg + (m0 + mt * 16 + r) * 1024 + cb + 16 * wv + q * 4) = w; }
}
__device__ __forceinline__ void scan1_item(const bf16_t* Qg, const bf16_t* Kg, bf16_t* Vg, const bf16_t* Pg, const float* DECg, float* SLOC, float* DSEG, int item, LAS unsigned char* lds) {
    int tid_l = threadIdx.x; asm volatile("" : "+v"(tid_l));
    const int tid = tid_l, lane = tid & 63, wv = __builtin_amdgcn_readfirstlane(tid >> 6), r = lane & 15, q = lane >> 4;
    const int bh = item >> 2, seg = item & 3, n0 = seg * CPS, nlast = n0 + CPS - 1;
    f32x4 S[8];
#pragma unroll
    for (int kt = 0; kt < 8; ++kt) S[kt] = (f32x4){0.f, 0.f, 0.f, 0.f};
    const size_t cb = (size_t)(bh & 7) * 128, mb = (size_t)(bh >> 3) * SEQ;
    Scan1Regs X, Y;
    asm volatile("" ::: "memory");
    scan1_load(X, Qg, Kg, Vg, Pg, DECg, bh, n0, mb, cb, tid, lane, wv);
    scan1_load(Y, Qg, Kg, Vg, Pg, DECg, bh, n0 + 1, mb, cb, tid, lane, wv);
#pragma unroll 1
    for (int n = n0; n <= nlast; n += 2) {
        scan1_chunk(X, S, n, nlast, Qg, Kg, Vg, Pg, DECg, bh, mb, cb, tid, lane, wv, r, q, lds);
        scan1_chunk(Y, S, n + 1, nlast, Qg, Kg, Vg, Pg, DECg, bh, mb, cb, tid, lane, wv, r, q, lds);
    }
    f32x4* sl = (f32x4*)SLOC + ((size_t)item * 8 + wv) * 8 * 64 + lane;
#pragma unroll
    for (int kt = 0; kt < 8; ++kt) sl[kt * 64] = S[kt];
    if (wv == 0) { f32x4* ds = (f32x4*)DSEG + (size_t)item * 8 * 64 + lane;
#pragma unroll
        for (int kt = 0; kt < 8; ++kt) { f32x4 cdv = (f32x4){1.f, 1.f, 1.f, 1.f};
            for (int n = n0; n <= nlast; ++n) cdv = cdv * *(const f32x4*)(DECg + (size_t)(bh * 32 + n) * 128 + kt * 16 + q * 4);
            ds[kt * 64] = cdv; } }
    __syncthreads();
}

constexpr int F_QH = 0, F_QT = 17408, F_KT = 34816, F_KHT = 52224, F_VT = 70656, F_P = 89088, F_TOT = 98304, F_DEC = 102400;
struct FRegs { unsigned q2[8], z2[8], v2[8]; };
__device__ __forceinline__ void f_load(FRegs& R, const bf16_t* Qg, const bf16_t* LFg, const bf16_t* Vg, int n, size_t mb, size_t cb, int lane, int wv) {
    const size_t rb = (mb + (size_t)n * 64 + wv * 8) * 1024 + cb + 2 * lane;
#pragma unroll
    for (int i = 0; i < 8; ++i) { R.q2[i] = *(const unsigned*)(Qg + rb + (size_t)i * 1024); R.z2[i] = *(const unsigned*)(LFg + rb + (size_t)i * 1024); R.v2[i] = *(const unsigned*)(Vg + rb + (size_t)i * 1024); }
    asm volatile("" ::: "memory");
}
__device__ __forceinline__ void f_chunk(FRegs& X, f32x4 (&S)[8], int n, int nlast, const float lb0, const float lb1, bf16_t* Qg, const bf16_t* LFg, bf16_t* Vg, float* DECg,
                                        int bh, size_t mb, size_t cb, int tid, int lane, int wv, int r, int q, LAS unsigned char* lds) {
    LAS bf16_t* QH = (LAS bf16_t*)(lds + F_QH); LAS bf16_t* QT = (LAS bf16_t*)(lds + F_QT); LAS bf16_t* KT = (LAS bf16_t*)(lds + F_KT);
    LAS bf16_t* KHT = (LAS bf16_t*)(lds + F_KHT); LAS bf16_t* VT = (LAS bf16_t*)(lds + F_VT); LAS bf16_t* Pm = (LAS bf16_t*)(lds + F_P);
    LAS float* TOT = (LAS float*)(lds + F_TOT); LAS float* DEC = (LAS float*)(lds + F_DEC);
    const size_t m0 = mb + (size_t)n * 64, rb = (m0 + wv * 8) * 1024 + cb + 2 * lane;
    float f0[8], f1[8]; float run0 = 0.f, run1 = 0.f;
#pragma unroll
    for (int i = 0; i < 8; ++i) { const float z0 = h_lo(X.z2[i]), z1 = h_hi(X.z2[i]);
        f0[i] = fmaxf(lb0 + (1.f - lb0) * sigmoid_f(z0), 1e-30f); f1[i] = fmaxf(lb1 + (1.f - lb1) * sigmoid_f(z1), 1e-30f); run0 += __logf(f0[i]); run1 += __logf(f1[i]); }
    *(LAS f32x2*)(TOT + wv * 128 + 2 * lane) = (f32x2){run0, run1};
    LBAR();
    float pre0 = 0.f, pre1 = 0.f, last0 = 0.f, last1 = 0.f;
#pragma unroll
    for (int w = 0; w < 8; ++w) { const f32x2 t = *(const LAS f32x2*)(TOT + w * 128 + 2 * lane); last0 += t.x; last1 += t.y; if (w < wv) { pre0 += t.x; pre1 += t.y; } }
    if (wv == 0) { const f32x2 dv = (f32x2){__expf(last0), __expf(last1)}; *(LAS f32x2*)(DEC + 2 * lane) = dv; *(f32x2*)(DECg + (size_t)(bh * 32 + n) * 128 + 2 * lane) = dv; }
    const float sc0 = __expf(fminf(-0.5f * last0, 60.f)), sc1 = __expf(fminf(-0.5f * last1, 60.f));
    float pf0 = __expf(pre0), pf1 = __expf(pre1), sf0 = __expf(last0 - pre0 - run0), sf1 = __expf(last1 - pre1 - run1);
    { float kh0[8], kh1[8];
#pragma unroll
      for (int i = 7; i >= 0; --i) { kh0[i] = (1.f - f0[i]) * sf0; kh1[i] = (1.f - f1[i]) * sf1; sf0 *= f0[i]; sf1 *= f1[i]; }
#pragma unroll
      for (int i = 0; i < 8; ++i) { pf0 *= f0[i]; pf1 *= f1[i];
          const float qh0 = silu_f(bf_lo(X.q2[i])) * pf0, qh1 = silu_f(bf_hi(X.q2[i])) * pf1; const int t = wv * 8 + i; const unsigned qp = pk_bf16(qh0, qh1);
          *(unsigned*)(Qg + rb + (size_t)i * 1024) = qp;
          *(LAS unsigned*)(QH + t * HQ_STR + 2 * lane) = qp;
          *(LAS unsigned*)(QT + t * HQ_STR + 2 * lane) = pk_bf16(qh0 * sc0, qh1 * sc1);
          *(LAS unsigned*)(KT + t * HQ_STR + 2 * lane) = pk_bf16(kh0[i] * sc0, kh1[i] * sc1); }
      u32x4 a, c; a.x = pk_bf16(kh0[0], kh0[1]); a.y = pk_bf16(kh0[2], kh0[3]); a.z = pk_bf16(kh0[4], kh0[5]); a.w = pk_bf16(kh0[6], kh0[7]);
      c.x = pk_bf16(kh1[0], kh1[1]); c.y = pk_bf16(kh1[2], kh1[3]); c.z = pk_bf16(kh1[4], kh1[5]); c.w = pk_bf16(kh1[6], kh1[7]);
      *(LAS u32x4*)(KHT + (2 * lane) * HK_STR + wv * 8) = a; *(LAS u32x4*)(KHT + (2 * lane + 1) * HK_STR + wv * 8) = c; }
    { u32x4 lo, hi; const unsigned* v2 = X.v2;
      lo.x = (v2[0] & 0xffffu) | (v2[1] << 16); lo.y = (v2[2] & 0xffffu) | (v2[3] << 16); lo.z = (v2[4] & 0xffffu) | (v2[5] << 16); lo.w = (v2[6] & 0xffffu) | (v2[7] << 16);
      hi.x = (v2[0] >> 16) | (v2[1] & 0xffff0000u); hi.y = (v2[2] >> 16) | (v2[3] & 0xffff0000u); hi.z = (v2[4] >> 16) | (v2[5] & 0xffff0000u); hi.w = (v2[6] >> 16) | (v2[7] & 0xffff0000u);
      *(LAS u32x4*)(VT + (2 * lane) * HK_STR + wv * 8) = lo; *(LAS u32x4*)(VT + (2 * lane + 1) * HK_STR + wv * 8) = hi; }
    f_load(X, Qg, LFg, Vg, (n + 2 <= nlast) ? n + 2 : nlast, mb, cb, lane, wv);
    LBAR();
    const int ti = wv >> 1;
    { bf16x8 qf[4], kf[2][4];
#pragma unroll
      for (int ks = 0; ks < 4; ++ks) { qf[ks] = *(const LAS bf16x8*)(QT + (ti * 16 + r) * HQ_STR + ks * 32 + q * 8);
          kf[0][ks] = *(const LAS bf16x8*)(KT + ((2 * (wv & 1)) * 16 + r) * HQ_STR + ks * 32 + q * 8); kf[1][ks] = *(const LAS bf16x8*)(KT + ((2 * (wv & 1) + 1) * 16 + r) * HQ_STR + ks * 32 + q * 8); }
      SCHED_FENCE();
#pragma unroll
      for (int jj = 0; jj < 2; ++jj) { const int tj = 2 * (wv & 1) + jj; f32x4 sc = (f32x4){0.f, 0.f, 0.f, 0.f};
          if (tj <= ti) {
#pragma unroll
              for (int ks = 0; ks < 4; ++ks) sc = MFMA16(kf[jj][ks], qf[ks], sc); }
          const int t = ti * 16 + r, s0 = tj * 16 + q * 4;
#pragma unroll
          for (int j = 0; j < 4; ++j) sc[j] = (s0 + j <= t) ? sc[j] : 0.f;
          u32x2 w; w.x = pk_bf16(sc[0], sc[1]); w.y = pk_bf16(sc[2], sc[3]);
          *(LAS u32x2*)(Pm + t * HK_STR + s0) = w; } }
    f32x4 o[4];
#pragma unroll
    for (int mt = 0; mt < 4; ++mt) o[mt] = (f32x4){0.f, 0.f, 0.f, 0.f};
    { bf16x8 qa[8], qb[8];
#pragma unroll
      for (int mt = 0; mt < 4; ++mt) { qa[mt] = QFRAG(0, mt); qa[4 + mt] = QFRAG(1, mt); }
      SCHED_FENCE();
#pragma unroll
      for (int mt = 0; mt < 4; ++mt) { qb[mt] = QFRAG(2, mt); qb[4 + mt] = QFRAG(3, mt); }
      { const bf16x8 s0 = SFRAG(0), s1 = SFRAG(1);
#pragma unroll
        for (int mt = 0; mt < 4; ++mt) o[mt] = MFMA16(s0, qa[mt], o[mt]);
#pragma unroll
        for (int mt = 0; mt < 4; ++mt) o[mt] = MFMA16(s1, qa[4 + mt], o[mt]); }
      SCHED_FENCE();
      { const bf16x8 s2 = SFRAG(2), s3 = SFRAG(3);
#pragma unroll
        for (int mt = 0; mt < 4; ++mt) o[mt] = MFMA16(s2, qb[mt], o[mt]);
#pragma unroll
        for (int mt = 0; mt < 4; ++mt) o[mt] = MFMA16(s3, qb[4 + mt], o[mt]); } }
    LBAR();
    bf16x8 vf[2], pf[6];
#pragma unroll
    for (int ks = 0; ks < 2; ++ks) vf[ks] = *(const LAS bf16x8*)(VT + (16 * wv + r) * HK_STR + ks * 32 + q * 8);
#pragma unroll
    for (int mt = 0; mt < 4; ++mt) pf[mt] = *(const LAS bf16x8*)(Pm + (mt * 16 + r) * HK_STR + q * 8);
    pf[4] = *(const LAS bf16x8*)(Pm + (2 * 16 + r) * HK_STR + 32 + q * 8); pf[5] = *(const LAS bf16x8*)(Pm + (3 * 16 + r) * HK_STR + 32 + q * 8);
    SCHED_FENCE();
    f32x4 deca[4], decb[4]; bf16x8 kfa[8], kfb[8];
#pragma unroll
    for (int kt = 0; kt < 4; ++kt) { deca[kt] = *(const LAS f32x4*)(DEC + kt * 16 + q * 4); kfa[2 * kt] = *(const LAS bf16x8*)(KHT + (kt * 16 + r) * HK_STR + q * 8); kfa[2 * kt + 1] = *(const LAS bf16x8*)(KHT + (kt * 16 + r) * HK_STR + 32 + q * 8); }
#pragma unroll
    for (int mt = 0; mt < 4; ++mt) o[mt] = MFMA16(vf[0], pf[mt], o[mt]);
    o[2] = MFMA16(vf[1], pf[4], o[2]); o[3] = MFMA16(vf[1], pf[5], o[3]);
    SCHED_FENCE();
#pragma unroll
    for (int kt = 4; kt < 8; ++kt) { decb[kt - 4] = *(const LAS f32x4*)(DEC + kt * 16 + q * 4); kfb[2 * (kt - 4)] = *(const LAS bf16x8*)(KHT + (kt * 16 + r) * HK_STR + q * 8); kfb[2 * (kt - 4) + 1] = *(const LAS bf16x8*)(KHT + (kt * 16 + r) * HK_STR + 32 + q * 8); }
#pragma unroll
    for (int kt = 0; kt < 4; ++kt) { S[kt] = S[kt] * deca[kt]; S[kt] = MFMA16(kfa[2 * kt], vf[0], S[kt]); S[kt] = MFMA16(kfa[2 * kt + 1], vf[1], S[kt]); }
    SCHED_FENCE();
#pragma unroll
    for (int kt = 4; kt < 8; ++kt) { S[kt] = S[kt] * decb[kt - 4]; S[kt] = MFMA16(kfb[2 * (kt - 4)], vf[0], S[kt]); S[kt] = MFMA16(kfb[2 * (kt - 4) + 1], vf[1], S[kt]); }
#pragma unroll
    for (int mt = 0; mt < 4; ++mt) { u32x2 w; w.x = pk_bf16(o[mt].x, o[mt].y); w.y = pk_bf16(o[mt].z, o[mt].w);
        *(u32x2*)(Vg + (m0 + mt * 16 + r) * 1024 + cb + 16 * wv + q * 4) = w; }
}
__device__ __forceinline__ void f_item(bf16_t* Qg, const bf16_t* LFg, bf16_t* Vg, float* DECg, float* SLOC, float* DSEG, const float* lbl, int item, LAS unsigned char* lds) {
    int tid_l = threadIdx.x; asm volatile("" : "+v"(tid_l));
    const int tid = tid_l, lane = tid & 63, wv = __builtin_amdgcn_readfirstlane(tid >> 6), r = lane & 15, q = lane >> 4;
    const int bh = item >> 2, seg = item & 3, n0 = seg * CPS, nlast = n0 + CPS - 1;
    f32x4 S[8];
#pragma unroll
    for (int kt = 0; kt < 8; ++kt) S[kt] = (f32x4){0.f, 0.f, 0.f, 0.f};
    const size_t cb = (size_t)(bh & 7) * 128, mb = (size_t)(bh >> 3) * SEQ;
    const f32x2 lbp = *(const f32x2*)(lbl + (bh & 7) * 128 + 2 * lane);
    FRegs X, Y;
    asm volatile("" ::: "memory");
    f_load(X, Qg, LFg, Vg, n0, mb, cb, lane, wv);
    f_load(Y, Qg, LFg, Vg, n0 + 1, mb, cb, lane, wv);
#pragma unroll 1
    for (int n = n0; n <= nlast; n += 2) {
        f_chunk(X, S, n, nlast, lbp.x, lbp.y, Qg, LFg, Vg, DECg, bh, mb, cb, tid, lane, wv, r, q, lds);
        f_chunk(Y, S, n + 1, nlast, lbp.x, lbp.y, Qg, LFg, Vg, DECg, bh, mb, cb, tid, lane, wv, r, q, lds);
    }
    f32x4* sl = (f32x4*)SLOC + ((size_t)item * 8 + wv) * 8 * 64 + lane;
#pragma unroll
    for (int kt = 0; kt < 8; ++kt) sl[kt * 64] = S[kt];
    __syncthreads();
    if (wv == 0) { f32x4* ds = (f32x4*)DSEG + (size_t)item * 8 * 64 + lane;
#pragma unroll
        for (int kt = 0; kt < 8; ++kt) { f32x4 cdv = (f32x4){1.f, 1.f, 1.f, 1.f};
            for (int n = n0; n <= nlast; ++n) cdv = cdv * *(const f32x4*)(DECg + (size_t)(bh * 32 + n) * 128 + kt * 16 + q * 4);
            ds[kt * 64] = cdv; } }
    __syncthreads();
}

struct Scan2Regs { unsigned q2[8]; f32x4 dc; u32x2 ol[4], hg[4], hgc[4]; f32x4 o[4]; };
__device__ __forceinline__ void scan2_load(Scan2Regs& R, const bf16_t* Qg, const bf16_t* OLg, const bf16_t* HGg, const float* DECg, int bh, int n, size_t mb, size_t cb, int tid, int lane, int wv, int r, int q) {
    R.dc = *(const f32x4*)(DECg + (size_t)(bh * 32 + n) * 128 + (tid & 31) * 4);
    const size_t rb = (mb + (size_t)n * 64 + wv * 8) * 1024 + cb + 2 * lane;
#pragma unroll
    for (int i = 0; i < 8; ++i) R.q2[i] = *(const unsigned*)(Qg + rb + (size_t)i * 1024);
#pragma unroll
    for (int mt = 0; mt < 4; ++mt) { const size_t ob = (mb + (size_t)n * 64 + mt * 16 + r) * 1024 + cb + 16 * wv + q * 4; R.ol[mt] = *(const u32x2*)(OLg + ob); R.hg[mt] = *(const u32x2*)(HGg + ob); }
    asm volatile("" ::: "memory");
}
__device__ __forceinline__ void scan2_chunk(Scan2Regs& X, Scan2Regs& Y, f32x4 (&S)[8], const f32x4 g4, int n, int n0, int nlast, const bf16_t* Qg, const bf16_t* OLg, bf16_t* HGg, const float* DECg,
                                            int bh, size_t mb, size_t cb, int tid, int lane, int wv, int r, int q, LAS unsigned char* lds) {
    LAS unsigned char* B = lds + (n & 1) * SB_SIZE;
    const size_t m0 = mb + (size_t)n * 64;
    u32x2 olx[4];
    if (n <= nlast) {
        LAS bf16_t* QH = (LAS bf16_t*)(B + SB_QH);
#pragma unroll
        for (int i = 0; i < 8; ++i) *(LAS unsigned*)(QH + (wv * 8 + i) * HQ_STR + 2 * lane) = X.q2[i];
        if (tid < 32) *(LAS f32x4*)((LAS float*)(B + SB_DEC) + tid * 4) = X.dc;
#pragma unroll
        for (int mt = 0; mt < 4; ++mt) { X.hgc[mt] = X.hg[mt]; olx[mt] = X.ol[mt]; }
        scan2_load(X, Qg, OLg, HGg, DECg, bh, (n + 2 <= nlast) ? n + 2 : nlast, mb, cb, tid, lane, wv, r, q);
    }
    LBAR();
    if (n > n0) {
        const LAS float* SSQ = (const LAS float*)(lds + ((n - 1) & 1) * SB_SIZE + SB_SSQ);
#pragma unroll
        for (int mt = 0; mt < 4; ++mt) { float tot = 0.f;
#pragma unroll
            for (int w = 0; w < 8; ++w) tot += SSQ[w * 64 + mt * 16 + r];
            const float rstd = rsqrtf(tot * (1.f / 128.f) + EPS);
            const f32x4 ov = Y.o[mt] * rstd * g4 * (f32x4){silu_f(bf_lo(Y.hgc[mt].x)), silu_f(bf_hi(Y.hgc[mt].x)), silu_f(bf_lo(Y.hgc[mt].y)), silu_f(bf_hi(Y.hgc[mt].y))};
            u32x2 w; w.x = pk_bf16(ov.x, ov.y); w.y = pk_bf16(ov.z, ov.w);
            *(u32x2*)(HGg + (m0 - 64 + mt * 16 + r) * 1024 + cb + 16 * wv + q * 4) = w; }
    }
    if (n <= nlast) {
        const LAS bf16_t* QH = (const LAS bf16_t*)(B + SB_QH); const LAS float* DEC = (const LAS float*)(B + SB_DEC); LAS float* SSQ = (LAS float*)(B + SB_SSQ);
        f32x4 o[4];
#pragma unroll
        for (int mt = 0; mt < 4; ++mt) o[mt] = (f32x4){bf_lo(olx[mt].x), bf_hi(olx[mt].x), bf_lo(olx[mt].y), bf_hi(olx[mt].y)};
        bf16x8 qa[8], qb[8];
#pragma unroll
        for (int mt = 0; mt < 4; ++mt) { qa[mt] = QFRAG(0, mt); qa[4 + mt] = QFRAG(1, mt); }
        SCHED_FENCE();
#pragma unroll
        for (int mt = 0; mt < 4; ++mt) { qb[mt] = QFRAG(2, mt); qb[4 + mt] = QFRAG(3, mt); }
        { const bf16x8 s0 = SFRAG(0), s1 = SFRAG(1);
#pragma unroll
          for (int mt = 0; mt < 4; ++mt) o[mt] = MFMA16(s0, qa[mt], o[mt]);
#pragma unroll
          for (int mt = 0; mt < 4; ++mt) o[mt] = MFMA16(s1, qa[4 + mt], o[mt]); }
        SCHED_FENCE();
        f32x4 dec[8];
#pragma unroll
        for (int kt = 0; kt < 8; ++kt) dec[kt] = *(const LAS f32x4*)(DEC + kt * 16 + q * 4);
        { const bf16x8 s2 = SFRAG(2), s3 = SFRAG(3);
#pragma unroll
          for (int mt = 0; mt < 4; ++mt) o[mt] = MFMA16(s2, qb[mt], o[mt]);
#pragma unroll
          for (int mt = 0; mt < 4; ++mt) o[mt] = MFMA16(s3, qb[4 + mt], o[mt]); }
        SCHED_FENCE();
#pragma unroll
        for (int kt = 0; kt < 8; ++kt) S[kt] = S[kt] * dec[kt];
        float ss[4], t16[4];
#pragma unroll
        for (int mt = 0; mt < 4; ++mt) { ss[mt] = (o[mt].x * o[mt].x + o[mt].y * o[mt].y) + (o[mt].z * o[mt].z + o[mt].w * o[mt].w); X.o[mt] = o[mt]; }
#pragma unroll
        for (int mt = 0; mt < 4; ++mt) t16[mt] = __shfl_xor(ss[mt], 16);
        SCHED_FENCE();
#pragma unroll
        for (int mt = 0; mt < 4; ++mt) ss[mt] += t16[mt];
#pragma unroll
        for (int mt = 0; mt < 4; ++mt) t16[mt] = __shfl_xor(ss[mt], 32);
        SCHED_FENCE();
#pragma unroll
        for (int mt = 0; mt < 4; ++mt) { ss[mt] += t16[mt]; if (q == 0) SSQ[wv * 64 + mt * 16 + r] = ss[mt]; }
    }
}
__device__ __forceinline__ void scan2_item(const bf16_t* Qg, const bf16_t* OLg, bf16_t* HGg, const float* DECg, const float* SLOC, const float* DSEG, const float* gnorm, int item, LAS unsigned char* lds) {
    int tid_l = threadIdx.x; asm volatile("" : "+v"(tid_l));
    const int tid = tid_l, lane = tid & 63, wv = __builtin_amdgcn_readfirstlane(tid >> 6), r = lane & 15, q = lane >> 4;
    const int bh = item >> 2, seg = item & 3, n0 = seg * CPS, nlast = n0 + CPS - 1;
    const f32x4 g4 = *(const f32x4*)(gnorm + 16 * wv + q * 4);
    const size_t cb = (size_t)(bh & 7) * 128, mb = (size_t)(bh >> 3) * SEQ;
    Scan2Regs X, Y;
#pragma unroll
    for (int mt = 0; mt < 4; ++mt) { X.o[mt] = (f32x4){0.f, 0.f, 0.f, 0.f}; Y.o[mt] = X.o[mt]; X.hgc[mt] = (u32x2){0u, 0u}; Y.hgc[mt] = X.hgc[mt]; }
    asm volatile("" ::: "memory");
    scan2_load(X, Qg, OLg, HGg, DECg, bh, n0, mb, cb, tid, lane, wv, r, q);
    scan2_load(Y, Qg, OLg, HGg, DECg, bh, n0 + 1, mb, cb, tid, lane, wv, r, q);
    f32x4 S[8];
#pragma unroll
    for (int kt = 0; kt < 8; ++kt) S[kt] = (f32x4){0.f, 0.f, 0.f, 0.f};
    for (int j = 0; j < seg; ++j) {
        const f32x4* sl = (const f32x4*)SLOC + ((size_t)(bh * NSEG + j) * 8 + wv) * 8 * 64 + lane; const f32x4* ds = (const f32x4*)DSEG + (size_t)(bh * NSEG + j) * 8 * 64 + lane;
#pragma unroll
        for (int kt = 0; kt < 8; ++kt) S[kt] = S[kt] * ds[kt * 64] + sl[kt * 64];
    }
#pragma unroll 1
    for (int n = n0; n <= nlast; n += 2) {
        scan2_chunk(X, Y, S, g4, n, n0, nlast, Qg, OLg, HGg, DECg, bh, mb, cb, tid, lane, wv, r, q, lds);
        scan2_chunk(Y, X, S, g4, n + 1, n0, nlast, Qg, OLg, HGg, DECg, bh, mb, cb, tid, lane, wv, r, q, lds);
    }
    scan2_chunk(X, Y, S, g4, nlast + 1, n0, nlast, Qg, OLg, HGg, DECg, bh, mb, cb, tid, lane, wv, r, q, lds);
    __syncthreads();
}
#undef QFRAG
#undef SFRAG

__global__ void __launch_bounds__(512, 2) fwd_megakernel(Params p) {
    extern __shared__ __attribute__((aligned(16))) unsigned char lds_raw[];
    LAS unsigned char* lds = (LAS unsigned char*)lds_raw;
#ifdef USE_CG_SYNC
    cg::grid_group grid = cg::this_grid();
#endif
    const int G = gridDim.x, blk = blockIdx.x;
    unsigned char* ws = p.ws;
    float* ADA = (float*)(ws + WS_ADA);
    bf16_t* H = (bf16_t*)(ws + WS_H); bf16_t* PV = (bf16_t*)(ws + WS_PV); bf16_t* PG = (bf16_t*)(ws + WS_PG); bf16_t* Q = (bf16_t*)(ws + WS_Q);
    bf16_t* LF = (bf16_t*)(ws + WS_LF); bf16_t* V = (bf16_t*)(ws + WS_V); bf16_t* HG = (bf16_t*)(ws + WS_HG);
    bf16_t* GATE = Q; bf16_t* MERGED = LF; bf16_t* Y = V;

    volatile LAS unsigned* stw = (volatile LAS unsigned*)(lds + LDS_BARW);
    unsigned* barw = (unsigned*)(ws + WS_BAR);
    if (threadIdx.x < 4) stw[threadIdx.x] = 0u;
    __syncthreads();
#ifdef USE_CG_SYNC
    if (blk == 0) for (int i = threadIdx.x; i < XCD_BAR_WORDS; i += 512) barw[i] = 0u;
    p0_prologue(p, lds);
    grid.sync();
    const XcdBarrier xb = xcd_barrier_post(barw, stw);
#else
    const XcdBarrier xb = xcd_barrier_post(barw, stw);
    p0_prologue(p, lds);
#ifdef DUP_P0
    __syncthreads(); p0_prologue(p, lds);
#endif
    xcd_barrier(xb);
#endif
#define GSYNC() xcd_barrier(xb)
#pragma unroll 1
    for (int l = 0; l < NL; ++l) {
#ifndef SKIP_P1
        if (l == 0) p1_rows<false, true>(p.x, nullptr, nullptr, nullptr, nullptr, p.g_pre, ADA, H);
        else p1_rows<true, true>(p.x, Y, ADA + (size_t)(l - 1) * NB * 3072, p.g_post + (size_t)(l - 1) * D, p.out, p.g_pre + (size_t)l * D, ADA + (size_t)l * NB * 3072, H);
#ifdef DUP_P1
        if (l == 0) p1_rows<false, true>(p.x, nullptr, nullptr, nullptr, nullptr, p.g_pre, ADA, H);
        else p1_rows<true, true>(p.x, Y, ADA + (size_t)(l - 1) * NB * 3072, p.g_post + (size_t)(l - 1) * D, p.out, p.g_pre + (size_t)l * D, ADA + (size_t)l * NB * 3072, H);
#endif
#endif
        GSYNC();
#pragma unroll 1
        for (int s = 0; s < 4; ++s) {
            const bf16_t* WinT = (const bf16_t*)(ws + WS_WIN) + (size_t)l * INW * D;
            pg8::Gemm g; g.M = M; g.N = D; g.K = D; g.A = nullptr; g.Bt = nullptr;
            pg8::StaticOrder S;
            if (s == 0) { g.N = NIN; S.init(M, NIN, G, blk); S.A0 = H; S.B0 = WinT; S.mode0 = 0; }
            else if (s == 1) { S.init(M, D, G, blk); S.dup = 3; S.A0 = H; S.B0 = WinT + (size_t)5120 * D; S.mode0 = 1;
                               S.A2 = HG; S.B2 = (const bf16_t*)(ws + WS_WHO) + (size_t)l * D * D; S.mode2 = 2; }
            else if (s == 2) { g.K = 512; S.init(M, D, G, blk); S.A0 = PG; S.B0 = (const bf16_t*)(ws + WS_WPO) + (size_t)l * D * 512; S.mode0 = 3; }
            else { S.init(M, D, G, blk); S.A0 = MERGED; S.B0 = (const bf16_t*)(ws + WS_WOUT) + (size_t)l * D * D; S.mode0 = 4; }
            EpiU E{ws};
#ifdef PROBE_G
            const unsigned long long tg0 = __builtin_amdgcn_s_memrealtime();
#endif
            pg8::gemm_phase<EpiU, pg8::StaticOrder, PG8_ALIGN_SEL, true>(lds, g, S, E);
#ifdef PROBE_G
            if ((PROBE_G >> s) & 1) probe_acc += __builtin_amdgcn_s_memrealtime() - tg0;
#endif
            if (s == 0) {
                GSYNC();
#ifdef PROBE_P3
                const unsigned long long tp0 = __builtin_amdgcn_s_memrealtime();
#endif
                bf16_t* Pg = (bf16_t*)(ws + WS_P); float* DECg = (float*)(ws + WS_DEC);
                float* SLOC = (float*)(ws + WS_P); float* DSEG = (float*)(ws + WS_DSEG);
                const bool own = (G == NB * 8 * NSEG);
                if (own) f_item(Q, LF, V, DECg, SLOC, DSEG, (const float*)(ws + WS_LB) + l * 1024, blk, lds);
                else prep_items(Q, LF, Pg, DECg, (const float*)(ws + WS_LB) + l * 1024, blk, G, 2048, lds);
                for (int pi = blk; pi < 1024; pi += G) {
                    const int gq = pi & 3, m0 = (pi >> 2) * 64;
                    const bf16_t* pw = (const bf16_t*)(ws + WS_POOLWT) + (size_t)(l * 4 + gq) * 16384; const float* ps = p.pool_scale + l * 512 + gq * 128;
                    if (gq == 0) pool_item<2>(PV, PG, pw, ps, m0, gq, lds); else if (gq == 1) pool_item<4>(PV, PG, pw, ps, m0, gq, lds);
                    else if (gq == 2) pool_item<8>(PV, PG, pw, ps, m0, gq, lds); else pool_item<16>(PV, PG, pw, ps, m0, gq, lds);
                }
                if (!own) { GSYNC(); for (int it = blk; it < NB * 8 * NSEG; it += G) scan1_item(Q, LF, V, Pg, DECg, SLOC, DSEG, it, lds); }
                GSYNC();
                for (int it = blk; it < NB * 8 * NSEG; it += G) scan2_item(Q, V, HG, DECg, SLOC, DSEG, p.hgrn_norm_g + l * 128, it, lds);
                GSYNC();
            } else if (s >= 2) GSYNC();
        }
    }
#ifdef DUP_SYNC
    for (int i = 0; i < 16; ++i) GSYNC();
#endif
    p1_rows<true, false>(p.out, Y, ADA + (size_t)(NL - 1) * NB * 3072, p.g_post + (size_t)(NL - 1) * D, p.out, nullptr, nullptr, nullptr);
#if defined(PROBE_P3) || defined(PROBE_G)
    __syncthreads();
    if (blk == 0 && threadIdx.x == 0) p.out[0] = 25.f * floorf((float)probe_acc * 0.01f / 25.f + 0.5f);
#endif
}

extern "C" void kernel_launch(void* const* d_in, const int* in_sizes, int n_in, void* d_out, int out_size, void* d_ws, size_t ws_size, hipStream_t stream) {
    static int grid_blocks = 0;
    if (grid_blocks == 0) {
        if (n_in != 14 || out_size != M * D || ws_size < WS_END) { fprintf(stderr, "kernel_launch: unexpected problem (n_in %d out %d ws %zu)\n", n_in, out_size, ws_size); grid_blocks = -1; return; }
        int dev = 0, cus = 0, per_cu = 0;
        (void)hipGetDevice(&dev);
        (void)hipDeviceGetAttribute(&cus, hipDeviceAttributeMultiprocessorCount, dev);
        (void)hipFuncSetAttribute((const void*)fwd_megakernel, hipFuncAttributeMaxDynamicSharedMemorySize, LDS_BYTES);
        (void)hipOccupancyMaxActiveBlocksPerMultiprocessor(&per_cu, (const void*)fwd_megakernel, 512, LDS_BYTES);
        if (per_cu < 1) { fprintf(stderr, "kernel_launch: occupancy query says %d blocks per CU\n", per_cu); grid_blocks = -1; return; }
        grid_blocks = cus;
    }
    if (grid_blocks < 0) return;
    Params p{};
    p.x = (const float*)d_in[0]; p.c = (const float*)d_in[1]; p.w_ada = (const float*)d_in[2]; p.b_ada = (const float*)d_in[3]; p.g_pre = (const float*)d_in[4]; p.g_post = (const float*)d_in[5];
    p.w_in = (const float*)d_in[6]; p.pool_w = (const float*)d_in[7]; p.pool_scale = (const float*)d_in[8]; p.lb_logits = (const float*)d_in[9]; p.hgrn_norm_g = (const float*)d_in[10];
    p.w_pool_o = (const float*)d_in[11]; p.w_hgrn_o = (const float*)d_in[12]; p.w_out = (const float*)d_in[13];
    p.out = (float*)d_out; p.ws = (unsigned char*)d_ws;
#ifndef USE_CG_SYNC
    (void)hipMemsetAsync((unsigned char*)d_ws + WS_BAR, 0, XCD_BAR_WORDS * sizeof(unsigned), stream);
#endif
    void* args[] = {&p};
    hipError_t e = hipLaunchCooperativeKernel((const void*)fwd_megakernel, dim3(grid_blocks), dim3(512), args, LDS_BYTES, stream);
    if (e != hipSuccess) fprintf(stderr, "cooperative launch failed: %s (grid %d)\n", hipGetErrorString(e), grid_blocks);
}
```

```cpp
#define PG8_ALIGN_SEL true
#define PG8_SP2_SEL true
#include <hip/hip_runtime.h>
#include <hip/hip_cooperative_groups.h>
#include <cstdio>
#include <cstdint>
namespace cg = cooperative_groups;
#define LAS __attribute__((address_space(3)))
namespace pg8 {
#define PG8_LAS __attribute__((address_space(3)))
typedef unsigned short bf16_t;
typedef short bf16x8 __attribute__((ext_vector_type(8)));
typedef float f32x4 __attribute__((ext_vector_type(4)));
typedef unsigned u32x4 __attribute__((ext_vector_type(4)));
constexpr int BM = 256, BK = 64, HALF = 128, HTB = HALF * BK * 2  , STAGE_BYTES = 8 * HTB, NXCD = 8, WGM = 8;

__host__ __device__ __forceinline__ int lds_byte(int r, int c) { const int st = (r >> 4) * 2 + (c >> 5), rr = r & 15, cc = c & 31, ob = rr * 64 + cc * 2; return st * 1024 + (ob ^ (((ob >> 9) & 1) << 5)); }
__host__ __device__ __forceinline__ void stage_rc(int b, int& R, int& C) { const int st = b / 1024, sb = b % 1024, swz = sb ^ (((sb >> 9) & 1) << 5); R = (st >> 1) * 16 + swz / 64; C = (st & 1) * 32 + (swz % 64) / 2; }
__host__ __device__ __forceinline__ int perm32(int rho) { const int n = rho >> 4, i = rho & 15; return 8 * (i >> 2) + 4 * n + (i & 3); }

struct Unit { int pm, pn; const unsigned short* A; const unsigned short* Bt; int mode; };
struct Gemm { const bf16_t* A; const bf16_t* Bt; int M, N, K; };

struct StaticOrder {
    int nM, nN, nwg, G, c, dup;
    const unsigned short *A0, *B0, *A2, *B2; int mode0, mode2;
    __host__ __device__ void init(int M, int N, int G_, int c_) { nM = M / BM; nN = N / BM; nwg = nM * nN; G = G_; c = c_; dup = 0; A0 = B0 = A2 = B2 = nullptr; mode0 = mode2 = 0; }
    __host__ __device__ bool next(int i, Unit& u) const {
        if (dup > 0 && i >= dup) return false;
        const long L = (dup > 0) ? (long)c : (long)i * G + c; if (L >= nwg) return false;
        int wgid = (int)L; { const int q = nwg / NXCD, r = nwg % NXCD, xcd = wgid % NXCD, off = wgid / NXCD; wgid = (xcd < r ? xcd * (q + 1) : r * (q + 1) + (xcd - r) * q) + off; }
        const int nig = WGM * nN, gid = wgid / nig, fm = gid * WGM, gsz = (nM - fm) < WGM ? (nM - fm) : WGM;
        u.pm = fm + ((wgid % nig) % gsz); u.pn = (wgid % nig) / gsz + ((dup > 0 && i == 1) ? nN : 0);
        const bool third = (dup > 0 && i == 2);
        u.A = third ? A2 : A0; u.Bt = third ? B2 : B0; u.mode = third ? mode2 : mode0; return true;
    }
    __device__ __forceinline__ void a_ready(const Unit&) const {}
    __device__ __forceinline__ void done(const Unit&) const {}
};
__device__ __forceinline__ unsigned cvt_pk_bf16(float lo, float hi) { unsigned r; asm volatile("v_cvt_pk_bf16_f32 %0, %1, %2" : "=v"(r) : "v"(lo), "v"(hi)); return r; }
template <class Epi, class Sched, bool ALIGN_EPI = false, bool SP2 = false>
__device__ __forceinline__ void gemm_phase(PG8_LAS unsigned char* lds, const Gemm g, const Sched& S, const Epi& E) {
    int tid_l = threadIdx.x; asm volatile("" : "+v"(tid_l));
    const int tid = tid_l, wid = __builtin_amdgcn_readfirstlane(tid >> 6), lane = tid & 63, wr = wid >> 2, wc = wid & 3, fr = lane & 15, fq = lane >> 4;
    const int K = g.K, nt = K / BK;
    unsigned voffA[2], voffB[2];
#pragma unroll
    for (int i = 0; i < 2; ++i) { int R, C; stage_rc(tid * 16 + i * 8192, R, C); const int Rb = Epi::PERM ? ((R & ~31) + perm32(R & 31)) : R;
        voffA[i] = (unsigned)(R * K + C) * 2u; voffB[i] = (unsigned)(Rb * K + C) * 2u; }
    const size_t kstep = (size_t)(BK * 2);
    const size_t hstep = (size_t)HALF * K * 2;
    const size_t tstep = 2 * hstep;
    const unsigned ldsw = (unsigned)wid * 1024u;
    const int aoff = lds_byte(wr * 64 + fr, fq * 8), boff = lds_byte(wc * 32 + fr, fq * 8);
#define PG8_SA(b, h) (((b) * 2 + (h)) * HTB)
#define PG8_SB(b, h) ((4 + (b) * 2 + (h)) * HTB)
#define PG8_STAGE(bufoff, gbase, voff) do { _Pragma("unroll") for (int _i = 0; _i < 2; ++_i) \
        __builtin_amdgcn_global_load_lds((const unsigned*)((const char*)(gbase) + (voff)[_i]), (PG8_LAS unsigned*)(lds + (bufoff) + ldsw + _i * 8192), 16, 0, 0); } while (0)
#define PG8_LDA(dst, b, h) do { _Pragma("unroll") for (int m = 0; m < 4; ++m) _Pragma("unroll") for (int k = 0; k < 2; ++k) dst[m][k] = *(const PG8_LAS bf16x8*)(lds + PG8_SA(b, h) + aoff + m * 2048 + k * 1024); } while (0)
#define PG8_LDB(dst, b, h) do { _Pragma("unroll") for (int n = 0; n < 2; ++n) _Pragma("unroll") for (int k = 0; k < 2; ++k) dst[n][k] = *(const PG8_LAS bf16x8*)(lds + PG8_SB(b, h) + boff + n * 2048 + k * 1024); } while (0)
#define PG8_MMA(ai, bj, At, Bt) do { __builtin_amdgcn_s_setprio(1); _Pragma("unroll") for (int m = 0; m < 4; ++m) _Pragma("unroll") for (int n = 0; n < 2; ++n) _Pragma("unroll") for (int k = 0; k < 2; ++k) \
        acc[ai][bj][m][n] = __builtin_amdgcn_mfma_f32_16x16x32_bf16(Bt[n][k], At[m][k], acc[ai][bj][m][n], 0, 0, 0); __builtin_amdgcn_s_setprio(0); } while (0)
#define PG8_WAIT_V(n) asm volatile("s_waitcnt vmcnt(" #n ")" ::: "memory")
#define PG8_WAIT_L(n) asm volatile("s_waitcnt lgkmcnt(" #n ")" ::: "memory")
#define PG8_BAR __builtin_amdgcn_s_barrier()
#define PG8_SCHED __builtin_amdgcn_sched_barrier(0)
    Unit cur, nxt; int ui = 0;
    if (!S.next(0, cur)) return;
    f32x4 acc[2][2][4][2];
#pragma unroll
    for (int a = 0; a < 2; ++a)
#pragma unroll
        for (int b = 0; b < 2; ++b)
#pragma unroll
            for (int m = 0; m < 4; ++m)
#pragma unroll
                for (int n = 0; n < 2; ++n) acc[a][b][m][n] = (f32x4){0.f, 0.f, 0.f, 0.f};
    bf16x8 At[4][2], B0[2][2], B1[2][2];
    const char* cA = (const char*)cur.A + (size_t)cur.pm * tstep; const char* cB = (const char*)cur.Bt + (size_t)cur.pn * tstep;
    S.a_ready(cur);
    if constexpr (SP2) {
        PG8_STAGE(PG8_SB(0, 0), cB, voffB); PG8_STAGE(PG8_SB(0, 1), cB + hstep, voffB); PG8_STAGE(PG8_SA(0, 0), cA, voffA); PG8_STAGE(PG8_SA(0, 1), cA + hstep, voffA);
        if (wr == 1) PG8_BAR;
        PG8_WAIT_V(2); PG8_BAR;
        PG8_STAGE(PG8_SB(1, 0), cB + kstep, voffB); PG8_STAGE(PG8_SA(1, 0), cA + kstep, voffA); PG8_STAGE(PG8_SB(1, 1), cB + hstep + kstep, voffB);
        PG8_WAIT_V(6); PG8_BAR;
    } else {
        PG8_STAGE(PG8_SB(0, 0), cB, voffB); PG8_STAGE(PG8_SA(0, 0), cA, voffA); PG8_STAGE(PG8_SB(0, 1), cB + hstep, voffB); PG8_STAGE(PG8_SA(0, 1), cA + hstep, voffA);
        if (wr == 1) PG8_BAR;
        PG8_WAIT_V(4); PG8_BAR;
        PG8_STAGE(PG8_SB(1, 0), cB + kstep, voffB); PG8_STAGE(PG8_SA(1, 0), cA + kstep, voffA); PG8_STAGE(PG8_SB(1, 1), cB + hstep + kstep, voffB);
        PG8_WAIT_V(6); PG8_BAR;
    }
    for (;;) {
        const bool has_next = S.next(ui + 1, nxt);
        const char* nA = has_next ? (const char*)nxt.A + (size_t)nxt.pm * tstep : cA; const char* nB = has_next ? (const char*)nxt.Bt + (size_t)nxt.pn * tstep : cB;
        for (int t = 0; t < nt; t += 2) {
            const bool last = (t == nt - 2);
            const char* a1 = cA + (size_t)(t + 1) * kstep;
            const char* a2 = last ? nA : cA + (size_t)(t + 2) * kstep; const char* b2 = last ? nB : cB + (size_t)(t + 2) * kstep;
            const char* a3 = a2 + kstep; const char* b3 = b2 + kstep;
            if (last && has_next) S.a_ready(nxt);
            if constexpr (SP2) {
            PG8_LDB(B0, 0, 0); PG8_LDB(B1, 0, 1); PG8_SCHED; PG8_LDA(At, 0, 0); PG8_STAGE(PG8_SA(1, 1), a1 + hstep, voffA);
            PG8_WAIT_V(8); PG8_WAIT_L(0); PG8_BAR; PG8_MMA(0, 0, At, B0); PG8_MMA(0, 1, At, B1); PG8_BAR; PG8_SCHED;
            PG8_LDA(At, 0, 1); PG8_STAGE(PG8_SB(0, 0), b2, voffB); PG8_STAGE(PG8_SB(0, 1), b2 + hstep, voffB); PG8_STAGE(PG8_SA(0, 0), a2, voffA);
            PG8_WAIT_V(8); PG8_WAIT_L(0); PG8_BAR; PG8_MMA(1, 0, At, B0); PG8_MMA(1, 1, At, B1); PG8_BAR; PG8_SCHED;
            PG8_LDB(B0, 1, 0); PG8_LDB(B1, 1, 1); PG8_SCHED; PG8_LDA(At, 1, 0); PG8_STAGE(PG8_SA(0, 1), a2 + hstep, voffA);
            PG8_WAIT_V(8); PG8_WAIT_L(0); PG8_BAR; PG8_MMA(0, 0, At, B0); PG8_MMA(0, 1, At, B1); PG8_BAR; PG8_SCHED;
            PG8_LDA(At, 1, 1); PG8_STAGE(PG8_SB(1, 0), b3, voffB); PG8_STAGE(PG8_SB(1, 1), b3 + hstep, voffB); PG8_STAGE(PG8_SA(1, 0), a3, voffA);
            PG8_WAIT_V(8); PG8_WAIT_L(0); PG8_BAR; PG8_MMA(1, 0, At, B0); PG8_MMA(1, 1, At, B1); PG8_BAR; PG8_SCHED;
            } else {
            PG8_LDB(B0, 0, 0); PG8_SCHED; PG8_LDA(At, 0, 0); PG8_STAGE(PG8_SA(1, 1), a1 + hstep, voffA);
            PG8_WAIT_L(8); PG8_BAR; PG8_WAIT_L(0); PG8_MMA(0, 0, At, B0); PG8_BAR; PG8_SCHED;
            PG8_LDB(B1, 0, 1); PG8_STAGE(PG8_SB(0, 0), b2, voffB);
            PG8_BAR; PG8_WAIT_L(0); PG8_MMA(0, 1, At, B1); PG8_BAR;
            PG8_LDA(At, 0, 1); PG8_STAGE(PG8_SA(0, 0), a2, voffA);
            PG8_BAR; PG8_WAIT_L(0); PG8_MMA(1, 0, At, B0); PG8_BAR; PG8_SCHED;
            PG8_STAGE(PG8_SB(0, 1), b2 + hstep, voffB);
            PG8_WAIT_V(6); PG8_BAR; PG8_MMA(1, 1, At, B1); PG8_BAR;
            PG8_LDB(B0, 1, 0); PG8_SCHED; PG8_LDA(At, 1, 0); PG8_STAGE(PG8_SA(0, 1), a2 + hstep, voffA);
            PG8_WAIT_L(8); PG8_BAR; PG8_WAIT_L(0); PG8_MMA(0, 0, At, B0); PG8_BAR; PG8_SCHED;
            PG8_LDB(B1, 1, 1); PG8_STAGE(PG8_SB(1, 0), b3, voffB);
            PG8_BAR; PG8_WAIT_L(0); PG8_MMA(0, 1, At, B1); PG8_BAR;
            PG8_LDA(At, 1, 1); PG8_STAGE(PG8_SA(1, 0), a3, voffA);
            PG8_BAR; PG8_WAIT_L(0); PG8_MMA(1, 0, At, B0); PG8_BAR; PG8_SCHED;
            PG8_STAGE(PG8_SB(1, 1), b3 + hstep, voffB);
            PG8_WAIT_V(6); PG8_BAR; PG8_MMA(1, 1, At, B1); PG8_BAR;
            }
        }
        if constexpr (ALIGN_EPI) { if (wr == 0) PG8_BAR; }
        if constexpr (!Epi::AFTER_DRAIN) { E(acc, cur, wr, wc, fr, fq); S.done(cur); }
        if (!has_next) break;
#pragma unroll
        for (int a = 0; a < 2; ++a)
#pragma unroll
            for (int b = 0; b < 2; ++b)
#pragma unroll
                for (int m = 0; m < 4; ++m)
#pragma unroll
                    for (int n = 0; n < 2; ++n) acc[a][b][m][n] = (f32x4){0.f, 0.f, 0.f, 0.f};
        cur = nxt; cA = nA; cB = nB; ++ui;
        if constexpr (ALIGN_EPI) { if (wr == 1) PG8_BAR; }
    }
    PG8_WAIT_V(0);
    if constexpr (!ALIGN_EPI) { if (wr == 0) PG8_BAR; }
    PG8_BAR;
    if constexpr (Epi::AFTER_DRAIN) { E.fused(acc, cur, wr, wc, fr, fq, lds, wid, lane); S.done(cur); }
#undef PG8_SA
#undef PG8_SB
#undef PG8_STAGE
#undef PG8_LDA
#undef PG8_LDB
#undef PG8_MMA
#undef PG8_WAIT_V
#undef PG8_WAIT_L
#undef PG8_BAR
#undef PG8_SCHED
}
}
#define XB_TMO      128
#define XB_XCNT(j)  (256  + 64 * (j))
#define XB_XSUB(j)  (1280 + 64 * (j))
#define XB_XGEN(j)  (2304 + 64 * (j))
#define XB_TOP      3328
#define XB_TOPGEN   3392
#define XCD_BAR_WORDS 3456
#define XB_SPIN_CAP (1u << 18)

__device__ __forceinline__ unsigned xb_ld(unsigned* p)              { return __hip_atomic_load(p, __ATOMIC_RELAXED, __HIP_MEMORY_SCOPE_AGENT); }
__device__ __forceinline__ unsigned xb_add(unsigned* p, unsigned v) { return __hip_atomic_fetch_add(p, v, __ATOMIC_RELAXED, __HIP_MEMORY_SCOPE_AGENT); }
__device__ __forceinline__ unsigned xb_xcc_id() { return (unsigned)__builtin_amdgcn_s_getreg((3 << 11) | 20) & 0xFu; }
#define XB_SPIN(cond, bar) do { unsigned _sp = 0; while (cond) { __builtin_amdgcn_s_sleep(1); \
    if ((++_sp & 255u) == 0u) { if (xb_ld(&(bar)[XB_TMO])) break; if (_sp > XB_SPIN_CAP) { atomicAdd(&(bar)[XB_TMO], 1u); break; } } } } while (0)

struct XcdBarrier {
    unsigned* bar; unsigned x;
    volatile LAS unsigned* st;
};

__device__ __forceinline__ XcdBarrier xcd_barrier_post(unsigned* bar, volatile LAS unsigned* st) {
    XcdBarrier b; b.bar = bar; b.x = xb_xcc_id(); b.st = st;
    if (threadIdx.x == 0) (void)xb_add(&bar[XB_XCNT(b.x)], 1u);
    return b;
}
__device__ __forceinline__ void xcd_barrier_complete(unsigned* bar, unsigned x, unsigned& nloc, unsigned& nx) {
    const unsigned G = gridDim.x * gridDim.y * gridDim.z;
    unsigned sum, cnt, mine, sp = 0u;
    for (;;) {
        sum = 0u; cnt = 0u; mine = 0u;
#pragma unroll
        for (unsigned j = 0; j < 16; ++j) { const unsigned c = xb_ld(&bar[XB_XCNT(j)]); sum += c; cnt += (c > 0u) ? 1u : 0u; mine = (j == x) ? c : mine; }
        if (sum == G) break;
        __builtin_amdgcn_s_sleep(1);
        if ((++sp & 255u) == 0u) { if (xb_ld(&bar[XB_TMO])) break; if (sp > XB_SPIN_CAP) { atomicAdd(&bar[XB_TMO], 1u); break; } }
    }
    nloc = mine > 0u ? mine : 1u; nx = cnt > 0u ? cnt : 1u;
}

__device__ __forceinline__ void xcd_barrier(const XcdBarrier& b) {
    asm volatile("s_waitcnt vmcnt(0)" ::: "memory");
    __syncthreads();
    if (threadIdx.x == 0) {
        unsigned* bar = b.bar;
        __builtin_amdgcn_s_waitcnt(0);
        unsigned nloc = b.st[0], nx = b.st[1];
        if (nloc == 0u) { xcd_barrier_complete(bar, b.x, nloc, nx); b.st[0] = nloc; b.st[1] = nx; }
        const unsigned old = xb_add(&bar[XB_XSUB(b.x)], 1u);
        const unsigned gen = old / nloc;
        if (old + 1u == (gen + 1u) * nloc) {
            __builtin_amdgcn_fence(__ATOMIC_RELEASE, "agent");
            asm volatile("s_waitcnt vmcnt(0)" ::: "memory");
            const unsigned og = xb_add(&bar[XB_TOP], 1u);
            const unsigned tg = og / nx;
            if (og + 1u == (tg + 1u) * nx) xb_add(&bar[XB_TOPGEN], 1u);
            else XB_SPIN(xb_ld(&bar[XB_TOPGEN]) == tg, bar);
            __builtin_amdgcn_fence(__ATOMIC_ACQUIRE, "agent");
            xb_add(&bar[XB_XGEN(b.x)], 1u);
            asm volatile("s_waitcnt vmcnt(0)" ::: "memory");
        } else {
            XB_SPIN(xb_ld(&bar[XB_XGEN(b.x)]) == gen, bar);
            __builtin_amdgcn_fence(__ATOMIC_ACQUIRE, "agent");
            asm volatile("s_waitcnt vmcnt(0)" ::: "memory");
        }
    }
    __syncthreads();
}


constexpr int NB = 8, SEQ = 2048, D = 1024, M = NB * SEQ, NL = 2, INW = 7168, NIN = 5120;
constexpr float EPS = 1e-6f;
#define LAS __attribute__((address_space(3)))
typedef unsigned short bf16_t;
typedef short bf16x8 __attribute__((ext_vector_type(8)));
typedef float f32x4 __attribute__((ext_vector_type(4)));
typedef float f32x2 __attribute__((ext_vector_type(2)));
typedef unsigned u32x4 __attribute__((ext_vector_type(4)));
typedef unsigned u32x2 __attribute__((ext_vector_type(2)));
typedef __bf16 bf2_t __attribute__((ext_vector_type(2)));
typedef _Float16 h2_t __attribute__((ext_vector_type(2)));

constexpr size_t MiB = 1u << 20;
constexpr size_t WS_ADA = 0;
constexpr size_t WS_LB = 256 * 1024;
constexpr size_t WS_POOLWT = 512 * 1024;
constexpr size_t WS_WIN = 1 * MiB;
constexpr size_t WS_WPO = 29 * MiB;
constexpr size_t WS_WHO = 31 * MiB;
constexpr size_t WS_WOUT = 35 * MiB;
constexpr size_t WS_H = 40 * MiB;
constexpr size_t WS_PV = 72 * MiB;
constexpr size_t WS_PG = 88 * MiB;
constexpr size_t WS_Q = 104 * MiB;
constexpr size_t WS_LF = 136 * MiB;
constexpr size_t WS_V = 168 * MiB;
constexpr size_t WS_HG = 200 * MiB;
constexpr size_t WS_P = 232 * MiB;
constexpr size_t WS_DEC = 248 * MiB;
constexpr size_t WS_BAR = 250 * MiB;
constexpr size_t WS_DSEG = 251 * MiB;
constexpr size_t WS_END = 253 * MiB;
constexpr int LDS_BYTES = 147456, LDS_BARW = 147392;

__device__ __forceinline__ unsigned pk_bf16(float lo, float hi) { bf2_t r = __builtin_convertvector((f32x2){lo, hi}, bf2_t); return __builtin_bit_cast(unsigned, r); }
__device__ __forceinline__ unsigned pk_f16(float lo, float hi) { h2_t r = __builtin_convertvector((f32x2){lo, hi}, h2_t); return __builtin_bit_cast(unsigned, r); }
__device__ __forceinline__ float bf_lo(unsigned w) { return __uint_as_float(w << 16); }
__device__ __forceinline__ float bf_hi(unsigned w) { return __uint_as_float(w & 0xffff0000u); }
__device__ __forceinline__ float h_lo(unsigned w) { h2_t r = __builtin_bit_cast(h2_t, w); return (float)r.x; }
__device__ __forceinline__ float h_hi(unsigned w) { h2_t r = __builtin_bit_cast(h2_t, w); return (float)r.y; }
__device__ __forceinline__ float sigmoid_f(float x) { return __builtin_amdgcn_rcpf(1.f + __expf(-x)); }
__device__ __forceinline__ float silu_f(float x) { return x * sigmoid_f(x); }
__device__ __forceinline__ float dpp_f(float v, const int ctrl_unused) { return v; }
#define DPP_ADD(v, ctrl) ((v) + __builtin_bit_cast(float, __builtin_amdgcn_update_dpp(0, __builtin_bit_cast(int, (v)), (ctrl), 0xf, 0xf, true)))
__device__ __forceinline__ float wave_sum(float v) {
    v = DPP_ADD(v, 0xB1);
    v = DPP_ADD(v, 0x4E);
    v = DPP_ADD(v, 0x124);
    v = DPP_ADD(v, 0x128);
    return (__builtin_amdgcn_readlane(v, 0) + __builtin_amdgcn_readlane(v, 16)) + (__builtin_amdgcn_readlane(v, 32) + __builtin_amdgcn_readlane(v, 48));
}
#define LBAR() do { asm volatile("s_waitcnt lgkmcnt(0)" ::: "memory"); __builtin_amdgcn_s_barrier(); asm volatile("" ::: "memory"); } while (0)
#define MFMA16(a, b, c) __builtin_amdgcn_mfma_f32_16x16x32_bf16((a), (b), (c), 0, 0, 0)

__device__ __forceinline__ void p0_transpose_item(const float* W, int K, int N, bf16_t* WT, LAS float* scr, int item, int lane) {
    const int nblk = N / 32, kb = item / nblk, nb = item % nblk, k0 = 64 * kb, n0 = 32 * nb;
#pragma unroll
    for (int i = 0; i < 32; ++i) { const int kk = 2 * i + (lane >> 5); scr[kk * 33 + (lane & 31)] = W[(size_t)(k0 + kk) * N + n0 + (lane & 31)]; }
    asm volatile("s_waitcnt lgkmcnt(0)" ::: "memory");
    const int c = lane & 7;
#pragma unroll
    for (int j = 0; j < 4; ++j) { const int n = (lane >> 3) + 8 * j; const LAS float* s = scr + (8 * c) * 33 + n;
        u32x4 o; o.x = pk_bf16(s[0 * 33], s[1 * 33]); o.y = pk_bf16(s[2 * 33], s[3 * 33]); o.z = pk_bf16(s[4 * 33], s[5 * 33]); o.w = pk_bf16(s[6 * 33], s[7 * 33]);
        *(u32x4*)(WT + (size_t)(n0 + n) * K + k0 + 8 * c) = o; }
    asm volatile("s_waitcnt lgkmcnt(0)" ::: "memory");
}

struct Params {
    const float *x, *c, *w_ada, *b_ada, *g_pre, *g_post, *w_in, *pool_w, *pool_scale, *lb_logits, *hgrn_norm_g, *w_pool_o, *w_hgrn_o, *w_out;
    float* out; unsigned char* ws;
};

__device__ __forceinline__ void p0_prologue(const Params& p, LAS unsigned char* lds) {
    const int tid = threadIdx.x, lane = tid & 63, wave = tid >> 6, blk = blockIdx.x, G = gridDim.x;
    float* ADA = (float*)(p.ws + WS_ADA);
    LAS float* cact = (LAS float*)(lds + 73728);
    LAS float* red = (LAS float*)(lds + 73728 + 32768);
    for (int job = blk; job < 192; job += G) {
        for (int i = tid; i < NB * D; i += 512) cact[i] = silu_f(p.c[i]);
        __syncthreads();
        const int l = job / 96, j0 = (job % 96) * 32, j = tid & 31, ks = tid >> 5;
        const float* w = p.w_ada + ((size_t)l * D + ks * 64) * 3072 + j0 + j;
        float a0 = 0.f, a1 = 0.f, a2 = 0.f, a3 = 0.f, a4 = 0.f, a5 = 0.f, a6 = 0.f, a7 = 0.f;
#pragma unroll 32
        for (int d = 0; d < 64; ++d) { const float wv = w[(size_t)d * 3072]; const LAS float* cc = cact + ks * 64 + d;
            a0 += cc[0] * wv; a1 += cc[1024] * wv; a2 += cc[2048] * wv; a3 += cc[3072] * wv; a4 += cc[4096] * wv; a5 += cc[5120] * wv; a6 += cc[6144] * wv; a7 += cc[7168] * wv; }
        LAS float* rr = red + (ks * 8) * 32 + j;
        rr[0] = a0; rr[32] = a1; rr[64] = a2; rr[96] = a3; rr[128] = a4; rr[160] = a5; rr[192] = a6; rr[224] = a7;
        __syncthreads();
        if (tid < 256) { const int b = tid >> 5; float s = p.b_ada[l * 3072 + j0 + j];
#pragma unroll
            for (int k2 = 0; k2 < 16; ++k2) s += red[(k2 * 8 + b) * 32 + j];
            ADA[(size_t)(l * NB + b) * 3072 + j0 + j] = s; }
        __syncthreads();
    }
    if (blk == G - 1) { float* LB = (float*)(p.ws + WS_LB);
        for (int j = tid; j < 1024; j += 512) { const float l0 = p.lb_logits[j], l1 = p.lb_logits[1024 + j], mx = fmaxf(l0, l1), e0 = __expf(l0 - mx), e1 = __expf(l1 - mx);
            const float p0 = e0 / (e0 + e1), p1 = e1 / (e0 + e1); const float c1 = (p0 + p1) - p0;
            LB[j] = 0.f; LB[1024 + j] = fminf(fmaxf(c1, 0.f), 1.f); } }
    LAS float* scr = (LAS float*)(lds + wave * 8448);
    constexpr int I_IN = (D / 64) * (INW / 32), I_PO = (512 / 64) * (D / 32), I_HO = (D / 64) * (D / 32), I_OUT = I_HO, I_PW = 4 * 8, I_LAYER = I_IN + I_PO + I_HO + I_OUT + I_PW;
    bf16_t* WinT = (bf16_t*)(p.ws + WS_WIN); bf16_t* WpoT = (bf16_t*)(p.ws + WS_WPO); bf16_t* WhoT = (bf16_t*)(p.ws + WS_WHO); bf16_t* WoutT = (bf16_t*)(p.ws + WS_WOUT); bf16_t* PoolWT = (bf16_t*)(p.ws + WS_POOLWT);
    for (int it = blk * 8 + wave; it < NL * I_LAYER; it += G * 8) {
        int r = it; const int l = r / I_LAYER; r -= l * I_LAYER;
        if (r < I_IN) { p0_transpose_item(p.w_in + (size_t)l * D * INW, D, INW, WinT + (size_t)l * INW * D, scr, r, lane); continue; } r -= I_IN;
        if (r < I_PO) { p0_transpose_item(p.w_pool_o + (size_t)l * 512 * D, 512, D, WpoT + (size_t)l * D * 512, scr, r, lane); continue; } r -= I_PO;
        if (r < I_HO) { p0_transpose_item(p.w_hgrn_o + (size_t)l * D * D, D, D, WhoT + (size_t)l * D * D, scr, r, lane); continue; } r -= I_HO;
        if (r < I_OUT) { p0_transpose_item(p.w_out + (size_t)l * D * D, D, D, WoutT + (size_t)l * D * D, scr, r, lane); continue; } r -= I_OUT;
        { const int g = r >> 3; r &= 7; p0_transpose_item(p.pool_w + (size_t)(l * 4 + g) * 16384, 128, 128, PoolWT + (size_t)(l * 4 + g) * 16384, scr, r, lane); }
    }
}

template <bool HAS_PREV, bool MAKE_H>
__device__ __forceinline__ void p1_rows(const float* xprev, const bf16_t* Y, const float* ada_prev, const float* gpost, float* xout, const float* gpre, const float* ada_cur, bf16_t* H) {
    int tid_l = threadIdx.x; asm volatile("" : "+v"(tid_l));
    const int lane = tid_l & 63, wave = tid_l >> 6;
    const int NW = gridDim.x * 8, rpw = (M + NW - 1) / NW, gw = blockIdx.x * 8 + wave;
    const int mbeg = gw * rpw, mend = (mbeg + rpw < M) ? mbeg + rpw : M;
    if (mbeg >= mend) return;
    f32x4 ga[4], hm[4], hs[4];
    int bcur = -1;
    f32x4 vn[4]; u32x2 yn[4];
#pragma unroll
    for (int j = 0; j < 4; ++j) { vn[j] = ((const f32x4*)(xprev + (size_t)mbeg * D) + lane)[64 * j]; if (HAS_PREV) yn[j] = ((const u32x2*)(Y + (size_t)mbeg * D) + lane)[64 * j]; else yn[j] = (u32x2){0u, 0u}; }
    for (int m = mbeg; m < mend; ++m) {
        const int b = m >> 11;
        if (b != bcur) { bcur = b;
#pragma unroll
            for (int j = 0; j < 4; ++j) {
                if (HAS_PREV) ga[j] = ((const f32x4*)(ada_prev + (size_t)b * 3072 + 2048) + lane)[64 * j] * ((const f32x4*)gpost + lane)[64 * j]; else ga[j] = (f32x4){0.f, 0.f, 0.f, 0.f};
                if (MAKE_H) { hm[j] = ((const f32x4*)gpre + lane)[64 * j] * (((const f32x4*)(ada_cur + (size_t)b * 3072 + 1024) + lane)[64 * j] + 1.f); hs[j] = ((const f32x4*)(ada_cur + (size_t)b * 3072) + lane)[64 * j]; }
                else { hm[j] = (f32x4){0.f, 0.f, 0.f, 0.f}; hs[j] = hm[j]; } } }
        f32x4 v[4]; u32x2 yw[4];
#pragma unroll
        for (int j = 0; j < 4; ++j) { v[j] = vn[j]; yw[j] = yn[j]; }
        { const int mn = (m + 1 < mend) ? m + 1 : m;
#pragma unroll
          for (int j = 0; j < 4; ++j) { vn[j] = ((const f32x4*)(xprev + (size_t)mn * D) + lane)[64 * j]; if (HAS_PREV) yn[j] = ((const u32x2*)(Y + (size_t)mn * D) + lane)[64 * j]; } }
        if (HAS_PREV) {
            f32x4 y[4]; float ss = 0.f;
#pragma unroll
            for (int j = 0; j < 4; ++j) { y[j] = (f32x4){bf_lo(yw[j].x), bf_hi(yw[j].x), bf_lo(yw[j].y), bf_hi(yw[j].y)}; ss += (y[j].x * y[j].x + y[j].y * y[j].y) + (y[j].z * y[j].z + y[j].w * y[j].w); }
            const float rstd = rsqrtf(wave_sum(ss) * (1.f / D) + EPS);
            f32x4* xo = (f32x4*)(xout + (size_t)m * D) + lane;
#pragma unroll
            for (int j = 0; j < 4; ++j) { v[j] = v[j] + ga[j] * (y[j] * rstd); xo[64 * j] = v[j]; }
        }
        if (MAKE_H) {
            float ss = 0.f;
#pragma unroll
            for (int j = 0; j < 4; ++j) ss += (v[j].x * v[j].x + v[j].y * v[j].y) + (v[j].z * v[j].z + v[j].w * v[j].w);
            const float rstd = rsqrtf(wave_sum(ss) * (1.f / D) + EPS);
            u32x2* ho = (u32x2*)(H + (size_t)m * D) + lane;
#pragma unroll
            for (int j = 0; j < 4; ++j) { const f32x4 hv = (v[j] * rstd) * hm[j] + hs[j]; u32x2 w; w.x = pk_bf16(hv.x, hv.y); w.y = pk_bf16(hv.z, hv.w); ho[64 * j] = w; }
        }
    }
}

struct EpiU {
    static constexpr bool PERM = true, AFTER_DRAIN = false;
    unsigned char* ws;
    __device__ __forceinline__ void operator()(const f32x4 (&acc)[2][2][4][2], const pg8::Unit& u, int wr, int wc, int fr, int fq) const {
        const int pn = u.pn, mode = u.mode; const int row0 = u.pm * 256 + wr * 64 + fr;
        size_t boff; int ld = 1024, colt = pn * 256, op;
        if (mode == 0) {
            if (pn < 2) { boff = WS_PV; ld = 512; op = 0; }
            else if (pn < 4) { boff = WS_PG; ld = 512; colt = (pn - 2) * 256; op = 0; }
            else if (pn < 8) { boff = WS_Q; colt = (pn - 4) * 256; op = 0; }
            else if (pn < 12) { boff = WS_LF; colt = (pn - 8) * 256; op = 2; }
            else if (pn < 16) { boff = WS_V; colt = (pn - 12) * 256; op = 0; }
            else { boff = WS_HG; colt = (pn - 16) * 256; op = 0; }
        } else if (mode == 1) { boff = (pn < 4) ? WS_Q : WS_V; colt = (pn & 3) * 256; op = 3; }
        else if (mode == 2) { boff = WS_LF; op = 4; }
        else if (mode == 3) { boff = WS_LF; op = 5; }
        else { boff = WS_V; op = 0; }
        bf16_t* base = (bf16_t*)(ws + boff); const bf16_t* Gp = (const bf16_t*)(ws + (mode == 2 ? WS_V : WS_Q));
        const int col0 = colt + wc * 32 + 8 * fq;
#pragma unroll
        for (int ai = 0; ai < 2; ++ai) {
            u32x4 gq[4][2], tq[4][2];
#pragma unroll
            for (int m = 0; m < 4; ++m)
#pragma unroll
                for (int bj = 0; bj < 2; ++bj) { gq[m][bj] = (u32x4){0u, 0u, 0u, 0u}; tq[m][bj] = gq[m][bj]; }
            if (op >= 4) {
#pragma unroll
                for (int m = 0; m < 4; ++m)
#pragma unroll
                    for (int bj = 0; bj < 2; ++bj) gq[m][bj] = *(const u32x4*)(Gp + (size_t)(row0 + ai * 128 + m * 16) * ld + col0 + bj * 128);
                if (op == 5) {
#pragma unroll
                    for (int m = 0; m < 4; ++m)
#pragma unroll
                        for (int bj = 0; bj < 2; ++bj) tq[m][bj] = *(const u32x4*)(base + (size_t)(row0 + ai * 128 + m * 16) * ld + col0 + bj * 128); }
            }
            asm volatile("" ::: "memory");
#pragma unroll
            for (int m = 0; m < 4; ++m) { const size_t off = (size_t)(row0 + ai * 128 + m * 16) * ld + col0;
#pragma unroll
                for (int bj = 0; bj < 2; ++bj) { f32x4 v0 = acc[ai][bj][m][0], v1 = acc[ai][bj][m][1];
                    if (op == 1) {
#pragma unroll
                        for (int j = 0; j < 4; ++j) { v0[j] = silu_f(v0[j]); v1[j] = silu_f(v1[j]); }
                    } else if (op == 3) {
#pragma unroll
                        for (int j = 0; j < 4; ++j) { v0[j] = sigmoid_f(v0[j]); v1[j] = sigmoid_f(v1[j]); }
                    } else if (op >= 4) { const u32x4 g = gq[m][bj];
                        v0 = v0 * (f32x4){bf_lo(g.x), bf_hi(g.x), bf_lo(g.y), bf_hi(g.y)}; v1 = v1 * (f32x4){bf_lo(g.z), bf_hi(g.z), bf_lo(g.w), bf_hi(g.w)};
                        if (op == 5) { const u32x4 t = tq[m][bj];
                            v0 = v0 + (f32x4){bf_lo(t.x), bf_hi(t.x), bf_lo(t.y), bf_hi(t.y)}; v1 = v1 + (f32x4){bf_lo(t.z), bf_hi(t.z), bf_lo(t.w), bf_hi(t.w)}; } }
                    u32x4 w;
                    if (op == 2) { w.x = pk_f16(v0[0], v0[1]); w.y = pk_f16(v0[2], v0[3]); w.z = pk_f16(v1[0], v1[1]); w.w = pk_f16(v1[2], v1[3]); }
                    else { w.x = pk_bf16(v0[0], v0[1]); w.y = pk_bf16(v0[2], v0[3]); w.z = pk_bf16(v1[0], v1[1]); w.w = pk_bf16(v1[2], v1[3]); }
                    *(u32x4*)(base + off + bj * 128) = w; } }
        }
    }
};

constexpr int AP_STRIDE = 136;
template <int W>
__device__ __forceinline__ void pool_item(const bf16_t* PV, bf16_t* PG, const bf16_t* PoolWT_g, const float* pscale_g, int m0, int g, LAS unsigned char* lds) {
    int tid_l = threadIdx.x; asm volatile("" : "+v"(tid_l));
    const int tid = tid_l, lane = tid & 63, wv = tid >> 6, r = lane & 15, q = lane >> 4;
    const int pos0 = (m0 & (SEQ - 1)) + wv * 8;
    const bf16_t* src = PV + (size_t)(m0 + wv * 8) * 512 + g * 128 + 2 * lane;
    float r0[W + 7], r1[W + 7];
#pragma unroll
    for (int i = 0; i < W + 7; ++i) { const int pp = pos0 - (W - 1) + i; unsigned w = 0u; if (pp >= 0) w = *(const unsigned*)(src + (ptrdiff_t)(i - (W - 1)) * 512); r0[i] = bf_lo(w); r1[i] = bf_hi(w); }
    bf16x8 wf[4]; u32x2 gw[4];
#pragma unroll
    for (int ks = 0; ks < 4; ++ks) wf[ks] = *(const bf16x8*)(PoolWT_g + (16 * wv + r) * 128 + ks * 32 + q * 8);
#pragma unroll
    for (int mt = 0; mt < 4; ++mt) gw[mt] = *(const u32x2*)(PG + (size_t)(m0 + mt * 16 + r) * 512 + g * 128 + 16 * wv + q * 4);
    const f32x4 sc = *(const f32x4*)(pscale_g + 16 * wv + q * 4);
    float s0 = 0.f, s1 = 0.f;
#pragma unroll
    for (int i = 0; i < W - 1; ++i) { s0 += r0[i]; s1 += r1[i]; }
    LAS bf16_t* AP = (LAS bf16_t*)lds;
    __syncthreads();
#pragma unroll
    for (int i = 0; i < 8; ++i) { s0 += r0[W - 1 + i]; s1 += r1[W - 1 + i];
        const int pos = pos0 + i; const float inv = 1.f / (float)(pos + 1 < W ? pos + 1 : W);
        *(LAS unsigned*)(AP + (wv * 8 + i) * AP_STRIDE + 2 * lane) = pk_bf16(s0 * inv - r0[W - 1 + i], s1 * inv - r1[W - 1 + i]);
        s0 -= r0[i]; s1 -= r1[i]; }
    __syncthreads();
    f32x4 o[4];
#pragma unroll
    for (int mt = 0; mt < 4; ++mt) o[mt] = (f32x4){0.f, 0.f, 0.f, 0.f};
    bf16x8 af[16];
#pragma unroll
    for (int ks = 0; ks < 4; ++ks)
#pragma unroll
        for (int mt = 0; mt < 4; ++mt) af[ks * 4 + mt] = *(const LAS bf16x8*)(AP + (mt * 16 + r) * AP_STRIDE + ks * 32 + q * 8);
    __builtin_amdgcn_sched_barrier(0);
#pragma unroll
    for (int ks = 0; ks < 4; ++ks)
#pragma unroll
        for (int mt = 0; mt < 4; ++mt) o[mt] = MFMA16(wf[ks], af[ks * 4 + mt], o[mt]);
#pragma unroll
    for (int mt = 0; mt < 4; ++mt) { bf16_t* pp = PG + (size_t)(m0 + mt * 16 + r) * 512 + g * 128 + 16 * wv + q * 4;
        const f32x4 ov = o[mt] * sc * (f32x4){silu_f(bf_lo(gw[mt].x)), silu_f(bf_hi(gw[mt].x)), silu_f(bf_lo(gw[mt].y)), silu_f(bf_hi(gw[mt].y))};
        u32x2 w; w.x = pk_bf16(ov.x, ov.y); w.y = pk_bf16(ov.z, ov.w); *(u32x2*)pp = w; }
}

constexpr int HQ_STR = 136, HK_STR = 72;
__device__ __forceinline__ void prep_items(bf16_t* Qg, bf16_t* LFg, bf16_t* Pg, float* DECg, const float* lbl, int first, int step, int total, LAS unsigned char* lds) {
    int tid_l = threadIdx.x; asm volatile("" : "+v"(tid_l));
    const int tid = tid_l, lane = tid & 63, wv = __builtin_amdgcn_readfirstlane(tid >> 6), r = lane & 15, q = lane >> 4;
    LAS bf16_t* QT = (LAS bf16_t*)(lds); LAS bf16_t* KT = (LAS bf16_t*)(lds + 17408); LAS float* TOT = (LAS float*)(lds + 34816);
    unsigned q2[8], lf2[8], qn[8], lfn[8];
    if (first < total) { const int bh = first >> 5, n = first & 31; const size_t rb = ((size_t)(bh >> 3) * SEQ + n * 64 + wv * 8) * 1024 + (size_t)(bh & 7) * 128 + 2 * lane;
#pragma unroll
        for (int i = 0; i < 8; ++i) { qn[i] = *(const unsigned*)(Qg + rb + (size_t)i * 1024); lfn[i] = *(const unsigned*)(LFg + rb + (size_t)i * 1024); } }
#pragma unroll 1
    for (int item = first; item < total; item += step) {
        const int bh = item >> 5, n = item & 31;
        const size_t rb = ((size_t)(bh >> 3) * SEQ + n * 64 + wv * 8) * 1024 + (size_t)(bh & 7) * 128 + 2 * lane;
#pragma unroll
        for (int i = 0; i < 8; ++i) { q2[i] = qn[i]; lf2[i] = lfn[i]; }
        const f32x2 lbp = *(const f32x2*)(lbl + (bh & 7) * 128 + 2 * lane); const float lb0 = lbp.x, lb1 = lbp.y;
        { const int inext = (item + step < total) ? item + step : item; const int bh2 = inext >> 5, n2 = inext & 31; const size_t rb2 = ((size_t)(bh2 >> 3) * SEQ + n2 * 64 + wv * 8) * 1024 + (size_t)(bh2 & 7) * 128 + 2 * lane;
#pragma unroll
            for (int i = 0; i < 8; ++i) { qn[i] = *(const unsigned*)(Qg + rb2 + (size_t)i * 1024); lfn[i] = *(const unsigned*)(LFg + rb2 + (size_t)i * 1024); } }
        float f0[8], f1[8]; float run0 = 0.f, run1 = 0.f;
#pragma unroll
        for (int i = 0; i < 8; ++i) { const float z0 = h_lo(lf2[i]), z1 = h_hi(lf2[i]);
            f0[i] = fmaxf(lb0 + (1.f - lb0) * sigmoid_f(z0), 1e-30f); f1[i] = fmaxf(lb1 + (1.f - lb1) * sigmoid_f(z1), 1e-30f); run0 += __logf(f0[i]); run1 += __logf(f1[i]); }
        *(LAS f32x2*)(TOT + wv * 128 + 2 * lane) = (f32x2){run0, run1};
        LBAR();
        float pre0 = 0.f, pre1 = 0.f, last0 = 0.f, last1 = 0.f;
#pragma unroll
        for (int w = 0; w < 8; ++w) { const f32x2 t = *(const LAS f32x2*)(TOT + w * 128 + 2 * lane); last0 += t.x; last1 += t.y; if (w < wv) { pre0 += t.x; pre1 += t.y; } }
        if (wv == 0) *(f32x2*)(DECg + (size_t)item * 128 + 2 * lane) = (f32x2){__expf(last0), __expf(last1)};
        const float sc0 = __expf(fminf(-0.5f * last0, 60.f)), sc1 = __expf(fminf(-0.5f * last1, 60.f));
        float pf0 = __expf(pre0), pf1 = __expf(pre1), sf0 = __expf(last0 - pre0 - run0), sf1 = __expf(last1 - pre1 - run1);
        float kh0[8], kh1[8];
#pragma unroll
        for (int i = 7; i >= 0; --i) { kh0[i] = (1.f - f0[i]) * sf0; kh1[i] = (1.f - f1[i]) * sf1; sf0 *= f0[i]; sf1 *= f1[i]; }
#pragma unroll
        for (int i = 0; i < 8; ++i) { pf0 *= f0[i]; pf1 *= f1[i];
            const float qh0 = silu_f(bf_lo(q2[i])) * pf0, qh1 = silu_f(bf_hi(q2[i])) * pf1; const int t = wv * 8 + i;
            *(unsigned*)(Qg + rb + (size_t)i * 1024) = pk_bf16(qh0, qh1);
            *(unsigned*)(LFg + rb + (size_t)i * 1024) = pk_bf16(kh0[i], kh1[i]);
            *(LAS unsigned*)(QT + t * HQ_STR + 2 * lane) = pk_bf16(qh0 * sc0, qh1 * sc1);
            *(LAS unsigned*)(KT + t * HQ_STR + 2 * lane) = pk_bf16(kh0[i] * sc0, kh1[i] * sc1); }
        LBAR();
        const int ti = wv >> 1;
        { bf16x8 qf[4], kf[2][4];
#pragma unroll
          for (int ks = 0; ks < 4; ++ks) { qf[ks] = *(const LAS bf16x8*)(QT + (ti * 16 + r) * HQ_STR + ks * 32 + q * 8);
              kf[0][ks] = *(const LAS bf16x8*)(KT + ((2 * (wv & 1)) * 16 + r) * HQ_STR + ks * 32 + q * 8); kf[1][ks] = *(const LAS bf16x8*)(KT + ((2 * (wv & 1) + 1) * 16 + r) * HQ_STR + ks * 32 + q * 8); }
          __builtin_amdgcn_sched_barrier(0);
#pragma unroll
          for (int jj = 0; jj < 2; ++jj) { const int tj = 2 * (wv & 1) + jj; f32x4 sc = (f32x4){0.f, 0.f, 0.f, 0.f};
              if (tj <= ti) {
#pragma unroll
                  for (int ks = 0; ks < 4; ++ks) sc = MFMA16(kf[jj][ks], qf[ks], sc); }
              const int t = ti * 16 + r, s0 = tj * 16 + q * 4;
#pragma unroll
              for (int j = 0; j < 4; ++j) sc[j] = (s0 + j <= t) ? sc[j] : 0.f;
              u32x2 w; w.x = pk_bf16(sc[0], sc[1]); w.y = pk_bf16(sc[2], sc[3]);
              *(u32x2*)(Pg + (size_t)item * 4096 + t * 64 + s0) = w; } }
    }
    __syncthreads();
}

constexpr int SB_QH = 0, SB_KHT = 17408, SB_VT = 35840, SB_P = 54272, SB_DEC = 63488, SB_SSQ = 64000, SB_SIZE = 66048;
struct ScanRegs { unsigned q2[8], k2[8], v2[8]; u32x4 pr; f32x4 dc; u32x2 hg[4]; f32x4 o[4]; };
__device__ __forceinline__ void scan_load(ScanRegs& R, const bf16_t* Qg, const bf16_t* Kg, const bf16_t* Vg, const bf16_t* Pg, const float* DECg, int bh, int n, size_t mb, size_t cb, int tid, int lane, int wv) {
    R.pr = *(const u32x4*)(Pg + (size_t)(bh * 32 + n) * 4096 + tid * 8);
    R.dc = *(const f32x4*)(DECg + (size_t)(bh * 32 + n) * 128 + (tid & 31) * 4);
    const size_t rb = (mb + (size_t)n * 64 + wv * 8) * 1024 + cb + 2 * lane;
#pragma unroll
    for (int i = 0; i < 8; ++i) { R.q2[i] = *(const unsigned*)(Qg + rb + (size_t)i * 1024); R.k2[i] = *(const unsigned*)(Kg + rb + (size_t)i * 1024); R.v2[i] = *(const unsigned*)(Vg + rb + (size_t)i * 1024); }
    asm volatile("" ::: "memory");
}
__device__ __forceinline__ void scan_chunk(ScanRegs& X, ScanRegs& Y, f32x4 (&S)[8], const f32x4 g4, int n, const bf16_t* Qg, const bf16_t* Kg, const bf16_t* Vg, const bf16_t* Pg, const float* DECg, bf16_t* HGg,
                                           int bh, size_t mb, size_t cb, int tid, int lane, int wv, int r, int q, LAS unsigned char* lds, bool dry) {
    constexpr int NCH = SEQ / 64;
    LAS unsigned char* B = lds + (n & 1) * SB_SIZE;
    const size_t m0 = mb + (size_t)n * 64;
    if (n < NCH) {
        LAS bf16_t* QH = (LAS bf16_t*)(B + SB_QH); LAS bf16_t* KHT = (LAS bf16_t*)(B + SB_KHT); LAS bf16_t* VT = (LAS bf16_t*)(B + SB_VT); LAS bf16_t* Pm = (LAS bf16_t*)(B + SB_P);
#pragma unroll
        for (int i = 0; i < 8; ++i) *(LAS unsigned*)(QH + (wv * 8 + i) * HQ_STR + 2 * lane) = X.q2[i];
        { u32x4 lo, hi; const unsigned* k2 = X.k2;
          lo.x = (k2[0] & 0xffffu) | (k2[1] << 16); lo.y = (k2[2] & 0xffffu) | (k2[3] << 16); lo.z = (k2[4] & 0xffffu) | (k2[5] << 16); lo.w = (k2[6] & 0xffffu) | (k2[7] << 16);
          hi.x = (k2[0] >> 16) | (k2[1] & 0xffff0000u); hi.y = (k2[2] >> 16) | (k2[3] & 0xffff0000u); hi.z = (k2[4] >> 16) | (k2[5] & 0xffff0000u); hi.w = (k2[6] >> 16) | (k2[7] & 0xffff0000u);
          *(LAS u32x4*)(KHT + (2 * lane) * HK_STR + wv * 8) = lo; *(LAS u32x4*)(KHT + (2 * lane + 1) * HK_STR + wv * 8) = hi; }
        { u32x4 lo, hi; const unsigned* v2 = X.v2;
          lo.x = (v2[0] & 0xffffu) | (v2[1] << 16); lo.y = (v2[2] & 0xffffu) | (v2[3] << 16); lo.z = (v2[4] & 0xffffu) | (v2[5] << 16); lo.w = (v2[6] & 0xffffu) | (v2[7] << 16);
          hi.x = (v2[0] >> 16) | (v2[1] & 0xffff0000u); hi.y = (v2[2] >> 16) | (v2[3] & 0xffff0000u); hi.z = (v2[4] >> 16) | (v2[5] & 0xffff0000u); hi.w = (v2[6] >> 16) | (v2[7] & 0xffff0000u);
          *(LAS u32x4*)(VT + (2 * lane) * HK_STR + wv * 8) = lo; *(LAS u32x4*)(VT + (2 * lane + 1) * HK_STR + wv * 8) = hi; }
        *(LAS u32x4*)(Pm + (tid >> 3) * HK_STR + (tid & 7) * 8) = X.pr;
        if (tid < 32) *(LAS f32x4*)((LAS float*)(B + SB_DEC) + tid * 4) = X.dc;
#pragma unroll
        for (int mt = 0; mt < 4; ++mt) X.hg[mt] = *(const u32x2*)(HGg + (m0 + mt * 16 + r) * 1024 + cb + 16 * wv + q * 4);
        scan_load(X, Qg, Kg, Vg, Pg, DECg, bh, (n + 2 < NCH) ? n + 2 : NCH - 1, mb, cb, tid, lane, wv);
    }
    LBAR();
    {
        const LAS float* SSQ = (const LAS float*)(lds + ((n - 1) & 1) * SB_SIZE + SB_SSQ);
#pragma unroll
        for (int mt = 0; mt < 4; ++mt) { float tot = 0.f;
#pragma unroll
            for (int w = 0; w < 8; ++w) tot += SSQ[w * 64 + mt * 16 + r];
            const float rstd = rsqrtf(tot * (1.f / 128.f) + EPS);
            const f32x4 ov = Y.o[mt] * rstd * g4 * (f32x4){bf_lo(Y.hg[mt].x), bf_hi(Y.hg[mt].x), bf_lo(Y.hg[mt].y), bf_hi(Y.hg[mt].y)};
            u32x2 w; w.x = pk_bf16(ov.x, ov.y); w.y = pk_bf16(ov.z, ov.w);
            if (n > 0 && (!dry || rstd == 12345.678f)) *(u32x2*)(HGg + (m0 - 64 + mt * 16 + r) * 1024 + cb + 16 * wv + q * 4) = w; }
    }
    if (n < NCH) {
        const LAS bf16_t* QH = (const LAS bf16_t*)(B + SB_QH); const LAS bf16_t* KHT = (const LAS bf16_t*)(B + SB_KHT); const LAS bf16_t* VT = (const LAS bf16_t*)(B + SB_VT); const LAS bf16_t* Pm = (const LAS bf16_t*)(B + SB_P);
        const LAS float* DEC = (const LAS float*)(B + SB_DEC); LAS float* SSQ = (LAS float*)(B + SB_SSQ);
#define SCHED_FENCE() __builtin_amdgcn_sched_barrier(0)
#define QFRAG(a, mt) __builtin_bit_cast(bf16x8, (u32x4){(*(const LAS u32x2*)(QH + ((mt) * 16 + r) * HQ_STR + 32 * (a) + q * 4)).x, (*(const LAS u32x2*)(QH + ((mt) * 16 + r) * HQ_STR + 32 * (a) + q * 4)).y, \
                                                        (*(const LAS u32x2*)(QH + ((mt) * 16 + r) * HQ_STR + 32 * (a) + 16 + q * 4)).x, (*(const LAS u32x2*)(QH + ((mt) * 16 + r) * HQ_STR + 32 * (a) + 16 + q * 4)).y})
#define SFRAG(a) __builtin_bit_cast(bf16x8, (u32x4){pk_bf16(S[2 * (a)][0], S[2 * (a)][1]), pk_bf16(S[2 * (a)][2], S[2 * (a)][3]), pk_bf16(S[2 * (a) + 1][0], S[2 * (a) + 1][1]), pk_bf16(S[2 * (a) + 1][2], S[2 * (a) + 1][3])})
        f32x4 o[4];
#pragma unroll
        for (int mt = 0; mt < 4; ++mt) o[mt] = (f32x4){0.f, 0.f, 0.f, 0.f};
        bf16x8 qa[8], qb[8];
#pragma unroll
        for (int mt = 0; mt < 4; ++mt) { qa[mt] = QFRAG(0, mt); qa[4 + mt] = QFRAG(1, mt); }
        SCHED_FENCE();
#pragma unroll
        for (int mt = 0; mt < 4; ++mt) { qb[mt] = QFRAG(2, mt); qb[4 + mt] = QFRAG(3, mt); }
        { const bf16x8 s0 = SFRAG(0), s1 = SFRAG(1);
#pragma unroll
          for (int mt = 0; mt < 4; ++mt) o[mt] = MFMA16(s0, qa[mt], o[mt]);
#pragma unroll
          for (int mt = 0; mt < 4; ++mt) o[mt] = MFMA16(s1, qa[4 + mt], o[mt]); }
        SCHED_FENCE();
        bf16x8 vf[2], pf[6];
#pragma unroll
        for (int ks = 0; ks < 2; ++ks) vf[ks] = *(const LAS bf16x8*)(VT + (16 * wv + r) * HK_STR + ks * 32 + q * 8);
#pragma unroll
        for (int mt = 0; mt < 4; ++mt) pf[mt] = *(const LAS bf16x8*)(Pm + (mt * 16 + r) * HK_STR + q * 8);
        pf[4] = *(const LAS bf16x8*)(Pm + (2 * 16 + r) * HK_STR + 32 + q * 8); pf[5] = *(const LAS bf16x8*)(Pm + (3 * 16 + r) * HK_STR + 32 + q * 8);
        { const bf16x8 s2 = SFRAG(2), s3 = SFRAG(3);
#pragma unroll
          for (int mt = 0; mt < 4; ++mt) o[mt] = MFMA16(s2, qb[mt], o[mt]);
#pragma unroll
          for (int mt = 0; mt < 4; ++mt) o[mt] = MFMA16(s3, qb[4 + mt], o[mt]); }
        SCHED_FENCE();
        f32x4 deca[4], decb[4]; bf16x8 kfa[8], kfb[8];
#pragma unroll
        for (int kt = 0; kt < 4; ++kt) { deca[kt] = *(const LAS f32x4*)(DEC + kt * 16 + q * 4); kfa[2 * kt] = *(const LAS bf16x8*)(KHT + (kt * 16 + r) * HK_STR + q * 8); kfa[2 * kt + 1] = *(const LAS bf16x8*)(KHT + (kt * 16 + r) * HK_STR + 32 + q * 8); }
#pragma unroll
        for (int mt = 0; mt < 4; ++mt) o[mt] = MFMA16(vf[0], pf[mt], o[mt]);
        o[2] = MFMA16(vf[1], pf[4], o[2]); o[3] = MFMA16(vf[1], pf[5], o[3]);
        SCHED_FENCE();
#pragma unroll
        for (int kt = 4; kt < 8; ++kt) { decb[kt - 4] = *(const LAS f32x4*)(DEC + kt * 16 + q * 4); kfb[2 * (kt - 4)] = *(const LAS bf16x8*)(KHT + (kt * 16 + r) * HK_STR + q * 8); kfb[2 * (kt - 4) + 1] = *(const LAS bf16x8*)(KHT + (kt * 16 + r) * HK_STR + 32 + q * 8); }
#pragma unroll
        for (int kt = 0; kt < 4; ++kt) { S[kt] = S[kt] * deca[kt]; S[kt] = MFMA16(kfa[2 * kt], vf[0], S[kt]); S[kt] = MFMA16(kfa[2 * kt + 1], vf[1], S[kt]); }
        SCHED_FENCE();
#pragma unroll
        for (int kt = 4; kt < 8; ++kt) { S[kt] = S[kt] * decb[kt - 4]; S[kt] = MFMA16(kfb[2 * (kt - 4)], vf[0], S[kt]); S[kt] = MFMA16(kfb[2 * (kt - 4) + 1], vf[1], S[kt]); }
        float ss[4];
#pragma unroll
        for (int mt = 0; mt < 4; ++mt) { ss[mt] = (o[mt].x * o[mt].x + o[mt].y * o[mt].y) + (o[mt].z * o[mt].z + o[mt].w * o[mt].w); X.o[mt] = o[mt]; }
        float t16[4];
#pragma unroll
        for (int mt = 0; mt < 4; ++mt) t16[mt] = __shfl_xor(ss[mt], 16);
        SCHED_FENCE();
#pragma unroll
        for (int mt = 0; mt < 4; ++mt) ss[mt] += t16[mt];
#pragma unroll
        for (int mt = 0; mt < 4; ++mt) t16[mt] = __shfl_xor(ss[mt], 32);
        SCHED_FENCE();
#pragma unroll
        for (int mt = 0; mt < 4; ++mt) { ss[mt] += t16[mt]; if (q == 0) SSQ[wv * 64 + mt * 16 + r] = ss[mt]; }
#undef QFRAG
#undef SFRAG
    }
}
__device__ __forceinline__ void scan_item(const bf16_t* Qg, const bf16_t* Kg, const bf16_t* Vg, const bf16_t* Pg, const float* DECg, bf16_t* HGg, const float* gnorm, int bh, LAS unsigned char* lds, bool dry = false) {
    int tid_l = threadIdx.x; asm volatile("" : "+v"(tid_l));
    const int tid = tid_l, lane = tid & 63, wv = __builtin_amdgcn_readfirstlane(tid >> 6), r = lane & 15, q = lane >> 4;
    f32x4 S[8];
#pragma unroll
    for (int kt = 0; kt < 8; ++kt) S[kt] = (f32x4){0.f, 0.f, 0.f, 0.f};
    const f32x4 g4 = *(const f32x4*)(gnorm + 16 * wv + q * 4);
    const size_t cb = (size_t)(bh & 7) * 128, mb = (size_t)(bh >> 3) * SEQ;
    ScanRegs X, Y;
    X.dc = (f32x4){0.f, 0.f, 0.f, 0.f}; Y.dc = X.dc;
#pragma unroll
    for (int mt = 0; mt < 4; ++mt) { X.o[mt] = (f32x4){0.f, 0.f, 0.f, 0.f}; Y.o[mt] = X.o[mt]; X.hg[mt] = (u32x2){0u, 0u}; Y.hg[mt] = X.hg[mt]; }
    asm volatile("" ::: "memory");
    scan_load(X, Qg, Kg, Vg, Pg, DECg, bh, 0, mb, cb, tid, lane, wv);
    scan_load(Y, Qg, Kg, Vg, Pg, DECg, bh, 1, mb, cb, tid, lane, wv);
#pragma unroll 1
    for (int n = 0; n < SEQ / 64; n += 2) {
        scan_chunk(X, Y, S, g4, n, Qg, Kg, Vg, Pg, DECg, HGg, bh, mb, cb, tid, lane, wv, r, q, lds, dry);
        scan_chunk(Y, X, S, g4, n + 1, Qg, Kg, Vg, Pg, DECg, HGg, bh, mb, cb, tid, lane, wv, r, q, lds, dry);
    }
    scan_chunk(X, Y, S, g4, SEQ / 64, Qg, Kg, Vg, Pg, DECg, HGg, bh, mb, cb, tid, lane, wv, r, q, lds, dry);
    __syncthreads();
}

constexpr int NSEG = 4, CPS = (SEQ / 64) / NSEG;
struct Scan1Regs { unsigned q2[8], k2[8], v2[8]; u32x4 pr; f32x4 dc; };
__device__ __forceinline__ void scan1_load(Scan1Regs& R, const bf16_t* Qg, const bf16_t* Kg, const bf16_t* Vg, const bf16_t* Pg, const float* DECg, int bh, int n, size_t mb, size_t cb, int tid, int lane, int wv) {
    R.pr = *(const u32x4*)(Pg + (size_t)(bh * 32 + n) * 4096 + tid * 8);
    R.dc = *(const f32x4*)(DECg + (size_t)(bh * 32 + n) * 128 + (tid & 31) * 4);
    const size_t rb = (mb + (size_t)n * 64 + wv * 8) * 1024 + cb + 2 * lane;
#pragma unroll
    for (int i = 0; i < 8; ++i) { R.q2[i] = *(const unsigned*)(Qg + rb + (size_t)i * 1024); R.k2[i] = *(const unsigned*)(Kg + rb + (size_t)i * 1024); R.v2[i] = *(const unsigned*)(Vg + rb + (size_t)i * 1024); }
    asm volatile("" ::: "memory");
}
#define SCHED_FENCE() __builtin_amdgcn_sched_barrier(0)
#define QFRAG(a, mt) __builtin_bit_cast(bf16x8, (u32x4){(*(const LAS u32x2*)(QH + ((mt) * 16 + r) * HQ_STR + 32 * (a) + q * 4)).x, (*(const LAS u32x2*)(QH + ((mt) * 16 + r) * HQ_STR + 32 * (a) + q * 4)).y, \
                                                        (*(const LAS u32x2*)(QH + ((mt) * 16 + r) * HQ_STR + 32 * (a) + 16 + q * 4)).x, (*(const LAS u32x2*)(QH + ((mt) * 16 + r) * HQ_STR + 32 * (a) + 16 + q * 4)).y})
#define SFRAG(a) __builtin_bit_cast(bf16x8, (u32x4){pk_bf16(S[2 * (a)][0], S[2 * (a)][1]), pk_bf16(S[2 * (a)][2], S[2 * (a)][3]), pk_bf16(S[2 * (a) + 1][0], S[2 * (a) + 1][1]), pk_bf16(S[2 * (a) + 1][2], S[2 * (a) + 1][3])})
__device__ __forceinline__ void scan1_chunk(Scan1Regs& X, f32x4 (&S)[8], int n, int nlast, const bf16_t* Qg, const bf16_t* Kg, bf16_t* Vg, const bf16_t* Pg, const float* DECg,
                                            int bh, size_t mb, size_t cb, int tid, int lane, int wv, int r, int q, LAS unsigned char* lds) {
    LAS unsigned char* B = lds + (n & 1) * SB_SIZE;
    const size_t m0 = mb + (size_t)n * 64;
    LAS bf16_t* QH = (LAS bf16_t*)(B + SB_QH); LAS bf16_t* KHT = (LAS bf16_t*)(B + SB_KHT); LAS bf16_t* VT = (LAS bf16_t*)(B + SB_VT); LAS bf16_t* Pm = (LAS bf16_t*)(B + SB_P);
    const LAS float* DEC = (const LAS float*)(B + SB_DEC);
#pragma unroll
    for (int i = 0; i < 8; ++i) *(LAS unsigned*)(QH + (wv * 8 + i) * HQ_STR + 2 * lane) = X.q2[i];
    { u32x4 lo, hi; const unsigned* k2 = X.k2;
      lo.x = (k2[0] & 0xffffu) | (k2[1] << 16); lo.y = (k2[2] & 0xffffu) | (k2[3] << 16); lo.z = (k2[4] & 0xffffu) | (k2[5] << 16); lo.w = (k2[6] & 0xffffu) | (k2[7] << 16);
      hi.x = (k2[0] >> 16) | (k2[1] & 0xffff0000u); hi.y = (k2[2] >> 16) | (k2[3] & 0xffff0000u); hi.z = (k2[4] >> 16) | (k2[5] & 0xffff0000u); hi.w = (k2[6] >> 16) | (k2[7] & 0xffff0000u);
      *(LAS u32x4*)(KHT + (2 * lane) * HK_STR + wv * 8) = lo; *(LAS u32x4*)(KHT + (2 * lane + 1) * HK_STR + wv * 8) = hi; }
    { u32x4 lo, hi; const unsigned* v2 = X.v2;
      lo.x = (v2[0] & 0xffffu) | (v2[1] << 16); lo.y = (v2[2] & 0xffffu) | (v2[3] << 16); lo.z = (v2[4] & 0xffffu) | (v2[5] << 16); lo.w = (v2[6] & 0xffffu) | (v2[7] << 16);
      hi.x = (v2[0] >> 16) | (v2[1] & 0xffff0000u); hi.y = (v2[2] >> 16) | (v2[3] & 0xffff0000u); hi.z = (v2[4] >> 16) | (v2[5] & 0xffff0000u); hi.w = (v2[6] >> 16) | (v2[7] & 0xffff0000u);
      *(LAS u32x4*)(VT + (2 * lane) * HK_STR + wv * 8) = lo; *(LAS u32x4*)(VT + (2 * lane + 1) * HK_STR + wv * 8) = hi; }
    *(LAS u32x4*)(Pm + (tid >> 3) * HK_STR + (tid & 7) * 8) = X.pr;
    if (tid < 32) *(LAS f32x4*)((LAS float*)(B + SB_DEC) + tid * 4) = X.dc;
    scan1_load(X, Qg, Kg, Vg, Pg, DECg, bh, (n + 2 <= nlast) ? n + 2 : nlast, mb, cb, tid, lane, wv);
    LBAR();
    f32x4 o[4];
#pragma unroll
    for (int mt = 0; mt < 4; ++mt) o[mt] = (f32x4){0.f, 0.f, 0.f, 0.f};
    bf16x8 qa[8], qb[8];
#pragma unroll
    for (int mt = 0; mt < 4; ++mt) { qa[mt] = QFRAG(0, mt); qa[4 + mt] = QFRAG(1, mt); }
    SCHED_FENCE();
#pragma unroll
    for (int mt = 0; mt < 4; ++mt) { qb[mt] = QFRAG(2, mt); qb[4 + mt] = QFRAG(3, mt); }
    { const bf16x8 s0 = SFRAG(0), s1 = SFRAG(1);
#pragma unroll
      for (int mt = 0; mt < 4; ++mt) o[mt] = MFMA16(s0, qa[mt], o[mt]);
#pragma unroll
      for (int mt = 0; mt < 4; ++mt) o[mt] = MFMA16(s1, qa[4 + mt], o[mt]); }
    SCHED_FENCE();
    bf16x8 vf[2], pf[6];
#pragma unroll
    for (int ks = 0; ks < 2; ++ks) vf[ks] = *(const LAS bf16x8*)(VT + (16 * wv + r) * HK_STR + ks * 32 + q * 8);
#pragma unroll
    for (int mt = 0; mt < 4; ++mt) pf[mt] = *(const LAS bf16x8*)(Pm + (mt * 16 + r) * HK_STR + q * 8);
    pf[4] = *(const LAS bf16x8*)(Pm + (2 * 16 + r) * HK_STR + 32 + q * 8); pf[5] = *(const LAS bf16x8*)(Pm + (3 * 16 + r) * HK_STR + 32 + q * 8);
    { const bf16x8 s2 = SFRAG(2), s3 = SFRAG(3);
#pragma unroll
      for (int mt = 0; mt < 4; ++mt) o[mt] = MFMA16(s2, qb[mt], o[mt]);
#pragma unroll
      for (int mt = 0; mt < 4; ++mt) o[mt] = MFMA16(s3, qb[4 + mt], o[mt]); }
    SCHED_FENCE();
    f32x4 deca[4], decb[4]; bf16x8 kfa[8], kfb[8];
#pragma unroll
    for (int kt = 0; kt < 4; ++kt) { deca[kt] = *(const LAS f32x4*)(DEC + kt * 16 + q * 4); kfa[2 * kt] = *(const LAS bf16x8*)(KHT + (kt * 16 + r) * HK_STR + q * 8); kfa[2 * kt + 1] = *(const LAS bf16x8*)(KHT + (kt * 16 + r) * HK_STR + 32 + q * 8); }
#pragma unroll
    for (int mt = 0; mt < 4; ++mt) o[mt] = MFMA16(vf[0], pf[mt], o[mt]);
    o[2] = MFMA16(vf[1], pf[4], o[2]); o[3] = MFMA16(vf[1], pf[5], o[3]);
    SCHED_FENCE();
#pragma unroll
    for (int kt = 4; kt < 8; ++kt) { decb[kt - 4] = *(const LAS f32x4*)(DEC + kt * 16 + q * 4); kfb[2 * (kt - 4)] = *(const LAS bf16x8*)(KHT + (kt * 16 + r) * HK_STR + q * 8); kfb[2 * (kt - 4) + 1] = *(const LAS bf16x8*)(KHT + (kt * 16 + r) * HK_STR + 32 + q * 8); }
#pragma unroll
    for (int kt = 0; kt < 4; ++kt) { S[kt] = S[kt] * deca[kt]; S[kt] = MFMA16(kfa[2 * kt], vf[0], S[kt]); S[kt] = MFMA16(kfa[2 * kt + 1], vf[1], S[kt]); }
    SCHED_FENCE();
#pragma unroll
    for (int kt = 4; kt < 8; ++kt) { S[kt] = S[kt] * decb[kt - 4]; S[kt] = MFMA16(kfb[2 * (kt - 4)], vf[0], S[kt]); S[kt] = MFMA16(kfb[2 * (kt - 4) + 1], vf[1], S[kt]); }
#pragma unroll
    for (int mt = 0; mt < 4; ++mt) { u32x2 w; w.x = pk_bf16(o[mt].x, o[mt].y); w.y = pk_bf16(o[mt].z, o[mt].w);
        *(u32x2*)(Vg + (m0 + mt * 16 + r) * 1024 + cb + 16 * wv + q * 4) = w; }
}
__device__ __forceinline__ void scan1_item(const bf16_t* Qg, const bf16_t* Kg, bf16_t* Vg, const bf16_t* Pg, const float* DECg, float* SLOC, float* DSEG, int item, LAS unsigned char* lds) {
    int tid_l = threadIdx.x; asm volatile("" : "+v"(tid_l));
    const int tid = tid_l, lane = tid & 63, wv = __builtin_amdgcn_readfirstlane(tid >> 6), r = lane & 15, q = lane >> 4;
    const int bh = item >> 2, seg = item & 3, n0 = seg * CPS, nlast = n0 + CPS - 1;
    f32x4 S[8];
#pragma unroll
    for (int kt = 0; kt < 8; ++kt) S[kt] = (f32x4){0.f, 0.f, 0.f, 0.f};
    const size_t cb = (size_t)(bh & 7) * 128, mb = (size_t)(bh >> 3) * SEQ;
    Scan1Regs X, Y;
    asm volatile("" ::: "memory");
    scan1_load(X, Qg, Kg, Vg, Pg, DECg, bh, n0, mb, cb, tid, lane, wv);
    scan1_load(Y, Qg, Kg, Vg, Pg, DECg, bh, n0 + 1, mb, cb, tid, lane, wv);
#pragma unroll 1
    for (int n = n0; n <= nlast; n += 2) {
        scan1_chunk(X, S, n, nlast, Qg, Kg, Vg, Pg, DECg, bh, mb, cb, tid, lane, wv, r, q, lds);
        scan1_chunk(Y, S, n + 1, nlast, Qg, Kg, Vg, Pg, DECg, bh, mb, cb, tid, lane, wv, r, q, lds);
    }
    f32x4* sl = (f32x4*)SLOC + ((size_t)item * 8 + wv) * 8 * 64 + lane;
#pragma unroll
    for (int kt = 0; kt < 8; ++kt) sl[kt * 64] = S[kt];
    if (wv == 0 && r == 0) {
#pragma unroll
        for (int kt = 0; kt < 8; ++kt) { f32x4 cdv = (f32x4){1.f, 1.f, 1.f, 1.f};
            for (int n = n0; n <= nlast; ++n) cdv = cdv * *(const f32x4*)(DECg + (size_t)(bh * 32 + n) * 128 + kt * 16 + q * 4);
            *(f32x4*)(DSEG + (size_t)item * 128 + kt * 16 + q * 4) = cdv; } }
    __syncthreads();
}

constexpr int F_QH = 0, F_QT = 17408, F_KT = 34816, F_KHT = 52224, F_VT = 70656, F_P = 89088, F_TOT = 98304, F_DEC = 102400;
struct FRegs { unsigned q2[8], z2[8], v2[8]; };
__device__ __forceinline__ void f_load(FRegs& R, const bf16_t* Qg, const bf16_t* LFg, const bf16_t* Vg, int n, size_t mb, size_t cb, int lane, int wv) {
    const size_t rb = (mb + (size_t)n * 64 + wv * 8) * 1024 + cb + 2 * lane;
#pragma unroll
    for (int i = 0; i < 8; ++i) { R.q2[i] = *(const unsigned*)(Qg + rb + (size_t)i * 1024); R.z2[i] = *(const unsigned*)(LFg + rb + (size_t)i * 1024); R.v2[i] = *(const unsigned*)(Vg + rb + (size_t)i * 1024); }
    asm volatile("" ::: "memory");
}
__device__ __forceinline__ void f_chunk(FRegs& X, f32x4 (&S)[8], float& cd0, float& cd1, int n, int nlast, const float lb0, const float lb1, bf16_t* Qg, const bf16_t* LFg, bf16_t* Vg, float* DECg,
                                        int bh, size_t mb, size_t cb, int tid, int lane, int wv, int r, int q, LAS unsigned char* lds) {
    LAS bf16_t* QH = (LAS bf16_t*)(lds + F_QH); LAS bf16_t* QT = (LAS bf16_t*)(lds + F_QT); LAS bf16_t* KT = (LAS bf16_t*)(lds + F_KT);
    LAS bf16_t* KHT = (LAS bf16_t*)(lds + F_KHT); LAS bf16_t* VT = (LAS bf16_t*)(lds + F_VT); LAS bf16_t* Pm = (LAS bf16_t*)(lds + F_P);
    LAS float* TOT = (LAS float*)(lds + F_TOT); LAS float* DEC = (LAS float*)(lds + F_DEC);
    const size_t m0 = mb + (size_t)n * 64, rb = (m0 + wv * 8) * 1024 + cb + 2 * lane;
    float f0[8], f1[8]; float run0 = 0.f, run1 = 0.f;
#pragma unroll
    for (int i = 0; i < 8; ++i) { const float z0 = h_lo(X.z2[i]), z1 = h_hi(X.z2[i]);
        f0[i] = fmaxf(lb0 + (1.f - lb0) * sigmoid_f(z0), 1e-30f); f1[i] = fmaxf(lb1 + (1.f - lb1) * sigmoid_f(z1), 1e-30f); run0 += __logf(f0[i]); run1 += __logf(f1[i]); }
    *(LAS f32x2*)(TOT + wv * 128 + 2 * lane) = (f32x2){run0, run1};
    LBAR();
    float pre0 = 0.f, pre1 = 0.f, last0 = 0.f, last1 = 0.f;
#pragma unroll
    for (int w = 0; w < 8; ++w) { const f32x2 t = *(const LAS f32x2*)(TOT + w * 128 + 2 * lane); last0 += t.x; last1 += t.y; if (w < wv) { pre0 += t.x; pre1 += t.y; } }
    { const f32x2 dv = (f32x2){__expf(last0), __expf(last1)}; cd0 *= dv.x; cd1 *= dv.y;
      if (wv == 0) { *(LAS f32x2*)(DEC + 2 * lane) = dv; *(f32x2*)(DECg + (size_t)(bh * 32 + n) * 128 + 2 * lane) = dv; } }
    const float sc0 = __expf(fminf(-0.5f * last0, 60.f)), sc1 = __expf(fminf(-0.5f * last1, 60.f));
    float pf0 = __expf(pre0), pf1 = __expf(pre1), sf0 = __expf(last0 - pre0 - run0), sf1 = __expf(last1 - pre1 - run1);
    { float kh0[8], kh1[8];
#pragma unroll
      for (int i = 7; i >= 0; --i) { kh0[i] = (1.f - f0[i]) * sf0; kh1[i] = (1.f - f1[i]) * sf1; sf0 *= f0[i]; sf1 *= f1[i]; }
#pragma unroll
      for (int i = 0; i < 8; ++i) { pf0 *= f0[i]; pf1 *= f1[i];
          const float qh0 = silu_f(bf_lo(X.q2[i])) * pf0, qh1 = silu_f(bf_hi(X.q2[i])) * pf1; const int t = wv * 8 + i; const unsigned qp = pk_bf16(qh0, qh1);
          *(unsigned*)(Qg + rb + (size_t)i * 1024) = qp;
          *(LAS unsigned*)(QH + t * HQ_STR + 2 * lane) = qp;
          *(LAS unsigned*)(QT + t * HQ_STR + 2 * lane) = pk_bf16(qh0 * sc0, qh1 * sc1);
          *(LAS unsigned*)(KT + t * HQ_STR + 2 * lane) = pk_bf16(kh0[i] * sc0, kh1[i] * sc1); }
      u32x4 a, c; a.x = pk_bf16(kh0[0], kh0[1]); a.y = pk_bf16(kh0[2], kh0[3]); a.z = pk_bf16(kh0[4], kh0[5]); a.w = pk_bf16(kh0[6], kh0[7]);
      c.x = pk_bf16(kh1[0], kh1[1]); c.y = pk_bf16(kh1[2], kh1[3]); c.z = pk_bf16(kh1[4], kh1[5]); c.w = pk_bf16(kh1[6], kh1[7]);
      *(LAS u32x4*)(KHT + (2 * lane) * HK_STR + wv * 8) = a; *(LAS u32x4*)(KHT + (2 * lane + 1) * HK_STR + wv * 8) = c; }
    { u32x4 lo, hi; const unsigned* v2 = X.v2;
      lo.x = (v2[0] & 0xffffu) | (v2[1] << 16); lo.y = (v2[2] & 0xffffu) | (v2[3] << 16); lo.z = (v2[4] & 0xffffu) | (v2[5] << 16); lo.w = (v2[6] & 0xffffu) | (v2[7] << 16);
      hi.x = (v2[0] >> 16) | (v2[1] & 0xffff0000u); hi.y = (v2[2] >> 16) | (v2[3] & 0xffff0000u); hi.z = (v2[4] >> 16) | (v2[5] & 0xffff0000u); hi.w = (v2[6] >> 16) | (v2[7] & 0xffff0000u);
      *(LAS u32x4*)(VT + (2 * lane) * HK_STR + wv * 8) = lo; *(LAS u32x4*)(VT + (2 * lane + 1) * HK_STR + wv * 8) = hi; }
    f_load(X, Qg, LFg, Vg, (n + 2 <= nlast) ? n + 2 : nlast, mb, cb, lane, wv);
    LBAR();
    const int ti = wv >> 1;
    { bf16x8 qf[4], kf[2][4];
#pragma unroll
      for (int ks = 0; ks < 4; ++ks) { qf[ks] = *(const LAS bf16x8*)(QT + (ti * 16 + r) * HQ_STR + ks * 32 + q * 8);
          kf[0][ks] = *(const LAS bf16x8*)(KT + ((2 * (wv & 1)) * 16 + r) * HQ_STR + ks * 32 + q * 8); kf[1][ks] = *(const LAS bf16x8*)(KT + ((2 * (wv & 1) + 1) * 16 + r) * HQ_STR + ks * 32 + q * 8); }
      SCHED_FENCE();
#pragma unroll
      for (int jj = 0; jj < 2; ++jj) { const int tj = 2 * (wv & 1) + jj; f32x4 sc = (f32x4){0.f, 0.f, 0.f, 0.f};
          if (tj <= ti) {
#pragma unroll
              for (int ks = 0; ks < 4; ++ks) sc = MFMA16(kf[jj][ks], qf[ks], sc); }
          const int t = ti * 16 + r, s0 = tj * 16 + q * 4;
#pragma unroll
          for (int j = 0; j < 4; ++j) sc[j] = (s0 + j <= t) ? sc[j] : 0.f;
          u32x2 w; w.x = pk_bf16(sc[0], sc[1]); w.y = pk_bf16(sc[2], sc[3]);
          *(LAS u32x2*)(Pm + t * HK_STR + s0) = w; } }
    f32x4 o[4];
#pragma unroll
    for (int mt = 0; mt < 4; ++mt) o[mt] = (f32x4){0.f, 0.f, 0.f, 0.f};
    { bf16x8 qa[8], qb[8];
#pragma unroll
      for (int mt = 0; mt < 4; ++mt) { qa[mt] = QFRAG(0, mt); qa[4 + mt] = QFRAG(1, mt); }
      SCHED_FENCE();
#pragma unroll
      for (int mt = 0; mt < 4; ++mt) { qb[mt] = QFRAG(2, mt); qb[4 + mt] = QFRAG(3, mt); }
      { const bf16x8 s0 = SFRAG(0), s1 = SFRAG(1);
#pragma unroll
        for (int mt = 0; mt < 4; ++mt) o[mt] = MFMA16(s0, qa[mt], o[mt]);
#pragma unroll
        for (int mt = 0; mt < 4; ++mt) o[mt] = MFMA16(s1, qa[4 + mt], o[mt]); }
      SCHED_FENCE();
      { const bf16x8 s2 = SFRAG(2), s3 = SFRAG(3);
#pragma unroll
        for (int mt = 0; mt < 4; ++mt) o[mt] = MFMA16(s2, qb[mt], o[mt]);
#pragma unroll
        for (int mt = 0; mt < 4; ++mt) o[mt] = MFMA16(s3, qb[4 + mt], o[mt]); } }
    LBAR();
    bf16x8 vf[2], pf[6];
#pragma unroll
    for (int ks = 0; ks < 2; ++ks) vf[ks] = *(const LAS bf16x8*)(VT + (16 * wv + r) * HK_STR + ks * 32 + q * 8);
#pragma unroll
    for (int mt = 0; mt < 4; ++mt) pf[mt] = *(const LAS bf16x8*)(Pm + (mt * 16 + r) * HK_STR + q * 8);
    pf[4] = *(const LAS bf16x8*)(Pm + (2 * 16 + r) * HK_STR + 32 + q * 8); pf[5] = *(const LAS bf16x8*)(Pm + (3 * 16 + r) * HK_STR + 32 + q * 8);
    SCHED_FENCE();
    f32x4 deca[4], decb[4]; bf16x8 kfa[8], kfb[8];
#pragma unroll
    for (int kt = 0; kt < 4; ++kt) { deca[kt] = *(const LAS f32x4*)(DEC + kt * 16 + q * 4); kfa[2 * kt] = *(const LAS bf16x8*)(KHT + (kt * 16 + r) * HK_STR + q * 8); kfa[2 * kt + 1] = *(const LAS bf16x8*)(KHT + (kt * 16 + r) * HK_STR + 32 + q * 8); }
#pragma unroll
    for (int mt = 0; mt < 4; ++mt) o[mt] = MFMA16(vf[0], pf[mt], o[mt]);
    o[2] = MFMA16(vf[1], pf[4], o[2]); o[3] = MFMA16(vf[1], pf[5], o[3]);
    SCHED_FENCE();
#pragma unroll
    for (int kt = 4; kt < 8; ++kt) { decb[kt - 4] = *(const LAS f32x4*)(DEC + kt * 16 + q * 4); kfb[2 * (kt - 4)] = *(const LAS bf16x8*)(KHT + (kt * 16 + r) * HK_STR + q * 8); kfb[2 * (kt - 4) + 1] = *(const LAS bf16x8*)(KHT + (kt * 16 + r) * HK_STR + 32 + q * 8); }
#pragma unroll
    for (int kt = 0; kt < 4; ++kt) { S[kt] = S[kt] * deca[kt]; S[kt] = MFMA16(kfa[2 * kt], vf[0], S[kt]); S[kt] = MFMA16(kfa[2 * kt + 1], vf[1], S[kt]); }
    SCHED_FENCE();
#pragma unroll
    for (int kt = 4; kt < 8; ++kt) { S[kt] = S[kt] * decb[kt - 4]; S[kt] = MFMA16(kfb[2 * (kt - 4)], vf[0], S[kt]); S[kt] = MFMA16(kfb[2 * (kt - 4) + 1], vf[1], S[kt]); }
#pragma unroll
    for (int mt = 0; mt < 4; ++mt) { u32x2 w; w.x = pk_bf16(o[mt].x, o[mt].y); w.y = pk_bf16(o[mt].z, o[mt].w);
        *(u32x2*)(Vg + (m0 + mt * 16 + r) * 1024 + cb + 16 * wv + q * 4) = w; }
}
__device__ __forceinline__ void f_item(bf16_t* Qg, const bf16_t* LFg, bf16_t* Vg, float* DECg, float* SLOC, float* DSEG, const float* lbl, int item, LAS unsigned char* lds) {
    int tid_l = threadIdx.x; asm volatile("" : "+v"(tid_l));
    const int tid = tid_l, lane = tid & 63, wv = __builtin_amdgcn_readfirstlane(tid >> 6), r = lane & 15, q = lane >> 4;
    const int bh = item >> 2, seg = item & 3, n0 = seg * CPS, nlast = n0 + CPS - 1;
    f32x4 S[8];
#pragma unroll
    for (int kt = 0; kt < 8; ++kt) S[kt] = (f32x4){0.f, 0.f, 0.f, 0.f};
    const size_t cb = (size_t)(bh & 7) * 128, mb = (size_t)(bh >> 3) * SEQ;
    const f32x2 lbp = *(const f32x2*)(lbl + (bh & 7) * 128 + 2 * lane);
    FRegs X, Y; float cd0 = 1.f, cd1 = 1.f;
    asm volatile("" ::: "memory");
    f_load(X, Qg, LFg, Vg, n0, mb, cb, lane, wv);
    f_load(Y, Qg, LFg, Vg, n0 + 1, mb, cb, lane, wv);
#pragma unroll 1
    for (int n = n0; n <= nlast; n += 2) {
        f_chunk(X, S, cd0, cd1, n, nlast, lbp.x, lbp.y, Qg, LFg, Vg, DECg, bh, mb, cb, tid, lane, wv, r, q, lds);
        f_chunk(Y, S, cd0, cd1, n + 1, nlast, lbp.x, lbp.y, Qg, LFg, Vg, DECg, bh, mb, cb, tid, lane, wv, r, q, lds);
    }
    f32x4* sl = (f32x4*)SLOC + ((size_t)item * 8 + wv) * 8 * 64 + lane;
#pragma unroll
    for (int kt = 0; kt < 8; ++kt) sl[kt * 64] = S[kt];
    if (wv == 0) *(f32x2*)(DSEG + (size_t)item * 128 + 2 * lane) = (f32x2){cd0, cd1};
    __syncthreads();
}

struct Scan2Regs { unsigned q2[8]; f32x4 dc; u32x2 ol[4], hg[4], hgc[4]; f32x4 o[4]; };
__device__ __forceinline__ void scan2_load(Scan2Regs& R, const bf16_t* Qg, const bf16_t* OLg, const bf16_t* HGg, const float* DECg, int bh, int n, size_t mb, size_t cb, int tid, int lane, int wv, int r, int q) {
    R.dc = *(const f32x4*)(DECg + (size_t)(bh * 32 + n) * 128 + (tid & 31) * 4);
    const size_t rb = (mb + (size_t)n * 64 + wv * 8) * 1024 + cb + 2 * lane;
#pragma unroll
    for (int i = 0; i < 8; ++i) R.q2[i] = *(const unsigned*)(Qg + rb + (size_t)i * 1024);
#pragma unroll
    for (int mt = 0; mt < 4; ++mt) { const size_t ob = (mb + (size_t)n * 64 + mt * 16 + r) * 1024 + cb + 16 * wv + q * 4; R.ol[mt] = *(const u32x2*)(OLg + ob); R.hg[mt] = *(const u32x2*)(HGg + ob); }
    asm volatile("" ::: "memory");
}
__device__ __forceinline__ void scan2_chunk(Scan2Regs& X, Scan2Regs& Y, f32x4 (&S)[8], const f32x4 g4, int n, int n0, int nlast, const bf16_t* Qg, const bf16_t* OLg, bf16_t* HGg, const float* DECg,
                                            int bh, size_t mb, size_t cb, int tid, int lane, int wv, int r, int q, LAS unsigned char* lds) {
    LAS unsigned char* B = lds + (n & 1) * SB_SIZE;
    const size_t m0 = mb + (size_t)n * 64;
    u32x2 olx[4];
    if (n <= nlast) {
        LAS bf16_t* QH = (LAS bf16_t*)(B + SB_QH);
#pragma unroll
        for (int i = 0; i < 8; ++i) *(LAS unsigned*)(QH + (wv * 8 + i) * HQ_STR + 2 * lane) = X.q2[i];
        if (tid < 32) *(LAS f32x4*)((LAS float*)(B + SB_DEC) + tid * 4) = X.dc;
#pragma unroll
        for (int mt = 0; mt < 4; ++mt) { X.hgc[mt] = X.hg[mt]; olx[mt] = X.ol[mt]; }
        scan2_load(X, Qg, OLg, HGg, DECg, bh, (n + 2 <= nlast) ? n + 2 : nlast, mb, cb, tid, lane, wv, r, q);
    }
    LBAR();
    if (n > n0) {
        const LAS float* SSQ = (const LAS float*)(lds + ((n - 1) & 1) * SB_SIZE + SB_SSQ);
#pragma unroll
        for (int mt = 0; mt < 4; ++mt) { float tot = 0.f;
#pragma unroll
            for (int w = 0; w < 8; ++w) tot += SSQ[w * 64 + mt * 16 + r];
            const float rstd = rsqrtf(tot * (1.f / 128.f) + EPS);
            const f32x4 ov = Y.o[mt] * rstd * g4 * (f32x4){silu_f(bf_lo(Y.hgc[mt].x)), silu_f(bf_hi(Y.hgc[mt].x)), silu_f(bf_lo(Y.hgc[mt].y)), silu_f(bf_hi(Y.hgc[mt].y))};
            u32x2 w; w.x = pk_bf16(ov.x, ov.y); w.y = pk_bf16(ov.z, ov.w);
            *(u32x2*)(HGg + (m0 - 64 + mt * 16 + r) * 1024 + cb + 16 * wv + q * 4) = w; }
    }
    if (n <= nlast) {
        const LAS bf16_t* QH = (const LAS bf16_t*)(B + SB_QH); const LAS float* DEC = (const LAS float*)(B + SB_DEC); LAS float* SSQ = (LAS float*)(B + SB_SSQ);
        f32x4 o[4];
#pragma unroll
        for (int mt = 0; mt < 4; ++mt) o[mt] = (f32x4){bf_lo(olx[mt].x), bf_hi(olx[mt].x), bf_lo(olx[mt].y), bf_hi(olx[mt].y)};
        bf16x8 qa[8], qb[8];
#pragma unroll
        for (int mt = 0; mt < 4; ++mt) { qa[mt] = QFRAG(0, mt); qa[4 + mt] = QFRAG(1, mt); }
        SCHED_FENCE();
#pragma unroll
        for (int mt = 0; mt < 4; ++mt) { qb[mt] = QFRAG(2, mt); qb[4 + mt] = QFRAG(3, mt); }
        { const bf16x8 s0 = SFRAG(0), s1 = SFRAG(1);
#pragma unroll
          for (int mt = 0; mt < 4; ++mt) o[mt] = MFMA16(s0, qa[mt], o[mt]);
#pragma unroll
          for (int mt = 0; mt < 4; ++mt) o[mt] = MFMA16(s1, qa[4 + mt], o[mt]); }
        SCHED_FENCE();
        f32x4 dec[8];
#pragma unroll
        for (int kt = 0; kt < 8; ++kt) dec[kt] = *(const LAS f32x4*)(DEC + kt * 16 + q * 4);
        { const bf16x8 s2 = SFRAG(2), s3 = SFRAG(3);
#pragma unroll
          for (int mt = 0; mt < 4; ++mt) o[mt] = MFMA16(s2, qb[mt], o[mt]);
#pragma unroll
          for (int mt = 0; mt < 4; ++mt) o[mt] = MFMA16(s3, qb[4 + mt], o[mt]); }
        SCHED_FENCE();
#pragma unroll
        for (int kt = 0; kt < 8; ++kt) S[kt] = S[kt] * dec[kt];
        float ss[4], t16[4];
#pragma unroll
        for (int mt = 0; mt < 4; ++mt) { ss[mt] = (o[mt].x * o[mt].x + o[mt].y * o[mt].y) + (o[mt].z * o[mt].z + o[mt].w * o[mt].w); X.o[mt] = o[mt]; }
#pragma unroll
        for (int mt = 0; mt < 4; ++mt) t16[mt] = __shfl_xor(ss[mt], 16);
        SCHED_FENCE();
#pragma unroll
        for (int mt = 0; mt < 4; ++mt) ss[mt] += t16[mt];
#pragma unroll
        for (int mt = 0; mt < 4; ++mt) t16[mt] = __shfl_xor(ss[mt], 32);
        SCHED_FENCE();
#pragma unroll
        for (int mt = 0; mt < 4; ++mt) { ss[mt] += t16[mt]; if (q == 0) SSQ[wv * 64 + mt * 16 + r] = ss[mt]; }
    }
}
__device__ __forceinline__ void scan2_item(const bf16_t* Qg, const bf16_t* OLg, bf16_t* HGg, const float* DECg, const float* SLOC, const float* DSEG, const float* gnorm, int item, LAS unsigned char* lds) {
    int tid_l = threadIdx.x; asm volatile("" : "+v"(tid_l));
    const int tid = tid_l, lane = tid & 63, wv = __builtin_amdgcn_readfirstlane(tid >> 6), r = lane & 15, q = lane >> 4;
    const int bh = item >> 2, seg = item & 3, n0 = seg * CPS, nlast = n0 + CPS - 1;
    const f32x4 g4 = *(const f32x4*)(gnorm + 16 * wv + q * 4);
    const size_t cb = (size_t)(bh & 7) * 128, mb = (size_t)(bh >> 3) * SEQ;
    Scan2Regs X, Y;
#pragma unroll
    for (int mt = 0; mt < 4; ++mt) { X.o[mt] = (f32x4){0.f, 0.f, 0.f, 0.f}; Y.o[mt] = X.o[mt]; X.hgc[mt] = (u32x2){0u, 0u}; Y.hgc[mt] = X.hgc[mt]; }
    asm volatile("" ::: "memory");
    scan2_load(X, Qg, OLg, HGg, DECg, bh, n0, mb, cb, tid, lane, wv, r, q);
    scan2_load(Y, Qg, OLg, HGg, DECg, bh, n0 + 1, mb, cb, tid, lane, wv, r, q);
    f32x4 S[8];
#pragma unroll
    for (int kt = 0; kt < 8; ++kt) S[kt] = (f32x4){0.f, 0.f, 0.f, 0.f};
    for (int j = 0; j < seg; ++j) {
        const f32x4* sl = (const f32x4*)SLOC + ((size_t)(bh * NSEG + j) * 8 + wv) * 8 * 64 + lane; const float* ds = DSEG + (size_t)(bh * NSEG + j) * 128 + q * 4;
#pragma unroll
        for (int kt = 0; kt < 8; ++kt) S[kt] = S[kt] * *(const f32x4*)(ds + kt * 16) + sl[kt * 64];
    }
#pragma unroll 1
    for (int n = n0; n <= nlast; n += 2) {
        scan2_chunk(X, Y, S, g4, n, n0, nlast, Qg, OLg, HGg, DECg, bh, mb, cb, tid, lane, wv, r, q, lds);
        scan2_chunk(Y, X, S, g4, n + 1, n0, nlast, Qg, OLg, HGg, DECg, bh, mb, cb, tid, lane, wv, r, q, lds);
    }
    scan2_chunk(X, Y, S, g4, nlast + 1, n0, nlast, Qg, OLg, HGg, DECg, bh, mb, cb, tid, lane, wv, r, q, lds);
    __syncthreads();
}
#undef QFRAG
#undef SFRAG

__global__ void __launch_bounds__(512, 2) fwd_megakernel(Params p) {
    extern __shared__ __attribute__((aligned(16))) unsigned char lds_raw[];
    LAS unsigned char* lds = (LAS unsigned char*)lds_raw;
#ifdef USE_CG_SYNC
    cg::grid_group grid = cg::this_grid();
#endif
    const int G = gridDim.x, blk = blockIdx.x;
    unsigned char* ws = p.ws;
    float* ADA = (float*)(ws + WS_ADA);
    bf16_t* H = (bf16_t*)(ws + WS_H); bf16_t* PV = (bf16_t*)(ws + WS_PV); bf16_t* PG = (bf16_t*)(ws + WS_PG); bf16_t* Q = (bf16_t*)(ws + WS_Q);
    bf16_t* LF = (bf16_t*)(ws + WS_LF); bf16_t* V = (bf16_t*)(ws + WS_V); bf16_t* HG = (bf16_t*)(ws + WS_HG);
    bf16_t* GATE = Q; bf16_t* MERGED = LF; bf16_t* Y = V;

    volatile LAS unsigned* stw = (volatile LAS unsigned*)(lds + LDS_BARW);
    unsigned* barw = (unsigned*)(ws + WS_BAR);
    if (threadIdx.x < 4) stw[threadIdx.x] = 0u;
    __syncthreads();
#ifdef USE_CG_SYNC
    if (blk == 0) for (int i = threadIdx.x; i < XCD_BAR_WORDS; i += 512) barw[i] = 0u;
    p0_prologue(p, lds);
    grid.sync();
    const XcdBarrier xb = xcd_barrier_post(barw, stw);
#else
    const XcdBarrier xb = xcd_barrier_post(barw, stw);
    p0_prologue(p, lds);
#ifdef DUP_P0
    __syncthreads(); p0_prologue(p, lds);
#endif
    xcd_barrier(xb);
#endif
#define GSYNC() xcd_barrier(xb)
#pragma unroll 1
    for (int l = 0; l < NL; ++l) {
#ifndef SKIP_P1
        if (l == 0) p1_rows<false, true>(p.x, nullptr, nullptr, nullptr, nullptr, p.g_pre, ADA, H);
        else p1_rows<true, true>(p.x, Y, ADA + (size_t)(l - 1) * NB * 3072, p.g_post + (size_t)(l - 1) * D, p.out, p.g_pre + (size_t)l * D, ADA + (size_t)l * NB * 3072, H);
#ifdef DUP_P1
        if (l == 0) p1_rows<false, true>(p.x, nullptr, nullptr, nullptr, nullptr, p.g_pre, ADA, H);
        else p1_rows<true, true>(p.x, Y, ADA + (size_t)(l - 1) * NB * 3072, p.g_post + (size_t)(l - 1) * D, p.out, p.g_pre + (size_t)l * D, ADA + (size_t)l * NB * 3072, H);
#endif
#endif
        GSYNC();
#pragma unroll 1
        for (int s = 0; s < 4; ++s) {
            const bf16_t* WinT = (const bf16_t*)(ws + WS_WIN) + (size_t)l * INW * D;
            pg8::Gemm g; g.M = M; g.N = D; g.K = D; g.A = nullptr; g.Bt = nullptr;
            pg8::StaticOrder S;
            if (s == 0) { g.N = NIN; S.init(M, NIN, G, blk); S.A0 = H; S.B0 = WinT; S.mode0 = 0; }
            else if (s == 1) { S.init(M, D, G, blk); S.dup = 3; S.A0 = H; S.B0 = WinT + (size_t)5120 * D; S.mode0 = 1;
                               S.A2 = HG; S.B2 = (const bf16_t*)(ws + WS_WHO) + (size_t)l * D * D; S.mode2 = 2; }
            else if (s == 2) { g.K = 512; S.init(M, D, G, blk); S.A0 = PG; S.B0 = (const bf16_t*)(ws + WS_WPO) + (size_t)l * D * 512; S.mode0 = 3; }
            else { S.init(M, D, G, blk); S.A0 = MERGED; S.B0 = (const bf16_t*)(ws + WS_WOUT) + (size_t)l * D * D; S.mode0 = 4; }
            EpiU E{ws};
#ifdef PROBE_G
            const unsigned long long tg0 = __builtin_amdgcn_s_memrealtime();
#endif
            pg8::gemm_phase<EpiU, pg8::StaticOrder, PG8_ALIGN_SEL, PG8_SP2_SEL>(lds, g, S, E);
#ifdef PROBE_G
            if ((PROBE_G >> s) & 1) probe_acc += __builtin_amdgcn_s_memrealtime() - tg0;
#endif
            if (s == 0) {
                GSYNC();
#ifdef PROBE_P3
                const unsigned long long tp0 = __builtin_amdgcn_s_memrealtime();
#endif
                bf16_t* Pg = (bf16_t*)(ws + WS_P); float* DECg = (float*)(ws + WS_DEC);
                float* SLOC = (float*)(ws + WS_P); float* DSEG = (float*)(ws + WS_DSEG);
                const bool own = (G == NB * 8 * NSEG);
                if (own) f_item(Q, LF, V, DECg, SLOC, DSEG, (const float*)(ws + WS_LB) + l * 1024, blk, lds);
                else prep_items(Q, LF, Pg, DECg, (const float*)(ws + WS_LB) + l * 1024, blk, G, 2048, lds);
                for (int pi = blk; pi < 1024; pi += G) {
                    const int gq = pi & 3, m0 = (pi >> 2) * 64;
                    const bf16_t* pw = (const bf16_t*)(ws + WS_POOLWT) + (size_t)(l * 4 + gq) * 16384; const float* ps = p.pool_scale + l * 512 + gq * 128;
                    if (gq == 0) pool_item<2>(PV, PG, pw, ps, m0, gq, lds); else if (gq == 1) pool_item<4>(PV, PG, pw, ps, m0, gq, lds);
                    else if (gq == 2) pool_item<8>(PV, PG, pw, ps, m0, gq, lds); else pool_item<16>(PV, PG, pw, ps, m0, gq, lds);
                }
                if (!own) { GSYNC(); for (int it = blk; it < NB * 8 * NSEG; it += G) scan1_item(Q, LF, V, Pg, DECg, SLOC, DSEG, it, lds); }
                GSYNC();
                for (int it = blk; it < NB * 8 * NSEG; it += G) scan2_item(Q, V, HG, DECg, SLOC, DSEG, p.hgrn_norm_g + l * 128, it, lds);
                GSYNC();
            } else if (s >= 2) GSYNC();
        }
    }
#ifdef DUP_SYNC
    for (int i = 0; i < 16; ++i) GSYNC();
#endif
    p1_rows<true, false>(p.out, Y, ADA + (size_t)(NL - 1) * NB * 3072, p.g_post + (size_t)(NL - 1) * D, p.out, nullptr, nullptr, nullptr);
#if defined(PROBE_P3) || defined(PROBE_G)
    __syncthreads();
    if (blk == 0 && threadIdx.x == 0) p.out[0] = 25.f * floorf((float)probe_acc * 0.01f / 25.f + 0.5f);
#endif
}

extern "C" void kernel_launch(void* const* d_in, const int* in_sizes, int n_in, void* d_out, int out_size, void* d_ws, size_t ws_size, hipStream_t stream) {
    static int grid_blocks = 0;
    if (grid_blocks == 0) {
        if (n_in != 14 || out_size != M * D || ws_size < WS_END) { fprintf(stderr, "kernel_launch: unexpected problem (n_in %d out %d ws %zu)\n", n_in, out_size, ws_size); grid_blocks = -1; return; }
        int dev = 0, cus = 0, per_cu = 0;
        (void)hipGetDevice(&dev);
        (void)hipDeviceGetAttribute(&cus, hipDeviceAttributeMultiprocessorCount, dev);
        (void)hipFuncSetAttribute((const void*)fwd_megakernel, hipFuncAttributeMaxDynamicSharedMemorySize, LDS_BYTES);
        (void)hipOccupancyMaxActiveBlocksPerMultiprocessor(&per_cu, (const void*)fwd_megakernel, 512, LDS_BYTES);
        if (per_cu < 1) { fprintf(stderr, "kernel_launch: occupancy query says %d blocks per CU\n", per_cu); grid_blocks = -1; return; }
        grid_blocks = cus;
    }
    if (grid_blocks < 0) return;
    Params p{};
    p.x = (const float*)d_in[0]; p.c = (const float*)d_in[1]; p.w_ada = (const float*)d_in[2]; p.b_ada = (const float*)d_in[3]; p.g_pre = (const float*)d_in[4]; p.g_post = (const float*)d_in[5];
    p.w_in = (const float*)d_in[6]; p.pool_w = (const float*)d_in[7]; p.pool_scale = (const float*)d_in[8]; p.lb_logits = (const float*)d_in[9]; p.hgrn_norm_g = (const float*)d_in[10];
    p.w_pool_o = (const float*)d_in[11]; p.w_hgrn_o = (const float*)d_in[12]; p.w_out = (const float*)d_in[13];
    p.out = (float*)d_out; p.ws = (unsigned char*)d_ws;
#ifndef USE_CG_SYNC
    (void)hipMemsetAsync((unsigned char*)d_ws + WS_BAR, 0, XCD_BAR_WORDS * sizeof(unsigned), stream);
#endif
    void* args[] = {&p};
    hipError_t e = hipLaunchCooperativeKernel((const void*)fwd_megakernel, dim3(grid_blocks), dim3(512), args, LDS_BYTES, stream);
    if (e != hipSuccess) fprintf(stderr, "cooperative launch failed: %s (grid %d)\n", hipGetErrorString(e), grid_blocks);
}
```

```cpp
#define PG8_ALIGN_SEL true
#define PG8_SP2_SEL true
#include <hip/hip_runtime.h>
#include <hip/hip_cooperative_groups.h>
#include <cstdio>
#include <cstdint>
namespace cg = cooperative_groups;
#define LAS __attribute__((address_space(3)))
namespace pg8 {
#define PG8_LAS __attribute__((address_space(3)))
typedef unsigned short bf16_t;
typedef short bf16x8 __attribute__((ext_vector_type(8)));
typedef float f32x4 __attribute__((ext_vector_type(4)));
typedef unsigned u32x4 __attribute__((ext_vector_type(4)));
constexpr int BM = 256, BK = 64, HALF = 128, HTB = HALF * BK * 2  , STAGE_BYTES = 8 * HTB, NXCD = 8, WGM = 8;

__host__ __device__ __forceinline__ int lds_byte(int r, int c) { const int st = (r >> 4) * 2 + (c >> 5), rr = r & 15, cc = c & 31, ob = rr * 64 + cc * 2; return st * 1024 + (ob ^ (((ob >> 9) & 1) << 5)); }
__host__ __device__ __forceinline__ void stage_rc(int b, int& R, int& C) { const int st = b / 1024, sb = b % 1024, swz = sb ^ (((sb >> 9) & 1) << 5); R = (st >> 1) * 16 + swz / 64; C = (st & 1) * 32 + (swz % 64) / 2; }
__host__ __device__ __forceinline__ int perm32(int rho) { const int n = rho >> 4, i = rho & 15; return 8 * (i >> 2) + 4 * n + (i & 3); }

struct Unit { int pm, pn; const unsigned short* A; const unsigned short* Bt; int mode; };
struct Gemm { const bf16_t* A; const bf16_t* Bt; int M, N, K; };

struct StaticOrder {
    int nM, nN, nwg, G, c, dup;
    const unsigned short *A0, *B0, *A2, *B2; int mode0, mode2;
    __host__ __device__ void init(int M, int N, int G_, int c_) { nM = M / BM; nN = N / BM; nwg = nM * nN; G = G_; c = c_; dup = 0; A0 = B0 = A2 = B2 = nullptr; mode0 = mode2 = 0; }
    __host__ __device__ bool next(int i, Unit& u) const {
        if (dup > 0 && i >= dup) return false;
        const long L = (dup > 0) ? (long)c : (long)i * G + c; if (L >= nwg) return false;
        int wgid = (int)L; { const int q = nwg / NXCD, r = nwg % NXCD, xcd = wgid % NXCD, off = wgid / NXCD; wgid = (xcd < r ? xcd * (q + 1) : r * (q + 1) + (xcd - r) * q) + off; }
        const int nig = WGM * nN, gid = wgid / nig, fm = gid * WGM, gsz = (nM - fm) < WGM ? (nM - fm) : WGM;
        u.pm = fm + ((wgid % nig) % gsz); u.pn = (wgid % nig) / gsz + ((dup > 0 && i == 1) ? nN : 0);
        const bool third = (dup > 0 && i == 2);
        u.A = third ? A2 : A0; u.Bt = third ? B2 : B0; u.mode = third ? mode2 : mode0; return true;
    }
    __device__ __forceinline__ void a_ready(const Unit&) const {}
    __device__ __forceinline__ void done(const Unit&) const {}
};
__device__ __forceinline__ unsigned cvt_pk_bf16(float lo, float hi) { unsigned r; asm volatile("v_cvt_pk_bf16_f32 %0, %1, %2" : "=v"(r) : "v"(lo), "v"(hi)); return r; }
template <class Epi, class Sched, bool ALIGN_EPI = false, bool SP2 = false>
__device__ __forceinline__ void gemm_phase(PG8_LAS unsigned char* lds, const Gemm g, const Sched& S, const Epi& E) {
    int tid_l = threadIdx.x; asm volatile("" : "+v"(tid_l));
    const int tid = tid_l, wid = __builtin_amdgcn_readfirstlane(tid >> 6), lane = tid & 63, wr = wid >> 2, wc = wid & 3, fr = lane & 15, fq = lane >> 4;
    const int K = g.K, nt = K / BK;
    unsigned voffA[2], voffB[2];
#pragma unroll
    for (int i = 0; i < 2; ++i) { int R, C; stage_rc(tid * 16 + i * 8192, R, C); const int Rb = Epi::PERM ? ((R & ~31) + perm32(R & 31)) : R;
        voffA[i] = (unsigned)(R * K + C) * 2u; voffB[i] = (unsigned)(Rb * K + C) * 2u; }
    const size_t kstep = (size_t)(BK * 2);
    const size_t hstep = (size_t)HALF * K * 2;
    const size_t tstep = 2 * hstep;
    const unsigned ldsw = (unsigned)wid * 1024u;
    const int aoff = lds_byte(wr * 64 + fr, fq * 8), boff = lds_byte(wc * 32 + fr, fq * 8);
#define PG8_SA(b, h) (((b) * 2 + (h)) * HTB)
#define PG8_SB(b, h) ((4 + (b) * 2 + (h)) * HTB)
#define PG8_STAGE(bufoff, gbase, voff) do { _Pragma("unroll") for (int _i = 0; _i < 2; ++_i) \
        __builtin_amdgcn_global_load_lds((const unsigned*)((const char*)(gbase) + (voff)[_i]), (PG8_LAS unsigned*)(lds + (bufoff) + ldsw + _i * 8192), 16, 0, 0); } while (0)
#define PG8_LDA(dst, b, h) do { _Pragma("unroll") for (int m = 0; m < 4; ++m) _Pragma("unroll") for (int k = 0; k < 2; ++k) dst[m][k] = *(const PG8_LAS bf16x8*)(lds + PG8_SA(b, h) + aoff + m * 2048 + k * 1024); } while (0)
#define PG8_LDB(dst, b, h) do { _Pragma("unroll") for (int n = 0; n < 2; ++n) _Pragma("unroll") for (int k = 0; k < 2; ++k) dst[n][k] = *(const PG8_LAS bf16x8*)(lds + PG8_SB(b, h) + boff + n * 2048 + k * 1024); } while (0)
#define PG8_MMA(ai, bj, At, Bt) do { __builtin_amdgcn_s_setprio(1); _Pragma("unroll") for (int m = 0; m < 4; ++m) _Pragma("unroll") for (int n = 0; n < 2; ++n) _Pragma("unroll") for (int k = 0; k < 2; ++k) \
        acc[ai][bj][m][n] = __builtin_amdgcn_mfma_f32_16x16x32_bf16(Bt[n][k], At[m][k], acc[ai][bj][m][n], 0, 0, 0); __builtin_amdgcn_s_setprio(0); } while (0)
#define PG8_WAIT_V(n) asm volatile("s_waitcnt vmcnt(" #n ")" ::: "memory")
#define PG8_WAIT_L(n) asm volatile("s_waitcnt lgkmcnt(" #n ")" ::: "memory")
#define PG8_BAR __builtin_amdgcn_s_barrier()
#define PG8_SCHED __builtin_amdgcn_sched_barrier(0)
    Unit cur, nxt; int ui = 0;
    if (!S.next(0, cur)) return;
    f32x4 acc[2][2][4][2];
#pragma unroll
    for (int a = 0; a < 2; ++a)
#pragma unroll
        for (int b = 0; b < 2; ++b)
#pragma unroll
            for (int m = 0; m < 4; ++m)
#pragma unroll
                for (int n = 0; n < 2; ++n) acc[a][b][m][n] = (f32x4){0.f, 0.f, 0.f, 0.f};
    bf16x8 At[4][2], B0[2][2], B1[2][2];
    const char* cA = (const char*)cur.A + (size_t)cur.pm * tstep; const char* cB = (const char*)cur.Bt + (size_t)cur.pn * tstep;
    S.a_ready(cur);
    if constexpr (SP2) {
        PG8_STAGE(PG8_SB(0, 0), cB, voffB); PG8_STAGE(PG8_SB(0, 1), cB + hstep, voffB); PG8_STAGE(PG8_SA(0, 0), cA, voffA); PG8_STAGE(PG8_SA(0, 1), cA + hstep, voffA);
        if (wr == 1) PG8_BAR;
        PG8_WAIT_V(2); PG8_BAR;
        PG8_STAGE(PG8_SB(1, 0), cB + kstep, voffB); PG8_STAGE(PG8_SA(1, 0), cA + kstep, voffA); PG8_STAGE(PG8_SB(1, 1), cB + hstep + kstep, voffB);
        PG8_WAIT_V(6); PG8_BAR;
    } else {
        PG8_STAGE(PG8_SB(0, 0), cB, voffB); PG8_STAGE(PG8_SA(0, 0), cA, voffA); PG8_STAGE(PG8_SB(0, 1), cB + hstep, voffB); PG8_STAGE(PG8_SA(0, 1), cA + hstep, voffA);
        if (wr == 1) PG8_BAR;
        PG8_WAIT_V(4); PG8_BAR;
        PG8_STAGE(PG8_SB(1, 0), cB + kstep, voffB); PG8_STAGE(PG8_SA(1, 0), cA + kstep, voffA); PG8_STAGE(PG8_SB(1, 1), cB + hstep + kstep, voffB);
        PG8_WAIT_V(6); PG8_BAR;
    }
    for (;;) {
        const bool has_next = S.next(ui + 1, nxt);
        const char* nA = has_next ? (const char*)nxt.A + (size_t)nxt.pm * tstep : cA; const char* nB = has_next ? (const char*)nxt.Bt + (size_t)nxt.pn * tstep : cB;
        for (int t = 0; t < nt; t += 2) {
            const bool last = (t == nt - 2);
            const char* a1 = cA + (size_t)(t + 1) * kstep;
            const char* a2 = last ? nA : cA + (size_t)(t + 2) * kstep; const char* b2 = last ? nB : cB + (size_t)(t + 2) * kstep;
            const char* a3 = a2 + kstep; const char* b3 = b2 + kstep;
            if (last && has_next) S.a_ready(nxt);
            if constexpr (SP2) {
            PG8_LDB(B0, 0, 0); PG8_LDB(B1, 0, 1); PG8_SCHED; PG8_LDA(At, 0, 0); PG8_STAGE(PG8_SA(1, 1), a1 + hstep, voffA);
            PG8_WAIT_V(8); PG8_WAIT_L(0); PG8_BAR; PG8_MMA(0, 0, At, B0); PG8_MMA(0, 1, At, B1); PG8_BAR; PG8_SCHED;
            PG8_LDA(At, 0, 1); PG8_STAGE(PG8_SB(0, 0), b2, voffB); PG8_STAGE(PG8_SB(0, 1), b2 + hstep, voffB); PG8_STAGE(PG8_SA(0, 0), a2, voffA);
            PG8_WAIT_V(8); PG8_WAIT_L(0); PG8_BAR; PG8_MMA(1, 0, At, B0); PG8_MMA(1, 1, At, B1); PG8_BAR; PG8_SCHED;
            PG8_LDB(B0, 1, 0); PG8_LDB(B1, 1, 1); PG8_SCHED; PG8_LDA(At, 1, 0); PG8_STAGE(PG8_SA(0, 1), a2 + hstep, voffA);
            PG8_WAIT_V(8); PG8_WAIT_L(0); PG8_BAR; PG8_MMA(0, 0, At, B0); PG8_MMA(0, 1, At, B1); PG8_BAR; PG8_SCHED;
            PG8_LDA(At, 1, 1); PG8_STAGE(PG8_SB(1, 0), b3, voffB); PG8_STAGE(PG8_SB(1, 1), b3 + hstep, voffB); PG8_STAGE(PG8_SA(1, 0), a3, voffA);
            PG8_WAIT_V(8); PG8_WAIT_L(0); PG8_BAR; PG8_MMA(1, 0, At, B0); PG8_MMA(1, 1, At, B1); PG8_BAR; PG8_SCHED;
            } else {
            PG8_LDB(B0, 0, 0); PG8_SCHED; PG8_LDA(At, 0, 0); PG8_STAGE(PG8_SA(1, 1), a1 + hstep, voffA);
            PG8_WAIT_L(8); PG8_BAR; PG8_WAIT_L(0); PG8_MMA(0, 0, At, B0); PG8_BAR; PG8_SCHED;
            PG8_LDB(B1, 0, 1); PG8_STAGE(PG8_SB(0, 0), b2, voffB);
            PG8_BAR; PG8_WAIT_L(0); PG8_MMA(0, 1, At, B1); PG8_BAR;
            PG8_LDA(At, 0, 1); PG8_STAGE(PG8_SA(0, 0), a2, voffA);
            PG8_BAR; PG8_WAIT_L(0); PG8_MMA(1, 0, At, B0); PG8_BAR; PG8_SCHED;
            PG8_STAGE(PG8_SB(0, 1), b2 + hstep, voffB);
            PG8_WAIT_V(6); PG8_BAR; PG8_MMA(1, 1, At, B1); PG8_BAR;
            PG8_LDB(B0, 1, 0); PG8_SCHED; PG8_LDA(At, 1, 0); PG8_STAGE(PG8_SA(0, 1), a2 + hstep, voffA);
            PG8_WAIT_L(8); PG8_BAR; PG8_WAIT_L(0); PG8_MMA(0, 0, At, B0); PG8_BAR; PG8_SCHED;
            PG8_LDB(B1, 1, 1); PG8_STAGE(PG8_SB(1, 0), b3, voffB);
            PG8_BAR; PG8_WAIT_L(0); PG8_MMA(0, 1, At, B1); PG8_BAR;
            PG8_LDA(At, 1, 1); PG8_STAGE(PG8_SA(1, 0), a3, voffA);
            PG8_BAR; PG8_WAIT_L(0); PG8_MMA(1, 0, At, B0); PG8_BAR; PG8_SCHED;
            PG8_STAGE(PG8_SB(1, 1), b3 + hstep, voffB);
            PG8_WAIT_V(6); PG8_BAR; PG8_MMA(1, 1, At, B1); PG8_BAR;
            }
        }
        if constexpr (ALIGN_EPI) { if (wr == 0) PG8_BAR; }
        if constexpr (!Epi::AFTER_DRAIN) { E(acc, cur, wr, wc, fr, fq); S.done(cur); }
        if (!has_next) break;
#pragma unroll
        for (int a = 0; a < 2; ++a)
#pragma unroll
            for (int b = 0; b < 2; ++b)
#pragma unroll
                for (int m = 0; m < 4; ++m)
#pragma unroll
                    for (int n = 0; n < 2; ++n) acc[a][b][m][n] = (f32x4){0.f, 0.f, 0.f, 0.f};
        cur = nxt; cA = nA; cB = nB; ++ui;
        if constexpr (ALIGN_EPI) { if (wr == 1) PG8_BAR; }
    }
    PG8_WAIT_V(0);
    if constexpr (!ALIGN_EPI) { if (wr == 0) PG8_BAR; }
    PG8_BAR;
    if constexpr (Epi::AFTER_DRAIN) { E.fused(acc, cur, wr, wc, fr, fq, lds, wid, lane); S.done(cur); }
#undef PG8_SA
#undef PG8_SB
#undef PG8_STAGE
#undef PG8_LDA
#undef PG8_LDB
#undef PG8_MMA
#undef PG8_WAIT_V
#undef PG8_WAIT_L
#undef PG8_BAR
#undef PG8_SCHED
}
}
#define XB_TMO      128
#define XB_XCNT(j)  (256  + 64 * (j))
#define XB_XSUB(j)  (1280 + 64 * (j))
#define XB_XGEN(j)  (2304 + 64 * (j))
#define XB_TOP      3328
#define XB_TOPGEN   3392
#define XCD_BAR_WORDS 3456
#define XB_SPIN_CAP (1u << 18)

__device__ __forceinline__ unsigned xb_ld(unsigned* p)              { return __hip_atomic_load(p, __ATOMIC_RELAXED, __HIP_MEMORY_SCOPE_AGENT); }
__device__ __forceinline__ unsigned xb_add(unsigned* p, unsigned v) { return __hip_atomic_fetch_add(p, v, __ATOMIC_RELAXED, __HIP_MEMORY_SCOPE_AGENT); }
__device__ __forceinline__ unsigned xb_xcc_id() { return (unsigned)__builtin_amdgcn_s_getreg((3 << 11) | 20) & 0xFu; }
#define XB_SPIN(cond, bar) do { unsigned _sp = 0; while (cond) { __builtin_amdgcn_s_sleep(1); \
    if ((++_sp & 255u) == 0u) { if (xb_ld(&(bar)[XB_TMO])) break; if (_sp > XB_SPIN_CAP) { atomicAdd(&(bar)[XB_TMO], 1u); break; } } } } while (0)

struct XcdBarrier {
    unsigned* bar; unsigned x;
    volatile LAS unsigned* st;
};

__device__ __forceinline__ XcdBarrier xcd_barrier_post(unsigned* bar, volatile LAS unsigned* st) {
    XcdBarrier b; b.bar = bar; b.x = xb_xcc_id(); b.st = st;
    if (threadIdx.x == 0) (void)xb_add(&bar[XB_XCNT(b.x)], 1u);
    return b;
}
__device__ __forceinline__ void xcd_barrier_complete(unsigned* bar, unsigned x, unsigned& nloc, unsigned& nx) {
    const unsigned G = gridDim.x * gridDim.y * gridDim.z;
    unsigned sum, cnt, mine, sp = 0u;
    for (;;) {
        sum = 0u; cnt = 0u; mine = 0u;
#pragma unroll
        for (unsigned j = 0; j < 16; ++j) { const unsigned c = xb_ld(&bar[XB_XCNT(j)]); sum += c; cnt += (c > 0u) ? 1u : 0u; mine = (j == x) ? c : mine; }
        if (sum == G) break;
        __builtin_amdgcn_s_sleep(1);
        if ((++sp & 255u) == 0u) { if (xb_ld(&bar[XB_TMO])) break; if (sp > XB_SPIN_CAP) { atomicAdd(&bar[XB_TMO], 1u); break; } }
    }
    nloc = mine > 0u ? mine : 1u; nx = cnt > 0u ? cnt : 1u;
}

__device__ __forceinline__ void xcd_barrier(const XcdBarrier& b) {
    asm volatile("s_waitcnt vmcnt(0)" ::: "memory");
    __syncthreads();
    if (threadIdx.x == 0) {
        unsigned* bar = b.bar;
        __builtin_amdgcn_s_waitcnt(0);
        unsigned nloc = b.st[0], nx = b.st[1];
        if (nloc == 0u) { xcd_barrier_complete(bar, b.x, nloc, nx); b.st[0] = nloc; b.st[1] = nx; }
        const unsigned old = xb_add(&bar[XB_XSUB(b.x)], 1u);
        const unsigned gen = old / nloc;
        if (old + 1u == (gen + 1u) * nloc) {
            __builtin_amdgcn_fence(__ATOMIC_RELEASE, "agent");
            asm volatile("s_waitcnt vmcnt(0)" ::: "memory");
            const unsigned og = xb_add(&bar[XB_TOP], 1u);
            const unsigned tg = og / nx;
            if (og + 1u == (tg + 1u) * nx) xb_add(&bar[XB_TOPGEN], 1u);
            else XB_SPIN(xb_ld(&bar[XB_TOPGEN]) == tg, bar);
            __builtin_amdgcn_fence(__ATOMIC_ACQUIRE, "agent");
            xb_add(&bar[XB_XGEN(b.x)], 1u);
            asm volatile("s_waitcnt vmcnt(0)" ::: "memory");
        } else {
            XB_SPIN(xb_ld(&bar[XB_XGEN(b.x)]) == gen, bar);
            __builtin_amdgcn_fence(__ATOMIC_ACQUIRE, "agent");
            asm volatile("s_waitcnt vmcnt(0)" ::: "memory");
        }
    }
    __syncthreads();
}


constexpr int NB = 8, SEQ = 2048, D = 1024, M = NB * SEQ, NL = 2, INW = 7168, NIN = 5120;
constexpr float EPS = 1e-6f;
#define LAS __attribute__((address_space(3)))
typedef unsigned short bf16_t;
typedef short bf16x8 __attribute__((ext_vector_type(8)));
typedef float f32x4 __attribute__((ext_vector_type(4)));
typedef float f32x2 __attribute__((ext_vector_type(2)));
typedef unsigned u32x4 __attribute__((ext_vector_type(4)));
typedef unsigned u32x2 __attribute__((ext_vector_type(2)));
typedef __bf16 bf2_t __attribute__((ext_vector_type(2)));
typedef _Float16 h2_t __attribute__((ext_vector_type(2)));

constexpr size_t MiB = 1u << 20;
constexpr size_t WS_ADA = 0;
constexpr size_t WS_LB = 256 * 1024;
constexpr size_t WS_POOLWT = 512 * 1024;
constexpr size_t WS_WIN = 1 * MiB;
constexpr size_t WS_WPO = 29 * MiB;
constexpr size_t WS_WHO = 31 * MiB;
constexpr size_t WS_WOUT = 35 * MiB;
constexpr size_t WS_H = 40 * MiB;
constexpr size_t WS_PV = 72 * MiB;
constexpr size_t WS_PG = 88 * MiB;
constexpr size_t WS_Q = 104 * MiB;
constexpr size_t WS_LF = 136 * MiB;
constexpr size_t WS_V = 168 * MiB;
constexpr size_t WS_HG = 200 * MiB;
constexpr size_t WS_P = 232 * MiB;
constexpr size_t WS_DEC = 248 * MiB;
constexpr size_t WS_BAR = 250 * MiB;
constexpr size_t WS_DSEG = 251 * MiB;
constexpr size_t WS_END = 253 * MiB;
constexpr int LDS_BYTES = 147456, LDS_BARW = 147392;

__device__ __forceinline__ unsigned pk_bf16(float lo, float hi) { bf2_t r = __builtin_convertvector((f32x2){lo, hi}, bf2_t); return __builtin_bit_cast(unsigned, r); }
__device__ __forceinline__ unsigned pk_f16(float lo, float hi) { h2_t r = __builtin_convertvector((f32x2){lo, hi}, h2_t); return __builtin_bit_cast(unsigned, r); }
__device__ __forceinline__ float bf_lo(unsigned w) { return __uint_as_float(w << 16); }
__device__ __forceinline__ float bf_hi(unsigned w) { return __uint_as_float(w & 0xffff0000u); }
__device__ __forceinline__ float h_lo(unsigned w) { h2_t r = __builtin_bit_cast(h2_t, w); return (float)r.x; }
__device__ __forceinline__ float h_hi(unsigned w) { h2_t r = __builtin_bit_cast(h2_t, w); return (float)r.y; }
__device__ __forceinline__ float sigmoid_f(float x) { return __builtin_amdgcn_rcpf(1.f + __expf(-x)); }
__device__ __forceinline__ float silu_f(float x) { return x * sigmoid_f(x); }
__device__ __forceinline__ float dpp_f(float v, const int ctrl_unused) { return v; }
#define DPP_ADD(v, ctrl) ((v) + __builtin_bit_cast(float, __builtin_amdgcn_update_dpp(0, __builtin_bit_cast(int, (v)), (ctrl), 0xf, 0xf, true)))
__device__ __forceinline__ float wave_sum(float v) {
    v = DPP_ADD(v, 0xB1);
    v = DPP_ADD(v, 0x4E);
    v = DPP_ADD(v, 0x124);
    v = DPP_ADD(v, 0x128);
    return (__builtin_amdgcn_readlane(v, 0) + __builtin_amdgcn_readlane(v, 16)) + (__builtin_amdgcn_readlane(v, 32) + __builtin_amdgcn_readlane(v, 48));
}
#define LBAR() do { asm volatile("s_waitcnt lgkmcnt(0)" ::: "memory"); __builtin_amdgcn_s_barrier(); asm volatile("" ::: "memory"); } while (0)
#define MFMA16(a, b, c) __builtin_amdgcn_mfma_f32_16x16x32_bf16((a), (b), (c), 0, 0, 0)

__device__ __forceinline__ void p0_transpose_item(const float* W, int K, int N, bf16_t* WT, LAS float* scr, int item, int lane) {
    const int nblk = N / 32, kb = item / nblk, nb = item % nblk, k0 = 64 * kb, n0 = 32 * nb;
#pragma unroll
    for (int i = 0; i < 32; ++i) { const int kk = 2 * i + (lane >> 5); scr[kk * 33 + (lane & 31)] = __builtin_nontemporal_load(W + (size_t)(k0 + kk) * N + n0 + (lane & 31)); }
    asm volatile("s_waitcnt lgkmcnt(0)" ::: "memory");
    const int c = lane & 7;
#pragma unroll
    for (int j = 0; j < 4; ++j) { const int n = (lane >> 3) + 8 * j; const LAS float* s = scr + (8 * c) * 33 + n;
        u32x4 o; o.x = pk_bf16(s[0 * 33], s[1 * 33]); o.y = pk_bf16(s[2 * 33], s[3 * 33]); o.z = pk_bf16(s[4 * 33], s[5 * 33]); o.w = pk_bf16(s[6 * 33], s[7 * 33]);
        *(u32x4*)(WT + (size_t)(n0 + n) * K + k0 + 8 * c) = o; }
    asm volatile("s_waitcnt lgkmcnt(0)" ::: "memory");
}

struct Params {
    const float *x, *c, *w_ada, *b_ada, *g_pre, *g_post, *w_in, *pool_w, *pool_scale, *lb_logits, *hgrn_norm_g, *w_pool_o, *w_hgrn_o, *w_out;
    float* out; unsigned char* ws;
};

__device__ __forceinline__ void p0_prologue(const Params& p, LAS unsigned char* lds) {
    const int tid = threadIdx.x, lane = tid & 63, wave = tid >> 6, blk = blockIdx.x, G = gridDim.x;
    float* ADA = (float*)(p.ws + WS_ADA);
    LAS float* cact = (LAS float*)(lds + 73728);
    LAS float* red = (LAS float*)(lds + 73728 + 32768);
    for (int job = blk; job < 192; job += G) {
        for (int i = tid; i < NB * D; i += 512) cact[i] = silu_f(p.c[i]);
        __syncthreads();
        const int l = job / 96, j0 = (job % 96) * 32, j = tid & 31, ks = tid >> 5;
        const float* w = p.w_ada + ((size_t)l * D + ks * 64) * 3072 + j0 + j;
        float a0 = 0.f, a1 = 0.f, a2 = 0.f, a3 = 0.f, a4 = 0.f, a5 = 0.f, a6 = 0.f, a7 = 0.f;
#pragma unroll 32
        for (int d = 0; d < 64; ++d) { const float wv = __builtin_nontemporal_load(w + (size_t)d * 3072); const LAS float* cc = cact + ks * 64 + d;
            a0 += cc[0] * wv; a1 += cc[1024] * wv; a2 += cc[2048] * wv; a3 += cc[3072] * wv; a4 += cc[4096] * wv; a5 += cc[5120] * wv; a6 += cc[6144] * wv; a7 += cc[7168] * wv; }
        LAS float* rr = red + (ks * 8) * 32 + j;
        rr[0] = a0; rr[32] = a1; rr[64] = a2; rr[96] = a3; rr[128] = a4; rr[160] = a5; rr[192] = a6; rr[224] = a7;
        __syncthreads();
        if (tid < 256) { const int b = tid >> 5; float s = p.b_ada[l * 3072 + j0 + j];
#pragma unroll
            for (int k2 = 0; k2 < 16; ++k2) s += red[(k2 * 8 + b) * 32 + j];
            ADA[(size_t)(l * NB + b) * 3072 + j0 + j] = s; }
        __syncthreads();
    }
    if (blk == G - 1) { float* LB = (float*)(p.ws + WS_LB);
        for (int j = tid; j < 1024; j += 512) { const float l0 = p.lb_logits[j], l1 = p.lb_logits[1024 + j], mx = fmaxf(l0, l1), e0 = __expf(l0 - mx), e1 = __expf(l1 - mx);
            const float p0 = e0 / (e0 + e1), p1 = e1 / (e0 + e1); const float c1 = (p0 + p1) - p0;
            LB[j] = 0.f; LB[1024 + j] = fminf(fmaxf(c1, 0.f), 1.f); } }
    LAS float* scr = (LAS float*)(lds + wave * 8448);
    constexpr int I_IN = (D / 64) * (INW / 32), I_PO = (512 / 64) * (D / 32), I_HO = (D / 64) * (D / 32), I_OUT = I_HO, I_PW = 4 * 8, I_LAYER = I_IN + I_PO + I_HO + I_OUT + I_PW;
    bf16_t* WinT = (bf16_t*)(p.ws + WS_WIN); bf16_t* WpoT = (bf16_t*)(p.ws + WS_WPO); bf16_t* WhoT = (bf16_t*)(p.ws + WS_WHO); bf16_t* WoutT = (bf16_t*)(p.ws + WS_WOUT); bf16_t* PoolWT = (bf16_t*)(p.ws + WS_POOLWT);
    for (int it = blk * 8 + wave; it < NL * I_LAYER; it += G * 8) {
        int r = it; const int l = r / I_LAYER; r -= l * I_LAYER;
        if (r < I_IN) { p0_transpose_item(p.w_in + (size_t)l * D * INW, D, INW, WinT + (size_t)l * INW * D, scr, r, lane); continue; } r -= I_IN;
        if (r < I_PO) { p0_transpose_item(p.w_pool_o + (size_t)l * 512 * D, 512, D, WpoT + (size_t)l * D * 512, scr, r, lane); continue; } r -= I_PO;
        if (r < I_HO) { p0_transpose_item(p.w_hgrn_o + (size_t)l * D * D, D, D, WhoT + (size_t)l * D * D, scr, r, lane); continue; } r -= I_HO;
        if (r < I_OUT) { p0_transpose_item(p.w_out + (size_t)l * D * D, D, D, WoutT + (size_t)l * D * D, scr, r, lane); continue; } r -= I_OUT;
        { const int g = r >> 3; r &= 7; p0_transpose_item(p.pool_w + (size_t)(l * 4 + g) * 16384, 128, 128, PoolWT + (size_t)(l * 4 + g) * 16384, scr, r, lane); }
    }
}

template <bool HAS_PREV, bool MAKE_H>
__device__ __forceinline__ void p1_rows(const float* xprev, const bf16_t* Y, const float* ada_prev, const float* gpost, float* xout, const float* gpre, const float* ada_cur, bf16_t* H) {
    int tid_l = threadIdx.x; asm volatile("" : "+v"(tid_l));
    const int lane = tid_l & 63, wave = tid_l >> 6;
    const int NW = gridDim.x * 8, rpw = (M + NW - 1) / NW, gw = blockIdx.x * 8 + wave;
    const int mbeg = gw * rpw, mend = (mbeg + rpw < M) ? mbeg + rpw : M;
    if (mbeg >= mend) return;
    f32x4 ga[4], hm[4], hs[4];
    int bcur = -1;
    f32x4 vn[4]; u32x2 yn[4];
#pragma unroll
    for (int j = 0; j < 4; ++j) { vn[j] = __builtin_nontemporal_load((const f32x4*)(xprev + (size_t)mbeg * D) + lane + 64 * j); if (HAS_PREV) yn[j] = __builtin_nontemporal_load((const u32x2*)(Y + (size_t)mbeg * D) + lane + 64 * j); else yn[j] = (u32x2){0u, 0u}; }
    for (int m = mbeg; m < mend; ++m) {
        const int b = m >> 11;
        if (b != bcur) { bcur = b;
#pragma unroll
            for (int j = 0; j < 4; ++j) {
                if (HAS_PREV) ga[j] = ((const f32x4*)(ada_prev + (size_t)b * 3072 + 2048) + lane)[64 * j] * ((const f32x4*)gpost + lane)[64 * j]; else ga[j] = (f32x4){0.f, 0.f, 0.f, 0.f};
                if (MAKE_H) { hm[j] = ((const f32x4*)gpre + lane)[64 * j] * (((const f32x4*)(ada_cur + (size_t)b * 3072 + 1024) + lane)[64 * j] + 1.f); hs[j] = ((const f32x4*)(ada_cur + (size_t)b * 3072) + lane)[64 * j]; }
                else { hm[j] = (f32x4){0.f, 0.f, 0.f, 0.f}; hs[j] = hm[j]; } } }
        f32x4 v[4]; u32x2 yw[4];
#pragma unroll
        for (int j = 0; j < 4; ++j) { v[j] = vn[j]; yw[j] = yn[j]; }
        { const int mn = (m + 1 < mend) ? m + 1 : m;
#pragma unroll
          for (int j = 0; j < 4; ++j) { vn[j] = __builtin_nontemporal_load((const f32x4*)(xprev + (size_t)mn * D) + lane + 64 * j); if (HAS_PREV) yn[j] = __builtin_nontemporal_load((const u32x2*)(Y + (size_t)mn * D) + lane + 64 * j); } }
        if (HAS_PREV) {
            f32x4 y[4]; float ss = 0.f;
#pragma unroll
            for (int j = 0; j < 4; ++j) { y[j] = (f32x4){bf_lo(yw[j].x), bf_hi(yw[j].x), bf_lo(yw[j].y), bf_hi(yw[j].y)}; ss += (y[j].x * y[j].x + y[j].y * y[j].y) + (y[j].z * y[j].z + y[j].w * y[j].w); }
            const float rstd = rsqrtf(wave_sum(ss) * (1.f / D) + EPS);
            f32x4* xo = (f32x4*)(xout + (size_t)m * D) + lane;
#pragma unroll
            for (int j = 0; j < 4; ++j) { v[j] = v[j] + ga[j] * (y[j] * rstd); __builtin_nontemporal_store(v[j], xo + 64 * j); }
        }
        if (MAKE_H) {
            float ss = 0.f;
#pragma unroll
            for (int j = 0; j < 4; ++j) ss += (v[j].x * v[j].x + v[j].y * v[j].y) + (v[j].z * v[j].z + v[j].w * v[j].w);
            const float rstd = rsqrtf(wave_sum(ss) * (1.f / D) + EPS);
            u32x2* ho = (u32x2*)(H + (size_t)m * D) + lane;
#pragma unroll
            for (int j = 0; j < 4; ++j) { const f32x4 hv = (v[j] * rstd) * hm[j] + hs[j]; u32x2 w; w.x = pk_bf16(hv.x, hv.y); w.y = pk_bf16(hv.z, hv.w); ho[64 * j] = w; }
        }
    }
}

struct EpiU {
    static constexpr bool PERM = true, AFTER_DRAIN = false;
    unsigned char* ws;
    __device__ __forceinline__ void operator()(const f32x4 (&acc)[2][2][4][2], const pg8::Unit& u, int wr, int wc, int fr, int fq) const {
        const int pn = u.pn, mode = u.mode; const int row0 = u.pm * 256 + wr * 64 + fr;
        size_t boff; int ld = 1024, colt = pn * 256, op;
        if (mode == 0) {
            if (pn < 2) { boff = WS_PV; ld = 512; op = 0; }
            else if (pn < 4) { boff = WS_PG; ld = 512; colt = (pn - 2) * 256; op = 0; }
            else if (pn < 8) { boff = WS_Q; colt = (pn - 4) * 256; op = 0; }
            else if (pn < 12) { boff = WS_LF; colt = (pn - 8) * 256; op = 2; }
            else if (pn < 16) { boff = WS_V; colt = (pn - 12) * 256; op = 0; }
            else { boff = WS_HG; colt = (pn - 16) * 256; op = 0; }
        } else if (mode == 1) { boff = (pn < 4) ? WS_Q : WS_V; colt = (pn & 3) * 256; op = 3; }
        else if (mode == 2) { boff = WS_LF; op = 4; }
        else if (mode == 3) { boff = WS_LF; op = 5; }
        else { boff = WS_V; op = 0; }
        bf16_t* base = (bf16_t*)(ws + boff); const bf16_t* Gp = (const bf16_t*)(ws + (mode == 2 ? WS_V : WS_Q));
        const int col0 = colt + wc * 32 + 8 * fq;
#pragma unroll
        for (int ai = 0; ai < 2; ++ai) {
            u32x4 gq[4][2], tq[4][2];
#pragma unroll
            for (int m = 0; m < 4; ++m)
#pragma unroll
                for (int bj = 0; bj < 2; ++bj) { gq[m][bj] = (u32x4){0u, 0u, 0u, 0u}; tq[m][bj] = gq[m][bj]; }
            if (op >= 4) {
#pragma unroll
                for (int m = 0; m < 4; ++m)
#pragma unroll
                    for (int bj = 0; bj < 2; ++bj) gq[m][bj] = *(const u32x4*)(Gp + (size_t)(row0 + ai * 128 + m * 16) * ld + col0 + bj * 128);
                if (op == 5) {
#pragma unroll
                    for (int m = 0; m < 4; ++m)
#pragma unroll
                        for (int bj = 0; bj < 2; ++bj) tq[m][bj] = *(const u32x4*)(base + (size_t)(row0 + ai * 128 + m * 16) * ld + col0 + bj * 128); }
            }
            asm volatile("" ::: "memory");
#pragma unroll
            for (int m = 0; m < 4; ++m) { const size_t off = (size_t)(row0 + ai * 128 + m * 16) * ld + col0;
#pragma unroll
                for (int bj = 0; bj < 2; ++bj) { f32x4 v0 = acc[ai][bj][m][0], v1 = acc[ai][bj][m][1];
                    if (op == 1) {
#pragma unroll
                        for (int j = 0; j < 4; ++j) { v0[j] = silu_f(v0[j]); v1[j] = silu_f(v1[j]); }
                    } else if (op == 3) {
#pragma unroll
                        for (int j = 0; j < 4; ++j) { v0[j] = sigmoid_f(v0[j]); v1[j] = sigmoid_f(v1[j]); }
                    } else if (op >= 4) { const u32x4 g = gq[m][bj];
                        v0 = v0 * (f32x4){bf_lo(g.x), bf_hi(g.x), bf_lo(g.y), bf_hi(g.y)}; v1 = v1 * (f32x4){bf_lo(g.z), bf_hi(g.z), bf_lo(g.w), bf_hi(g.w)};
                        if (op == 5) { const u32x4 t = tq[m][bj];
                            v0 = v0 + (f32x4){bf_lo(t.x), bf_hi(t.x), bf_lo(t.y), bf_hi(t.y)}; v1 = v1 + (f32x4){bf_lo(t.z), bf_hi(t.z), bf_lo(t.w), bf_hi(t.w)}; } }
                    u32x4 w;
                    if (op == 2) { w.x = pk_f16(v0[0], v0[1]); w.y = pk_f16(v0[2], v0[3]); w.z = pk_f16(v1[0], v1[1]); w.w = pk_f16(v1[2], v1[3]); }
                    else { w.x = pk_bf16(v0[0], v0[1]); w.y = pk_bf16(v0[2], v0[3]); w.z = pk_bf16(v1[0], v1[1]); w.w = pk_bf16(v1[2], v1[3]); }
                    *(u32x4*)(base + off + bj * 128) = w; } }
        }
    }
};

constexpr int AP_STRIDE = 136;
template <int W>
__device__ __forceinline__ void pool_item(const bf16_t* PV, bf16_t* PG, const bf16_t* PoolWT_g, const float* pscale_g, int m0, int g, LAS unsigned char* lds) {
    int tid_l = threadIdx.x; asm volatile("" : "+v"(tid_l));
    const int tid = tid_l, lane = tid & 63, wv = tid >> 6, r = lane & 15, q = lane >> 4;
    const int pos0 = (m0 & (SEQ - 1)) + wv * 8;
    const bf16_t* src = PV + (size_t)(m0 + wv * 8) * 512 + g * 128 + 2 * lane;
    float r0[W + 7], r1[W + 7];
#pragma unroll
    for (int i = 0; i < W + 7; ++i) { const int pp = pos0 - (W - 1) + i; unsigned w = 0u; if (pp >= 0) w = *(const unsigned*)(src + (ptrdiff_t)(i - (W - 1)) * 512); r0[i] = bf_lo(w); r1[i] = bf_hi(w); }
    bf16x8 wf[4]; u32x2 gw[4];
#pragma unroll
    for (int ks = 0; ks < 4; ++ks) wf[ks] = *(const bf16x8*)(PoolWT_g + (16 * wv + r) * 128 + ks * 32 + q * 8);
#pragma unroll
    for (int mt = 0; mt < 4; ++mt) gw[mt] = *(const u32x2*)(PG + (size_t)(m0 + mt * 16 + r) * 512 + g * 128 + 16 * wv + q * 4);
    const f32x4 sc = *(const f32x4*)(pscale_g + 16 * wv + q * 4);
    float s0 = 0.f, s1 = 0.f;
#pragma unroll
    for (int i = 0; i < W - 1; ++i) { s0 += r0[i]; s1 += r1[i]; }
    LAS bf16_t* AP = (LAS bf16_t*)lds;
    __syncthreads();
#pragma unroll
    for (int i = 0; i < 8; ++i) { s0 += r0[W - 1 + i]; s1 += r1[W - 1 + i];
        const int pos = pos0 + i; const float inv = 1.f / (float)(pos + 1 < W ? pos + 1 : W);
        *(LAS unsigned*)(AP + (wv * 8 + i) * AP_STRIDE + 2 * lane) = pk_bf16(s0 * inv - r0[W - 1 + i], s1 * inv - r1[W - 1 + i]);
        s0 -= r0[i]; s1 -= r1[i]; }
    __syncthreads();
    f32x4 o[4];
#pragma unroll
    for (int mt = 0; mt < 4; ++mt) o[mt] = (f32x4){0.f, 0.f, 0.f, 0.f};
    bf16x8 af[16];
#pragma unroll
    for (int ks = 0; ks < 4; ++ks)
#pragma unroll
        for (int mt = 0; mt < 4; ++mt) af[ks * 4 + mt] = *(const LAS bf16x8*)(AP + (mt * 16 + r) * AP_STRIDE + ks * 32 + q * 8);
    __builtin_amdgcn_sched_barrier(0);
#pragma unroll
    for (int ks = 0; ks < 4; ++ks)
#pragma unroll
        for (int mt = 0; mt < 4; ++mt) o[mt] = MFMA16(wf[ks], af[ks * 4 + mt], o[mt]);
#pragma unroll
    for (int mt = 0; mt < 4; ++mt) { bf16_t* pp = PG + (size_t)(m0 + mt * 16 + r) * 512 + g * 128 + 16 * wv + q * 4;
        const f32x4 ov = o[mt] * sc * (f32x4){silu_f(bf_lo(gw[mt].x)), silu_f(bf_hi(gw[mt].x)), silu_f(bf_lo(gw[mt].y)), silu_f(bf_hi(gw[mt].y))};
        u32x2 w; w.x = pk_bf16(ov.x, ov.y); w.y = pk_bf16(ov.z, ov.w); *(u32x2*)pp = w; }
}

template <int W>
__device__ __forceinline__ void pool_tiles(const bf16_t* PV, bf16_t* PG, const bf16_t* PoolWT_g, const float* pscale_g, int g, int T0, int Tstep, LAS unsigned char* lds) {
    int tid_l = threadIdx.x; asm volatile("" : "+v"(tid_l));
    const int tid = tid_l, lane = tid & 63, wv = tid >> 6, r = lane & 15, q = lane >> 4;
    constexpr int NT = M / 64;
    if (T0 >= NT) return;
    bf16x8 wf[4];
#pragma unroll
    for (int ks = 0; ks < 4; ++ks) wf[ks] = *(const bf16x8*)(PoolWT_g + (16 * wv + r) * 128 + ks * 32 + q * 8);
    const f32x4 sc = *(const f32x4*)(pscale_g + 16 * wv + q * 4);
    unsigned raw[W + 7]; u32x2 gw[4];
    { const int m0 = T0 * 64, pos0 = (m0 & (SEQ - 1)) + wv * 8; const bf16_t* src = PV + (size_t)(m0 + wv * 8) * 512 + g * 128 + 2 * lane;
#pragma unroll
      for (int i = 0; i < W + 7; ++i) { raw[i] = 0u; if (pos0 - (W - 1) + i >= 0) raw[i] = *(const unsigned*)(src + (ptrdiff_t)(i - (W - 1)) * 512); }
#pragma unroll
      for (int mt = 0; mt < 4; ++mt) gw[mt] = *(const u32x2*)(PG + (size_t)(m0 + mt * 16 + r) * 512 + g * 128 + 16 * wv + q * 4); }
    LAS bf16_t* AP = (LAS bf16_t*)lds;
#pragma unroll 1
    for (int T = T0; T < NT; T += Tstep) {
        const int m0 = T * 64, pos0 = (m0 & (SEQ - 1)) + wv * 8;
        float r0[W + 7], r1[W + 7]; u32x2 gc[4];
#pragma unroll
        for (int i = 0; i < W + 7; ++i) { r0[i] = bf_lo(raw[i]); r1[i] = bf_hi(raw[i]); }
#pragma unroll
        for (int mt = 0; mt < 4; ++mt) gc[mt] = gw[mt];
        { const int Tn = (T + Tstep < NT) ? T + Tstep : T; const int mn = Tn * 64, posn = (mn & (SEQ - 1)) + wv * 8; const bf16_t* src = PV + (size_t)(mn + wv * 8) * 512 + g * 128 + 2 * lane;
#pragma unroll
          for (int i = 0; i < W + 7; ++i) { raw[i] = 0u; if (posn - (W - 1) + i >= 0) raw[i] = *(const unsigned*)(src + (ptrdiff_t)(i - (W - 1)) * 512); }
#pragma unroll
          for (int mt = 0; mt < 4; ++mt) gw[mt] = *(const u32x2*)(PG + (size_t)(mn + mt * 16 + r) * 512 + g * 128 + 16 * wv + q * 4); }
        float s0 = 0.f, s1 = 0.f;
#pragma unroll
        for (int i = 0; i < W - 1; ++i) { s0 += r0[i]; s1 += r1[i]; }
        LBAR();
#pragma unroll
        for (int i = 0; i < 8; ++i) { s0 += r0[W - 1 + i]; s1 += r1[W - 1 + i];
            const int pos = pos0 + i; const float inv = 1.f / (float)(pos + 1 < W ? pos + 1 : W);
            *(LAS unsigned*)(AP + (wv * 8 + i) * AP_STRIDE + 2 * lane) = pk_bf16(s0 * inv - r0[W - 1 + i], s1 * inv - r1[W - 1 + i]);
            s0 -= r0[i]; s1 -= r1[i]; }
        LBAR();
        f32x4 o[4];
#pragma unroll
        for (int mt = 0; mt < 4; ++mt) o[mt] = (f32x4){0.f, 0.f, 0.f, 0.f};
        bf16x8 af[16];
#pragma unroll
        for (int ks = 0; ks < 4; ++ks)
#pragma unroll
            for (int mt = 0; mt < 4; ++mt) af[ks * 4 + mt] = *(const LAS bf16x8*)(AP + (mt * 16 + r) * AP_STRIDE + ks * 32 + q * 8);
        __builtin_amdgcn_sched_barrier(0);
#pragma unroll
        for (int ks = 0; ks < 4; ++ks)
#pragma unroll
            for (int mt = 0; mt < 4; ++mt) o[mt] = MFMA16(wf[ks], af[ks * 4 + mt], o[mt]);
#pragma unroll
        for (int mt = 0; mt < 4; ++mt) { bf16_t* pp = PG + (size_t)(m0 + mt * 16 + r) * 512 + g * 128 + 16 * wv + q * 4;
            const f32x4 ov = o[mt] * sc * (f32x4){silu_f(bf_lo(gc[mt].x)), silu_f(bf_hi(gc[mt].x)), silu_f(bf_lo(gc[mt].y)), silu_f(bf_hi(gc[mt].y))};
            u32x2 w; w.x = pk_bf16(ov.x, ov.y); w.y = pk_bf16(ov.z, ov.w); *(u32x2*)pp = w; }
    }
    __syncthreads();
}

constexpr int HQ_STR = 136, HK_STR = 72;
__device__ __forceinline__ void prep_items(bf16_t* Qg, bf16_t* LFg, bf16_t* Pg, float* DECg, const float* lbl, int first, int step, int total, LAS unsigned char* lds) {
    int tid_l = threadIdx.x; asm volatile("" : "+v"(tid_l));
    const int tid = tid_l, lane = tid & 63, wv = __builtin_amdgcn_readfirstlane(tid >> 6), r = lane & 15, q = lane >> 4;
    LAS bf16_t* QT = (LAS bf16_t*)(lds); LAS bf16_t* KT = (LAS bf16_t*)(lds + 17408); LAS float* TOT = (LAS float*)(lds + 34816);
    unsigned q2[8], lf2[8], qn[8], lfn[8];
    if (first < total) { const int bh = first >> 5, n = first & 31; const size_t rb = ((size_t)(bh >> 3) * SEQ + n * 64 + wv * 8) * 1024 + (size_t)(bh & 7) * 128 + 2 * lane;
#pragma unroll
        for (int i = 0; i < 8; ++i) { qn[i] = *(const unsigned*)(Qg + rb + (size_t)i * 1024); lfn[i] = *(const unsigned*)(LFg + rb + (size_t)i * 1024); } }
#pragma unroll 1
    for (int item = first; item < total; item += step) {
        const int bh = item >> 5, n = item & 31;
        const size_t rb = ((size_t)(bh >> 3) * SEQ + n * 64 + wv * 8) * 1024 + (size_t)(bh & 7) * 128 + 2 * lane;
#pragma unroll
        for (int i = 0; i < 8; ++i) { q2[i] = qn[i]; lf2[i] = lfn[i]; }
        const f32x2 lbp = *(const f32x2*)(lbl + (bh & 7) * 128 + 2 * lane); const float lb0 = lbp.x, lb1 = lbp.y;
        { const int inext = (item + step < total) ? item + step : item; const int bh2 = inext >> 5, n2 = inext & 31; const size_t rb2 = ((size_t)(bh2 >> 3) * SEQ + n2 * 64 + wv * 8) * 1024 + (size_t)(bh2 & 7) * 128 + 2 * lane;
#pragma unroll
            for (int i = 0; i < 8; ++i) { qn[i] = *(const unsigned*)(Qg + rb2 + (size_t)i * 1024); lfn[i] = *(const unsigned*)(LFg + rb2 + (size_t)i * 1024); } }
        float f0[8], f1[8]; float run0 = 0.f, run1 = 0.f;
#pragma unroll
        for (int i = 0; i < 8; ++i) { const float z0 = h_lo(lf2[i]), z1 = h_hi(lf2[i]);
            f0[i] = fmaxf(lb0 + (1.f - lb0) * sigmoid_f(z0), 1e-30f); f1[i] = fmaxf(lb1 + (1.f - lb1) * sigmoid_f(z1), 1e-30f); run0 += __logf(f0[i]); run1 += __logf(f1[i]); }
        *(LAS f32x2*)(TOT + wv * 128 + 2 * lane) = (f32x2){run0, run1};
        LBAR();
        float pre0 = 0.f, pre1 = 0.f, last0 = 0.f, last1 = 0.f;
#pragma unroll
        for (int w = 0; w < 8; ++w) { const f32x2 t = *(const LAS f32x2*)(TOT + w * 128 + 2 * lane); last0 += t.x; last1 += t.y; if (w < wv) { pre0 += t.x; pre1 += t.y; } }
        if (wv == 0) *(f32x2*)(DECg + (size_t)item * 128 + 2 * lane) = (f32x2){__expf(last0), __expf(last1)};
        const float sc0 = __expf(fminf(-0.5f * last0, 60.f)), sc1 = __expf(fminf(-0.5f * last1, 60.f));
        float pf0 = __expf(pre0), pf1 = __expf(pre1), sf0 = __expf(last0 - pre0 - run0), sf1 = __expf(last1 - pre1 - run1);
        float kh0[8], kh1[8];
#pragma unroll
        for (int i = 7; i >= 0; --i) { kh0[i] = (1.f - f0[i]) * sf0; kh1[i] = (1.f - f1[i]) * sf1; sf0 *= f0[i]; sf1 *= f1[i]; }
#pragma unroll
        for (int i = 0; i < 8; ++i) { pf0 *= f0[i]; pf1 *= f1[i];
            const float qh0 = silu_f(bf_lo(q2[i])) * pf0, qh1 = silu_f(bf_hi(q2[i])) * pf1; const int t = wv * 8 + i;
            *(unsigned*)(Qg + rb + (size_t)i * 1024) = pk_bf16(qh0, qh1);
            *(unsigned*)(LFg + rb + (size_t)i * 1024) = pk_bf16(kh0[i], kh1[i]);
            *(LAS unsigned*)(QT + t * HQ_STR + 2 * lane) = pk_bf16(qh0 * sc0, qh1 * sc1);
            *(LAS unsigned*)(KT + t * HQ_STR + 2 * lane) = pk_bf16(kh0[i] * sc0, kh1[i] * sc1); }
        LBAR();
        const int ti = wv >> 1;
        { bf16x8 qf[4], kf[2][4];
#pragma unroll
          for (int ks = 0; ks < 4; ++ks) { qf[ks] = *(const LAS bf16x8*)(QT + (ti * 16 + r) * HQ_STR + ks * 32 + q * 8);
              kf[0][ks] = *(const LAS bf16x8*)(KT + ((2 * (wv & 1)) * 16 + r) * HQ_STR + ks * 32 + q * 8); kf[1][ks] = *(const LAS bf16x8*)(KT + ((2 * (wv & 1) + 1) * 16 + r) * HQ_STR + ks * 32 + q * 8); }
          __builtin_amdgcn_sched_barrier(0);
#pragma unroll
          for (int jj = 0; jj < 2; ++jj) { const int tj = 2 * (wv & 1) + jj; f32x4 sc = (f32x4){0.f, 0.f, 0.f, 0.f};
              if (tj <= ti) {
#pragma unroll
                  for (int ks = 0; ks < 4; ++ks) sc = MFMA16(kf[jj][ks], qf[ks], sc); }
              const int t = ti * 16 + r, s0 = tj * 16 + q * 4;
#pragma unroll
              for (int j = 0; j < 4; ++j) sc[j] = (s0 + j <= t) ? sc[j] : 0.f;
              u32x2 w; w.x = pk_bf16(sc[0], sc[1]); w.y = pk_bf16(sc[2], sc[3]);
              *(u32x2*)(Pg + (size_t)item * 4096 + t * 64 + s0) = w; } }
    }
    __syncthreads();
}

constexpr int SB_QH = 0, SB_KHT = 17408, SB_VT = 35840, SB_P = 54272, SB_DEC = 63488, SB_SSQ = 64000, SB_SIZE = 66048;
struct ScanRegs { unsigned q2[8], k2[8], v2[8]; u32x4 pr; f32x4 dc; u32x2 hg[4]; f32x4 o[4]; };
__device__ __forceinline__ void scan_load(ScanRegs& R, const bf16_t* Qg, const bf16_t* Kg, const bf16_t* Vg, const bf16_t* Pg, const float* DECg, int bh, int n, size_t mb, size_t cb, int tid, int lane, int wv) {
    R.pr = *(const u32x4*)(Pg + (size_t)(bh * 32 + n) * 4096 + tid * 8);
    R.dc = *(const f32x4*)(DECg + (size_t)(bh * 32 + n) * 128 + (tid & 31) * 4);
    const size_t rb = (mb + (size_t)n * 64 + wv * 8) * 1024 + cb + 2 * lane;
#pragma unroll
    for (int i = 0; i < 8; ++i) { R.q2[i] = *(const unsigned*)(Qg + rb + (size_t)i * 1024); R.k2[i] = *(const unsigned*)(Kg + rb + (size_t)i * 1024); R.v2[i] = *(const unsigned*)(Vg + rb + (size_t)i * 1024); }
    asm volatile("" ::: "memory");
}
__device__ __forceinline__ void scan_chunk(ScanRegs& X, ScanRegs& Y, f32x4 (&S)[8], const f32x4 g4, int n, const bf16_t* Qg, const bf16_t* Kg, const bf16_t* Vg, const bf16_t* Pg, const float* DECg, bf16_t* HGg,
                                           int bh, size_t mb, size_t cb, int tid, int lane, int wv, int r, int q, LAS unsigned char* lds, bool dry) {
    constexpr int NCH = SEQ / 64;
    LAS unsigned char* B = lds + (n & 1) * SB_SIZE;
    const size_t m0 = mb + (size_t)n * 64;
    if (n < NCH) {
        LAS bf16_t* QH = (LAS bf16_t*)(B + SB_QH); LAS bf16_t* KHT = (LAS bf16_t*)(B + SB_KHT); LAS bf16_t* VT = (LAS bf16_t*)(B + SB_VT); LAS bf16_t* Pm = (LAS bf16_t*)(B + SB_P);
#pragma unroll
        for (int i = 0; i < 8; ++i) *(LAS unsigned*)(QH + (wv * 8 + i) * HQ_STR + 2 * lane) = X.q2[i];
        { u32x4 lo, hi; const unsigned* k2 = X.k2;
          lo.x = (k2[0] & 0xffffu) | (k2[1] << 16); lo.y = (k2[2] & 0xffffu) | (k2[3] << 16); lo.z = (k2[4] & 0xffffu) | (k2[5] << 16); lo.w = (k2[6] & 0xffffu) | (k2[7] << 16);
          hi.x = (k2[0] >> 16) | (k2[1] & 0xffff0000u); hi.y = (k2[2] >> 16) | (k2[3] & 0xffff0000u); hi.z = (k2[4] >> 16) | (k2[5] & 0xffff0000u); hi.w = (k2[6] >> 16) | (k2[7] & 0xffff0000u);
          *(LAS u32x4*)(KHT + (2 * lane) * HK_STR + wv * 8) = lo; *(LAS u32x4*)(KHT + (2 * lane + 1) * HK_STR + wv * 8) = hi; }
        { u32x4 lo, hi; const unsigned* v2 = X.v2;
          lo.x = (v2[0] & 0xffffu) | (v2[1] << 16); lo.y = (v2[2] & 0xffffu) | (v2[3] << 16); lo.z = (v2[4] & 0xffffu) | (v2[5] << 16); lo.w = (v2[6] & 0xffffu) | (v2[7] << 16);
          hi.x = (v2[0] >> 16) | (v2[1] & 0xffff0000u); hi.y = (v2[2] >> 16) | (v2[3] & 0xffff0000u); hi.z = (v2[4] >> 16) | (v2[5] & 0xffff0000u); hi.w = (v2[6] >> 16) | (v2[7] & 0xffff0000u);
          *(LAS u32x4*)(VT + (2 * lane) * HK_STR + wv * 8) = lo; *(LAS u32x4*)(VT + (2 * lane + 1) * HK_STR + wv * 8) = hi; }
        *(LAS u32x4*)(Pm + (tid >> 3) * HK_STR + (tid & 7) * 8) = X.pr;
        if (tid < 32) *(LAS f32x4*)((LAS float*)(B + SB_DEC) + tid * 4) = X.dc;
#pragma unroll
        for (int mt = 0; mt < 4; ++mt) X.hg[mt] = *(const u32x2*)(HGg + (m0 + mt * 16 + r) * 1024 + cb + 16 * wv + q * 4);
        scan_load(X, Qg, Kg, Vg, Pg, DECg, bh, (n + 2 < NCH) ? n + 2 : NCH - 1, mb, cb, tid, lane, wv);
    }
    LBAR();
    {
        const LAS float* SSQ = (const LAS float*)(lds + ((n - 1) & 1) * SB_SIZE + SB_SSQ);
#pragma unroll
        for (int mt = 0; mt < 4; ++mt) { float tot = 0.f;
#pragma unroll
            for (int w = 0; w < 8; ++w) tot += SSQ[w * 64 + mt * 16 + r];
            const float rstd = rsqrtf(tot * (1.f / 128.f) + EPS);
            const f32x4 ov = Y.o[mt] * rstd * g4 * (f32x4){bf_lo(Y.hg[mt].x), bf_hi(Y.hg[mt].x), bf_lo(Y.hg[mt].y), bf_hi(Y.hg[mt].y)};
            u32x2 w; w.x = pk_bf16(ov.x, ov.y); w.y = pk_bf16(ov.z, ov.w);
            if (n > 0 && (!dry || rstd == 12345.678f)) *(u32x2*)(HGg + (m0 - 64 + mt * 16 + r) * 1024 + cb + 16 * wv + q * 4) = w; }
    }
    if (n < NCH) {
        const LAS bf16_t* QH = (const LAS bf16_t*)(B + SB_QH); const LAS bf16_t* KHT = (const LAS bf16_t*)(B + SB_KHT); const LAS bf16_t* VT = (const LAS bf16_t*)(B + SB_VT); const LAS bf16_t* Pm = (const LAS bf16_t*)(B + SB_P);
        const LAS float* DEC = (const LAS float*)(B + SB_DEC); LAS float* SSQ = (LAS float*)(B + SB_SSQ);
#define SCHED_FENCE() __builtin_amdgcn_sched_barrier(0)
#define QFRAG(a, mt) __builtin_bit_cast(bf16x8, (u32x4){(*(const LAS u32x2*)(QH + ((mt) * 16 + r) * HQ_STR + 32 * (a) + q * 4)).x, (*(const LAS u32x2*)(QH + ((mt) * 16 + r) * HQ_STR + 32 * (a) + q * 4)).y, \
                                                        (*(const LAS u32x2*)(QH + ((mt) * 16 + r) * HQ_STR + 32 * (a) + 16 + q * 4)).x, (*(const LAS u32x2*)(QH + ((mt) * 16 + r) * HQ_STR + 32 * (a) + 16 + q * 4)).y})
#define SFRAG(a) __builtin_bit_cast(bf16x8, (u32x4){pk_bf16(S[2 * (a)][0], S[2 * (a)][1]), pk_bf16(S[2 * (a)][2], S[2 * (a)][3]), pk_bf16(S[2 * (a) + 1][0], S[2 * (a) + 1][1]), pk_bf16(S[2 * (a) + 1][2], S[2 * (a) + 1][3])})
        f32x4 o[4];
#pragma unroll
        for (int mt = 0; mt < 4; ++mt) o[mt] = (f32x4){0.f, 0.f, 0.f, 0.f};
        bf16x8 qa[8], qb[8];
#pragma unroll
        for (int mt = 0; mt < 4; ++mt) { qa[mt] = QFRAG(0, mt); qa[4 + mt] = QFRAG(1, mt); }
        SCHED_FENCE();
#pragma unroll
        for (int mt = 0; mt < 4; ++mt) { qb[mt] = QFRAG(2, mt); qb[4 + mt] = QFRAG(3, mt); }
        { const bf16x8 s0 = SFRAG(0), s1 = SFRAG(1);
#pragma unroll
          for (int mt = 0; mt < 4; ++mt) o[mt] = MFMA16(s0, qa[mt], o[mt]);
#pragma unroll
          for (int mt = 0; mt < 4; ++mt) o[mt] = MFMA16(s1, qa[4 + mt], o[mt]); }
        SCHED_FENCE();
        bf16x8 vf[2], pf[6];
#pragma unroll
        for (int ks = 0; ks < 2; ++ks) vf[ks] = *(const LAS bf16x8*)(VT + (16 * wv + r) * HK_STR + ks * 32 + q * 8);
#pragma unroll
        for (int mt = 0; mt < 4; ++mt) pf[mt] = *(const LAS bf16x8*)(Pm + (mt * 16 + r) * HK_STR + q * 8);
        pf[4] = *(const LAS bf16x8*)(Pm + (2 * 16 + r) * HK_STR + 32 + q * 8); pf[5] = *(const LAS bf16x8*)(Pm + (3 * 16 + r) * HK_STR + 32 + q * 8);
        { const bf16x8 s2 = SFRAG(2), s3 = SFRAG(3);
#pragma unroll
          for (int mt = 0; mt < 4; ++mt) o[mt] = MFMA16(s2, qb[mt], o[mt]);
#pragma unroll
          for (int mt = 0; mt < 4; ++mt) o[mt] = MFMA16(s3, qb[4 + mt], o[mt]); }
        SCHED_FENCE();
        f32x4 deca[4], decb[4]; bf16x8 kfa[8], kfb[8];
#pragma unroll
        for (int kt = 0; kt < 4; ++kt) { deca[kt] = *(const LAS f32x4*)(DEC + kt * 16 + q * 4); kfa[2 * kt] = *(const LAS bf16x8*)(KHT + (kt * 16 + r) * HK_STR + q * 8); kfa[2 * kt + 1] = *(const LAS bf16x8*)(KHT + (kt * 16 + r) * HK_STR + 32 + q * 8); }
#pragma unroll
        for (int mt = 0; mt < 4; ++mt) o[mt] = MFMA16(vf[0], pf[mt], o[mt]);
        o[2] = MFMA16(vf[1], pf[4], o[2]); o[3] = MFMA16(vf[1], pf[5], o[3]);
        SCHED_FENCE();
#pragma unroll
        for (int kt = 4; kt < 8; ++kt) { decb[kt - 4] = *(const LAS f32x4*)(DEC + kt * 16 + q * 4); kfb[2 * (kt - 4)] = *(const LAS bf16x8*)(KHT + (kt * 16 + r) * HK_STR + q * 8); kfb[2 * (kt - 4) + 1] = *(const LAS bf16x8*)(KHT + (kt * 16 + r) * HK_STR + 32 + q * 8); }
#pragma unroll
        for (int kt = 0; kt < 4; ++kt) { S[kt] = S[kt] * deca[kt]; S[kt] = MFMA16(kfa[2 * kt], vf[0], S[kt]); S[kt] = MFMA16(kfa[2 * kt + 1], vf[1], S[kt]); }
        SCHED_FENCE();
#pragma unroll
        for (int kt = 4; kt < 8; ++kt) { S[kt] = S[kt] * decb[kt - 4]; S[kt] = MFMA16(kfb[2 * (kt - 4)], vf[0], S[kt]); S[kt] = MFMA16(kfb[2 * (kt - 4) + 1], vf[1], S[kt]); }
        float ss[4];
#pragma unroll
        for (int mt = 0; mt < 4; ++mt) { ss[mt] = (o[mt].x * o[mt].x + o[mt].y * o[mt].y) + (o[mt].z * o[mt].z + o[mt].w * o[mt].w); X.o[mt] = o[mt]; }
        float t16[4];
#pragma unroll
        for (int mt = 0; mt < 4; ++mt) t16[mt] = __shfl_xor(ss[mt], 16);
        SCHED_FENCE();
#pragma unroll
        for (int mt = 0; mt < 4; ++mt) ss[mt] += t16[mt];
#pragma unroll
        for (int mt = 0; mt < 4; ++mt) t16[mt] = __shfl_xor(ss[mt], 32);
        SCHED_FENCE();
#pragma unroll
        for (int mt = 0; mt < 4; ++mt) { ss[mt] += t16[mt]; if (q == 0) SSQ[wv * 64 + mt * 16 + r] = ss[mt]; }
#undef QFRAG
#undef SFRAG
    }
}
__device__ __forceinline__ void scan_item(const bf16_t* Qg, const bf16_t* Kg, const bf16_t* Vg, const bf16_t* Pg, const float* DECg, bf16_t* HGg, const float* gnorm, int bh, LAS unsigned char* lds, bool dry = false) {
    int tid_l = threadIdx.x; asm volatile("" : "+v"(tid_l));
    const int tid = tid_l, lane = tid & 63, wv = __builtin_amdgcn_readfirstlane(tid >> 6), r = lane & 15, q = lane >> 4;
    f32x4 S[8];
#pragma unroll
    for (int kt = 0; kt < 8; ++kt) S[kt] = (f32x4){0.f, 0.f, 0.f, 0.f};
    const f32x4 g4 = *(const f32x4*)(gnorm + 16 * wv + q * 4);
    const size_t cb = (size_t)(bh & 7) * 128, mb = (size_t)(bh >> 3) * SEQ;
    ScanRegs X, Y;
    X.dc = (f32x4){0.f, 0.f, 0.f, 0.f}; Y.dc = X.dc;
#pragma unroll
    for (int mt = 0; mt < 4; ++mt) { X.o[mt] = (f32x4){0.f, 0.f, 0.f, 0.f}; Y.o[mt] = X.o[mt]; X.hg[mt] = (u32x2){0u, 0u}; Y.hg[mt] = X.hg[mt]; }
    asm volatile("" ::: "memory");
    scan_load(X, Qg, Kg, Vg, Pg, DECg, bh, 0, mb, cb, tid, lane, wv);
    scan_load(Y, Qg, Kg, Vg, Pg, DECg, bh, 1, mb, cb, tid, lane, wv);
#pragma unroll 1
    for (int n = 0; n < SEQ / 64; n += 2) {
        scan_chunk(X, Y, S, g4, n, Qg, Kg, Vg, Pg, DECg, HGg, bh, mb, cb, tid, lane, wv, r, q, lds, dry);
        scan_chunk(Y, X, S, g4, n + 1, Qg, Kg, Vg, Pg, DECg, HGg, bh, mb, cb, tid, lane, wv, r, q, lds, dry);
    }
    scan_chunk(X, Y, S, g4, SEQ / 64, Qg, Kg, Vg, Pg, DECg, HGg, bh, mb, cb, tid, lane, wv, r, q, lds, dry);
    __syncthreads();
}

constexpr int NSEG = 4, CPS = (SEQ / 64) / NSEG;
struct Scan1Regs { unsigned q2[8], k2[8], v2[8]; u32x4 pr; f32x4 dc; };
__device__ __forceinline__ void scan1_load(Scan1Regs& R, const bf16_t* Qg, const bf16_t* Kg, const bf16_t* Vg, const bf16_t* Pg, const float* DECg, int bh, int n, size_t mb, size_t cb, int tid, int lane, int wv) {
    R.pr = *(const u32x4*)(Pg + (size_t)(bh * 32 + n) * 4096 + tid * 8);
    R.dc = *(const f32x4*)(DECg + (size_t)(bh * 32 + n) * 128 + (tid & 31) * 4);
    const size_t rb = (mb + (size_t)n * 64 + wv * 8) * 1024 + cb + 2 * lane;
#pragma unroll
    for (int i = 0; i < 8; ++i) { R.q2[i] = *(const unsigned*)(Qg + rb + (size_t)i * 1024); R.k2[i] = *(const unsigned*)(Kg + rb + (size_t)i * 1024); R.v2[i] = *(const unsigned*)(Vg + rb + (size_t)i * 1024); }
    asm volatile("" ::: "memory");
}
#define SCHED_FENCE() __builtin_amdgcn_sched_barrier(0)
#define QFRAG(a, mt) __builtin_bit_cast(bf16x8, (u32x4){(*(const LAS u32x2*)(QH + ((mt) * 16 + r) * HQ_STR + 32 * (a) + q * 4)).x, (*(const LAS u32x2*)(QH + ((mt) * 16 + r) * HQ_STR + 32 * (a) + q * 4)).y, \
                                                        (*(const LAS u32x2*)(QH + ((mt) * 16 + r) * HQ_STR + 32 * (a) + 16 + q * 4)).x, (*(const LAS u32x2*)(QH + ((mt) * 16 + r) * HQ_STR + 32 * (a) + 16 + q * 4)).y})
#define SFRAG(a) __builtin_bit_cast(bf16x8, (u32x4){pk_bf16(S[2 * (a)][0], S[2 * (a)][1]), pk_bf16(S[2 * (a)][2], S[2 * (a)][3]), pk_bf16(S[2 * (a) + 1][0], S[2 * (a) + 1][1]), pk_bf16(S[2 * (a) + 1][2], S[2 * (a) + 1][3])})
__device__ __forceinline__ void scan1_chunk(Scan1Regs& X, f32x4 (&S)[8], int n, int nlast, const bf16_t* Qg, const bf16_t* Kg, bf16_t* Vg, const bf16_t* Pg, const float* DECg,
                                            int bh, size_t mb, size_t cb, int tid, int lane, int wv, int r, int q, LAS unsigned char* lds) {
    LAS unsigned char* B = lds + (n & 1) * SB_SIZE;
    const size_t m0 = mb + (size_t)n * 64;
    LAS bf16_t* QH = (LAS bf16_t*)(B + SB_QH); LAS bf16_t* KHT = (LAS bf16_t*)(B + SB_KHT); LAS bf16_t* VT = (LAS bf16_t*)(B + SB_VT); LAS bf16_t* Pm = (LAS bf16_t*)(B + SB_P);
    const LAS float* DEC = (const LAS float*)(B + SB_DEC);
#pragma unroll
    for (int i = 0; i < 8; ++i) *(LAS unsigned*)(QH + (wv * 8 + i) * HQ_STR + 2 * lane) = X.q2[i];
    { u32x4 lo, hi; const unsigned* k2 = X.k2;
      lo.x = (k2[0] & 0xffffu) | (k2[1] << 16); lo.y = (k2[2] & 0xffffu) | (k2[3] << 16); lo.z = (k2[4] & 0xffffu) | (k2[5] << 16); lo.w = (k2[6] & 0xffffu) | (k2[7] << 16);
      hi.x = (k2[0] >> 16) | (k2[1] & 0xffff0000u); hi.y = (k2[2] >> 16) | (k2[3] & 0xffff0000u); hi.z = (k2[4] >> 16) | (k2[5] & 0xffff0000u); hi.w = (k2[6] >> 16) | (k2[7] & 0xffff0000u);
      *(LAS u32x4*)(KHT + (2 * lane) * HK_STR + wv * 8) = lo; *(LAS u32x4*)(KHT + (2 * lane + 1) * HK_STR + wv * 8) = hi; }
    { u32x4 lo, hi; const unsigned* v2 = X.v2;
      lo.x = (v2[0] & 0xffffu) | (v2[1] << 16); lo.y = (v2[2] & 0xffffu) | (v2[3] << 16); lo.z = (v2[4] & 0xffffu) | (v2[5] << 16); lo.w = (v2[6] & 0xffffu) | (v2[7] << 16);
      hi.x = (v2[0] >> 16) | (v2[1] & 0xffff0000u); hi.y = (v2[2] >> 16) | (v2[3] & 0xffff0000u); hi.z = (v2[4] >> 16) | (v2[5] & 0xffff0000u); hi.w = (v2[6] >> 16) | (v2[7] & 0xffff0000u);
      *(LAS u32x4*)(VT + (2 * lane) * HK_STR + wv * 8) = lo; *(LAS u32x4*)(VT + (2 * lane + 1) * HK_STR + wv * 8) = hi; }
    *(LAS u32x4*)(Pm + (tid >> 3) * HK_STR + (tid & 7) * 8) = X.pr;
    if (tid < 32) *(LAS f32x4*)((LAS float*)(B + SB_DEC) + tid * 4) = X.dc;
    scan1_load(X, Qg, Kg, Vg, Pg, DECg, bh, (n + 2 <= nlast) ? n + 2 : nlast, mb, cb, tid, lane, wv);
    LBAR();
    f32x4 o[4];
#pragma unroll
    for (int mt = 0; mt < 4; ++mt) o[mt] = (f32x4){0.f, 0.f, 0.f, 0.f};
    bf16x8 qa[8], qb[8];
#pragma unroll
    for (int mt = 0; mt < 4; ++mt) { qa[mt] = QFRAG(0, mt); qa[4 + mt] = QFRAG(1, mt); }
    SCHED_FENCE();
#pragma unroll
    for (int mt = 0; mt < 4; ++mt) { qb[mt] = QFRAG(2, mt); qb[4 + mt] = QFRAG(3, mt); }
    { const bf16x8 s0 = SFRAG(0), s1 = SFRAG(1);
#pragma unroll
      for (int mt = 0; mt < 4; ++mt) o[mt] = MFMA16(s0, qa[mt], o[mt]);
#pragma unroll
      for (int mt = 0; mt < 4; ++mt) o[mt] = MFMA16(s1, qa[4 + mt], o[mt]); }
    SCHED_FENCE();
    bf16x8 vf[2], pf[6];
#pragma unroll
    for (int ks = 0; ks < 2; ++ks) vf[ks] = *(const LAS bf16x8*)(VT + (16 * wv + r) * HK_STR + ks * 32 + q * 8);
#pragma unroll
    for (int mt = 0; mt < 4; ++mt) pf[mt] = *(const LAS bf16x8*)(Pm + (mt * 16 + r) * HK_STR + q * 8);
    pf[4] = *(const LAS bf16x8*)(Pm + (2 * 16 + r) * HK_STR + 32 + q * 8); pf[5] = *(const LAS bf16x8*)(Pm + (3 * 16 + r) * HK_STR + 32 + q * 8);
    { const bf16x8 s2 = SFRAG(2), s3 = SFRAG(3);
#pragma unroll
      for (int mt = 0; mt < 4; ++mt) o[mt] = MFMA16(s2, qb[mt], o[mt]);
#pragma unroll
      for (int mt = 0; mt < 4; ++mt) o[mt] = MFMA16(s3, qb[4 + mt], o[mt]); }
    SCHED_FENCE();
    f32x4 deca[4], decb[4]; bf16x8 kfa[8], kfb[8];
#pragma unroll
    for (int kt = 0; kt < 4; ++kt) { deca[kt] = *(const LAS f32x4*)(DEC + kt * 16 + q * 4); kfa[2 * kt] = *(const LAS bf16x8*)(KHT + (kt * 16 + r) * HK_STR + q * 8); kfa[2 * kt + 1] = *(const LAS bf16x8*)(KHT + (kt * 16 + r) * HK_STR + 32 + q * 8); }
#pragma unroll
    for (int mt = 0; mt < 4; ++mt) o[mt] = MFMA16(vf[0], pf[mt], o[mt]);
    o[2] = MFMA16(vf[1], pf[4], o[2]); o[3] = MFMA16(vf[1], pf[5], o[3]);
    SCHED_FENCE();
#pragma unroll
    for (int kt = 4; kt < 8; ++kt) { decb[kt - 4] = *(const LAS f32x4*)(DEC + kt * 16 + q * 4); kfb[2 * (kt - 4)] = *(const LAS bf16x8*)(KHT + (kt * 16 + r) * HK_STR + q * 8); kfb[2 * (kt - 4) + 1] = *(const LAS bf16x8*)(KHT + (kt * 16 + r) * HK_STR + 32 + q * 8); }
#pragma unroll
    for (int kt = 0; kt < 4; ++kt) { S[kt] = S[kt] * deca[kt]; S[kt] = MFMA16(kfa[2 * kt], vf[0], S[kt]); S[kt] = MFMA16(kfa[2 * kt + 1], vf[1], S[kt]); }
    SCHED_FENCE();
#pragma unroll
    for (int kt = 4; kt < 8; ++kt) { S[kt] = S[kt] * decb[kt - 4]; S[kt] = MFMA16(kfb[2 * (kt - 4)], vf[0], S[kt]); S[kt] = MFMA16(kfb[2 * (kt - 4) + 1], vf[1], S[kt]); }
#pragma unroll
    for (int mt = 0; mt < 4; ++mt) { u32x2 w; w.x = pk_bf16(o[mt].x, o[mt].y); w.y = pk_bf16(o[mt].z, o[mt].w);
        *(u32x2*)(Vg + (m0 + mt * 16 + r) * 1024 + cb + 16 * wv + q * 4) = w; }
}
__device__ __forceinline__ void scan1_item(const bf16_t* Qg, const bf16_t* Kg, bf16_t* Vg, const bf16_t* Pg, const float* DECg, float* SLOC, float* DSEG, int item, LAS unsigned char* lds) {
    int tid_l = threadIdx.x; asm volatile("" : "+v"(tid_l));
    const int tid = tid_l, lane = tid & 63, wv = __builtin_amdgcn_readfirstlane(tid >> 6), r = lane & 15, q = lane >> 4;
    const int bh = item >> 2, seg = item & 3, n0 = seg * CPS, nlast = n0 + CPS - 1;
    f32x4 S[8];
#pragma unroll
    for (int kt = 0; kt < 8; ++kt) S[kt] = (f32x4){0.f, 0.f, 0.f, 0.f};
    const size_t cb = (size_t)(bh & 7) * 128, mb = (size_t)(bh >> 3) * SEQ;
    Scan1Regs X, Y;
    asm volatile("" ::: "memory");
    scan1_load(X, Qg, Kg, Vg, Pg, DECg, bh, n0, mb, cb, tid, lane, wv);
    scan1_load(Y, Qg, Kg, Vg, Pg, DECg, bh, n0 + 1, mb, cb, tid, lane, wv);
#pragma unroll 1
    for (int n = n0; n <= nlast; n += 2) {
        scan1_chunk(X, S, n, nlast, Qg, Kg, Vg, Pg, DECg, bh, mb, cb, tid, lane, wv, r, q, lds);
        scan1_chunk(Y, S, n + 1, nlast, Qg, Kg, Vg, Pg, DECg, bh, mb, cb, tid, lane, wv, r, q, lds);
    }
    f32x4* sl = (f32x4*)SLOC + ((size_t)item * 8 + wv) * 8 * 64 + lane;
#pragma unroll
    for (int kt = 0; kt < 8; ++kt) sl[kt * 64] = S[kt];
    if (wv == 0 && r == 0) {
#pragma unroll
        for (int kt = 0; kt < 8; ++kt) { f32x4 cdv = (f32x4){1.f, 1.f, 1.f, 1.f};
            for (int n = n0; n <= nlast; ++n) cdv = cdv * *(const f32x4*)(DECg + (size_t)(bh * 32 + n) * 128 + kt * 16 + q * 4);
            *(f32x4*)(DSEG + (size_t)item * 128 + kt * 16 + q * 4) = cdv; } }
    __syncthreads();
}

constexpr int F_QH = 0, F_QT = 17408, F_KT = 34816, F_KHT = 52224, F_VT = 70656, F_P = 89088, F_TOT = 98304, F_DEC = 102400;
struct FRegs { unsigned q2[8], z2[8], v2[8]; };
__device__ __forceinline__ void f_load(FRegs& R, const bf16_t* Qg, const bf16_t* LFg, const bf16_t* Vg, int n, size_t mb, size_t cb, int lane, int wv) {
    const size_t rb = (mb + (size_t)n * 64 + wv * 8) * 1024 + cb + 2 * lane;
#pragma unroll
    for (int i = 0; i < 8; ++i) { R.q2[i] = *(const unsigned*)(Qg + rb + (size_t)i * 1024); R.z2[i] = *(const unsigned*)(LFg + rb + (size_t)i * 1024); R.v2[i] = *(const unsigned*)(Vg + rb + (size_t)i * 1024); }
    asm volatile("" ::: "memory");
}
__device__ __forceinline__ void f_chunk(FRegs& X, f32x4 (&S)[8], float& cd0, float& cd1, int n, int nlast, const float lb0, const float lb1, bf16_t* Qg, const bf16_t* LFg, bf16_t* Vg, float* DECg,
                                        int bh, size_t mb, size_t cb, int tid, int lane, int wv, int r, int q, LAS unsigned char* lds) {
    LAS bf16_t* QH = (LAS bf16_t*)(lds + F_QH); LAS bf16_t* QT = (LAS bf16_t*)(lds + F_QT); LAS bf16_t* KT = (LAS bf16_t*)(lds + F_KT);
    LAS bf16_t* KHT = (LAS bf16_t*)(lds + F_KHT); LAS bf16_t* VT = (LAS bf16_t*)(lds + F_VT); LAS bf16_t* Pm = (LAS bf16_t*)(lds + F_P);
    LAS float* TOT = (LAS float*)(lds + F_TOT); LAS float* DEC = (LAS float*)(lds + F_DEC);
    const size_t m0 = mb + (size_t)n * 64, rb = (m0 + wv * 8) * 1024 + cb + 2 * lane;
    float f0[8], f1[8]; float run0 = 0.f, run1 = 0.f;
#pragma unroll
    for (int i = 0; i < 8; ++i) { const float z0 = h_lo(X.z2[i]), z1 = h_hi(X.z2[i]);
        f0[i] = fmaxf(lb0 + (1.f - lb0) * sigmoid_f(z0), 1e-30f); f1[i] = fmaxf(lb1 + (1.f - lb1) * sigmoid_f(z1), 1e-30f); run0 += __logf(f0[i]); run1 += __logf(f1[i]); }
    *(LAS f32x2*)(TOT + wv * 128 + 2 * lane) = (f32x2){run0, run1};
    LBAR();
    float pre0 = 0.f, pre1 = 0.f, last0 = 0.f, last1 = 0.f;
#pragma unroll
    for (int w = 0; w < 8; ++w) { const f32x2 t = *(const LAS f32x2*)(TOT + w * 128 + 2 * lane); last0 += t.x; last1 += t.y; if (w < wv) { pre0 += t.x; pre1 += t.y; } }
    { const f32x2 dv = (f32x2){__expf(last0), __expf(last1)}; cd0 *= dv.x; cd1 *= dv.y;
      if (wv == 0) { *(LAS f32x2*)(DEC + 2 * lane) = dv; *(f32x2*)(DECg + (size_t)(bh * 32 + n) * 128 + 2 * lane) = dv; } }
    const float sc0 = __expf(fminf(-0.5f * last0, 60.f)), sc1 = __expf(fminf(-0.5f * last1, 60.f));
    float pf0 = __expf(pre0), pf1 = __expf(pre1), sf0 = __expf(last0 - pre0 - run0), sf1 = __expf(last1 - pre1 - run1);
    { float kh0[8], kh1[8];
#pragma unroll
      for (int i = 7; i >= 0; --i) { kh0[i] = (1.f - f0[i]) * sf0; kh1[i] = (1.f - f1[i]) * sf1; sf0 *= f0[i]; sf1 *= f1[i]; }
#pragma unroll
      for (int i = 0; i < 8; ++i) { pf0 *= f0[i]; pf1 *= f1[i];
          const float qh0 = silu_f(bf_lo(X.q2[i])) * pf0, qh1 = silu_f(bf_hi(X.q2[i])) * pf1; const int t = wv * 8 + i; const unsigned qp = pk_bf16(qh0, qh1);
          *(unsigned*)(Qg + rb + (size_t)i * 1024) = qp;
          *(LAS unsigned*)(QH + t * HQ_STR + 2 * lane) = qp;
          *(LAS unsigned*)(QT + t * HQ_STR + 2 * lane) = pk_bf16(qh0 * sc0, qh1 * sc1);
          *(LAS unsigned*)(KT + t * HQ_STR + 2 * lane) = pk_bf16(kh0[i] * sc0, kh1[i] * sc1); }
      u32x4 a, c; a.x = pk_bf16(kh0[0], kh0[1]); a.y = pk_bf16(kh0[2], kh0[3]); a.z = pk_bf16(kh0[4], kh0[5]); a.w = pk_bf16(kh0[6], kh0[7]);
      c.x = pk_bf16(kh1[0], kh1[1]); c.y = pk_bf16(kh1[2], kh1[3]); c.z = pk_bf16(kh1[4], kh1[5]); c.w = pk_bf16(kh1[6], kh1[7]);
      *(LAS u32x4*)(KHT + (2 * lane) * HK_STR + wv * 8) = a; *(LAS u32x4*)(KHT + (2 * lane + 1) * HK_STR + wv * 8) = c; }
    { u32x4 lo, hi; const unsigned* v2 = X.v2;
      lo.x = (v2[0] & 0xffffu) | (v2[1] << 16); lo.y = (v2[2] & 0xffffu) | (v2[3] << 16); lo.z = (v2[4] & 0xffffu) | (v2[5] << 16); lo.w = (v2[6] & 0xffffu) | (v2[7] << 16);
      hi.x = (v2[0] >> 16) | (v2[1] & 0xffff0000u); hi.y = (v2[2] >> 16) | (v2[3] & 0xffff0000u); hi.z = (v2[4] >> 16) | (v2[5] & 0xffff0000u); hi.w = (v2[6] >> 16) | (v2[7] & 0xffff0000u);
      *(LAS u32x4*)(VT + (2 * lane) * HK_STR + wv * 8) = lo; *(LAS u32x4*)(VT + (2 * lane + 1) * HK_STR + wv * 8) = hi; }
    f_load(X, Qg, LFg, Vg, (n + 2 <= nlast) ? n + 2 : nlast, mb, cb, lane, wv);
    LBAR();
    const int ti = wv >> 1;
    { bf16x8 qf[4], kf[2][4];
#pragma unroll
      for (int ks = 0; ks < 4; ++ks) { qf[ks] = *(const LAS bf16x8*)(QT + (ti * 16 + r) * HQ_STR + ks * 32 + q * 8);
          kf[0][ks] = *(const LAS bf16x8*)(KT + ((2 * (wv & 1)) * 16 + r) * HQ_STR + ks * 32 + q * 8); kf[1][ks] = *(const LAS bf16x8*)(KT + ((2 * (wv & 1) + 1) * 16 + r) * HQ_STR + ks * 32 + q * 8); }
      SCHED_FENCE();
#pragma unroll
      for (int jj = 0; jj < 2; ++jj) { const int tj = 2 * (wv & 1) + jj; f32x4 sc = (f32x4){0.f, 0.f, 0.f, 0.f};
          if (tj <= ti) {
#pragma unroll
              for (int ks = 0; ks < 4; ++ks) sc = MFMA16(kf[jj][ks], qf[ks], sc); }
          const int t = ti * 16 + r, s0 = tj * 16 + q * 4;
#pragma unroll
          for (int j = 0; j < 4; ++j) sc[j] = (s0 + j <= t) ? sc[j] : 0.f;
          u32x2 w; w.x = pk_bf16(sc[0], sc[1]); w.y = pk_bf16(sc[2], sc[3]);
          *(LAS u32x2*)(Pm + t * HK_STR + s0) = w; } }
    f32x4 o[4];
#pragma unroll
    for (int mt = 0; mt < 4; ++mt) o[mt] = (f32x4){0.f, 0.f, 0.f, 0.f};
    { bf16x8 qa[8], qb[8];
#pragma unroll
      for (int mt = 0; mt < 4; ++mt) { qa[mt] = QFRAG(0, mt); qa[4 + mt] = QFRAG(1, mt); }
      SCHED_FENCE();
#pragma unroll
      for (int mt = 0; mt < 4; ++mt) { qb[mt] = QFRAG(2, mt); qb[4 + mt] = QFRAG(3, mt); }
      { const bf16x8 s0 = SFRAG(0), s1 = SFRAG(1);
#pragma unroll
        for (int mt = 0; mt < 4; ++mt) o[mt] = MFMA16(s0, qa[mt], o[mt]);
#pragma unroll
        for (int mt = 0; mt < 4; ++mt) o[mt] = MFMA16(s1, qa[4 + mt], o[mt]); }
      SCHED_FENCE();
      { const bf16x8 s2 = SFRAG(2), s3 = SFRAG(3);
#pragma unroll
        for (int mt = 0; mt < 4; ++mt) o[mt] = MFMA16(s2, qb[mt], o[mt]);
#pragma unroll
        for (int mt = 0; mt < 4; ++mt) o[mt] = MFMA16(s3, qb[4 + mt], o[mt]); } }
    LBAR();
    bf16x8 vf[2], pf[6];
#pragma unroll
    for (int ks = 0; ks < 2; ++ks) vf[ks] = *(const LAS bf16x8*)(VT + (16 * wv + r) * HK_STR + ks * 32 + q * 8);
#pragma unroll
    for (int mt = 0; mt < 4; ++mt) pf[mt] = *(const LAS bf16x8*)(Pm + (mt * 16 + r) * HK_STR + q * 8);
    pf[4] = *(const LAS bf16x8*)(Pm + (2 * 16 + r) * HK_STR + 32 + q * 8); pf[5] = *(const LAS bf16x8*)(Pm + (3 * 16 + r) * HK_STR + 32 + q * 8);
    SCHED_FENCE();
    f32x4 deca[4], decb[4]; bf16x8 kfa[8], kfb[8];
#pragma unroll
    for (int kt = 0; kt < 4; ++kt) { deca[kt] = *(const LAS f32x4*)(DEC + kt * 16 + q * 4); kfa[2 * kt] = *(const LAS bf16x8*)(KHT + (kt * 16 + r) * HK_STR + q * 8); kfa[2 * kt + 1] = *(const LAS bf16x8*)(KHT + (kt * 16 + r) * HK_STR + 32 + q * 8); }
#pragma unroll
    for (int mt = 0; mt < 4; ++mt) o[mt] = MFMA16(vf[0], pf[mt], o[mt]);
    o[2] = MFMA16(vf[1], pf[4], o[2]); o[3] = MFMA16(vf[1], pf[5], o[3]);
    SCHED_FENCE();
#pragma unroll
    for (int kt = 4; kt < 8; ++kt) { decb[kt - 4] = *(const LAS f32x4*)(DEC + kt * 16 + q * 4); kfb[2 * (kt - 4)] = *(const LAS bf16x8*)(KHT + (kt * 16 + r) * HK_STR + q * 8); kfb[2 * (kt - 4) + 1] = *(const LAS bf16x8*)(KHT + (kt * 16 + r) * HK_STR + 32 + q * 8); }
#pragma unroll
    for (int kt = 0; kt < 4; ++kt) { S[kt] = S[kt] * deca[kt]; S[kt] = MFMA16(kfa[2 * kt], vf[0], S[kt]); S[kt] = MFMA16(kfa[2 * kt + 1], vf[1], S[kt]); }
    SCHED_FENCE();
#pragma unroll
    for (int kt = 4; kt < 8; ++kt) { S[kt] = S[kt] * decb[kt - 4]; S[kt] = MFMA16(kfb[2 * (kt - 4)], vf[0], S[kt]); S[kt] = MFMA16(kfb[2 * (kt - 4) + 1], vf[1], S[kt]); }
#pragma unroll
    for (int mt = 0; mt < 4; ++mt) { u32x2 w; w.x = pk_bf16(o[mt].x, o[mt].y); w.y = pk_bf16(o[mt].z, o[mt].w);
        *(u32x2*)(Vg + (m0 + mt * 16 + r) * 1024 + cb + 16 * wv + q * 4) = w; }
}
__device__ __forceinline__ void f_item(bf16_t* Qg, const bf16_t* LFg, bf16_t* Vg, float* DECg, float* SLOC, float* DSEG, const float* lbl, int item, LAS unsigned char* lds) {
    int tid_l = threadIdx.x; asm volatile("" : "+v"(tid_l));
    const int tid = tid_l, lane = tid & 63, wv = __builtin_amdgcn_readfirstlane(tid >> 6), r = lane & 15, q = lane >> 4;
    const int bh = item >> 2, seg = item & 3, n0 = seg * CPS, nlast = n0 + CPS - 1;
    f32x4 S[8];
#pragma unroll
    for (int kt = 0; kt < 8; ++kt) S[kt] = (f32x4){0.f, 0.f, 0.f, 0.f};
    const size_t cb = (size_t)(bh & 7) * 128, mb = (size_t)(bh >> 3) * SEQ;
    const f32x2 lbp = *(const f32x2*)(lbl + (bh & 7) * 128 + 2 * lane);
    FRegs X, Y; float cd0 = 1.f, cd1 = 1.f;
    asm volatile("" ::: "memory");
    f_load(X, Qg, LFg, Vg, n0, mb, cb, lane, wv);
    f_load(Y, Qg, LFg, Vg, n0 + 1, mb, cb, lane, wv);
#pragma unroll 1
    for (int n = n0; n <= nlast; n += 2) {
        f_chunk(X, S, cd0, cd1, n, nlast, lbp.x, lbp.y, Qg, LFg, Vg, DECg, bh, mb, cb, tid, lane, wv, r, q, lds);
        f_chunk(Y, S, cd0, cd1, n + 1, nlast, lbp.x, lbp.y, Qg, LFg, Vg, DECg, bh, mb, cb, tid, lane, wv, r, q, lds);
    }
    f32x4* sl = (f32x4*)SLOC + ((size_t)item * 8 + wv) * 8 * 64 + lane;
#pragma unroll
    for (int kt = 0; kt < 8; ++kt) sl[kt * 64] = S[kt];
    if (wv == 0) *(f32x2*)(DSEG + (size_t)item * 128 + 2 * lane) = (f32x2){cd0, cd1};
    __syncthreads();
}

struct Scan2Regs { unsigned q2[8]; f32x4 dc; u32x2 ol[4], hg[4], hgc[4]; f32x4 o[4]; };
__device__ __forceinline__ void scan2_load(Scan2Regs& R, const bf16_t* Qg, const bf16_t* OLg, const bf16_t* HGg, const float* DECg, int bh, int n, size_t mb, size_t cb, int tid, int lane, int wv, int r, int q) {
    R.dc = *(const f32x4*)(DECg + (size_t)(bh * 32 + n) * 128 + (tid & 31) * 4);
    const size_t rb = (mb + (size_t)n * 64 + wv * 8) * 1024 + cb + 2 * lane;
#pragma unroll
    for (int i = 0; i < 8; ++i) R.q2[i] = *(const unsigned*)(Qg + rb + (size_t)i * 1024);
#pragma unroll
    for (int mt = 0; mt < 4; ++mt) { const size_t ob = (mb + (size_t)n * 64 + mt * 16 + r) * 1024 + cb + 16 * wv + q * 4; R.ol[mt] = *(const u32x2*)(OLg + ob); R.hg[mt] = *(const u32x2*)(HGg + ob); }
    asm volatile("" ::: "memory");
}
__device__ __forceinline__ void scan2_chunk(Scan2Regs& X, Scan2Regs& Y, f32x4 (&S)[8], const f32x4 g4, int n, int n0, int nlast, const bf16_t* Qg, const bf16_t* OLg, bf16_t* HGg, const float* DECg,
                                            int bh, size_t mb, size_t cb, int tid, int lane, int wv, int r, int q, LAS unsigned char* lds) {
    LAS unsigned char* B = lds + (n & 1) * SB_SIZE;
    const size_t m0 = mb + (size_t)n * 64;
    u32x2 olx[4];
    if (n <= nlast) {
        LAS bf16_t* QH = (LAS bf16_t*)(B + SB_QH);
#pragma unroll
        for (int i = 0; i < 8; ++i) *(LAS unsigned*)(QH + (wv * 8 + i) * HQ_STR + 2 * lane) = X.q2[i];
        if (tid < 32) *(LAS f32x4*)((LAS float*)(B + SB_DEC) + tid * 4) = X.dc;
#pragma unroll
        for (int mt = 0; mt < 4; ++mt) { X.hgc[mt] = X.hg[mt]; olx[mt] = X.ol[mt]; }
        scan2_load(X, Qg, OLg, HGg, DECg, bh, (n + 2 <= nlast) ? n + 2 : nlast, mb, cb, tid, lane, wv, r, q);
    }
    LBAR();
    if (n > n0) {
        const LAS float* SSQ = (const LAS float*)(lds + ((n - 1) & 1) * SB_SIZE + SB_SSQ);
#pragma unroll
        for (int mt = 0; mt < 4; ++mt) { float tot = 0.f;
#pragma unroll
            for (int w = 0; w < 8; ++w) tot += SSQ[w * 64 + mt * 16 + r];
            const float rstd = rsqrtf(tot * (1.f / 128.f) + EPS);
            const f32x4 ov = Y.o[mt] * rstd * g4 * (f32x4){silu_f(bf_lo(Y.hgc[mt].x)), silu_f(bf_hi(Y.hgc[mt].x)), silu_f(bf_lo(Y.hgc[mt].y)), silu_f(bf_hi(Y.hgc[mt].y))};
            u32x2 w; w.x = pk_bf16(ov.x, ov.y); w.y = pk_bf16(ov.z, ov.w);
            *(u32x2*)(HGg + (m0 - 64 + mt * 16 + r) * 1024 + cb + 16 * wv + q * 4) = w; }
    }
    if (n <= nlast) {
        const LAS bf16_t* QH = (const LAS bf16_t*)(B + SB_QH); const LAS float* DEC = (const LAS float*)(B + SB_DEC); LAS float* SSQ = (LAS float*)(B + SB_SSQ);
        f32x4 o[4];
#pragma unroll
        for (int mt = 0; mt < 4; ++mt) o[mt] = (f32x4){bf_lo(olx[mt].x), bf_hi(olx[mt].x), bf_lo(olx[mt].y), bf_hi(olx[mt].y)};
        bf16x8 qa[8], qb[8];
#pragma unroll
        for (int mt = 0; mt < 4; ++mt) { qa[mt] = QFRAG(0, mt); qa[4 + mt] = QFRAG(1, mt); }
        SCHED_FENCE();
#pragma unroll
        for (int mt = 0; mt < 4; ++mt) { qb[mt] = QFRAG(2, mt); qb[4 + mt] = QFRAG(3, mt); }
        { const bf16x8 s0 = SFRAG(0), s1 = SFRAG(1);
#pragma unroll
          for (int mt = 0; mt < 4; ++mt) o[mt] = MFMA16(s0, qa[mt], o[mt]);
#pragma unroll
          for (int mt = 0; mt < 4; ++mt) o[mt] = MFMA16(s1, qa[4 + mt], o[mt]); }
        SCHED_FENCE();
        f32x4 dec[8];
#pragma unroll
        for (int kt = 0; kt < 8; ++kt) dec[kt] = *(const LAS f32x4*)(DEC + kt * 16 + q * 4);
        { const bf16x8 s2 = SFRAG(2), s3 = SFRAG(3);
#pragma unroll
          for (int mt = 0; mt < 4; ++mt) o[mt] = MFMA16(s2, qb[mt], o[mt]);
#pragma unroll
          for (int mt = 0; mt < 4; ++mt) o[mt] = MFMA16(s3, qb[4 + mt], o[mt]); }
        SCHED_FENCE();
#pragma unroll
        for (int kt = 0; kt < 8; ++kt) S[kt] = S[kt] * dec[kt];
        float ss[4], t16[4];
#pragma unroll
        for (int mt = 0; mt < 4; ++mt) { ss[mt] = (o[mt].x * o[mt].x + o[mt].y * o[mt].y) + (o[mt].z * o[mt].z + o[mt].w * o[mt].w); X.o[mt] = o[mt]; }
#pragma unroll
        for (int mt = 0; mt < 4; ++mt) t16[mt] = __shfl_xor(ss[mt], 16);
        SCHED_FENCE();
#pragma unroll
        for (int mt = 0; mt < 4; ++mt) ss[mt] += t16[mt];
#pragma unroll
        for (int mt = 0; mt < 4; ++mt) t16[mt] = __shfl_xor(ss[mt], 32);
        SCHED_FENCE();
#pragma unroll
        for (int mt = 0; mt < 4; ++mt) { ss[mt] += t16[mt]; if (q == 0) SSQ[wv * 64 + mt * 16 + r] = ss[mt]; }
    }
}
__device__ __forceinline__ void scan2_item(const bf16_t* Qg, const bf16_t* OLg, bf16_t* HGg, const float* DECg, const float* SLOC, const float* DSEG, const float* gnorm, int item, LAS unsigned char* lds) {
    int tid_l = threadIdx.x; asm volatile("" : "+v"(tid_l));
    const int tid = tid_l, lane = tid & 63, wv = __builtin_amdgcn_readfirstlane(tid >> 6), r = lane & 15, q = lane >> 4;
    const int bh = item >> 2, seg = item & 3, n0 = seg * CPS, nlast = n0 + CPS - 1;
    const f32x4 g4 = *(const f32x4*)(gnorm + 16 * wv + q * 4);
    const size_t cb = (size_t)(bh & 7) * 128, mb = (size_t)(bh >> 3) * SEQ;
    Scan2Regs X, Y;
#pragma unroll
    for (int mt = 0; mt < 4; ++mt) { X.o[mt] = (f32x4){0.f, 0.f, 0.f, 0.f}; Y.o[mt] = X.o[mt]; X.hgc[mt] = (u32x2){0u, 0u}; Y.hgc[mt] = X.hgc[mt]; }
    asm volatile("" ::: "memory");
    scan2_load(X, Qg, OLg, HGg, DECg, bh, n0, mb, cb, tid, lane, wv, r, q);
    scan2_load(Y, Qg, OLg, HGg, DECg, bh, n0 + 1, mb, cb, tid, lane, wv, r, q);
    f32x4 S[8];
#pragma unroll
    for (int kt = 0; kt < 8; ++kt) S[kt] = (f32x4){0.f, 0.f, 0.f, 0.f};
    { const f32x4* sl0 = (const f32x4*)SLOC + ((size_t)(bh * NSEG + 0) * 8 + wv) * 8 * 64 + lane; const f32x4* sl1 = sl0 + (size_t)8 * 8 * 64; const f32x4* sl2 = sl1 + (size_t)8 * 8 * 64;
      const float* d1 = DSEG + (size_t)(bh * NSEG + 1) * 128 + q * 4; const float* d2 = d1 + 128;
      if (seg == 1) {
#pragma unroll
          for (int kt = 0; kt < 8; ++kt) S[kt] = sl0[kt * 64];
      } else if (seg == 2) {
#pragma unroll
          for (int kt = 0; kt < 8; ++kt) S[kt] = sl0[kt * 64] * *(const f32x4*)(d1 + kt * 16) + sl1[kt * 64];
      } else if (seg == 3) {
#pragma unroll
          for (int kt = 0; kt < 8; ++kt) S[kt] = (sl0[kt * 64] * *(const f32x4*)(d1 + kt * 16) + sl1[kt * 64]) * *(const f32x4*)(d2 + kt * 16) + sl2[kt * 64];
      } }
    static_assert(NSEG == 4, "the segment fold above is written out for 4 segments");
#pragma unroll 1
    for (int n = n0; n <= nlast; n += 2) {
        scan2_chunk(X, Y, S, g4, n, n0, nlast, Qg, OLg, HGg, DECg, bh, mb, cb, tid, lane, wv, r, q, lds);
        scan2_chunk(Y, X, S, g4, n + 1, n0, nlast, Qg, OLg, HGg, DECg, bh, mb, cb, tid, lane, wv, r, q, lds);
    }
    scan2_chunk(X, Y, S, g4, nlast + 1, n0, nlast, Qg, OLg, HGg, DECg, bh, mb, cb, tid, lane, wv, r, q, lds);
    __syncthreads();
}
#undef QFRAG
#undef SFRAG

__global__ void __launch_bounds__(512, 2) fwd_megakernel(Params p) {
    extern __shared__ __attribute__((aligned(16))) unsigned char lds_raw[];
    LAS unsigned char* lds = (LAS unsigned char*)lds_raw;
#ifdef USE_CG_SYNC
    cg::grid_group grid = cg::this_grid();
#endif
    const int G = gridDim.x, blk = blockIdx.x;
    unsigned char* ws = p.ws;
    float* ADA = (float*)(ws + WS_ADA);
    bf16_t* H = (bf16_t*)(ws + WS_H); bf16_t* PV = (bf16_t*)(ws + WS_PV); bf16_t* PG = (bf16_t*)(ws + WS_PG); bf16_t* Q = (bf16_t*)(ws + WS_Q);
    bf16_t* LF = (bf16_t*)(ws + WS_LF); bf16_t* V = (bf16_t*)(ws + WS_V); bf16_t* HG = (bf16_t*)(ws + WS_HG);
    bf16_t* GATE = Q; bf16_t* MERGED = LF; bf16_t* Y = V;

    volatile LAS unsigned* stw = (volatile LAS unsigned*)(lds + LDS_BARW);
    unsigned* barw = (unsigned*)(ws + WS_BAR);
    if (threadIdx.x < 4) stw[threadIdx.x] = 0u;
    __syncthreads();
#ifdef USE_CG_SYNC
    if (blk == 0) for (int i = threadIdx.x; i < XCD_BAR_WORDS; i += 512) barw[i] = 0u;
    p0_prologue(p, lds);
    grid.sync();
    const XcdBarrier xb = xcd_barrier_post(barw, stw);
#else
    const XcdBarrier xb = xcd_barrier_post(barw, stw);
    p0_prologue(p, lds);
#ifdef DUP_P0
    __syncthreads(); p0_prologue(p, lds);
#endif
    xcd_barrier(xb);
#endif
#define GSYNC() xcd_barrier(xb)
#pragma unroll 1
    for (int l = 0; l < NL; ++l) {
#ifndef SKIP_P1
        if (l == 0) p1_rows<false, true>(p.x, nullptr, nullptr, nullptr, nullptr, p.g_pre, ADA, H);
        else p1_rows<true, true>(p.x, Y, ADA + (size_t)(l - 1) * NB * 3072, p.g_post + (size_t)(l - 1) * D, p.out, p.g_pre + (size_t)l * D, ADA + (size_t)l * NB * 3072, H);
#ifdef DUP_P1
        if (l == 0) p1_rows<false, true>(p.x, nullptr, nullptr, nullptr, nullptr, p.g_pre, ADA, H);
        else p1_rows<true, true>(p.x, Y, ADA + (size_t)(l - 1) * NB * 3072, p.g_post + (size_t)(l - 1) * D, p.out, p.g_pre + (size_t)l * D, ADA + (size_t)l * NB * 3072, H);
#endif
#endif
        GSYNC();
#pragma unroll 1
        for (int s = 0; s < 4; ++s) {
            const bf16_t* WinT = (const bf16_t*)(ws + WS_WIN) + (size_t)l * INW * D;
            pg8::Gemm g; g.M = M; g.N = D; g.K = D; g.A = nullptr; g.Bt = nullptr;
            pg8::StaticOrder S;
            if (s == 0) { g.N = NIN; S.init(M, NIN, G, blk); S.A0 = H; S.B0 = WinT; S.mode0 = 0; }
            else if (s == 1) { S.init(M, D, G, blk); S.dup = 3; S.A0 = H; S.B0 = WinT + (size_t)5120 * D; S.mode0 = 1;
                               S.A2 = HG; S.B2 = (const bf16_t*)(ws + WS_WHO) + (size_t)l * D * D; S.mode2 = 2; }
            else if (s == 2) { g.K = 512; S.init(M, D, G, blk); S.A0 = PG; S.B0 = (const bf16_t*)(ws + WS_WPO) + (size_t)l * D * 512; S.mode0 = 3; }
            else { S.init(M, D, G, blk); S.A0 = MERGED; S.B0 = (const bf16_t*)(ws + WS_WOUT) + (size_t)l * D * D; S.mode0 = 4; }
            EpiU E{ws};
#ifdef PROBE_G
            const unsigned long long tg0 = __builtin_amdgcn_s_memrealtime();
#endif
            pg8::gemm_phase<EpiU, pg8::StaticOrder, PG8_ALIGN_SEL, PG8_SP2_SEL>(lds, g, S, E);
#ifdef PROBE_G
            if ((PROBE_G >> s) & 1) probe_acc += __builtin_amdgcn_s_memrealtime() - tg0;
#endif
            if (s == 0) {
                GSYNC();
#ifdef PROBE_P3
                const unsigned long long tp0 = __builtin_amdgcn_s_memrealtime();
#endif
                bf16_t* Pg = (bf16_t*)(ws + WS_P); float* DECg = (float*)(ws + WS_DEC);
                float* SLOC = (float*)(ws + WS_P); float* DSEG = (float*)(ws + WS_DSEG);
                const bool own = (G == NB * 8 * NSEG);
                if (own) f_item(Q, LF, V, DECg, SLOC, DSEG, (const float*)(ws + WS_LB) + l * 1024, blk, lds);
                else prep_items(Q, LF, Pg, DECg, (const float*)(ws + WS_LB) + l * 1024, blk, G, 2048, lds);
                if ((G & 3) == 0) {
                    const int gq = blk & 3; const bf16_t* pw = (const bf16_t*)(ws + WS_POOLWT) + (size_t)(l * 4 + gq) * 16384; const float* ps = p.pool_scale + l * 512 + gq * 128;
                    __syncthreads();
                    if (gq == 0) pool_tiles<2>(PV, PG, pw, ps, gq, blk >> 2, G >> 2, lds); else if (gq == 1) pool_tiles<4>(PV, PG, pw, ps, gq, blk >> 2, G >> 2, lds);
                    else if (gq == 2) pool_tiles<8>(PV, PG, pw, ps, gq, blk >> 2, G >> 2, lds); else pool_tiles<16>(PV, PG, pw, ps, gq, blk >> 2, G >> 2, lds);
                } else for (int pi = blk; pi < 1024; pi += G) {
                    const int gq = pi & 3, m0 = (pi >> 2) * 64;
                    const bf16_t* pw = (const bf16_t*)(ws + WS_POOLWT) + (size_t)(l * 4 + gq) * 16384; const float* ps = p.pool_scale + l * 512 + gq * 128;
                    if (gq == 0) pool_item<2>(PV, PG, pw, ps, m0, gq, lds); else if (gq == 1) pool_item<4>(PV, PG, pw, ps, m0, gq, lds);
                    else if (gq == 2) pool_item<8>(PV, PG, pw, ps, m0, gq, lds); else pool_item<16>(PV, PG, pw, ps, m0, gq, lds);
                }
                if (!own) { GSYNC(); for (int it = blk; it < NB * 8 * NSEG; it += G) scan1_item(Q, LF, V, Pg, DECg, SLOC, DSEG, it, lds); }
                GSYNC();
                for (int it = blk; it < NB * 8 * NSEG; it += G) scan2_item(Q, V, HG, DECg, SLOC, DSEG, p.hgrn_norm_g + l * 128, it, lds);
                GSYNC();
            } else if (s >= 2) GSYNC();
        }
    }
#ifdef DUP_SYNC
    for (int i = 0; i < 16; ++i) GSYNC();
#endif
    p1_rows<true, false>(p.out, Y, ADA + (size_t)(NL - 1) * NB * 3072, p.g_post + (size_t)(NL - 1) * D, p.out, nullptr, nullptr, nullptr);
#if defined(PROBE_P3) || defined(PROBE_G)
    __syncthreads();
    if (blk == 0 && threadIdx.x == 0) p.out[0] = 25.f * floorf((float)probe_acc * 0.01f / 25.f + 0.5f);
#endif
}

extern "C" void kernel_launch(void* const* d_in, const int* in_sizes, int n_in, void* d_out, int out_size, void* d_ws, size_t ws_size, hipStream_t stream) {
    static int grid_blocks = 0;
    if (grid_blocks == 0) {
        if (n_in != 14 || out_size != M * D || ws_size < WS_END) { fprintf(stderr, "kernel_launch: unexpected problem (n_in %d out %d ws %zu)\n", n_in, out_size, ws_size); grid_blocks = -1; return; }
        int dev = 0, cus = 0, per_cu = 0;
        (void)hipGetDevice(&dev);
        (void)hipDeviceGetAttribute(&cus, hipDeviceAttributeMultiprocessorCount, dev);
        (void)hipFuncSetAttribute((const void*)fwd_megakernel, hipFuncAttributeMaxDynamicSharedMemorySize, LDS_BYTES);
        (void)hipOccupancyMaxActiveBlocksPerMultiprocessor(&per_cu, (const void*)fwd_megakernel, 512, LDS_BYTES);
        if (per_cu < 1) { fprintf(stderr, "kernel_launch: occupancy query says %d blocks per CU\n", per_cu); grid_blocks = -1; return; }
        grid_blocks = cus;
    }
    if (grid_blocks < 0) return;
    Params p{};
    p.x = (const float*)d_in[0]; p.c = (const float*)d_in[1]; p.w_ada = (const float*)d_in[2]; p.b_ada = (const float*)d_in[3]; p.g_pre = (const float*)d_in[4]; p.g_post = (const float*)d_in[5];
    p.w_in = (const float*)d_in[6]; p.pool_w = (const float*)d_in[7]; p.pool_scale = (const float*)d_in[8]; p.lb_logits = (const float*)d_in[9]; p.hgrn_norm_g = (const float*)d_in[10];
    p.w_pool_o = (const float*)d_in[11]; p.w_hgrn_o = (const float*)d_in[12]; p.w_out = (const float*)d_in[13];
    p.out = (float*)d_out; p.ws = (unsigned char*)d_ws;
#ifndef USE_CG_SYNC
    (void)hipMemsetAsync((unsigned char*)d_ws + WS_BAR, 0, XCD_BAR_WORDS * sizeof(unsigned), stream);
#endif
    void* args[] = {&p};
    hipError_t e = hipLaunchCooperativeKernel((const void*)fwd_megakernel, dim3(grid_blocks), dim3(512), args, LDS_BYTES, stream);
    if (e != hipSuccess) fprintf(stderr, "cooperative launch failed: %s (grid %d)\n", hipGetErrorString(e), grid_blocks);
}
```

```cpp
#define PG8_ALIGN_SEL true
#define PG8_SP2_SEL true
#include <hip/hip_runtime.h>
#include <hip/hip_cooperative_groups.h>
#include <cstdio>
#include <cstdint>
namespace cg = cooperative_groups;
#define LAS __attribute__((address_space(3)))
namespace pg8 {
#define PG8_LAS __attribute__((address_space(3)))
typedef unsigned short bf16_t;
typedef short bf16x8 __attribute__((ext_vector_type(8)));
typedef float f32x4 __attribute__((ext_vector_type(4)));
typedef unsigned u32x4 __attribute__((ext_vector_type(4)));
constexpr int BM = 256, BK = 64, HALF = 128, HTB = HALF * BK * 2  , STAGE_BYTES = 8 * HTB, NXCD = 8, WGM = 8;

__host__ __device__ __forceinline__ int lds_byte(int r, int c) { const int st = (r >> 4) * 2 + (c >> 5), rr = r & 15, cc = c & 31, ob = rr * 64 + cc * 2; return st * 1024 + (ob ^ (((ob >> 9) & 1) << 5)); }
__host__ __device__ __forceinline__ void stage_rc(int b, int& R, int& C) { const int st = b / 1024, sb = b % 1024, swz = sb ^ (((sb >> 9) & 1) << 5); R = (st >> 1) * 16 + swz / 64; C = (st & 1) * 32 + (swz % 64) / 2; }
__host__ __device__ __forceinline__ int perm32(int rho) { const int n = rho >> 4, i = rho & 15; return 8 * (i >> 2) + 4 * n + (i & 3); }

struct Unit { int pm, pn; const unsigned short* A; const unsigned short* Bt; int mode; };
struct Gemm { const bf16_t* A; const bf16_t* Bt; int M, N, K; };

struct StaticOrder {
    int nM, nN, nwg, G, c, dup;
    const unsigned short *A0, *B0, *A2, *B2; int mode0, mode2;
    __host__ __device__ void init(int M, int N, int G_, int c_) { nM = M / BM; nN = N / BM; nwg = nM * nN; G = G_; c = c_; dup = 0; A0 = B0 = A2 = B2 = nullptr; mode0 = mode2 = 0; }
    __host__ __device__ bool next(int i, Unit& u) const {
        if (dup > 0 && i >= dup) return false;
        const long L = (dup > 0) ? (long)c : (long)i * G + c; if (L >= nwg) return false;
        int wgid = (int)L; { const int q = nwg / NXCD, r = nwg % NXCD, xcd = wgid % NXCD, off = wgid / NXCD; wgid = (xcd < r ? xcd * (q + 1) : r * (q + 1) + (xcd - r) * q) + off; }
        const int nig = WGM * nN, gid = wgid / nig, fm = gid * WGM, gsz = (nM - fm) < WGM ? (nM - fm) : WGM;
        u.pm = fm + ((wgid % nig) % gsz); u.pn = (wgid % nig) / gsz + ((dup > 0 && i == 1) ? nN : 0);
        const bool third = (dup > 0 && i == 2);
        u.A = third ? A2 : A0; u.Bt = third ? B2 : B0; u.mode = third ? mode2 : mode0; return true;
    }
    __device__ __forceinline__ void a_ready(const Unit&) const {}
    __device__ __forceinline__ void done(const Unit&) const {}
};
__device__ __forceinline__ unsigned cvt_pk_bf16(float lo, float hi) { unsigned r; asm volatile("v_cvt_pk_bf16_f32 %0, %1, %2" : "=v"(r) : "v"(lo), "v"(hi)); return r; }
template <class Epi, class Sched, bool ALIGN_EPI = false, bool SP2 = false>
__device__ __forceinline__ void gemm_phase(PG8_LAS unsigned char* lds, const Gemm g, const Sched& S, const Epi& E) {
    int tid_l = threadIdx.x; asm volatile("" : "+v"(tid_l));
    const int tid = tid_l, wid = __builtin_amdgcn_readfirstlane(tid >> 6), lane = tid & 63, wr = wid >> 2, wc = wid & 3, fr = lane & 15, fq = lane >> 4;
    const int K = g.K, nt = K / BK;
    unsigned voffA[2], voffB[2];
#pragma unroll
    for (int i = 0; i < 2; ++i) { int R, C; stage_rc(tid * 16 + i * 8192, R, C); const int Rb = Epi::PERM ? ((R & ~31) + perm32(R & 31)) : R;
        voffA[i] = (unsigned)(R * K + C) * 2u; voffB[i] = (unsigned)(Rb * K + C) * 2u; }
    const size_t kstep = (size_t)(BK * 2);
    const size_t hstep = (size_t)HALF * K * 2;
    const size_t tstep = 2 * hstep;
    const unsigned ldsw = (unsigned)wid * 1024u;
    const int aoff = lds_byte(wr * 64 + fr, fq * 8), boff = lds_byte(wc * 32 + fr, fq * 8);
#define PG8_SA(b, h) (((b) * 2 + (h)) * HTB)
#define PG8_SB(b, h) ((4 + (b) * 2 + (h)) * HTB)
#define PG8_STAGE(bufoff, gbase, voff) do { _Pragma("unroll") for (int _i = 0; _i < 2; ++_i) \
        __builtin_amdgcn_global_load_lds((const unsigned*)((const char*)(gbase) + (voff)[_i]), (PG8_LAS unsigned*)(lds + (bufoff) + ldsw + _i * 8192), 16, 0, 0); } while (0)
#define PG8_LDA(dst, b, h) do { _Pragma("unroll") for (int m = 0; m < 4; ++m) _Pragma("unroll") for (int k = 0; k < 2; ++k) dst[m][k] = *(const PG8_LAS bf16x8*)(lds + PG8_SA(b, h) + aoff + m * 2048 + k * 1024); } while (0)
#define PG8_LDB(dst, b, h) do { _Pragma("unroll") for (int n = 0; n < 2; ++n) _Pragma("unroll") for (int k = 0; k < 2; ++k) dst[n][k] = *(const PG8_LAS bf16x8*)(lds + PG8_SB(b, h) + boff + n * 2048 + k * 1024); } while (0)
#define PG8_MMA(ai, bj, At, Bt) do { __builtin_amdgcn_s_setprio(1); _Pragma("unroll") for (int m = 0; m < 4; ++m) _Pragma("unroll") for (int n = 0; n < 2; ++n) _Pragma("unroll") for (int k = 0; k < 2; ++k) \
        acc[ai][bj][m][n] = __builtin_amdgcn_mfma_f32_16x16x32_bf16(Bt[n][k], At[m][k], acc[ai][bj][m][n], 0, 0, 0); __builtin_amdgcn_s_setprio(0); } while (0)
#define PG8_WAIT_V(n) asm volatile("s_waitcnt vmcnt(" #n ")" ::: "memory")
#define PG8_WAIT_L(n) asm volatile("s_waitcnt lgkmcnt(" #n ")" ::: "memory")
#define PG8_BAR __builtin_amdgcn_s_barrier()
#define PG8_SCHED __builtin_amdgcn_sched_barrier(0)
    Unit cur, nxt; int ui = 0;
    if (!S.next(0, cur)) return;
    f32x4 acc[2][2][4][2];
#pragma unroll
    for (int a = 0; a < 2; ++a)
#pragma unroll
        for (int b = 0; b < 2; ++b)
#pragma unroll
            for (int m = 0; m < 4; ++m)
#pragma unroll
                for (int n = 0; n < 2; ++n) acc[a][b][m][n] = (f32x4){0.f, 0.f, 0.f, 0.f};
    bf16x8 At[4][2], B0[2][2], B1[2][2];
    const char* cA = (const char*)cur.A + (size_t)cur.pm * tstep; const char* cB = (const char*)cur.Bt + (size_t)cur.pn * tstep;
    S.a_ready(cur);
    if constexpr (SP2) {
        PG8_STAGE(PG8_SB(0, 0), cB, voffB); PG8_STAGE(PG8_SB(0, 1), cB + hstep, voffB); PG8_STAGE(PG8_SA(0, 0), cA, voffA); PG8_STAGE(PG8_SA(0, 1), cA + hstep, voffA);
        if (wr == 1) PG8_BAR;
        PG8_WAIT_V(2); PG8_BAR;
        PG8_STAGE(PG8_SB(1, 0), cB + kstep, voffB); PG8_STAGE(PG8_SA(1, 0), cA + kstep, voffA); PG8_STAGE(PG8_SB(1, 1), cB + hstep + kstep, voffB);
        PG8_WAIT_V(6); PG8_BAR;
    } else {
        PG8_STAGE(PG8_SB(0, 0), cB, voffB); PG8_STAGE(PG8_SA(0, 0), cA, voffA); PG8_STAGE(PG8_SB(0, 1), cB + hstep, voffB); PG8_STAGE(PG8_SA(0, 1), cA + hstep, voffA);
        if (wr == 1) PG8_BAR;
        PG8_WAIT_V(4); PG8_BAR;
        PG8_STAGE(PG8_SB(1, 0), cB + kstep, voffB); PG8_STAGE(PG8_SA(1, 0), cA + kstep, voffA); PG8_STAGE(PG8_SB(1, 1), cB + hstep + kstep, voffB);
        PG8_WAIT_V(6); PG8_BAR;
    }
    for (;;) {
        const bool has_next = S.next(ui + 1, nxt);
        const char* nA = has_next ? (const char*)nxt.A + (size_t)nxt.pm * tstep : cA; const char* nB = has_next ? (const char*)nxt.Bt + (size_t)nxt.pn * tstep : cB;
        for (int t = 0; t < nt; t += 2) {
            const bool last = (t == nt - 2);
            const char* a1 = cA + (size_t)(t + 1) * kstep;
            const char* a2 = last ? nA : cA + (size_t)(t + 2) * kstep; const char* b2 = last ? nB : cB + (size_t)(t + 2) * kstep;
            const char* a3 = a2 + kstep; const char* b3 = b2 + kstep;
            if (last && has_next) S.a_ready(nxt);
            if constexpr (SP2) {
            PG8_LDB(B0, 0, 0); PG8_LDB(B1, 0, 1); PG8_SCHED; PG8_LDA(At, 0, 0); PG8_STAGE(PG8_SA(1, 1), a1 + hstep, voffA);
            PG8_WAIT_V(8); PG8_WAIT_L(0); PG8_BAR; PG8_MMA(0, 0, At, B0); PG8_MMA(0, 1, At, B1); PG8_BAR; PG8_SCHED;
            PG8_LDA(At, 0, 1); PG8_STAGE(PG8_SB(0, 0), b2, voffB); PG8_STAGE(PG8_SB(0, 1), b2 + hstep, voffB); PG8_STAGE(PG8_SA(0, 0), a2, voffA);
            PG8_WAIT_V(8); PG8_WAIT_L(0); PG8_BAR; PG8_MMA(1, 0, At, B0); PG8_MMA(1, 1, At, B1); PG8_BAR; PG8_SCHED;
            PG8_LDB(B0, 1, 0); PG8_LDB(B1, 1, 1); PG8_SCHED; PG8_LDA(At, 1, 0); PG8_STAGE(PG8_SA(0, 1), a2 + hstep, voffA);
            PG8_WAIT_V(8); PG8_WAIT_L(0); PG8_BAR; PG8_MMA(0, 0, At, B0); PG8_MMA(0, 1, At, B1); PG8_BAR; PG8_SCHED;
            PG8_LDA(At, 1, 1); PG8_STAGE(PG8_SB(1, 0), b3, voffB); PG8_STAGE(PG8_SB(1, 1), b3 + hstep, voffB); PG8_STAGE(PG8_SA(1, 0), a3, voffA);
            PG8_WAIT_V(8); PG8_WAIT_L(0); PG8_BAR; PG8_MMA(1, 0, At, B0); PG8_MMA(1, 1, At, B1); PG8_BAR; PG8_SCHED;
            } else {
            PG8_LDB(B0, 0, 0); PG8_SCHED; PG8_LDA(At, 0, 0); PG8_STAGE(PG8_SA(1, 1), a1 + hstep, voffA);
            PG8_WAIT_L(8); PG8_BAR; PG8_WAIT_L(0); PG8_MMA(0, 0, At, B0); PG8_BAR; PG8_SCHED;
            PG8_LDB(B1, 0, 1); PG8_STAGE(PG8_SB(0, 0), b2, voffB);
            PG8_BAR; PG8_WAIT_L(0); PG8_MMA(0, 1, At, B1); PG8_BAR;
            PG8_LDA(At, 0, 1); PG8_STAGE(PG8_SA(0, 0), a2, voffA);
            PG8_BAR; PG8_WAIT_L(0); PG8_MMA(1, 0, At, B0); PG8_BAR; PG8_SCHED;
            PG8_STAGE(PG8_SB(0, 1), b2 + hstep, voffB);
            PG8_WAIT_V(6); PG8_BAR; PG8_MMA(1, 1, At, B1); PG8_BAR;
            PG8_LDB(B0, 1, 0); PG8_SCHED; PG8_LDA(At, 1, 0); PG8_STAGE(PG8_SA(0, 1), a2 + hstep, voffA);
            PG8_WAIT_L(8); PG8_BAR; PG8_WAIT_L(0); PG8_MMA(0, 0, At, B0); PG8_BAR; PG8_SCHED;
            PG8_LDB(B1, 1, 1); PG8_STAGE(PG8_SB(1, 0), b3, voffB);
            PG8_BAR; PG8_WAIT_L(0); PG8_MMA(0, 1, At, B1); PG8_BAR;
            PG8_LDA(At, 1, 1); PG8_STAGE(PG8_SA(1, 0), a3, voffA);
            PG8_BAR; PG8_WAIT_L(0); PG8_MMA(1, 0, At, B0); PG8_BAR; PG8_SCHED;
            PG8_STAGE(PG8_SB(1, 1), b3 + hstep, voffB);
            PG8_WAIT_V(6); PG8_BAR; PG8_MMA(1, 1, At, B1); PG8_BAR;
            }
        }
        if constexpr (ALIGN_EPI) { if (wr == 0) PG8_BAR; }
        if constexpr (!Epi::AFTER_DRAIN) { E(acc, cur, wr, wc, fr, fq); S.done(cur); }
        if (!has_next) break;
#pragma unroll
        for (int a = 0; a < 2; ++a)
#pragma unroll
            for (int b = 0; b < 2; ++b)
#pragma unroll
                for (int m = 0; m < 4; ++m)
#pragma unroll
                    for (int n = 0; n < 2; ++n) acc[a][b][m][n] = (f32x4){0.f, 0.f, 0.f, 0.f};
        cur = nxt; cA = nA; cB = nB; ++ui;
        if constexpr (ALIGN_EPI) { if (wr == 1) PG8_BAR; }
    }
    PG8_WAIT_V(0);
    if constexpr (!ALIGN_EPI) { if (wr == 0) PG8_BAR; }
    PG8_BAR;
    if constexpr (Epi::AFTER_DRAIN) { E.fused(acc, cur, wr, wc, fr, fq, lds, wid, lane); S.done(cur); }
#undef PG8_SA
#undef PG8_SB
#undef PG8_STAGE
#undef PG8_LDA
#undef PG8_LDB
#undef PG8_MMA
#undef PG8_WAIT_V
#undef PG8_WAIT_L
#undef PG8_BAR
#undef PG8_SCHED
}
}
#define XB_TMO      128
#define XB_XCNT(j)  (256  + 64 * (j))
#define XB_XSUB(j)  (1280 + 64 * (j))
#define XB_XGEN(j)  (2304 + 64 * (j))
#define XB_TOP      3328
#define XB_TOPGEN   3392
#define XCD_BAR_WORDS 3456
#define XB_SPIN_CAP (1u << 18)

__device__ __forceinline__ unsigned xb_ld(unsigned* p)              { return __hip_atomic_load(p, __ATOMIC_RELAXED, __HIP_MEMORY_SCOPE_AGENT); }
__device__ __forceinline__ unsigned xb_add(unsigned* p, unsigned v) { return __hip_atomic_fetch_add(p, v, __ATOMIC_RELAXED, __HIP_MEMORY_SCOPE_AGENT); }
__device__ __forceinline__ unsigned xb_xcc_id() { return (unsigned)__builtin_amdgcn_s_getreg((3 << 11) | 20) & 0xFu; }
#define XB_SPIN(cond, bar) do { unsigned _sp = 0; while (cond) { __builtin_amdgcn_s_sleep(1); \
    if ((++_sp & 255u) == 0u) { if (xb_ld(&(bar)[XB_TMO])) break; if (_sp > XB_SPIN_CAP) { atomicAdd(&(bar)[XB_TMO], 1u); break; } } } } while (0)

struct XcdBarrier {
    unsigned* bar; unsigned x;
    volatile LAS unsigned* st;
};

__device__ __forceinline__ XcdBarrier xcd_barrier_post(unsigned* bar, volatile LAS unsigned* st) {
    XcdBarrier b; b.bar = bar; b.x = xb_xcc_id(); b.st = st;
    if (threadIdx.x == 0) (void)xb_add(&bar[XB_XCNT(b.x)], 1u);
    return b;
}
__device__ __forceinline__ void xcd_barrier_complete(unsigned* bar, unsigned x, unsigned& nloc, unsigned& nx) {
    const unsigned G = gridDim.x * gridDim.y * gridDim.z;
    unsigned sum, cnt, mine, sp = 0u;
    for (;;) {
        sum = 0u; cnt = 0u; mine = 0u;
#pragma unroll
        for (unsigned j = 0; j < 16; ++j) { const unsigned c = xb_ld(&bar[XB_XCNT(j)]); sum += c; cnt += (c > 0u) ? 1u : 0u; mine = (j == x) ? c : mine; }
        if (sum == G) break;
        __builtin_amdgcn_s_sleep(1);
        if ((++sp & 255u) == 0u) { if (xb_ld(&bar[XB_TMO])) break; if (sp > XB_SPIN_CAP) { atomicAdd(&bar[XB_TMO], 1u); break; } }
    }
    nloc = mine > 0u ? mine : 1u; nx = cnt > 0u ? cnt : 1u;
}

__device__ __forceinline__ void xcd_barrier(const XcdBarrier& b) {
    asm volatile("s_waitcnt vmcnt(0)" ::: "memory");
    __syncthreads();
    if (threadIdx.x == 0) {
        unsigned* bar = b.bar;
        __builtin_amdgcn_s_waitcnt(0);
        unsigned nloc = b.st[0], nx = b.st[1];
        if (nloc == 0u) { xcd_barrier_complete(bar, b.x, nloc, nx); b.st[0] = nloc; b.st[1] = nx; }
        const unsigned old = xb_add(&bar[XB_XSUB(b.x)], 1u);
        const unsigned gen = old / nloc;
        if (old + 1u == (gen + 1u) * nloc) {
            __builtin_amdgcn_fence(__ATOMIC_RELEASE, "agent");
            asm volatile("s_waitcnt vmcnt(0)" ::: "memory");
            const unsigned og = xb_add(&bar[XB_TOP], 1u);
            const unsigned tg = og / nx;
            if (og + 1u == (tg + 1u) * nx) xb_add(&bar[XB_TOPGEN], 1u);
            else XB_SPIN(xb_ld(&bar[XB_TOPGEN]) == tg, bar);
            __builtin_amdgcn_fence(__ATOMIC_ACQUIRE, "agent");
            xb_add(&bar[XB_XGEN(b.x)], 1u);
            asm volatile("s_waitcnt vmcnt(0)" ::: "memory");
        } else {
            XB_SPIN(xb_ld(&bar[XB_XGEN(b.x)]) == gen, bar);
            __builtin_amdgcn_fence(__ATOMIC_ACQUIRE, "agent");
            asm volatile("s_waitcnt vmcnt(0)" ::: "memory");
        }
    }
    __syncthreads();
}


constexpr int NB = 8, SEQ = 2048, D = 1024, M = NB * SEQ, NL = 2, INW = 7168, NIN = 5120;
constexpr float EPS = 1e-6f;
#define LAS __attribute__((address_space(3)))
typedef unsigned short bf16_t;
typedef short bf16x8 __attribute__((ext_vector_type(8)));
typedef float f32x4 __attribute__((ext_vector_type(4)));
typedef float f32x2 __attribute__((ext_vector_type(2)));
typedef unsigned u32x4 __attribute__((ext_vector_type(4)));
typedef unsigned u32x2 __attribute__((ext_vector_type(2)));
typedef __bf16 bf2_t __attribute__((ext_vector_type(2)));
typedef _Float16 h2_t __attribute__((ext_vector_type(2)));

constexpr size_t MiB = 1u << 20;
constexpr size_t WS_ADA = 0;
constexpr size_t WS_LB = 256 * 1024;
constexpr size_t WS_POOLWT = 512 * 1024;
constexpr size_t WS_WIN = 1 * MiB;
constexpr size_t WS_WPO = 29 * MiB;
constexpr size_t WS_WHO = 31 * MiB;
constexpr size_t WS_WOUT = 35 * MiB;
constexpr size_t WS_H = 40 * MiB;
constexpr size_t WS_PV = 72 * MiB;
constexpr size_t WS_PG = 88 * MiB;
constexpr size_t WS_Q = 104 * MiB;
constexpr size_t WS_LF = 136 * MiB;
constexpr size_t WS_V = 168 * MiB;
constexpr size_t WS_HG = 200 * MiB;
constexpr size_t WS_P = 232 * MiB;
constexpr size_t WS_DEC = 248 * MiB;
constexpr size_t WS_BAR = 250 * MiB;
constexpr size_t WS_DSEG = 251 * MiB;
constexpr size_t WS_END = 253 * MiB;
constexpr int LDS_BYTES = 147456, LDS_BARW = 147392;

__device__ __forceinline__ unsigned pk_bf16(float lo, float hi) { bf2_t r = __builtin_convertvector((f32x2){lo, hi}, bf2_t); return __builtin_bit_cast(unsigned, r); }
__device__ __forceinline__ unsigned pk_f16(float lo, float hi) { h2_t r = __builtin_convertvector((f32x2){lo, hi}, h2_t); return __builtin_bit_cast(unsigned, r); }
__device__ __forceinline__ float bf_lo(unsigned w) { return __uint_as_float(w << 16); }
__device__ __forceinline__ float bf_hi(unsigned w) { return __uint_as_float(w & 0xffff0000u); }
__device__ __forceinline__ float h_lo(unsigned w) { h2_t r = __builtin_bit_cast(h2_t, w); return (float)r.x; }
__device__ __forceinline__ float h_hi(unsigned w) { h2_t r = __builtin_bit_cast(h2_t, w); return (float)r.y; }
__device__ __forceinline__ float sigmoid_f(float x) { return __builtin_amdgcn_rcpf(1.f + __expf(-x)); }
__device__ __forceinline__ float silu_f(float x) { return x * sigmoid_f(x); }
__device__ __forceinline__ float dpp_f(float v, const int ctrl_unused) { return v; }
#define DPP_ADD(v, ctrl) ((v) + __builtin_bit_cast(float, __builtin_amdgcn_update_dpp(0, __builtin_bit_cast(int, (v)), (ctrl), 0xf, 0xf, true)))
__device__ __forceinline__ float wave_sum(float v) {
    v = DPP_ADD(v, 0xB1);
    v = DPP_ADD(v, 0x4E);
    v = DPP_ADD(v, 0x124);
    v = DPP_ADD(v, 0x128);
    return (__builtin_amdgcn_readlane(v, 0) + __builtin_amdgcn_readlane(v, 16)) + (__builtin_amdgcn_readlane(v, 32) + __builtin_amdgcn_readlane(v, 48));
}
#define LBAR() do { asm volatile("s_waitcnt lgkmcnt(0)" ::: "memory"); __builtin_amdgcn_s_barrier(); asm volatile("" ::: "memory"); } while (0)
#define MFMA16(a, b, c) __builtin_amdgcn_mfma_f32_16x16x32_bf16((a), (b), (c), 0, 0, 0)

__device__ __forceinline__ void p0_transpose_item(const float* W, int K, int N, bf16_t* WT, LAS float* scr, int item, int lane) {
    const int nblk = N / 32, kb = item / nblk, nb = item % nblk, k0 = 64 * kb, n0 = 32 * nb;
#pragma unroll
    for (int i = 0; i < 32; ++i) { const int kk = 2 * i + (lane >> 5); scr[kk * 33 + (lane & 31)] = __builtin_nontemporal_load(W + (size_t)(k0 + kk) * N + n0 + (lane & 31)); }
    asm volatile("s_waitcnt lgkmcnt(0)" ::: "memory");
    const int c = lane & 7;
#pragma unroll
    for (int j = 0; j < 4; ++j) { const int n = (lane >> 3) + 8 * j; const LAS float* s = scr + (8 * c) * 33 + n;
        u32x4 o; o.x = pk_bf16(s[0 * 33], s[1 * 33]); o.y = pk_bf16(s[2 * 33], s[3 * 33]); o.z = pk_bf16(s[4 * 33], s[5 * 33]); o.w = pk_bf16(s[6 * 33], s[7 * 33]);
        *(u32x4*)(WT + (size_t)(n0 + n) * K + k0 + 8 * c) = o; }
    asm volatile("s_waitcnt lgkmcnt(0)" ::: "memory");
}

struct Params {
    const float *x, *c, *w_ada, *b_ada, *g_pre, *g_post, *w_in, *pool_w, *pool_scale, *lb_logits, *hgrn_norm_g, *w_pool_o, *w_hgrn_o, *w_out;
    float* out; unsigned char* ws;
};

__device__ __forceinline__ void p0_prologue(const Params& p, LAS unsigned char* lds) {
    const int tid = threadIdx.x, lane = tid & 63, wave = tid >> 6, blk = blockIdx.x, G = gridDim.x;
    float* ADA = (float*)(p.ws + WS_ADA);
    LAS float* cact = (LAS float*)(lds + 73728);
    LAS float* red = (LAS float*)(lds + 73728 + 32768);
    for (int job = blk; job < 192; job += G) {
        for (int i = tid; i < NB * D; i += 512) cact[i] = silu_f(p.c[i]);
        __syncthreads();
        const int l = job / 96, j0 = (job % 96) * 32, j = tid & 31, ks = tid >> 5;
        const float* w = p.w_ada + ((size_t)l * D + ks * 64) * 3072 + j0 + j;
        float a0 = 0.f, a1 = 0.f, a2 = 0.f, a3 = 0.f, a4 = 0.f, a5 = 0.f, a6 = 0.f, a7 = 0.f;
#pragma unroll 32
        for (int d = 0; d < 64; ++d) { const float wv = __builtin_nontemporal_load(w + (size_t)d * 3072); const LAS float* cc = cact + ks * 64 + d;
            a0 += cc[0] * wv; a1 += cc[1024] * wv; a2 += cc[2048] * wv; a3 += cc[3072] * wv; a4 += cc[4096] * wv; a5 += cc[5120] * wv; a6 += cc[6144] * wv; a7 += cc[7168] * wv; }
        LAS float* rr = red + (ks * 8) * 32 + j;
        rr[0] = a0; rr[32] = a1; rr[64] = a2; rr[96] = a3; rr[128] = a4; rr[160] = a5; rr[192] = a6; rr[224] = a7;
        __syncthreads();
        if (tid < 256) { const int b = tid >> 5; float s = p.b_ada[l * 3072 + j0 + j];
#pragma unroll
            for (int k2 = 0; k2 < 16; ++k2) s += red[(k2 * 8 + b) * 32 + j];
            ADA[(size_t)(l * NB + b) * 3072 + j0 + j] = s; }
        __syncthreads();
    }
    if (blk == G - 1) { float* LB = (float*)(p.ws + WS_LB);
        for (int j = tid; j < 1024; j += 512) { const float l0 = p.lb_logits[j], l1 = p.lb_logits[1024 + j], mx = fmaxf(l0, l1), e0 = __expf(l0 - mx), e1 = __expf(l1 - mx);
            const float p0 = e0 / (e0 + e1), p1 = e1 / (e0 + e1); const float c1 = (p0 + p1) - p0;
            LB[j] = 0.f; LB[1024 + j] = fminf(fmaxf(c1, 0.f), 1.f); } }
    LAS float* scr = (LAS float*)(lds + wave * 8448);
    constexpr int I_IN = (D / 64) * (INW / 32), I_PO = (512 / 64) * (D / 32), I_HO = (D / 64) * (D / 32), I_OUT = I_HO, I_PW = 4 * 8, I_LAYER = I_IN + I_PO + I_HO + I_OUT + I_PW;
    bf16_t* WinT = (bf16_t*)(p.ws + WS_WIN); bf16_t* WpoT = (bf16_t*)(p.ws + WS_WPO); bf16_t* WhoT = (bf16_t*)(p.ws + WS_WHO); bf16_t* WoutT = (bf16_t*)(p.ws + WS_WOUT); bf16_t* PoolWT = (bf16_t*)(p.ws + WS_POOLWT);
    for (int it = blk * 8 + wave; it < NL * I_LAYER; it += G * 8) {
        int r = it; const int l = r / I_LAYER; r -= l * I_LAYER;
        if (r < I_IN) { p0_transpose_item(p.w_in + (size_t)l * D * INW, D, INW, WinT + (size_t)l * INW * D, scr, r, lane); continue; } r -= I_IN;
        if (r < I_PO) { p0_transpose_item(p.w_pool_o + (size_t)l * 512 * D, 512, D, WpoT + (size_t)l * D * 512, scr, r, lane); continue; } r -= I_PO;
        if (r < I_HO) { p0_transpose_item(p.w_hgrn_o + (size_t)l * D * D, D, D, WhoT + (size_t)l * D * D, scr, r, lane); continue; } r -= I_HO;
        if (r < I_OUT) { p0_transpose_item(p.w_out + (size_t)l * D * D, D, D, WoutT + (size_t)l * D * D, scr, r, lane); continue; } r -= I_OUT;
        { const int g = r >> 3; r &= 7; p0_transpose_item(p.pool_w + (size_t)(l * 4 + g) * 16384, 128, 128, PoolWT + (size_t)(l * 4 + g) * 16384, scr, r, lane); }
    }
}

template <bool HAS_PREV, bool MAKE_H>
__device__ __forceinline__ void p1_rows(const float* xprev, const bf16_t* Y, const float* ada_prev, const float* gpost, float* xout, const float* gpre, const float* ada_cur, bf16_t* H) {
    int tid_l = threadIdx.x; asm volatile("" : "+v"(tid_l));
    const int lane = tid_l & 63, wave = tid_l >> 6;
    const int NW = gridDim.x * 8, rpw = (M + NW - 1) / NW, gw = blockIdx.x * 8 + wave;
    const int mbeg = gw * rpw, mend = (mbeg + rpw < M) ? mbeg + rpw : M;
    if (mbeg >= mend) return;
    f32x4 ga[4], hm[4], hs[4];
    int bcur = -1;
    f32x4 vn[4]; u32x2 yn[4];
#pragma unroll
    for (int j = 0; j < 4; ++j) { vn[j] = __builtin_nontemporal_load((const f32x4*)(xprev + (size_t)mbeg * D) + lane + 64 * j); if (HAS_PREV) yn[j] = ((const u32x2*)(Y + (size_t)mbeg * D) + lane)[64 * j]; else yn[j] = (u32x2){0u, 0u}; }
    for (int m = mbeg; m < mend; ++m) {
        const int b = m >> 11;
        if (b != bcur) { bcur = b;
#pragma unroll
            for (int j = 0; j < 4; ++j) {
                if (HAS_PREV) ga[j] = ((const f32x4*)(ada_prev + (size_t)b * 3072 + 2048) + lane)[64 * j] * ((const f32x4*)gpost + lane)[64 * j]; else ga[j] = (f32x4){0.f, 0.f, 0.f, 0.f};
                if (MAKE_H) { hm[j] = ((const f32x4*)gpre + lane)[64 * j] * (((const f32x4*)(ada_cur + (size_t)b * 3072 + 1024) + lane)[64 * j] + 1.f); hs[j] = ((const f32x4*)(ada_cur + (size_t)b * 3072) + lane)[64 * j]; }
                else { hm[j] = (f32x4){0.f, 0.f, 0.f, 0.f}; hs[j] = hm[j]; } } }
        f32x4 v[4]; u32x2 yw[4];
#pragma unroll
        for (int j = 0; j < 4; ++j) { v[j] = vn[j]; yw[j] = yn[j]; }
        { const int mn = (m + 1 < mend) ? m + 1 : m;
#pragma unroll
          for (int j = 0; j < 4; ++j) { vn[j] = __builtin_nontemporal_load((const f32x4*)(xprev + (size_t)mn * D) + lane + 64 * j); if (HAS_PREV) yn[j] = ((const u32x2*)(Y + (size_t)mn * D) + lane)[64 * j]; } }
        if (HAS_PREV) {
            f32x4 y[4]; float ss = 0.f;
#pragma unroll
            for (int j = 0; j < 4; ++j) { y[j] = (f32x4){bf_lo(yw[j].x), bf_hi(yw[j].x), bf_lo(yw[j].y), bf_hi(yw[j].y)}; ss += (y[j].x * y[j].x + y[j].y * y[j].y) + (y[j].z * y[j].z + y[j].w * y[j].w); }
            const float rstd = rsqrtf(wave_sum(ss) * (1.f / D) + EPS);
            f32x4* xo = (f32x4*)(xout + (size_t)m * D) + lane;
#pragma unroll
            for (int j = 0; j < 4; ++j) { v[j] = v[j] + ga[j] * (y[j] * rstd); __builtin_nontemporal_store(v[j], xo + 64 * j); }
        }
        if (MAKE_H) {
            float ss = 0.f;
#pragma unroll
            for (int j = 0; j < 4; ++j) ss += (v[j].x * v[j].x + v[j].y * v[j].y) + (v[j].z * v[j].z + v[j].w * v[j].w);
            const float rstd = rsqrtf(wave_sum(ss) * (1.f / D) + EPS);
            u32x2* ho = (u32x2*)(H + (size_t)m * D) + lane;
#pragma unroll
            for (int j = 0; j < 4; ++j) { const f32x4 hv = (v[j] * rstd) * hm[j] + hs[j]; u32x2 w; w.x = pk_bf16(hv.x, hv.y); w.y = pk_bf16(hv.z, hv.w); ho[64 * j] = w; }
        }
    }
}

struct EpiU {
    static constexpr bool PERM = true, AFTER_DRAIN = false;
    unsigned char* ws;
    __device__ __forceinline__ void operator()(const f32x4 (&acc)[2][2][4][2], const pg8::Unit& u, int wr, int wc, int fr, int fq) const {
        const int pn = u.pn, mode = u.mode; const int row0 = u.pm * 256 + wr * 64 + fr;
        size_t boff; int ld = 1024, colt = pn * 256, op;
        if (mode == 0) {
            if (pn < 2) { boff = WS_PV; ld = 512; op = 0; }
            else if (pn < 4) { boff = WS_PG; ld = 512; colt = (pn - 2) * 256; op = 0; }
            else if (pn < 8) { boff = WS_Q; colt = (pn - 4) * 256; op = 0; }
            else if (pn < 12) { boff = WS_LF; colt = (pn - 8) * 256; op = 2; }
            else if (pn < 16) { boff = WS_V; colt = (pn - 12) * 256; op = 0; }
            else { boff = WS_HG; colt = (pn - 16) * 256; op = 0; }
        } else if (mode == 1) { boff = (pn < 4) ? WS_Q : WS_V; colt = (pn & 3) * 256; op = 3; }
        else if (mode == 2) { boff = WS_LF; op = 4; }
        else if (mode == 3) { boff = WS_LF; op = 5; }
        else { boff = WS_V; op = 0; }
        bf16_t* base = (bf16_t*)(ws + boff); const bf16_t* Gp = (const bf16_t*)(ws + (mode == 2 ? WS_V : WS_Q));
        const int col0 = colt + wc * 32 + 8 * fq;
#pragma unroll
        for (int ai = 0; ai < 2; ++ai) {
            u32x4 gq[4][2], tq[4][2];
#pragma unroll
            for (int m = 0; m < 4; ++m)
#pragma unroll
                for (int bj = 0; bj < 2; ++bj) { gq[m][bj] = (u32x4){0u, 0u, 0u, 0u}; tq[m][bj] = gq[m][bj]; }
            if (op >= 4) {
#pragma unroll
                for (int m = 0; m < 4; ++m)
#pragma unroll
                    for (int bj = 0; bj < 2; ++bj) gq[m][bj] = *(const u32x4*)(Gp + (size_t)(row0 + ai * 128 + m * 16) * ld + col0 + bj * 128);
                if (op == 5) {
#pragma unroll
                    for (int m = 0; m < 4; ++m)
#pragma unroll
                        for (int bj = 0; bj < 2; ++bj) tq[m][bj] = *(const u32x4*)(base + (size_t)(row0 + ai * 128 + m * 16) * ld + col0 + bj * 128); }
            }
            asm volatile("" ::: "memory");
#pragma unroll
            for (int m = 0; m < 4; ++m) { const size_t off = (size_t)(row0 + ai * 128 + m * 16) * ld + col0;
#pragma unroll
                for (int bj = 0; bj < 2; ++bj) { f32x4 v0 = acc[ai][bj][m][0], v1 = acc[ai][bj][m][1];
                    if (op == 1) {
#pragma unroll
                        for (int j = 0; j < 4; ++j) { v0[j] = silu_f(v0[j]); v1[j] = silu_f(v1[j]); }
                    } else if (op == 3) {
#pragma unroll
                        for (int j = 0; j < 4; ++j) { v0[j] = sigmoid_f(v0[j]); v1[j] = sigmoid_f(v1[j]); }
                    } else if (op >= 4) { const u32x4 g = gq[m][bj];
                        v0 = v0 * (f32x4){bf_lo(g.x), bf_hi(g.x), bf_lo(g.y), bf_hi(g.y)}; v1 = v1 * (f32x4){bf_lo(g.z), bf_hi(g.z), bf_lo(g.w), bf_hi(g.w)};
                        if (op == 5) { const u32x4 t = tq[m][bj];
                            v0 = v0 + (f32x4){bf_lo(t.x), bf_hi(t.x), bf_lo(t.y), bf_hi(t.y)}; v1 = v1 + (f32x4){bf_lo(t.z), bf_hi(t.z), bf_lo(t.w), bf_hi(t.w)}; } }
                    u32x4 w;
                    if (op == 2) { w.x = pk_f16(v0[0], v0[1]); w.y = pk_f16(v0[2], v0[3]); w.z = pk_f16(v1[0], v1[1]); w.w = pk_f16(v1[2], v1[3]); }
                    else { w.x = pk_bf16(v0[0], v0[1]); w.y = pk_bf16(v0[2], v0[3]); w.z = pk_bf16(v1[0], v1[1]); w.w = pk_bf16(v1[2], v1[3]); }
                    *(u32x4*)(base + off + bj * 128) = w; } }
        }
    }
};

constexpr int AP_STRIDE = 136;
template <int W>
__device__ __forceinline__ void pool_item(const bf16_t* PV, bf16_t* PG, const bf16_t* PoolWT_g, const float* pscale_g, int m0, int g, LAS unsigned char* lds) {
    int tid_l = threadIdx.x; asm volatile("" : "+v"(tid_l));
    const int tid = tid_l, lane = tid & 63, wv = tid >> 6, r = lane & 15, q = lane >> 4;
    const int pos0 = (m0 & (SEQ - 1)) + wv * 8;
    const bf16_t* src = PV + (size_t)(m0 + wv * 8) * 512 + g * 128 + 2 * lane;
    float r0[W + 7], r1[W + 7];
#pragma unroll
    for (int i = 0; i < W + 7; ++i) { const int pp = pos0 - (W - 1) + i; unsigned w = 0u; if (pp >= 0) w = *(const unsigned*)(src + (ptrdiff_t)(i - (W - 1)) * 512); r0[i] = bf_lo(w); r1[i] = bf_hi(w); }
    bf16x8 wf[4]; u32x2 gw[4];
#pragma unroll
    for (int ks = 0; ks < 4; ++ks) wf[ks] = *(const bf16x8*)(PoolWT_g + (16 * wv + r) * 128 + ks * 32 + q * 8);
#pragma unroll
    for (int mt = 0; mt < 4; ++mt) gw[mt] = *(const u32x2*)(PG + (size_t)(m0 + mt * 16 + r) * 512 + g * 128 + 16 * wv + q * 4);
    const f32x4 sc = *(const f32x4*)(pscale_g + 16 * wv + q * 4);
    float s0 = 0.f, s1 = 0.f;
#pragma unroll
    for (int i = 0; i < W - 1; ++i) { s0 += r0[i]; s1 += r1[i]; }
    LAS bf16_t* AP = (LAS bf16_t*)lds;
    __syncthreads();
#pragma unroll
    for (int i = 0; i < 8; ++i) { s0 += r0[W - 1 + i]; s1 += r1[W - 1 + i];
        const int pos = pos0 + i; const float inv = 1.f / (float)(pos + 1 < W ? pos + 1 : W);
        *(LAS unsigned*)(AP + (wv * 8 + i) * AP_STRIDE + 2 * lane) = pk_bf16(s0 * inv - r0[W - 1 + i], s1 * inv - r1[W - 1 + i]);
        s0 -= r0[i]; s1 -= r1[i]; }
    __syncthreads();
    f32x4 o[4];
#pragma unroll
    for (int mt = 0; mt < 4; ++mt) o[mt] = (f32x4){0.f, 0.f, 0.f, 0.f};
    bf16x8 af[16];
#pragma unroll
    for (int ks = 0; ks < 4; ++ks)
#pragma unroll
        for (int mt = 0; mt < 4; ++mt) af[ks * 4 + mt] = *(const LAS bf16x8*)(AP + (mt * 16 + r) * AP_STRIDE + ks * 32 + q * 8);
    __builtin_amdgcn_sched_barrier(0);
#pragma unroll
    for (int ks = 0; ks < 4; ++ks)
#pragma unroll
        for (int mt = 0; mt < 4; ++mt) o[mt] = MFMA16(wf[ks], af[ks * 4 + mt], o[mt]);
#pragma unroll
    for (int mt = 0; mt < 4; ++mt) { bf16_t* pp = PG + (size_t)(m0 + mt * 16 + r) * 512 + g * 128 + 16 * wv + q * 4;
        const f32x4 ov = o[mt] * sc * (f32x4){silu_f(bf_lo(gw[mt].x)), silu_f(bf_hi(gw[mt].x)), silu_f(bf_lo(gw[mt].y)), silu_f(bf_hi(gw[mt].y))};
        u32x2 w; w.x = pk_bf16(ov.x, ov.y); w.y = pk_bf16(ov.z, ov.w); *(u32x2*)pp = w; }
}

template <int W>
__device__ __forceinline__ void pool_tiles(const bf16_t* PV, bf16_t* PG, const bf16_t* PoolWT_g, const float* pscale_g, int g, int T0, int Tstep, LAS unsigned char* lds) {
    int tid_l = threadIdx.x; asm volatile("" : "+v"(tid_l));
    const int tid = tid_l, lane = tid & 63, wv = tid >> 6, r = lane & 15, q = lane >> 4;
    constexpr int NT = M / 64;
    if (T0 >= NT) return;
    bf16x8 wf[4];
#pragma unroll
    for (int ks = 0; ks < 4; ++ks) wf[ks] = *(const bf16x8*)(PoolWT_g + (16 * wv + r) * 128 + ks * 32 + q * 8);
    const f32x4 sc = *(const f32x4*)(pscale_g + 16 * wv + q * 4);
    unsigned raw[W + 7]; u32x2 gw[4];
    { const int m0 = T0 * 64, pos0 = (m0 & (SEQ - 1)) + wv * 8; const bf16_t* src = PV + (size_t)(m0 + wv * 8) * 512 + g * 128 + 2 * lane;
#pragma unroll
      for (int i = 0; i < W + 7; ++i) { raw[i] = 0u; if (pos0 - (W - 1) + i >= 0) raw[i] = *(const unsigned*)(src + (ptrdiff_t)(i - (W - 1)) * 512); }
#pragma unroll
      for (int mt = 0; mt < 4; ++mt) gw[mt] = *(const u32x2*)(PG + (size_t)(m0 + mt * 16 + r) * 512 + g * 128 + 16 * wv + q * 4); }
    LAS bf16_t* AP = (LAS bf16_t*)lds;
#pragma unroll 1
    for (int T = T0; T < NT; T += Tstep) {
        const int m0 = T * 64, pos0 = (m0 & (SEQ - 1)) + wv * 8;
        float r0[W + 7], r1[W + 7]; u32x2 gc[4];
#pragma unroll
        for (int i = 0; i < W + 7; ++i) { r0[i] = bf_lo(raw[i]); r1[i] = bf_hi(raw[i]); }
#pragma unroll
        for (int mt = 0; mt < 4; ++mt) gc[mt] = gw[mt];
        { const int Tn = (T + Tstep < NT) ? T + Tstep : T; const int mn = Tn * 64, posn = (mn & (SEQ - 1)) + wv * 8; const bf16_t* src = PV + (size_t)(mn + wv * 8) * 512 + g * 128 + 2 * lane;
#pragma unroll
          for (int i = 0; i < W + 7; ++i) { raw[i] = 0u; if (posn - (W - 1) + i >= 0) raw[i] = *(const unsigned*)(src + (ptrdiff_t)(i - (W - 1)) * 512); }
#pragma unroll
          for (int mt = 0; mt < 4; ++mt) gw[mt] = *(const u32x2*)(PG + (size_t)(mn + mt * 16 + r) * 512 + g * 128 + 16 * wv + q * 4); }
        float s0 = 0.f, s1 = 0.f;
#pragma unroll
        for (int i = 0; i < W - 1; ++i) { s0 += r0[i]; s1 += r1[i]; }
        LBAR();
#pragma unroll
        for (int i = 0; i < 8; ++i) { s0 += r0[W - 1 + i]; s1 += r1[W - 1 + i];
            const int pos = pos0 + i; const float inv = 1.f / (float)(pos + 1 < W ? pos + 1 : W);
            *(LAS unsigned*)(AP + (wv * 8 + i) * AP_STRIDE + 2 * lane) = pk_bf16(s0 * inv - r0[W - 1 + i], s1 * inv - r1[W - 1 + i]);
            s0 -= r0[i]; s1 -= r1[i]; }
        LBAR();
        f32x4 o[4];
#pragma unroll
        for (int mt = 0; mt < 4; ++mt) o[mt] = (f32x4){0.f, 0.f, 0.f, 0.f};
        bf16x8 af[16];
#pragma unroll
        for (int ks = 0; ks < 4; ++ks)
#pragma unroll
            for (int mt = 0; mt < 4; ++mt) af[ks * 4 + mt] = *(const LAS bf16x8*)(AP + (mt * 16 + r) * AP_STRIDE + ks * 32 + q * 8);
        __builtin_amdgcn_sched_barrier(0);
#pragma unroll
        for (int ks = 0; ks < 4; ++ks)
#pragma unroll
            for (int mt = 0; mt < 4; ++mt) o[mt] = MFMA16(wf[ks], af[ks * 4 + mt], o[mt]);
#pragma unroll
        for (int mt = 0; mt < 4; ++mt) { bf16_t* pp = PG + (size_t)(m0 + mt * 16 + r) * 512 + g * 128 + 16 * wv + q * 4;
            const f32x4 ov = o[mt] * sc * (f32x4){silu_f(bf_lo(gc[mt].x)), silu_f(bf_hi(gc[mt].x)), silu_f(bf_lo(gc[mt].y)), silu_f(bf_hi(gc[mt].y))};
            u32x2 w; w.x = pk_bf16(ov.x, ov.y); w.y = pk_bf16(ov.z, ov.w); *(u32x2*)pp = w; }
    }
    __syncthreads();
}

constexpr int HQ_STR = 136, HK_STR = 72;
__device__ __forceinline__ void prep_items(bf16_t* Qg, bf16_t* LFg, bf16_t* Pg, float* DECg, const float* lbl, int first, int step, int total, LAS unsigned char* lds) {
    int tid_l = threadIdx.x; asm volatile("" : "+v"(tid_l));
    const int tid = tid_l, lane = tid & 63, wv = __builtin_amdgcn_readfirstlane(tid >> 6), r = lane & 15, q = lane >> 4;
    LAS bf16_t* QT = (LAS bf16_t*)(lds); LAS bf16_t* KT = (LAS bf16_t*)(lds + 17408); LAS float* TOT = (LAS float*)(lds + 34816);
    unsigned q2[8], lf2[8], qn[8], lfn[8];
    if (first < total) { const int bh = first >> 5, n = first & 31; const size_t rb = ((size_t)(bh >> 3) * SEQ + n * 64 + wv * 8) * 1024 + (size_t)(bh & 7) * 128 + 2 * lane;
#pragma unroll
        for (int i = 0; i < 8; ++i) { qn[i] = *(const unsigned*)(Qg + rb + (size_t)i * 1024); lfn[i] = *(const unsigned*)(LFg + rb + (size_t)i * 1024); } }
#pragma unroll 1
    for (int item = first; item < total; item += step) {
        const int bh = item >> 5, n = item & 31;
        const size_t rb = ((size_t)(bh >> 3) * SEQ + n * 64 + wv * 8) * 1024 + (size_t)(bh & 7) * 128 + 2 * lane;
#pragma unroll
        for (int i = 0; i < 8; ++i) { q2[i] = qn[i]; lf2[i] = lfn[i]; }
        const f32x2 lbp = *(const f32x2*)(lbl + (bh & 7) * 128 + 2 * lane); const float lb0 = lbp.x, lb1 = lbp.y;
        { const int inext = (item + step < total) ? item + step : item; const int bh2 = inext >> 5, n2 = inext & 31; const size_t rb2 = ((size_t)(bh2 >> 3) * SEQ + n2 * 64 + wv * 8) * 1024 + (size_t)(bh2 & 7) * 128 + 2 * lane;
#pragma unroll
            for (int i = 0; i < 8; ++i) { qn[i] = *(const unsigned*)(Qg + rb2 + (size_t)i * 1024); lfn[i] = *(const unsigned*)(LFg + rb2 + (size_t)i * 1024); } }
        float f0[8], f1[8]; float run0 = 0.f, run1 = 0.f;
#pragma unroll
        for (int i = 0; i < 8; ++i) { const float z0 = h_lo(lf2[i]), z1 = h_hi(lf2[i]);
            f0[i] = fmaxf(lb0 + (1.f - lb0) * sigmoid_f(z0), 1e-30f); f1[i] = fmaxf(lb1 + (1.f - lb1) * sigmoid_f(z1), 1e-30f); run0 += __logf(f0[i]); run1 += __logf(f1[i]); }
        *(LAS f32x2*)(TOT + wv * 128 + 2 * lane) = (f32x2){run0, run1};
        LBAR();
        float pre0 = 0.f, pre1 = 0.f, last0 = 0.f, last1 = 0.f;
#pragma unroll
        for (int w = 0; w < 8; ++w) { const f32x2 t = *(const LAS f32x2*)(TOT + w * 128 + 2 * lane); last0 += t.x; last1 += t.y; if (w < wv) { pre0 += t.x; pre1 += t.y; } }
        if (wv == 0) *(f32x2*)(DECg + (size_t)item * 128 + 2 * lane) = (f32x2){__expf(last0), __expf(last1)};
        const float sc0 = __expf(fminf(-0.5f * last0, 60.f)), sc1 = __expf(fminf(-0.5f * last1, 60.f));
        float pf0 = __expf(pre0), pf1 = __expf(pre1), sf0 = __expf(last0 - pre0 - run0), sf1 = __expf(last1 - pre1 - run1);
        float kh0[8], kh1[8];
#pragma unroll
        for (int i = 7; i >= 0; --i) { kh0[i] = (1.f - f0[i]) * sf0; kh1[i] = (1.f - f1[i]) * sf1; sf0 *= f0[i]; sf1 *= f1[i]; }
#pragma unroll
        for (int i = 0; i < 8; ++i) { pf0 *= f0[i]; pf1 *= f1[i];
            const float qh0 = silu_f(bf_lo(q2[i])) * pf0, qh1 = silu_f(bf_hi(q2[i])) * pf1; const int t = wv * 8 + i;
            *(unsigned*)(Qg + rb + (size_t)i * 1024) = pk_bf16(qh0, qh1);
            *(unsigned*)(LFg + rb + (size_t)i * 1024) = pk_bf16(kh0[i], kh1[i]);
            *(LAS unsigned*)(QT + t * HQ_STR + 2 * lane) = pk_bf16(qh0 * sc0, qh1 * sc1);
            *(LAS unsigned*)(KT + t * HQ_STR + 2 * lane) = pk_bf16(kh0[i] * sc0, kh1[i] * sc1); }
        LBAR();
        const int ti = wv >> 1;
        { bf16x8 qf[4], kf[2][4];
#pragma unroll
          for (int ks = 0; ks < 4; ++ks) { qf[ks] = *(const LAS bf16x8*)(QT + (ti * 16 + r) * HQ_STR + ks * 32 + q * 8);
              kf[0][ks] = *(const LAS bf16x8*)(KT + ((2 * (wv & 1)) * 16 + r) * HQ_STR + ks * 32 + q * 8); kf[1][ks] = *(const LAS bf16x8*)(KT + ((2 * (wv & 1) + 1) * 16 + r) * HQ_STR + ks * 32 + q * 8); }
          __builtin_amdgcn_sched_barrier(0);
#pragma unroll
          for (int jj = 0; jj < 2; ++jj) { const int tj = 2 * (wv & 1) + jj; f32x4 sc = (f32x4){0.f, 0.f, 0.f, 0.f};
              if (tj <= ti) {
#pragma unroll
                  for (int ks = 0; ks < 4; ++ks) sc = MFMA16(kf[jj][ks], qf[ks], sc); }
              const int t = ti * 16 + r, s0 = tj * 16 + q * 4;
#pragma unroll
              for (int j = 0; j < 4; ++j) sc[j] = (s0 + j <= t) ? sc[j] : 0.f;
              u32x2 w; w.x = pk_bf16(sc[0], sc[1]); w.y = pk_bf16(sc[2], sc[3]);
              *(u32x2*)(Pg + (size_t)item * 4096 + t * 64 + s0) = w; } }
    }
    __syncthreads();
}

constexpr int SB_QH = 0, SB_KHT = 17408, SB_VT = 35840, SB_P = 54272, SB_DEC = 63488, SB_SSQ = 64000, SB_SIZE = 66048;
struct ScanRegs { unsigned q2[8], k2[8], v2[8]; u32x4 pr; f32x4 dc; u32x2 hg[4]; f32x4 o[4]; };
__device__ __forceinline__ void scan_load(ScanRegs& R, const bf16_t* Qg, const bf16_t* Kg, const bf16_t* Vg, const bf16_t* Pg, const float* DECg, int bh, int n, size_t mb, size_t cb, int tid, int lane, int wv) {
    R.pr = *(const u32x4*)(Pg + (size_t)(bh * 32 + n) * 4096 + tid * 8);
    R.dc = *(const f32x4*)(DECg + (size_t)(bh * 32 + n) * 128 + (tid & 31) * 4);
    const size_t rb = (mb + (size_t)n * 64 + wv * 8) * 1024 + cb + 2 * lane;
#pragma unroll
    for (int i = 0; i < 8; ++i) { R.q2[i] = *(const unsigned*)(Qg + rb + (size_t)i * 1024); R.k2[i] = *(const unsigned*)(Kg + rb + (size_t)i * 1024); R.v2[i] = *(const unsigned*)(Vg + rb + (size_t)i * 1024); }
    asm volatile("" ::: "memory");
}
__device__ __forceinline__ void scan_chunk(ScanRegs& X, ScanRegs& Y, f32x4 (&S)[8], const f32x4 g4, int n, const bf16_t* Qg, const bf16_t* Kg, const bf16_t* Vg, const bf16_t* Pg, const float* DECg, bf16_t* HGg,
                                           int bh, size_t mb, size_t cb, int tid, int lane, int wv, int r, int q, LAS unsigned char* lds, bool dry) {
    constexpr int NCH = SEQ / 64;
    LAS unsigned char* B = lds + (n & 1) * SB_SIZE;
    const size_t m0 = mb + (size_t)n * 64;
    if (n < NCH) {
        LAS bf16_t* QH = (LAS bf16_t*)(B + SB_QH); LAS bf16_t* KHT = (LAS bf16_t*)(B + SB_KHT); LAS bf16_t* VT = (LAS bf16_t*)(B + SB_VT); LAS bf16_t* Pm = (LAS bf16_t*)(B + SB_P);
#pragma unroll
        for (int i = 0; i < 8; ++i) *(LAS unsigned*)(QH + (wv * 8 + i) * HQ_STR + 2 * lane) = X.q2[i];
        { u32x4 lo, hi; const unsigned* k2 = X.k2;
          lo.x = (k2[0] & 0xffffu) | (k2[1] << 16); lo.y = (k2[2] & 0xffffu) | (k2[3] << 16); lo.z = (k2[4] & 0xffffu) | (k2[5] << 16); lo.w = (k2[6] & 0xffffu) | (k2[7] << 16);
          hi.x = (k2[0] >> 16) | (k2[1] & 0xffff0000u); hi.y = (k2[2] >> 16) | (k2[3] & 0xffff0000u); hi.z = (k2[4] >> 16) | (k2[5] & 0xffff0000u); hi.w = (k2[6] >> 16) | (k2[7] & 0xffff0000u);
          *(LAS u32x4*)(KHT + (2 * lane) * HK_STR + wv * 8) = lo; *(LAS u32x4*)(KHT + (2 * lane + 1) * HK_STR + wv * 8) = hi; }
        { u32x4 lo, hi; const unsigned* v2 = X.v2;
          lo.x = (v2[0] & 0xffffu) | (v2[1] << 16); lo.y = (v2[2] & 0xffffu) | (v2[3] << 16); lo.z = (v2[4] & 0xffffu) | (v2[5] << 16); lo.w = (v2[6] & 0xffffu) | (v2[7] << 16);
          hi.x = (v2[0] >> 16) | (v2[1] & 0xffff0000u); hi.y = (v2[2] >> 16) | (v2[3] & 0xffff0000u); hi.z = (v2[4] >> 16) | (v2[5] & 0xffff0000u); hi.w = (v2[6] >> 16) | (v2[7] & 0xffff0000u);
          *(LAS u32x4*)(VT + (2 * lane) * HK_STR + wv * 8) = lo; *(LAS u32x4*)(VT + (2 * lane + 1) * HK_STR + wv * 8) = hi; }
        *(LAS u32x4*)(Pm + (tid >> 3) * HK_STR + (tid & 7) * 8) = X.pr;
        if (tid < 32) *(LAS f32x4*)((LAS float*)(B + SB_DEC) + tid * 4) = X.dc;
#pragma unroll
        for (int mt = 0; mt < 4; ++mt) X.hg[mt] = *(const u32x2*)(HGg + (m0 + mt * 16 + r) * 1024 + cb + 16 * wv + q * 4);
        scan_load(X, Qg, Kg, Vg, Pg, DECg, bh, (n + 2 < NCH) ? n + 2 : NCH - 1, mb, cb, tid, lane, wv);
    }
    LBAR();
    {
        const LAS float* SSQ = (const LAS float*)(lds + ((n - 1) & 1) * SB_SIZE + SB_SSQ);
#pragma unroll
        for (int mt = 0; mt < 4; ++mt) { float tot = 0.f;
#pragma unroll
            for (int w = 0; w < 8; ++w) tot += SSQ[w * 64 + mt * 16 + r];
            const float rstd = rsqrtf(tot * (1.f / 128.f) + EPS);
            const f32x4 ov = Y.o[mt] * rstd * g4 * (f32x4){bf_lo(Y.hg[mt].x), bf_hi(Y.hg[mt].x), bf_lo(Y.hg[mt].y), bf_hi(Y.hg[mt].y)};
            u32x2 w; w.x = pk_bf16(ov.x, ov.y); w.y = pk_bf16(ov.z, ov.w);
            if (n > 0 && (!dry || rstd == 12345.678f)) *(u32x2*)(HGg + (m0 - 64 + mt * 16 + r) * 1024 + cb + 16 * wv + q * 4) = w; }
    }
    if (n < NCH) {
        const LAS bf16_t* QH = (const LAS bf16_t*)(B + SB_QH); const LAS bf16_t* KHT = (const LAS bf16_t*)(B + SB_KHT); const LAS bf16_t* VT = (const LAS bf16_t*)(B + SB_VT); const LAS bf16_t* Pm = (const LAS bf16_t*)(B + SB_P);
        const LAS float* DEC = (const LAS float*)(B + SB_DEC); LAS float* SSQ = (LAS float*)(B + SB_SSQ);
#define SCHED_FENCE() __builtin_amdgcn_sched_barrier(0)
#define QFRAG(a, mt) __builtin_bit_cast(bf16x8, (u32x4){(*(const LAS u32x2*)(QH + ((mt) * 16 + r) * HQ_STR + 32 * (a) + q * 4)).x, (*(const LAS u32x2*)(QH + ((mt) * 16 + r) * HQ_STR + 32 * (a) + q * 4)).y, \
                                                        (*(const LAS u32x2*)(QH + ((mt) * 16 + r) * HQ_STR + 32 * (a) + 16 + q * 4)).x, (*(const LAS u32x2*)(QH + ((mt) * 16 + r) * HQ_STR + 32 * (a) + 16 + q * 4)).y})
#define SFRAG(a) __builtin_bit_cast(bf16x8, (u32x4){pk_bf16(S[2 * (a)][0], S[2 * (a)][1]), pk_bf16(S[2 * (a)][2], S[2 * (a)][3]), pk_bf16(S[2 * (a) + 1][0], S[2 * (a) + 1][1]), pk_bf16(S[2 * (a) + 1][2], S[2 * (a) + 1][3])})
        f32x4 o[4];
#pragma unroll
        for (int mt = 0; mt < 4; ++mt) o[mt] = (f32x4){0.f, 0.f, 0.f, 0.f};
        bf16x8 qa[8], qb[8];
#pragma unroll
        for (int mt = 0; mt < 4; ++mt) { qa[mt] = QFRAG(0, mt); qa[4 + mt] = QFRAG(1, mt); }
        SCHED_FENCE();
#pragma unroll
        for (int mt = 0; mt < 4; ++mt) { qb[mt] = QFRAG(2, mt); qb[4 + mt] = QFRAG(3, mt); }
        { const bf16x8 s0 = SFRAG(0), s1 = SFRAG(1);
#pragma unroll
          for (int mt = 0; mt < 4; ++mt) o[mt] = MFMA16(s0, qa[mt], o[mt]);
#pragma unroll
          for (int mt = 0; mt < 4; ++mt) o[mt] = MFMA16(s1, qa[4 + mt], o[mt]); }
        SCHED_FENCE();
        bf16x8 vf[2], pf[6];
#pragma unroll
        for (int ks = 0; ks < 2; ++ks) vf[ks] = *(const LAS bf16x8*)(VT + (16 * wv + r) * HK_STR + ks * 32 + q * 8);
#pragma unroll
        for (int mt = 0; mt < 4; ++mt) pf[mt] = *(const LAS bf16x8*)(Pm + (mt * 16 + r) * HK_STR + q * 8);
        pf[4] = *(const LAS bf16x8*)(Pm + (2 * 16 + r) * HK_STR + 32 + q * 8); pf[5] = *(const LAS bf16x8*)(Pm + (3 * 16 + r) * HK_STR + 32 + q * 8);
        { const bf16x8 s2 = SFRAG(2), s3 = SFRAG(3);
#pragma unroll
          for (int mt = 0; mt < 4; ++mt) o[mt] = MFMA16(s2, qb[mt], o[mt]);
#pragma unroll
          for (int mt = 0; mt < 4; ++mt) o[mt] = MFMA16(s3, qb[4 + mt], o[mt]); }
        SCHED_FENCE();
        f32x4 deca[4], decb[4]; bf16x8 kfa[8], kfb[8];
#pragma unroll
        for (int kt = 0; kt < 4; ++kt) { deca[kt] = *(const LAS f32x4*)(DEC + kt * 16 + q * 4); kfa[2 * kt] = *(const LAS bf16x8*)(KHT + (kt * 16 + r) * HK_STR + q * 8); kfa[2 * kt + 1] = *(const LAS bf16x8*)(KHT + (kt * 16 + r) * HK_STR + 32 + q * 8); }
#pragma unroll
        for (int mt = 0; mt < 4; ++mt) o[mt] = MFMA16(vf[0], pf[mt], o[mt]);
        o[2] = MFMA16(vf[1], pf[4], o[2]); o[3] = MFMA16(vf[1], pf[5], o[3]);
        SCHED_FENCE();
#pragma unroll
        for (int kt = 4; kt < 8; ++kt) { decb[kt - 4] = *(const LAS f32x4*)(DEC + kt * 16 + q * 4); kfb[2 * (kt - 4)] = *(const LAS bf16x8*)(KHT + (kt * 16 + r) * HK_STR + q * 8); kfb[2 * (kt - 4) + 1] = *(const LAS bf16x8*)(KHT + (kt * 16 + r) * HK_STR + 32 + q * 8); }
#pragma unroll
        for (int kt = 0; kt < 4; ++kt) { S[kt] = S[kt] * deca[kt]; S[kt] = MFMA16(kfa[2 * kt], vf[0], S[kt]); S[kt] = MFMA16(kfa[2 * kt + 1], vf[1], S[kt]); }
        SCHED_FENCE();
#pragma unroll
        for (int kt = 4; kt < 8; ++kt) { S[kt] = S[kt] * decb[kt - 4]; S[kt] = MFMA16(kfb[2 * (kt - 4)], vf[0], S[kt]); S[kt] = MFMA16(kfb[2 * (kt - 4) + 1], vf[1], S[kt]); }
        float ss[4];
#pragma unroll
        for (int mt = 0; mt < 4; ++mt) { ss[mt] = (o[mt].x * o[mt].x + o[mt].y * o[mt].y) + (o[mt].z * o[mt].z + o[mt].w * o[mt].w); X.o[mt] = o[mt]; }
        float t16[4];
#pragma unroll
        for (int mt = 0; mt < 4; ++mt) t16[mt] = __shfl_xor(ss[mt], 16);
        SCHED_FENCE();
#pragma unroll
        for (int mt = 0; mt < 4; ++mt) ss[mt] += t16[mt];
#pragma unroll
        for (int mt = 0; mt < 4; ++mt) t16[mt] = __shfl_xor(ss[mt], 32);
        SCHED_FENCE();
#pragma unroll
        for (int mt = 0; mt < 4; ++mt) { ss[mt] += t16[mt]; if (q == 0) SSQ[wv * 64 + mt * 16 + r] = ss[mt]; }
#undef QFRAG
#undef SFRAG
    }
}
__device__ __forceinline__ void scan_item(const bf16_t* Qg, const bf16_t* Kg, const bf16_t* Vg, const bf16_t* Pg, const float* DECg, bf16_t* HGg, const float* gnorm, int bh, LAS unsigned char* lds, bool dry = false) {
    int tid_l = threadIdx.x; asm volatile("" : "+v"(tid_l));
    const int tid = tid_l, lane = tid & 63, wv = __builtin_amdgcn_readfirstlane(tid >> 6), r = lane & 15, q = lane >> 4;
    f32x4 S[8];
#pragma unroll
    for (int kt = 0; kt < 8; ++kt) S[kt] = (f32x4){0.f, 0.f, 0.f, 0.f};
    const f32x4 g4 = *(const f32x4*)(gnorm + 16 * wv + q * 4);
    const size_t cb = (size_t)(bh & 7) * 128, mb = (size_t)(bh >> 3) * SEQ;
    ScanRegs X, Y;
    X.dc = (f32x4){0.f, 0.f, 0.f, 0.f}; Y.dc = X.dc;
#pragma unroll
    for (int mt = 0; mt < 4; ++mt) { X.o[mt] = (f32x4){0.f, 0.f, 0.f, 0.f}; Y.o[mt] = X.o[mt]; X.hg[mt] = (u32x2){0u, 0u}; Y.hg[mt] = X.hg[mt]; }
    asm volatile("" ::: "memory");
    scan_load(X, Qg, Kg, Vg, Pg, DECg, bh, 0, mb, cb, tid, lane, wv);
    scan_load(Y, Qg, Kg, Vg, Pg, DECg, bh, 1, mb, cb, tid, lane, wv);
#pragma unroll 1
    for (int n = 0; n < SEQ / 64; n += 2) {
        scan_chunk(X, Y, S, g4, n, Qg, Kg, Vg, Pg, DECg, HGg, bh, mb, cb, tid, lane, wv, r, q, lds, dry);
        scan_chunk(Y, X, S, g4, n + 1, Qg, Kg, Vg, Pg, DECg, HGg, bh, mb, cb, tid, lane, wv, r, q, lds, dry);
    }
    scan_chunk(X, Y, S, g4, SEQ / 64, Qg, Kg, Vg, Pg, DECg, HGg, bh, mb, cb, tid, lane, wv, r, q, lds, dry);
    __syncthreads();
}

constexpr int NSEG = 4, CPS = (SEQ / 64) / NSEG;
struct Scan1Regs { unsigned q2[8], k2[8], v2[8]; u32x4 pr; f32x4 dc; };
__device__ __forceinline__ void scan1_load(Scan1Regs& R, const bf16_t* Qg, const bf16_t* Kg, const bf16_t* Vg, const bf16_t* Pg, const float* DECg, int bh, int n, size_t mb, size_t cb, int tid, int lane, int wv) {
    R.pr = *(const u32x4*)(Pg + (size_t)(bh * 32 + n) * 4096 + tid * 8);
    R.dc = *(const f32x4*)(DECg + (size_t)(bh * 32 + n) * 128 + (tid & 31) * 4);
    const size_t rb = (mb + (size_t)n * 64 + wv * 8) * 1024 + cb + 2 * lane;
#pragma unroll
    for (int i = 0; i < 8; ++i) { R.q2[i] = *(const unsigned*)(Qg + rb + (size_t)i * 1024); R.k2[i] = *(const unsigned*)(Kg + rb + (size_t)i * 1024); R.v2[i] = *(const unsigned*)(Vg + rb + (size_t)i * 1024); }
    asm volatile("" ::: "memory");
}
#define SCHED_FENCE() __builtin_amdgcn_sched_barrier(0)
#define QFRAG(a, mt) __builtin_bit_cast(bf16x8, (u32x4){(*(const LAS u32x2*)(QH + ((mt) * 16 + r) * HQ_STR + 32 * (a) + q * 4)).x, (*(const LAS u32x2*)(QH + ((mt) * 16 + r) * HQ_STR + 32 * (a) + q * 4)).y, \
                                                        (*(const LAS u32x2*)(QH + ((mt) * 16 + r) * HQ_STR + 32 * (a) + 16 + q * 4)).x, (*(const LAS u32x2*)(QH + ((mt) * 16 + r) * HQ_STR + 32 * (a) + 16 + q * 4)).y})
#define SFRAG(a) __builtin_bit_cast(bf16x8, (u32x4){pk_bf16(S[2 * (a)][0], S[2 * (a)][1]), pk_bf16(S[2 * (a)][2], S[2 * (a)][3]), pk_bf16(S[2 * (a) + 1][0], S[2 * (a) + 1][1]), pk_bf16(S[2 * (a) + 1][2], S[2 * (a) + 1][3])})
__device__ __forceinline__ void scan1_chunk(Scan1Regs& X, f32x4 (&S)[8], int n, int nlast, const bf16_t* Qg, const bf16_t* Kg, bf16_t* Vg, const bf16_t* Pg, const float* DECg,
                                            int bh, size_t mb, size_t cb, int tid, int lane, int wv, int r, int q, LAS unsigned char* lds) {
    LAS unsigned char* B = lds + (n & 1) * SB_SIZE;
    const size_t m0 = mb + (size_t)n * 64;
    LAS bf16_t* QH = (LAS bf16_t*)(B + SB_QH); LAS bf16_t* KHT = (LAS bf16_t*)(B + SB_KHT); LAS bf16_t* VT = (LAS bf16_t*)(B + SB_VT); LAS bf16_t* Pm = (LAS bf16_t*)(B + SB_P);
    const LAS float* DEC = (const LAS float*)(B + SB_DEC);
#pragma unroll
    for (int i = 0; i < 8; ++i) *(LAS unsigned*)(QH + (wv * 8 + i) * HQ_STR + 2 * lane) = X.q2[i];
    { u32x4 lo, hi; const unsigned* k2 = X.k2;
      lo.x = (k2[0] & 0xffffu) | (k2[1] << 16); lo.y = (k2[2] & 0xffffu) | (k2[3] << 16); lo.z = (k2[4] & 0xffffu) | (k2[5] << 16); lo.w = (k2[6] & 0xffffu) | (k2[7] << 16);
      hi.x = (k2[0] >> 16) | (k2[1] & 0xffff0000u); hi.y = (k2[2] >> 16) | (k2[3] & 0xffff0000u); hi.z = (k2[4] >> 16) | (k2[5] & 0xffff0000u); hi.w = (k2[6] >> 16) | (k2[7] & 0xffff0000u);
      *(LAS u32x4*)(KHT + (2 * lane) * HK_STR + wv * 8) = lo; *(LAS u32x4*)(KHT + (2 * lane + 1) * HK_STR + wv * 8) = hi; }
    { u32x4 lo, hi; const unsigned* v2 = X.v2;
      lo.x = (v2[0] & 0xffffu) | (v2[1] << 16); lo.y = (v2[2] & 0xffffu) | (v2[3] << 16); lo.z = (v2[4] & 0xffffu) | (v2[5] << 16); lo.w = (v2[6] & 0xffffu) | (v2[7] << 16);
      hi.x = (v2[0] >> 16) | (v2[1] & 0xffff0000u); hi.y = (v2[2] >> 16) | (v2[3] & 0xffff0000u); hi.z = (v2[4] >> 16) | (v2[5] & 0xffff0000u); hi.w = (v2[6] >> 16) | (v2[7] & 0xffff0000u);
      *(LAS u32x4*)(VT + (2 * lane) * HK_STR + wv * 8) = lo; *(LAS u32x4*)(VT + (2 * lane + 1) * HK_STR + wv * 8) = hi; }
    *(LAS u32x4*)(Pm + (tid >> 3) * HK_STR + (tid & 7) * 8) = X.pr;
    if (tid < 32) *(LAS f32x4*)((LAS float*)(B + SB_DEC) + tid * 4) = X.dc;
    scan1_load(X, Qg, Kg, Vg, Pg, DECg, bh, (n + 2 <= nlast) ? n + 2 : nlast, mb, cb, tid, lane, wv);
    LBAR();
    f32x4 o[4];
#pragma unroll
    for (int mt = 0; mt < 4; ++mt) o[mt] = (f32x4){0.f, 0.f, 0.f, 0.f};
    bf16x8 qa[8], qb[8];
#pragma unroll
    for (int mt = 0; mt < 4; ++mt) { qa[mt] = QFRAG(0, mt); qa[4 + mt] = QFRAG(1, mt); }
    SCHED_FENCE();
#pragma unroll
    for (int mt = 0; mt < 4; ++mt) { qb[mt] = QFRAG(2, mt); qb[4 + mt] = QFRAG(3, mt); }
    { const bf16x8 s0 = SFRAG(0), s1 = SFRAG(1);
#pragma unroll
      for (int mt = 0; mt < 4; ++mt) o[mt] = MFMA16(s0, qa[mt], o[mt]);
#pragma unroll
      for (int mt = 0; mt < 4; ++mt) o[mt] = MFMA16(s1, qa[4 + mt], o[mt]); }
    SCHED_FENCE();
    bf16x8 vf[2], pf[6];
#pragma unroll
    for (int ks = 0; ks < 2; ++ks) vf[ks] = *(const LAS bf16x8*)(VT + (16 * wv + r) * HK_STR + ks * 32 + q * 8);
#pragma unroll
    for (int mt = 0; mt < 4; ++mt) pf[mt] = *(const LAS bf16x8*)(Pm + (mt * 16 + r) * HK_STR + q * 8);
    pf[4] = *(const LAS bf16x8*)(Pm + (2 * 16 + r) * HK_STR + 32 + q * 8); pf[5] = *(const LAS bf16x8*)(Pm + (3 * 16 + r) * HK_STR + 32 + q * 8);
    { const bf16x8 s2 = SFRAG(2), s3 = SFRAG(3);
#pragma unroll
      for (int mt = 0; mt < 4; ++mt) o[mt] = MFMA16(s2, qb[mt], o[mt]);
#pragma unroll
      for (int mt = 0; mt < 4; ++mt) o[mt] = MFMA16(s3, qb[4 + mt], o[mt]); }
    SCHED_FENCE();
    f32x4 deca[4], decb[4]; bf16x8 kfa[8], kfb[8];
#pragma unroll
    for (int kt = 0; kt < 4; ++kt) { deca[kt] = *(const LAS f32x4*)(DEC + kt * 16 + q * 4); kfa[2 * kt] = *(const LAS bf16x8*)(KHT + (kt * 16 + r) * HK_STR + q * 8); kfa[2 * kt + 1] = *(const LAS bf16x8*)(KHT + (kt * 16 + r) * HK_STR + 32 + q * 8); }
#pragma unroll
    for (int mt = 0; mt < 4; ++mt) o[mt] = MFMA16(vf[0], pf[mt], o[mt]);
    o[2] = MFMA16(vf[1], pf[4], o[2]); o[3] = MFMA16(vf[1], pf[5], o[3]);
    SCHED_FENCE();
#pragma unroll
    for (int kt = 4; kt < 8; ++kt) { decb[kt - 4] = *(const LAS f32x4*)(DEC + kt * 16 + q * 4); kfb[2 * (kt - 4)] = *(const LAS bf16x8*)(KHT + (kt * 16 + r) * HK_STR + q * 8); kfb[2 * (kt - 4) + 1] = *(const LAS bf16x8*)(KHT + (kt * 16 + r) * HK_STR + 32 + q * 8); }
#pragma unroll
    for (int kt = 0; kt < 4; ++kt) { S[kt] = S[kt] * deca[kt]; S[kt] = MFMA16(kfa[2 * kt], vf[0], S[kt]); S[kt] = MFMA16(kfa[2 * kt + 1], vf[1], S[kt]); }
    SCHED_FENCE();
#pragma unroll
    for (int kt = 4; kt < 8; ++kt) { S[kt] = S[kt] * decb[kt - 4]; S[kt] = MFMA16(kfb[2 * (kt - 4)], vf[0], S[kt]); S[kt] = MFMA16(kfb[2 * (kt - 4) + 1], vf[1], S[kt]); }
#pragma unroll
    for (int mt = 0; mt < 4; ++mt) { u32x2 w; w.x = pk_bf16(o[mt].x, o[mt].y); w.y = pk_bf16(o[mt].z, o[mt].w);
        *(u32x2*)(Vg + (m0 + mt * 16 + r) * 1024 + cb + 16 * wv + q * 4) = w; }
}
__device__ __forceinline__ void scan1_item(const bf16_t* Qg, const bf16_t* Kg, bf16_t* Vg, const bf16_t* Pg, const float* DECg, float* SLOC, float* DSEG, int item, LAS unsigned char* lds) {
    int tid_l = threadIdx.x; asm volatile("" : "+v"(tid_l));
    const int tid = tid_l, lane = tid & 63, wv = __builtin_amdgcn_readfirstlane(tid >> 6), r = lane & 15, q = lane >> 4;
    const int bh = item >> 2, seg = item & 3, n0 = seg * CPS, nlast = n0 + CPS - 1;
    f32x4 S[8];
#pragma unroll
    for (int kt = 0; kt < 8; ++kt) S[kt] = (f32x4){0.f, 0.f, 0.f, 0.f};
    const size_t cb = (size_t)(bh & 7) * 128, mb = (size_t)(bh >> 3) * SEQ;
    Scan1Regs X, Y;
    asm volatile("" ::: "memory");
    scan1_load(X, Qg, Kg, Vg, Pg, DECg, bh, n0, mb, cb, tid, lane, wv);
    scan1_load(Y, Qg, Kg, Vg, Pg, DECg, bh, n0 + 1, mb, cb, tid, lane, wv);
#pragma unroll 1
    for (int n = n0; n <= nlast; n += 2) {
        scan1_chunk(X, S, n, nlast, Qg, Kg, Vg, Pg, DECg, bh, mb, cb, tid, lane, wv, r, q, lds);
        scan1_chunk(Y, S, n + 1, nlast, Qg, Kg, Vg, Pg, DECg, bh, mb, cb, tid, lane, wv, r, q, lds);
    }
    f32x4* sl = (f32x4*)SLOC + ((size_t)item * 8 + wv) * 8 * 64 + lane;
#pragma unroll
    for (int kt = 0; kt < 8; ++kt) sl[kt * 64] = S[kt];
    if (wv == 0 && r == 0) {
#pragma unroll
        for (int kt = 0; kt < 8; ++kt) { f32x4 cdv = (f32x4){1.f, 1.f, 1.f, 1.f};
            for (int n = n0; n <= nlast; ++n) cdv = cdv * *(const f32x4*)(DECg + (size_t)(bh * 32 + n) * 128 + kt * 16 + q * 4);
            *(f32x4*)(DSEG + (size_t)item * 128 + kt * 16 + q * 4) = cdv; } }
    __syncthreads();
}

constexpr int F_QH = 0, F_QT = 17408, F_KT = 34816, F_KHT = 52224, F_VT = 70656, F_P = 89088, F_TOT = 98304, F_DEC = 102400;
struct FRegs { unsigned q2[8], z2[8], v2[8]; };
__device__ __forceinline__ void f_load(FRegs& R, const bf16_t* Qg, const bf16_t* LFg, const bf16_t* Vg, int n, size_t mb, size_t cb, int lane, int wv) {
    const size_t rb = (mb + (size_t)n * 64 + wv * 8) * 1024 + cb + 2 * lane;
#pragma unroll
    for (int i = 0; i < 8; ++i) { R.q2[i] = *(const unsigned*)(Qg + rb + (size_t)i * 1024); R.z2[i] = *(const unsigned*)(LFg + rb + (size_t)i * 1024); R.v2[i] = *(const unsigned*)(Vg + rb + (size_t)i * 1024); }
    asm volatile("" ::: "memory");
}
__device__ __forceinline__ void f_chunk(FRegs& X, f32x4 (&S)[8], float& cd0, float& cd1, int n, int nlast, const float lb0, const float lb1, bf16_t* Qg, const bf16_t* LFg, bf16_t* Vg, float* DECg,
                                        int bh, size_t mb, size_t cb, int tid, int lane, int wv, int r, int q, LAS unsigned char* lds) {
    LAS bf16_t* QH = (LAS bf16_t*)(lds + F_QH); LAS bf16_t* QT = (LAS bf16_t*)(lds + F_QT); LAS bf16_t* KT = (LAS bf16_t*)(lds + F_KT);
    LAS bf16_t* KHT = (LAS bf16_t*)(lds + F_KHT); LAS bf16_t* VT = (LAS bf16_t*)(lds + F_VT); LAS bf16_t* Pm = (LAS bf16_t*)(lds + F_P);
    LAS float* TOT = (LAS float*)(lds + F_TOT); LAS float* DEC = (LAS float*)(lds + F_DEC);
    const size_t m0 = mb + (size_t)n * 64, rb = (m0 + wv * 8) * 1024 + cb + 2 * lane;
    float f0[8], f1[8]; float run0 = 0.f, run1 = 0.f;
#pragma unroll
    for (int i = 0; i < 8; ++i) { const float z0 = h_lo(X.z2[i]), z1 = h_hi(X.z2[i]);
        f0[i] = fmaxf(lb0 + (1.f - lb0) * sigmoid_f(z0), 1e-30f); f1[i] = fmaxf(lb1 + (1.f - lb1) * sigmoid_f(z1), 1e-30f); run0 += __logf(f0[i]); run1 += __logf(f1[i]); }
    *(LAS f32x2*)(TOT + wv * 128 + 2 * lane) = (f32x2){run0, run1};
    LBAR();
    float pre0 = 0.f, pre1 = 0.f, last0 = 0.f, last1 = 0.f;
#pragma unroll
    for (int w = 0; w < 8; ++w) { const f32x2 t = *(const LAS f32x2*)(TOT + w * 128 + 2 * lane); last0 += t.x; last1 += t.y; if (w < wv) { pre0 += t.x; pre1 += t.y; } }
    { const f32x2 dv = (f32x2){__expf(last0), __expf(last1)}; cd0 *= dv.x; cd1 *= dv.y;
      if (wv == 0) { *(LAS f32x2*)(DEC + 2 * lane) = dv; *(f32x2*)(DECg + (size_t)(bh * 32 + n) * 128 + 2 * lane) = dv; } }
    const float sc0 = __expf(fminf(-0.5f * last0, 60.f)), sc1 = __expf(fminf(-0.5f * last1, 60.f));
    float pf0 = __expf(pre0), pf1 = __expf(pre1), sf0 = __expf(last0 - pre0 - run0), sf1 = __expf(last1 - pre1 - run1);
    { float kh0[8], kh1[8];
#pragma unroll
      for (int i = 7; i >= 0; --i) { kh0[i] = (1.f - f0[i]) * sf0; kh1[i] = (1.f - f1[i]) * sf1; sf0 *= f0[i]; sf1 *= f1[i]; }
#pragma unroll
      for (int i = 0; i < 8; ++i) { pf0 *= f0[i]; pf1 *= f1[i];
          const float qh0 = silu_f(bf_lo(X.q2[i])) * pf0, qh1 = silu_f(bf_hi(X.q2[i])) * pf1; const int t = wv * 8 + i; const unsigned qp = pk_bf16(qh0, qh1);
          *(unsigned*)(Qg + rb + (size_t)i * 1024) = qp;
          *(LAS unsigned*)(QH + t * HQ_STR + 2 * lane) = qp;
          *(LAS unsigned*)(QT + t * HQ_STR + 2 * lane) = pk_bf16(qh0 * sc0, qh1 * sc1);
          *(LAS unsigned*)(KT + t * HQ_STR + 2 * lane) = pk_bf16(kh0[i] * sc0, kh1[i] * sc1); }
      u32x4 a, c; a.x = pk_bf16(kh0[0], kh0[1]); a.y = pk_bf16(kh0[2], kh0[3]); a.z = pk_bf16(kh0[4], kh0[5]); a.w = pk_bf16(kh0[6], kh0[7]);
      c.x = pk_bf16(kh1[0], kh1[1]); c.y = pk_bf16(kh1[2], kh1[3]); c.z = pk_bf16(kh1[4], kh1[5]); c.w = pk_bf16(kh1[6], kh1[7]);
      *(LAS u32x4*)(KHT + (2 * lane) * HK_STR + wv * 8) = a; *(LAS u32x4*)(KHT + (2 * lane + 1) * HK_STR + wv * 8) = c; }
    { u32x4 lo, hi; const unsigned* v2 = X.v2;
      lo.x = (v2[0] & 0xffffu) | (v2[1] << 16); lo.y = (v2[2] & 0xffffu) | (v2[3] << 16); lo.z = (v2[4] & 0xffffu) | (v2[5] << 16); lo.w = (v2[6] & 0xffffu) | (v2[7] << 16);
      hi.x = (v2[0] >> 16) | (v2[1] & 0xffff0000u); hi.y = (v2[2] >> 16) | (v2[3] & 0xffff0000u); hi.z = (v2[4] >> 16) | (v2[5] & 0xffff0000u); hi.w = (v2[6] >> 16) | (v2[7] & 0xffff0000u);
      *(LAS u32x4*)(VT + (2 * lane) * HK_STR + wv * 8) = lo; *(LAS u32x4*)(VT + (2 * lane + 1) * HK_STR + wv * 8) = hi; }
    f_load(X, Qg, LFg, Vg, (n + 2 <= nlast) ? n + 2 : nlast, mb, cb, lane, wv);
    LBAR();
    const int ti = wv >> 1;
    { bf16x8 qf[4], kf[2][4];
#pragma unroll
      for (int ks = 0; ks < 4; ++ks) { qf[ks] = *(const LAS bf16x8*)(QT + (ti * 16 + r) * HQ_STR + ks * 32 + q * 8);
          kf[0][ks] = *(const LAS bf16x8*)(KT + ((2 * (wv & 1)) * 16 + r) * HQ_STR + ks * 32 + q * 8); kf[1][ks] = *(const LAS bf16x8*)(KT + ((2 * (wv & 1) + 1) * 16 + r) * HQ_STR + ks * 32 + q * 8); }
      SCHED_FENCE();
#pragma unroll
      for (int jj = 0; jj < 2; ++jj) { const int tj = 2 * (wv & 1) + jj; f32x4 sc = (f32x4){0.f, 0.f, 0.f, 0.f};
          if (tj <= ti) {
#pragma unroll
              for (int ks = 0; ks < 4; ++ks) sc = MFMA16(kf[jj][ks], qf[ks], sc); }
          const int t = ti * 16 + r, s0 = tj * 16 + q * 4;
#pragma unroll
          for (int j = 0; j < 4; ++j) sc[j] = (s0 + j <= t) ? sc[j] : 0.f;
          u32x2 w; w.x = pk_bf16(sc[0], sc[1]); w.y = pk_bf16(sc[2], sc[3]);
          *(LAS u32x2*)(Pm + t * HK_STR + s0) = w; } }
    f32x4 o[4];
#pragma unroll
    for (int mt = 0; mt < 4; ++mt) o[mt] = (f32x4){0.f, 0.f, 0.f, 0.f};
    { bf16x8 qa[8], qb[8];
#pragma unroll
      for (int mt = 0; mt < 4; ++mt) { qa[mt] = QFRAG(0, mt); qa[4 + mt] = QFRAG(1, mt); }
      SCHED_FENCE();
#pragma unroll
      for (int mt = 0; mt < 4; ++mt) { qb[mt] = QFRAG(2, mt); qb[4 + mt] = QFRAG(3, mt); }
      { const bf16x8 s0 = SFRAG(0), s1 = SFRAG(1);
#pragma unroll
        for (int mt = 0; mt < 4; ++mt) o[mt] = MFMA16(s0, qa[mt], o[mt]);
#pragma unroll
        for (int mt = 0; mt < 4; ++mt) o[mt] = MFMA16(s1, qa[4 + mt], o[mt]); }
      SCHED_FENCE();
      { const bf16x8 s2 = SFRAG(2), s3 = SFRAG(3);
#pragma unroll
        for (int mt = 0; mt < 4; ++mt) o[mt] = MFMA16(s2, qb[mt], o[mt]);
#pragma unroll
        for (int mt = 0; mt < 4; ++mt) o[mt] = MFMA16(s3, qb[4 + mt], o[mt]); } }
    LBAR();
    bf16x8 vf[2], pf[6];
#pragma unroll
    for (int ks = 0; ks < 2; ++ks) vf[ks] = *(const LAS bf16x8*)(VT + (16 * wv + r) * HK_STR + ks * 32 + q * 8);
#pragma unroll
    for (int mt = 0; mt < 4; ++mt) pf[mt] = *(const LAS bf16x8*)(Pm + (mt * 16 + r) * HK_STR + q * 8);
    pf[4] = *(const LAS bf16x8*)(Pm + (2 * 16 + r) * HK_STR + 32 + q * 8); pf[5] = *(const LAS bf16x8*)(Pm + (3 * 16 + r) * HK_STR + 32 + q * 8);
    SCHED_FENCE();
    f32x4 deca[4], decb[4]; bf16x8 kfa[8], kfb[8];
#pragma unroll
    for (int kt = 0; kt < 4; ++kt) { deca[kt] = *(const LAS f32x4*)(DEC + kt * 16 + q * 4); kfa[2 * kt] = *(const LAS bf16x8*)(KHT + (kt * 16 + r) * HK_STR + q * 8); kfa[2 * kt + 1] = *(const LAS bf16x8*)(KHT + (kt * 16 + r) * HK_STR + 32 + q * 8); }
#pragma unroll
    for (int mt = 0; mt < 4; ++mt) o[mt] = MFMA16(vf[0], pf[mt], o[mt]);
    o[2] = MFMA16(vf[1], pf[4], o[2]); o[3] = MFMA16(vf[1], pf[5], o[3]);
    SCHED_FENCE();
#pragma unroll
    for (int kt = 4; kt < 8; ++kt) { decb[kt - 4] = *(const LAS f32x4*)(DEC + kt * 16 + q * 4); kfb[2 * (kt - 4)] = *(const LAS bf16x8*)(KHT + (kt * 16 + r) * HK_STR + q * 8); kfb[2 * (kt - 4) + 1] = *(const LAS bf16x8*)(KHT + (kt * 16 + r) * HK_STR + 32 + q * 8); }
#pragma unroll
    for (int kt = 0; kt < 4; ++kt) { S[kt] = S[kt] * deca[kt]; S[kt] = MFMA16(kfa[2 * kt], vf[0], S[kt]); S[kt] = MFMA16(kfa[2 * kt + 1], vf[1], S[kt]); }
    SCHED_FENCE();
#pragma unroll
    for (int kt = 4; kt < 8; ++kt) { S[kt] = S[kt] * decb[kt - 4]; S[kt] = MFMA16(kfb[2 * (kt - 4)], vf[0], S[kt]); S[kt] = MFMA16(kfb[2 * (kt - 4) + 1], vf[1], S[kt]); }
#pragma unroll
    for (int mt = 0; mt < 4; ++mt) { u32x2 w; w.x = pk_bf16(o[mt].x, o[mt].y); w.y = pk_bf16(o[mt].z, o[mt].w);
        *(u32x2*)(Vg + (m0 + mt * 16 + r) * 1024 + cb + 16 * wv + q * 4) = w; }
}
__device__ __forceinline__ void f_item(bf16_t* Qg, const bf16_t* LFg, bf16_t* Vg, float* DECg, float* SLOC, float* DSEG, const float* lbl, int item, LAS unsigned char* lds) {
    int tid_l = threadIdx.x; asm volatile("" : "+v"(tid_l));
    const int tid = tid_l, lane = tid & 63, wv = __builtin_amdgcn_readfirstlane(tid >> 6), r = lane & 15, q = lane >> 4;
    const int bh = item >> 2, seg = item & 3, n0 = seg * CPS, nlast = n0 + CPS - 1;
    f32x4 S[8];
#pragma unroll
    for (int kt = 0; kt < 8; ++kt) S[kt] = (f32x4){0.f, 0.f, 0.f, 0.f};
    const size_t cb = (size_t)(bh & 7) * 128, mb = (size_t)(bh >> 3) * SEQ;
    const f32x2 lbp = *(const f32x2*)(lbl + (bh & 7) * 128 + 2 * lane);
    FRegs X, Y; float cd0 = 1.f, cd1 = 1.f;
    asm volatile("" ::: "memory");
    f_load(X, Qg, LFg, Vg, n0, mb, cb, lane, wv);
    f_load(Y, Qg, LFg, Vg, n0 + 1, mb, cb, lane, wv);
#pragma unroll 1
    for (int n = n0; n <= nlast; n += 2) {
        f_chunk(X, S, cd0, cd1, n, nlast, lbp.x, lbp.y, Qg, LFg, Vg, DECg, bh, mb, cb, tid, lane, wv, r, q, lds);
        f_chunk(Y, S, cd0, cd1, n + 1, nlast, lbp.x, lbp.y, Qg, LFg, Vg, DECg, bh, mb, cb, tid, lane, wv, r, q, lds);
    }
    f32x4* sl = (f32x4*)SLOC + ((size_t)item * 8 + wv) * 8 * 64 + lane;
#pragma unroll
    for (int kt = 0; kt < 8; ++kt) sl[kt * 64] = S[kt];
    if (wv == 0) *(f32x2*)(DSEG + (size_t)item * 128 + 2 * lane) = (f32x2){cd0, cd1};
    __syncthreads();
}

struct Scan2Regs { unsigned q2[8]; f32x4 dc; u32x2 ol[4], hg[4], hgc[4]; f32x4 o[4]; };
__device__ __forceinline__ void scan2_load(Scan2Regs& R, const bf16_t* Qg, const bf16_t* OLg, const bf16_t* HGg, const float* DECg, int bh, int n, size_t mb, size_t cb, int tid, int lane, int wv, int r, int q) {
    R.dc = *(const f32x4*)(DECg + (size_t)(bh * 32 + n) * 128 + (tid & 31) * 4);
    const size_t rb = (mb + (size_t)n * 64 + wv * 8) * 1024 + cb + 2 * lane;
#pragma unroll
    for (int i = 0; i < 8; ++i) R.q2[i] = *(const unsigned*)(Qg + rb + (size_t)i * 1024);
#pragma unroll
    for (int mt = 0; mt < 4; ++mt) { const size_t ob = (mb + (size_t)n * 64 + mt * 16 + r) * 1024 + cb + 16 * wv + q * 4; R.ol[mt] = *(const u32x2*)(OLg + ob); R.hg[mt] = *(const u32x2*)(HGg + ob); }
    asm volatile("" ::: "memory");
}
__device__ __forceinline__ void scan2_chunk(Scan2Regs& X, Scan2Regs& Y, f32x4 (&S)[8], const f32x4 g4, int n, int n0, int nlast, const bf16_t* Qg, const bf16_t* OLg, bf16_t* HGg, const float* DECg,
                                            int bh, size_t mb, size_t cb, int tid, int lane, int wv, int r, int q, LAS unsigned char* lds) {
    LAS unsigned char* B = lds + (n & 1) * SB_SIZE;
    const size_t m0 = mb + (size_t)n * 64;
    u32x2 olx[4];
    if (n <= nlast) {
        LAS bf16_t* QH = (LAS bf16_t*)(B + SB_QH);
#pragma unroll
        for (int i = 0; i < 8; ++i) *(LAS unsigned*)(QH + (wv * 8 + i) * HQ_STR + 2 * lane) = X.q2[i];
        if (tid < 32) *(LAS f32x4*)((LAS float*)(B + SB_DEC) + tid * 4) = X.dc;
#pragma unroll
        for (int mt = 0; mt < 4; ++mt) { X.hgc[mt] = X.hg[mt]; olx[mt] = X.ol[mt]; }
        scan2_load(X, Qg, OLg, HGg, DECg, bh, (n + 2 <= nlast) ? n + 2 : nlast, mb, cb, tid, lane, wv, r, q);
    }
    LBAR();
    if (n > n0) {
        const LAS float* SSQ = (const LAS float*)(lds + ((n - 1) & 1) * SB_SIZE + SB_SSQ);
#pragma unroll
        for (int mt = 0; mt < 4; ++mt) { float tot = 0.f;
#pragma unroll
            for (int w = 0; w < 8; ++w) tot += SSQ[w * 64 + mt * 16 + r];
            const float rstd = rsqrtf(tot * (1.f / 128.f) + EPS);
            const f32x4 ov = Y.o[mt] * rstd * g4 * (f32x4){silu_f(bf_lo(Y.hgc[mt].x)), silu_f(bf_hi(Y.hgc[mt].x)), silu_f(bf_lo(Y.hgc[mt].y)), silu_f(bf_hi(Y.hgc[mt].y))};
            u32x2 w; w.x = pk_bf16(ov.x, ov.y); w.y = pk_bf16(ov.z, ov.w);
            *(u32x2*)(HGg + (m0 - 64 + mt * 16 + r) * 1024 + cb + 16 * wv + q * 4) = w; }
    }
    if (n <= nlast) {
        const LAS bf16_t* QH = (const LAS bf16_t*)(B + SB_QH); const LAS float* DEC = (const LAS float*)(B + SB_DEC); LAS float* SSQ = (LAS float*)(B + SB_SSQ);
        f32x4 o[4];
#pragma unroll
        for (int mt = 0; mt < 4; ++mt) o[mt] = (f32x4){bf_lo(olx[mt].x), bf_hi(olx[mt].x), bf_lo(olx[mt].y), bf_hi(olx[mt].y)};
        bf16x8 qa[8], qb[8];
#pragma unroll
        for (int mt = 0; mt < 4; ++mt) { qa[mt] = QFRAG(0, mt); qa[4 + mt] = QFRAG(1, mt); }
        SCHED_FENCE();
#pragma unroll
        for (int mt = 0; mt < 4; ++mt) { qb[mt] = QFRAG(2, mt); qb[4 + mt] = QFRAG(3, mt); }
        { const bf16x8 s0 = SFRAG(0), s1 = SFRAG(1);
#pragma unroll
          for (int mt = 0; mt < 4; ++mt) o[mt] = MFMA16(s0, qa[mt], o[mt]);
#pragma unroll
          for (int mt = 0; mt < 4; ++mt) o[mt] = MFMA16(s1, qa[4 + mt], o[mt]); }
        SCHED_FENCE();
        f32x4 dec[8];
#pragma unroll
        for (int kt = 0; kt < 8; ++kt) dec[kt] = *(const LAS f32x4*)(DEC + kt * 16 + q * 4);
        { const bf16x8 s2 = SFRAG(2), s3 = SFRAG(3);
#pragma unroll
          for (int mt = 0; mt < 4; ++mt) o[mt] = MFMA16(s2, qb[mt], o[mt]);
#pragma unroll
          for (int mt = 0; mt < 4; ++mt) o[mt] = MFMA16(s3, qb[4 + mt], o[mt]); }
        SCHED_FENCE();
#pragma unroll
        for (int kt = 0; kt < 8; ++kt) S[kt] = S[kt] * dec[kt];
        float ss[4], t16[4];
#pragma unroll
        for (int mt = 0; mt < 4; ++mt) { ss[mt] = (o[mt].x * o[mt].x + o[mt].y * o[mt].y) + (o[mt].z * o[mt].z + o[mt].w * o[mt].w); X.o[mt] = o[mt]; }
#pragma unroll
        for (int mt = 0; mt < 4; ++mt) t16[mt] = __shfl_xor(ss[mt], 16);
        SCHED_FENCE();
#pragma unroll
        for (int mt = 0; mt < 4; ++mt) ss[mt] += t16[mt];
#pragma unroll
        for (int mt = 0; mt < 4; ++mt) t16[mt] = __shfl_xor(ss[mt], 32);
        SCHED_FENCE();
#pragma unroll
        for (int mt = 0; mt < 4; ++mt) { ss[mt] += t16[mt]; if (q == 0) SSQ[wv * 64 + mt * 16 + r] = ss[mt]; }
    }
}
__device__ __forceinline__ void scan2_item(const bf16_t* Qg, const bf16_t* OLg, bf16_t* HGg, const float* DECg, const float* SLOC, const float* DSEG, const float* gnorm, int item, LAS unsigned char* lds) {
    int tid_l = threadIdx.x; asm volatile("" : "+v"(tid_l));
    const int tid = tid_l, lane = tid & 63, wv = __builtin_amdgcn_readfirstlane(tid >> 6), r = lane & 15, q = lane >> 4;
    const int bh = item >> 2, seg = item & 3, n0 = seg * CPS, nlast = n0 + CPS - 1;
    const f32x4 g4 = *(const f32x4*)(gnorm + 16 * wv + q * 4);
    const size_t cb = (size_t)(bh & 7) * 128, mb = (size_t)(bh >> 3) * SEQ;
    Scan2Regs X, Y;
#pragma unroll
    for (int mt = 0; mt < 4; ++mt) { X.o[mt] = (f32x4){0.f, 0.f, 0.f, 0.f}; Y.o[mt] = X.o[mt]; X.hgc[mt] = (u32x2){0u, 0u}; Y.hgc[mt] = X.hgc[mt]; }
    asm volatile("" ::: "memory");
    scan2_load(X, Qg, OLg, HGg, DECg, bh, n0, mb, cb, tid, lane, wv, r, q);
    scan2_load(Y, Qg, OLg, HGg, DECg, bh, n0 + 1, mb, cb, tid, lane, wv, r, q);
    f32x4 S[8];
#pragma unroll
    for (int kt = 0; kt < 8; ++kt) S[kt] = (f32x4){0.f, 0.f, 0.f, 0.f};
    { const f32x4* sl0 = (const f32x4*)SLOC + ((size_t)(bh * NSEG + 0) * 8 + wv) * 8 * 64 + lane; const f32x4* sl1 = sl0 + (size_t)8 * 8 * 64; const f32x4* sl2 = sl1 + (size_t)8 * 8 * 64;
      const float* d1 = DSEG + (size_t)(bh * NSEG + 1) * 128 + q * 4; const float* d2 = d1 + 128;
      if (seg == 1) {
#pragma unroll
          for (int kt = 0; kt < 8; ++kt) S[kt] = sl0[kt * 64];
      } else if (seg == 2) {
#pragma unroll
          for (int kt = 0; kt < 8; ++kt) S[kt] = sl0[kt * 64] * *(const f32x4*)(d1 + kt * 16) + sl1[kt * 64];
      } else if (seg == 3) {
#pragma unroll
          for (int kt = 0; kt < 8; ++kt) S[kt] = (sl0[kt * 64] * *(const f32x4*)(d1 + kt * 16) + sl1[kt * 64]) * *(const f32x4*)(d2 + kt * 16) + sl2[kt * 64];
      } }
    static_assert(NSEG == 4, "the segment fold above is written out for 4 segments");
#pragma unroll 1
    for (int n = n0; n <= nlast; n += 2) {
        scan2_chunk(X, Y, S, g4, n, n0, nlast, Qg, OLg, HGg, DECg, bh, mb, cb, tid, lane, wv, r, q, lds);
        scan2_chunk(Y, X, S, g4, n + 1, n0, nlast, Qg, OLg, HGg, DECg, bh, mb, cb, tid, lane, wv, r, q, lds);
    }
    scan2_chunk(X, Y, S, g4, nlast + 1, n0, nlast, Qg, OLg, HGg, DECg, bh, mb, cb, tid, lane, wv, r, q, lds);
    __syncthreads();
}
#undef QFRAG
#undef SFRAG

__global__ void __launch_bounds__(512, 2) fwd_megakernel(Params p) {
    extern __shared__ __attribute__((aligned(16))) unsigned char lds_raw[];
    LAS unsigned char* lds = (LAS unsigned char*)lds_raw;
#ifdef USE_CG_SYNC
    cg::grid_group grid = cg::this_grid();
#endif
    const int G = gridDim.x, blk = blockIdx.x;
    unsigned char* ws = p.ws;
    float* ADA = (float*)(ws + WS_ADA);
    bf16_t* H = (bf16_t*)(ws + WS_H); bf16_t* PV = (bf16_t*)(ws + WS_PV); bf16_t* PG = (bf16_t*)(ws + WS_PG); bf16_t* Q = (bf16_t*)(ws + WS_Q);
    bf16_t* LF = (bf16_t*)(ws + WS_LF); bf16_t* V = (bf16_t*)(ws + WS_V); bf16_t* HG = (bf16_t*)(ws + WS_HG);
    bf16_t* GATE = Q; bf16_t* MERGED = LF; bf16_t* Y = V;

    volatile LAS unsigned* stw = (volatile LAS unsigned*)(lds + LDS_BARW);
    unsigned* barw = (unsigned*)(ws + WS_BAR);
    if (threadIdx.x < 4) stw[threadIdx.x] = 0u;
    __syncthreads();
#ifdef USE_CG_SYNC
    if (blk == 0) for (int i = threadIdx.x; i < XCD_BAR_WORDS; i += 512) barw[i] = 0u;
    p0_prologue(p, lds);
    grid.sync();
    const XcdBarrier xb = xcd_barrier_post(barw, stw);
#else
    const XcdBarrier xb = xcd_barrier_post(barw, stw);
    p0_prologue(p, lds);
#ifdef DUP_P0
    __syncthreads(); p0_prologue(p, lds);
#endif
    xcd_barrier(xb);
#endif
#define GSYNC() xcd_barrier(xb)
#pragma unroll 1
    for (int l = 0; l < NL; ++l) {
#ifndef SKIP_P1
        if (l == 0) p1_rows<false, true>(p.x, nullptr, nullptr, nullptr, nullptr, p.g_pre, ADA, H);
        else p1_rows<true, true>(p.x, Y, ADA + (size_t)(l - 1) * NB * 3072, p.g_post + (size_t)(l - 1) * D, p.out, p.g_pre + (size_t)l * D, ADA + (size_t)l * NB * 3072, H);
#ifdef DUP_P1
        if (l == 0) p1_rows<false, true>(p.x, nullptr, nullptr, nullptr, nullptr, p.g_pre, ADA, H);
        else p1_rows<true, true>(p.x, Y, ADA + (size_t)(l - 1) * NB * 3072, p.g_post + (size_t)(l - 1) * D, p.out, p.g_pre + (size_t)l * D, ADA + (size_t)l * NB * 3072, H);
#endif
#endif
        GSYNC();
#pragma unroll 1
        for (int s = 0; s < 4; ++s) {
            const bf16_t* WinT = (const bf16_t*)(ws + WS_WIN) + (size_t)l * INW * D;
            pg8::Gemm g; g.M = M; g.N = D; g.K = D; g.A = nullptr; g.Bt = nullptr;
            pg8::StaticOrder S;
            if (s == 0) { g.N = NIN; S.init(M, NIN, G, blk); S.A0 = H; S.B0 = WinT; S.mode0 = 0; }
            else if (s == 1) { S.init(M, D, G, blk); S.dup = 3; S.A0 = H; S.B0 = WinT + (size_t)5120 * D; S.mode0 = 1;
                               S.A2 = HG; S.B2 = (const bf16_t*)(ws + WS_WHO) + (size_t)l * D * D; S.mode2 = 2; }
            else if (s == 2) { g.K = 512; S.init(M, D, G, blk); S.A0 = PG; S.B0 = (const bf16_t*)(ws + WS_WPO) + (size_t)l * D * 512; S.mode0 = 3; }
            else { S.init(M, D, G, blk); S.A0 = MERGED; S.B0 = (const bf16_t*)(ws + WS_WOUT) + (size_t)l * D * D; S.mode0 = 4; }
            EpiU E{ws};
#ifdef PROBE_G
            const unsigned long long tg0 = __builtin_amdgcn_s_memrealtime();
#endif
            pg8::gemm_phase<EpiU, pg8::StaticOrder, PG8_ALIGN_SEL, PG8_SP2_SEL>(lds, g, S, E);
#ifdef PROBE_G
            if ((PROBE_G >> s) & 1) probe_acc += __builtin_amdgcn_s_memrealtime() - tg0;
#endif
            if (s == 0) {
                GSYNC();
#ifdef PROBE_P3
                const unsigned long long tp0 = __builtin_amdgcn_s_memrealtime();
#endif
                bf16_t* Pg = (bf16_t*)(ws + WS_P); float* DECg = (float*)(ws + WS_DEC);
                float* SLOC = (float*)(ws + WS_P); float* DSEG = (float*)(ws + WS_DSEG);
                const bool own = (G == NB * 8 * NSEG);
                if (!own) prep_items(Q, LF, Pg, DECg, (const float*)(ws + WS_LB) + l * 1024, blk, G, 2048, lds);
                if ((G & 3) == 0) {
                    const int gq = blk & 3; const bf16_t* pw = (const bf16_t*)(ws + WS_POOLWT) + (size_t)(l * 4 + gq) * 16384; const float* ps = p.pool_scale + l * 512 + gq * 128;
                    __syncthreads();
                    if (gq == 0) pool_tiles<2>(PV, PG, pw, ps, gq, blk >> 2, G >> 2, lds); else if (gq == 1) pool_tiles<4>(PV, PG, pw, ps, gq, blk >> 2, G >> 2, lds);
                    else if (gq == 2) pool_tiles<8>(PV, PG, pw, ps, gq, blk >> 2, G >> 2, lds); else pool_tiles<16>(PV, PG, pw, ps, gq, blk >> 2, G >> 2, lds);
                } else for (int pi = blk; pi < 1024; pi += G) {
                    const int gq = pi & 3, m0 = (pi >> 2) * 64;
                    const bf16_t* pw = (const bf16_t*)(ws + WS_POOLWT) + (size_t)(l * 4 + gq) * 16384; const float* ps = p.pool_scale + l * 512 + gq * 128;
                    if (gq == 0) pool_item<2>(PV, PG, pw, ps, m0, gq, lds); else if (gq == 1) pool_item<4>(PV, PG, pw, ps, m0, gq, lds);
                    else if (gq == 2) pool_item<8>(PV, PG, pw, ps, m0, gq, lds); else pool_item<16>(PV, PG, pw, ps, m0, gq, lds);
                }
                if (own) { __syncthreads(); f_item(Q, LF, V, DECg, SLOC, DSEG, (const float*)(ws + WS_LB) + l * 1024, blk, lds); }
                if (!own) { GSYNC(); for (int it = blk; it < NB * 8 * NSEG; it += G) scan1_item(Q, LF, V, Pg, DECg, SLOC, DSEG, it, lds); }
                GSYNC();
                for (int it = blk; it < NB * 8 * NSEG; it += G) scan2_item(Q, V, HG, DECg, SLOC, DSEG, p.hgrn_norm_g + l * 128, it, lds);
                GSYNC();
            } else if (s >= 2) GSYNC();
        }
    }
#ifdef DUP_SYNC
    for (int i = 0; i < 16; ++i) GSYNC();
#endif
    p1_rows<true, false>(p.out, Y, ADA + (size_t)(NL - 1) * NB * 3072, p.g_post + (size_t)(NL - 1) * D, p.out, nullptr, nullptr, nullptr);
#if defined(PROBE_P3) || defined(PROBE_G)
    __syncthreads();
    if (blk == 0 && threadIdx.x == 0) p.out[0] = 25.f * floorf((float)probe_acc * 0.01f / 25.f + 0.5f);
#endif
}

extern "C" void kernel_launch(void* const* d_in, const int* in_sizes, int n_in, void* d_out, int out_size, void* d_ws, size_t ws_size, hipStream_t stream) {
    static int grid_blocks = 0;
    if (grid_blocks == 0) {
        if (n_in != 14 || out_size != M * D || ws_size < WS_END) { fprintf(stderr, "kernel_launch: unexpected problem (n_in %d out %d ws %zu)\n", n_in, out_size, ws_size); grid_blocks = -1; return; }
        int dev = 0, cus = 0, per_cu = 0;
        (void)hipGetDevice(&dev);
        (void)hipDeviceGetAttribute(&cus, hipDeviceAttributeMultiprocessorCount, dev);
        (void)hipFuncSetAttribute((const void*)fwd_megakernel, hipFuncAttributeMaxDynamicSharedMemorySize, LDS_BYTES);
        (void)hipOccupancyMaxActiveBlocksPerMultiprocessor(&per_cu, (const void*)fwd_megakernel, 512, LDS_BYTES);
        if (per_cu < 1) { fprintf(stderr, "kernel_launch: occupancy query says %d blocks per CU\n", per_cu); grid_blocks = -1; return; }
        grid_blocks = cus;
    }
    if (grid_blocks < 0) return;
    Params p{};
    p.x = (const float*)d_in[0]; p.c = (const float*)d_in[1]; p.w_ada = (const float*)d_in[2]; p.b_ada = (const float*)d_in[3]; p.g_pre = (const float*)d_in[4]; p.g_post = (const float*)d_in[5];
    p.w_in = (const float*)d_in[6]; p.pool_w = (const float*)d_in[7]; p.pool_scale = (const float*)d_in[8]; p.lb_logits = (const float*)d_in[9]; p.hgrn_norm_g = (const float*)d_in[10];
    p.w_pool_o = (const float*)d_in[11]; p.w_hgrn_o = (const float*)d_in[12]; p.w_out = (const float*)d_in[13];
    p.out = (float*)d_out; p.ws = (unsigned char*)d_ws;
#ifndef USE_CG_SYNC
    (void)hipMemsetAsync((unsigned char*)d_ws + WS_BAR, 0, XCD_BAR_WORDS * sizeof(unsigned), stream);
#endif
    void* args[] = {&p};
    hipError_t e = hipLaunchCooperativeKernel((const void*)fwd_megakernel, dim3(grid_blocks), dim3(512), args, LDS_BYTES, stream);
    if (e != hipSuccess) fprintf(stderr, "cooperative launch failed: %s (grid %d)\n", hipGetErrorString(e), grid_blocks);
}
```

```cpp
#define PG8_ALIGN_SEL true
#define PG8_SP2_SEL true
#include <hip/hip_runtime.h>
#include <hip/hip_cooperative_groups.h>
#include <cstdio>
#include <cstdint>
namespace cg = cooperative_groups;
#define LAS __attribute__((address_space(3)))
namespace pg8 {
#define PG8_LAS __attribute__((address_space(3)))
typedef unsigned short bf16_t;
typedef short bf16x8 __attribute__((ext_vector_type(8)));
typedef float f32x4 __attribute__((ext_vector_type(4)));
typedef unsigned u32x4 __attribute__((ext_vector_type(4)));
constexpr int BM = 256, BK = 64, HALF = 128, HTB = HALF * BK * 2  , STAGE_BYTES = 8 * HTB, NXCD = 8, WGM = 8;

__host__ __device__ __forceinline__ int lds_byte(int r, int c) { const int st = (r >> 4) * 2 + (c >> 5), rr = r & 15, cc = c & 31, ob = rr * 64 + cc * 2; return st * 1024 + (ob ^ (((ob >> 9) & 1) << 5)); }
__host__ __device__ __forceinline__ void stage_rc(int b, int& R, int& C) { const int st = b / 1024, sb = b % 1024, swz = sb ^ (((sb >> 9) & 1) << 5); R = (st >> 1) * 16 + swz / 64; C = (st & 1) * 32 + (swz % 64) / 2; }
__host__ __device__ __forceinline__ int perm32(int rho) { const int n = rho >> 4, i = rho & 15; return 8 * (i >> 2) + 4 * n + (i & 3); }

struct Unit { int pm, pn; const unsigned short* A; const unsigned short* Bt; int mode; };
struct Gemm { const bf16_t* A; const bf16_t* Bt; int M, N, K; };

struct StaticOrder {
    int nM, nN, nwg, G, c, dup;
    const unsigned short *A0, *B0, *A2, *B2; int mode0, mode2;
    __host__ __device__ void init(int M, int N, int G_, int c_) { nM = M / BM; nN = N / BM; nwg = nM * nN; G = G_; c = c_; dup = 0; A0 = B0 = A2 = B2 = nullptr; mode0 = mode2 = 0; }
    __host__ __device__ bool next(int i, Unit& u) const {
        if (dup > 0 && i >= dup) return false;
        const long L = (dup > 0) ? (long)c : (long)i * G + c; if (L >= nwg) return false;
        int wgid = (int)L; { const int q = nwg / NXCD, r = nwg % NXCD, xcd = wgid % NXCD, off = wgid / NXCD; wgid = (xcd < r ? xcd * (q + 1) : r * (q + 1) + (xcd - r) * q) + off; }
        const int nig = WGM * nN, gid = wgid / nig, fm = gid * WGM, gsz = (nM - fm) < WGM ? (nM - fm) : WGM;
        u.pm = fm + ((wgid % nig) % gsz); u.pn = (wgid % nig) / gsz + ((dup > 0 && i == 1) ? nN : 0);
        const bool third = (dup > 0 && i == 2);
        u.A = third ? A2 : A0; u.Bt = third ? B2 : B0; u.mode = third ? mode2 : mode0; return true;
    }
    __device__ __forceinline__ void a_ready(const Unit&) const {}
    __device__ __forceinline__ void done(const Unit&) const {}
};
__device__ __forceinline__ unsigned cvt_pk_bf16(float lo, float hi) { unsigned r; asm volatile("v_cvt_pk_bf16_f32 %0, %1, %2" : "=v"(r) : "v"(lo), "v"(hi)); return r; }
template <class Epi, class Sched, bool ALIGN_EPI = false, bool SP2 = false>
__device__ __forceinline__ void gemm_phase(PG8_LAS unsigned char* lds, const Gemm g, const Sched& S, const Epi& E) {
    int tid_l = threadIdx.x; asm volatile("" : "+v"(tid_l));
    const int tid = tid_l, wid = __builtin_amdgcn_readfirstlane(tid >> 6), lane = tid & 63, wr = wid >> 2, wc = wid & 3, fr = lane & 15, fq = lane >> 4;
    const int K = g.K, nt = K / BK;
    unsigned voffA[2], voffB[2];
#pragma unroll
    for (int i = 0; i < 2; ++i) { int R, C; stage_rc(tid * 16 + i * 8192, R, C); const int Rb = Epi::PERM ? ((R & ~31) + perm32(R & 31)) : R;
        voffA[i] = (unsigned)(R * K + C) * 2u; voffB[i] = (unsigned)(Rb * K + C) * 2u; }
    const size_t kstep = (size_t)(BK * 2);
    const size_t hstep = (size_t)HALF * K * 2;
    const size_t tstep = 2 * hstep;
    const unsigned ldsw = (unsigned)wid * 1024u;
    const int aoff = lds_byte(wr * 64 + fr, fq * 8), boff = lds_byte(wc * 32 + fr, fq * 8);
#define PG8_SA(b, h) (((b) * 2 + (h)) * HTB)
#define PG8_SB(b, h) ((4 + (b) * 2 + (h)) * HTB)
#define PG8_STAGE(bufoff, gbase, voff) do { _Pragma("unroll") for (int _i = 0; _i < 2; ++_i) \
        __builtin_amdgcn_global_load_lds((const unsigned*)((const char*)(gbase) + (voff)[_i]), (PG8_LAS unsigned*)(lds + (bufoff) + ldsw + _i * 8192), 16, 0, 0); } while (0)
#define PG8_LDA(dst, b, h) do { _Pragma("unroll") for (int m = 0; m < 4; ++m) _Pragma("unroll") for (int k = 0; k < 2; ++k) dst[m][k] = *(const PG8_LAS bf16x8*)(lds + PG8_SA(b, h) + aoff + m * 2048 + k * 1024); } while (0)
#define PG8_LDB(dst, b, h) do { _Pragma("unroll") for (int n = 0; n < 2; ++n) _Pragma("unroll") for (int k = 0; k < 2; ++k) dst[n][k] = *(const PG8_LAS bf16x8*)(lds + PG8_SB(b, h) + boff + n * 2048 + k * 1024); } while (0)
#define PG8_MMA(ai, bj, At, Bt) do { __builtin_amdgcn_s_setprio(1); _Pragma("unroll") for (int m = 0; m < 4; ++m) _Pragma("unroll") for (int n = 0; n < 2; ++n) _Pragma("unroll") for (int k = 0; k < 2; ++k) \
        acc[ai][bj][m][n] = __builtin_amdgcn_mfma_f32_16x16x32_bf16(Bt[n][k], At[m][k], acc[ai][bj][m][n], 0, 0, 0); __builtin_amdgcn_s_setprio(0); } while (0)
#define PG8_WAIT_V(n) asm volatile("s_waitcnt vmcnt(" #n ")" ::: "memory")
#define PG8_WAIT_L(n) asm volatile("s_waitcnt lgkmcnt(" #n ")" ::: "memory")
#define PG8_BAR __builtin_amdgcn_s_barrier()
#define PG8_SCHED __builtin_amdgcn_sched_barrier(0)
    Unit cur, nxt; int ui = 0;
    if (!S.next(0, cur)) return;
    f32x4 acc[2][2][4][2];
#pragma unroll
    for (int a = 0; a < 2; ++a)
#pragma unroll
        for (int b = 0; b < 2; ++b)
#pragma unroll
            for (int m = 0; m < 4; ++m)
#pragma unroll
                for (int n = 0; n < 2; ++n) acc[a][b][m][n] = (f32x4){0.f, 0.f, 0.f, 0.f};
    bf16x8 At[4][2], B0[2][2], B1[2][2];
    const char* cA = (const char*)cur.A + (size_t)cur.pm * tstep; const char* cB = (const char*)cur.Bt + (size_t)cur.pn * tstep;
    S.a_ready(cur);
    if constexpr (SP2) {
        PG8_STAGE(PG8_SB(0, 0), cB, voffB); PG8_STAGE(PG8_SB(0, 1), cB + hstep, voffB); PG8_STAGE(PG8_SA(0, 0), cA, voffA); PG8_STAGE(PG8_SA(0, 1), cA + hstep, voffA);
        if (wr == 1) PG8_BAR;
        PG8_WAIT_V(2); PG8_BAR;
        PG8_STAGE(PG8_SB(1, 0), cB + kstep, voffB); PG8_STAGE(PG8_SA(1, 0), cA + kstep, voffA); PG8_STAGE(PG8_SB(1, 1), cB + hstep + kstep, voffB);
        PG8_WAIT_V(6); PG8_BAR;
    } else {
        PG8_STAGE(PG8_SB(0, 0), cB, voffB); PG8_STAGE(PG8_SA(0, 0), cA, voffA); PG8_STAGE(PG8_SB(0, 1), cB + hstep, voffB); PG8_STAGE(PG8_SA(0, 1), cA + hstep, voffA);
        if (wr == 1) PG8_BAR;
        PG8_WAIT_V(4); PG8_BAR;
        PG8_STAGE(PG8_SB(1, 0), cB + kstep, voffB); PG8_STAGE(PG8_SA(1, 0), cA + kstep, voffA); PG8_STAGE(PG8_SB(1, 1), cB + hstep + kstep, voffB);
        PG8_WAIT_V(6); PG8_BAR;
    }
    for (;;) {
        const bool has_next = S.next(ui + 1, nxt);
        const char* nA = has_next ? (const char*)nxt.A + (size_t)nxt.pm * tstep : cA; const char* nB = has_next ? (const char*)nxt.Bt + (size_t)nxt.pn * tstep : cB;
        for (int t = 0; t < nt; t += 2) {
            const bool last = (t == nt - 2);
            const char* a1 = cA + (size_t)(t + 1) * kstep;
            const char* a2 = last ? nA : cA + (size_t)(t + 2) * kstep; const char* b2 = last ? nB : cB + (size_t)(t + 2) * kstep;
            const char* a3 = a2 + kstep; const char* b3 = b2 + kstep;
            if (last && has_next) S.a_ready(nxt);
            if constexpr (SP2) {
            PG8_LDB(B0, 0, 0); PG8_LDB(B1, 0, 1); PG8_SCHED; PG8_LDA(At, 0, 0); PG8_STAGE(PG8_SA(1, 1), a1 + hstep, voffA);
            PG8_WAIT_V(8); PG8_WAIT_L(0); PG8_BAR; PG8_MMA(0, 0, At, B0); PG8_MMA(0, 1, At, B1); PG8_BAR; PG8_SCHED;
            PG8_LDA(At, 0, 1); PG8_STAGE(PG8_SB(0, 0), b2, voffB); PG8_STAGE(PG8_SB(0, 1), b2 + hstep, voffB); PG8_STAGE(PG8_SA(0, 0), a2, voffA);
            PG8_WAIT_V(8); PG8_WAIT_L(0); PG8_BAR; PG8_MMA(1, 0, At, B0); PG8_MMA(1, 1, At, B1); PG8_BAR; PG8_SCHED;
            PG8_LDB(B0, 1, 0); PG8_LDB(B1, 1, 1); PG8_SCHED; PG8_LDA(At, 1, 0); PG8_STAGE(PG8_SA(0, 1), a2 + hstep, voffA);
            PG8_WAIT_V(8); PG8_WAIT_L(0); PG8_BAR; PG8_MMA(0, 0, At, B0); PG8_MMA(0, 1, At, B1); PG8_BAR; PG8_SCHED;
            PG8_LDA(At, 1, 1); PG8_STAGE(PG8_SB(1, 0), b3, voffB); PG8_STAGE(PG8_SB(1, 1), b3 + hstep, voffB); PG8_STAGE(PG8_SA(1, 0), a3, voffA);
            PG8_WAIT_V(8); PG8_WAIT_L(0); PG8_BAR; PG8_MMA(1, 0, At, B0); PG8_MMA(1, 1, At, B1); PG8_BAR; PG8_SCHED;
            } else {
            PG8_LDB(B0, 0, 0); PG8_SCHED; PG8_LDA(At, 0, 0); PG8_STAGE(PG8_SA(1, 1), a1 + hstep, voffA);
            PG8_WAIT_L(8); PG8_BAR; PG8_WAIT_L(0); PG8_MMA(0, 0, At, B0); PG8_BAR; PG8_SCHED;
            PG8_LDB(B1, 0, 1); PG8_STAGE(PG8_SB(0, 0), b2, voffB);
            PG8_BAR; PG8_WAIT_L(0); PG8_MMA(0, 1, At, B1); PG8_BAR;
            PG8_LDA(At, 0, 1); PG8_STAGE(PG8_SA(0, 0), a2, voffA);
            PG8_BAR; PG8_WAIT_L(0); PG8_MMA(1, 0, At, B0); PG8_BAR; PG8_SCHED;
            PG8_STAGE(PG8_SB(0, 1), b2 + hstep, voffB);
            PG8_WAIT_V(6); PG8_BAR; PG8_MMA(1, 1, At, B1); PG8_BAR;
            PG8_LDB(B0, 1, 0); PG8_SCHED; PG8_LDA(At, 1, 0); PG8_STAGE(PG8_SA(0, 1), a2 + hstep, voffA);
            PG8_WAIT_L(8); PG8_BAR; PG8_WAIT_L(0); PG8_MMA(0, 0, At, B0); PG8_BAR; PG8_SCHED;
            PG8_LDB(B1, 1, 1); PG8_STAGE(PG8_SB(1, 0), b3, voffB);
            PG8_BAR; PG8_WAIT_L(0); PG8_MMA(0, 1, At, B1); PG8_BAR;
            PG8_LDA(At, 1, 1); PG8_STAGE(PG8_SA(1, 0), a3, voffA);
            PG8_BAR; PG8_WAIT_L(0); PG8_MMA(1, 0, At, B0); PG8_BAR; PG8_SCHED;
            PG8_STAGE(PG8_SB(1, 1), b3 + hstep, voffB);
            PG8_WAIT_V(6); PG8_BAR; PG8_MMA(1, 1, At, B1); PG8_BAR;
            }
        }
        if constexpr (ALIGN_EPI) { if (wr == 0) PG8_BAR; }
        if constexpr (!Epi::AFTER_DRAIN) { E(acc, cur, wr, wc, fr, fq); S.done(cur); }
        if (!has_next) break;
#pragma unroll
        for (int a = 0; a < 2; ++a)
#pragma unroll
            for (int b = 0; b < 2; ++b)
#pragma unroll
                for (int m = 0; m < 4; ++m)
#pragma unroll
                    for (int n = 0; n < 2; ++n) acc[a][b][m][n] = (f32x4){0.f, 0.f, 0.f, 0.f};
        cur = nxt; cA = nA; cB = nB; ++ui;
        if constexpr (ALIGN_EPI) { if (wr == 1) PG8_BAR; }
    }
    PG8_WAIT_V(0);
    if constexpr (!ALIGN_EPI) { if (wr == 0) PG8_BAR; }
    PG8_BAR;
    if constexpr (Epi::AFTER_DRAIN) { E.fused(acc, cur, wr, wc, fr, fq, lds, wid, lane); S.done(cur); }
#undef PG8_SA
#undef PG8_SB
#undef PG8_STAGE
#undef PG8_LDA
#undef PG8_LDB
#undef PG8_MMA
#undef PG8_WAIT_V
#undef PG8_WAIT_L
#undef PG8_BAR
#undef PG8_SCHED
}
}
#define XB_TMO      128
#define XB_XCNT(j)  (256  + 64 * (j))
#define XB_XSUB(j)  (1280 + 64 * (j))
#define XB_XGEN(j)  (2304 + 64 * (j))
#define XB_TOP      3328
#define XB_TOPGEN   3392
#define XCD_BAR_WORDS 3456
#define XB_SPIN_CAP (1u << 18)

__device__ __forceinline__ unsigned xb_ld(unsigned* p)              { return __hip_atomic_load(p, __ATOMIC_RELAXED, __HIP_MEMORY_SCOPE_AGENT); }
__device__ __forceinline__ unsigned xb_add(unsigned* p, unsigned v) { return __hip_atomic_fetch_add(p, v, __ATOMIC_RELAXED, __HIP_MEMORY_SCOPE_AGENT); }
__device__ __forceinline__ unsigned xb_xcc_id() { return (unsigned)__builtin_amdgcn_s_getreg((3 << 11) | 20) & 0xFu; }
#define XB_SPIN(cond, bar) do { unsigned _sp = 0; while (cond) { __builtin_amdgcn_s_sleep(1); \
    if ((++_sp & 255u) == 0u) { if (xb_ld(&(bar)[XB_TMO])) break; if (_sp > XB_SPIN_CAP) { atomicAdd(&(bar)[XB_TMO], 1u); break; } } } } while (0)

struct XcdBarrier {
    unsigned* bar; unsigned x;
    volatile LAS unsigned* st;
};

__device__ __forceinline__ XcdBarrier xcd_barrier_post(unsigned* bar, volatile LAS unsigned* st) {
    XcdBarrier b; b.bar = bar; b.x = xb_xcc_id(); b.st = st;
    if (threadIdx.x == 0) (void)xb_add(&bar[XB_XCNT(b.x)], 1u);
    return b;
}
__device__ __forceinline__ void xcd_barrier_complete(unsigned* bar, unsigned x, unsigned& nloc, unsigned& nx) {
    const unsigned G = gridDim.x * gridDim.y * gridDim.z;
    unsigned sum, cnt, mine, sp = 0u;
    for (;;) {
        sum = 0u; cnt = 0u; mine = 0u;
#pragma unroll
        for (unsigned j = 0; j < 16; ++j) { const unsigned c = xb_ld(&bar[XB_XCNT(j)]); sum += c; cnt += (c > 0u) ? 1u : 0u; mine = (j == x) ? c : mine; }
        if (sum == G) break;
        __builtin_amdgcn_s_sleep(1);
        if ((++sp & 255u) == 0u) { if (xb_ld(&bar[XB_TMO])) break; if (sp > XB_SPIN_CAP) { atomicAdd(&bar[XB_TMO], 1u); break; } }
    }
    nloc = mine > 0u ? mine : 1u; nx = cnt > 0u ? cnt : 1u;
}

__device__ __forceinline__ void xcd_barrier(const XcdBarrier& b) {
    asm volatile("s_waitcnt vmcnt(0)" ::: "memory");
    __syncthreads();
    if (threadIdx.x == 0) {
        unsigned* bar = b.bar;
        __builtin_amdgcn_s_waitcnt(0);
        unsigned nloc = b.st[0], nx = b.st[1];
        if (nloc == 0u) { xcd_barrier_complete(bar, b.x, nloc, nx); b.st[0] = nloc; b.st[1] = nx; }
        const unsigned old = xb_add(&bar[XB_XSUB(b.x)], 1u);
        const unsigned gen = old / nloc;
        if (old + 1u == (gen + 1u) * nloc) {
            __builtin_amdgcn_fence(__ATOMIC_RELEASE, "agent");
            asm volatile("s_waitcnt vmcnt(0)" ::: "memory");
            const unsigned og = xb_add(&bar[XB_TOP], 1u);
            const unsigned tg = og / nx;
            if (og + 1u == (tg + 1u) * nx) xb_add(&bar[XB_TOPGEN], 1u);
            else XB_SPIN(xb_ld(&bar[XB_TOPGEN]) == tg, bar);
            __builtin_amdgcn_fence(__ATOMIC_ACQUIRE, "agent");
            xb_add(&bar[XB_XGEN(b.x)], 1u);
            asm volatile("s_waitcnt vmcnt(0)" ::: "memory");
        } else {
            XB_SPIN(xb_ld(&bar[XB_XGEN(b.x)]) == gen, bar);
            __builtin_amdgcn_fence(__ATOMIC_ACQUIRE, "agent");
            asm volatile("s_waitcnt vmcnt(0)" ::: "memory");
        }
    }
    __syncthreads();
}


constexpr int NB = 8, SEQ = 2048, D = 1024, M = NB * SEQ, NL = 2, INW = 7168, NIN = 5120;
constexpr float EPS = 1e-6f;
#define LAS __attribute__((address_space(3)))
typedef unsigned short bf16_t;
typedef short bf16x8 __attribute__((ext_vector_type(8)));
typedef float f32x4 __attribute__((ext_vector_type(4)));
typedef float f32x2 __attribute__((ext_vector_type(2)));
typedef unsigned u32x4 __attribute__((ext_vector_type(4)));
typedef unsigned u32x2 __attribute__((ext_vector_type(2)));
typedef __bf16 bf2_t __attribute__((ext_vector_type(2)));
typedef _Float16 h2_t __attribute__((ext_vector_type(2)));

constexpr size_t MiB = 1u << 20;
constexpr size_t WS_ADA = 0;
constexpr size_t WS_LB = 256 * 1024;
constexpr size_t WS_POOLWT = 512 * 1024;
constexpr size_t WS_WIN = 1 * MiB;
constexpr size_t WS_WPO = 29 * MiB;
constexpr size_t WS_WHO = 31 * MiB;
constexpr size_t WS_WOUT = 35 * MiB;
constexpr size_t WS_H = 40 * MiB;
constexpr size_t WS_PV = 72 * MiB;
constexpr size_t WS_PG = 88 * MiB;
constexpr size_t WS_Q = 104 * MiB;
constexpr size_t WS_LF = 136 * MiB;
constexpr size_t WS_V = 168 * MiB;
constexpr size_t WS_HG = 200 * MiB;
constexpr size_t WS_P = 232 * MiB;
constexpr size_t WS_DEC = 248 * MiB;
constexpr size_t WS_BAR = 250 * MiB;
constexpr size_t WS_DSEG = 251 * MiB;
constexpr size_t WS_END = 253 * MiB;
constexpr int LDS_BYTES = 147456, LDS_BARW = 147392;

__device__ __forceinline__ unsigned pk_bf16(float lo, float hi) { bf2_t r = __builtin_convertvector((f32x2){lo, hi}, bf2_t); return __builtin_bit_cast(unsigned, r); }
__device__ __forceinline__ unsigned pk_f16(float lo, float hi) { h2_t r = __builtin_convertvector((f32x2){lo, hi}, h2_t); return __builtin_bit_cast(unsigned, r); }
__device__ __forceinline__ float bf_lo(unsigned w) { return __uint_as_float(w << 16); }
__device__ __forceinline__ float bf_hi(unsigned w) { return __uint_as_float(w & 0xffff0000u); }
__device__ __forceinline__ float h_lo(unsigned w) { h2_t r = __builtin_bit_cast(h2_t, w); return (float)r.x; }
__device__ __forceinline__ float h_hi(unsigned w) { h2_t r = __builtin_bit_cast(h2_t, w); return (float)r.y; }
__device__ __forceinline__ float fexp(float x) { return __builtin_amdgcn_exp2f(x * 1.44269504088896f); }
__device__ __forceinline__ float flog(float x) { return __builtin_amdgcn_logf(x) * 0.693147180559945f; }
__device__ __forceinline__ float sigmoid_f(float x) { return __builtin_amdgcn_rcpf(1.f + fexp(-x)); }
__device__ __forceinline__ float silu_f(float x) { return x * sigmoid_f(x); }
__device__ __forceinline__ float dpp_f(float v, const int ctrl_unused) { return v; }
#define DPP_ADD(v, ctrl) ((v) + __builtin_bit_cast(float, __builtin_amdgcn_update_dpp(0, __builtin_bit_cast(int, (v)), (ctrl), 0xf, 0xf, true)))
__device__ __forceinline__ float wave_sum(float v) {
    v = DPP_ADD(v, 0xB1);
    v = DPP_ADD(v, 0x4E);
    v = DPP_ADD(v, 0x124);
    v = DPP_ADD(v, 0x128);
    return (__builtin_amdgcn_readlane(v, 0) + __builtin_amdgcn_readlane(v, 16)) + (__builtin_amdgcn_readlane(v, 32) + __builtin_amdgcn_readlane(v, 48));
}
#define LBAR() do { asm volatile("s_waitcnt lgkmcnt(0)" ::: "memory"); __builtin_amdgcn_s_barrier(); asm volatile("" ::: "memory"); } while (0)
#define MFMA16(a, b, c) __builtin_amdgcn_mfma_f32_16x16x32_bf16((a), (b), (c), 0, 0, 0)

__device__ __forceinline__ void p0_transpose_item(const float* W, int K, int N, bf16_t* WT, LAS float* scr, int item, int lane) {
    const int nblk = N / 32, kb = item / nblk, nb = item % nblk, k0 = 64 * kb, n0 = 32 * nb;
#pragma unroll
    for (int i = 0; i < 32; ++i) { const int kk = 2 * i + (lane >> 5); scr[kk * 33 + (lane & 31)] = __builtin_nontemporal_load(W + (size_t)(k0 + kk) * N + n0 + (lane & 31)); }
    asm volatile("s_waitcnt lgkmcnt(0)" ::: "memory");
    const int c = lane & 7;
#pragma unroll
    for (int j = 0; j < 4; ++j) { const int n = (lane >> 3) + 8 * j; const LAS float* s = scr + (8 * c) * 33 + n;
        u32x4 o; o.x = pk_bf16(s[0 * 33], s[1 * 33]); o.y = pk_bf16(s[2 * 33], s[3 * 33]); o.z = pk_bf16(s[4 * 33], s[5 * 33]); o.w = pk_bf16(s[6 * 33], s[7 * 33]);
        *(u32x4*)(WT + (size_t)(n0 + n) * K + k0 + 8 * c) = o; }
    asm volatile("s_waitcnt lgkmcnt(0)" ::: "memory");
}

struct Params {
    const float *x, *c, *w_ada, *b_ada, *g_pre, *g_post, *w_in, *pool_w, *pool_scale, *lb_logits, *hgrn_norm_g, *w_pool_o, *w_hgrn_o, *w_out;
    float* out; unsigned char* ws;
};

__device__ __forceinline__ void p0_prologue(const Params& p, LAS unsigned char* lds) {
    const int tid = threadIdx.x, lane = tid & 63, wave = tid >> 6, blk = blockIdx.x, G = gridDim.x;
    float* ADA = (float*)(p.ws + WS_ADA);
    LAS float* cact = (LAS float*)(lds + 73728);
    LAS float* red = (LAS float*)(lds + 73728 + 32768);
    for (int job = blk; job < 192; job += G) {
        for (int i = tid; i < NB * D; i += 512) cact[i] = silu_f(p.c[i]);
        __syncthreads();
        const int l = job / 96, j0 = (job % 96) * 32, j = tid & 31, ks = tid >> 5;
        const float* w = p.w_ada + ((size_t)l * D + ks * 64) * 3072 + j0 + j;
        float a0 = 0.f, a1 = 0.f, a2 = 0.f, a3 = 0.f, a4 = 0.f, a5 = 0.f, a6 = 0.f, a7 = 0.f;
#pragma unroll 32
        for (int d = 0; d < 64; ++d) { const float wv = __builtin_nontemporal_load(w + (size_t)d * 3072); const LAS float* cc = cact + ks * 64 + d;
            a0 += cc[0] * wv; a1 += cc[1024] * wv; a2 += cc[2048] * wv; a3 += cc[3072] * wv; a4 += cc[4096] * wv; a5 += cc[5120] * wv; a6 += cc[6144] * wv; a7 += cc[7168] * wv; }
        LAS float* rr = red + (ks * 8) * 32 + j;
        rr[0] = a0; rr[32] = a1; rr[64] = a2; rr[96] = a3; rr[128] = a4; rr[160] = a5; rr[192] = a6; rr[224] = a7;
        __syncthreads();
        if (tid < 256) { const int b = tid >> 5; float s = p.b_ada[l * 3072 + j0 + j];
#pragma unroll
            for (int k2 = 0; k2 < 16; ++k2) s += red[(k2 * 8 + b) * 32 + j];
            ADA[(size_t)(l * NB + b) * 3072 + j0 + j] = s; }
        __syncthreads();
    }
    if (blk == G - 1) { float* LB = (float*)(p.ws + WS_LB);
        for (int j = tid; j < 1024; j += 512) { const float l0 = p.lb_logits[j], l1 = p.lb_logits[1024 + j], mx = fmaxf(l0, l1), e0 = fexp(l0 - mx), e1 = fexp(l1 - mx);
            const float p0 = e0 / (e0 + e1), p1 = e1 / (e0 + e1); const float c1 = (p0 + p1) - p0;
            LB[j] = 0.f; LB[1024 + j] = fminf(fmaxf(c1, 0.f), 1.f); } }
    LAS float* scr = (LAS float*)(lds + wave * 8448);
    constexpr int I_IN = (D / 64) * (INW / 32), I_PO = (512 / 64) * (D / 32), I_HO = (D / 64) * (D / 32), I_OUT = I_HO, I_PW = 4 * 8, I_LAYER = I_IN + I_PO + I_HO + I_OUT + I_PW;
    bf16_t* WinT = (bf16_t*)(p.ws + WS_WIN); bf16_t* WpoT = (bf16_t*)(p.ws + WS_WPO); bf16_t* WhoT = (bf16_t*)(p.ws + WS_WHO); bf16_t* WoutT = (bf16_t*)(p.ws + WS_WOUT); bf16_t* PoolWT = (bf16_t*)(p.ws + WS_POOLWT);
    for (int it = blk * 8 + wave; it < NL * I_LAYER; it += G * 8) {
        int r = it; const int l = r / I_LAYER; r -= l * I_LAYER;
        if (r < I_IN) { p0_transpose_item(p.w_in + (size_t)l * D * INW, D, INW, WinT + (size_t)l * INW * D, scr, r, lane); continue; } r -= I_IN;
        if (r < I_PO) { p0_transpose_item(p.w_pool_o + (size_t)l * 512 * D, 512, D, WpoT + (size_t)l * D * 512, scr, r, lane); continue; } r -= I_PO;
        if (r < I_HO) { p0_transpose_item(p.w_hgrn_o + (size_t)l * D * D, D, D, WhoT + (size_t)l * D * D, scr, r, lane); continue; } r -= I_HO;
        if (r < I_OUT) { p0_transpose_item(p.w_out + (size_t)l * D * D, D, D, WoutT + (size_t)l * D * D, scr, r, lane); continue; } r -= I_OUT;
        { const int g = r >> 3; r &= 7; p0_transpose_item(p.pool_w + (size_t)(l * 4 + g) * 16384, 128, 128, PoolWT + (size_t)(l * 4 + g) * 16384, scr, r, lane); }
    }
}

template <bool HAS_PREV, bool MAKE_H>
__device__ __forceinline__ void p1_rows(const float* xprev, const bf16_t* Y, const float* ada_prev, const float* gpost, float* xout, const float* gpre, const float* ada_cur, bf16_t* H) {
    int tid_l = threadIdx.x; asm volatile("" : "+v"(tid_l));
    const int lane = tid_l & 63, wave = tid_l >> 6;
    const int NW = gridDim.x * 8, rpw = (M + NW - 1) / NW, gw = blockIdx.x * 8 + wave;
    const int mbeg = gw * rpw, mend = (mbeg + rpw < M) ? mbeg + rpw : M;
    if (mbeg >= mend) return;
    f32x4 ga[4], hm[4], hs[4];
    int bcur = -1;
    f32x4 vn[4]; u32x2 yn[4];
#pragma unroll
    for (int j = 0; j < 4; ++j) { vn[j] = __builtin_nontemporal_load((const f32x4*)(xprev + (size_t)mbeg * D) + lane + 64 * j); if (HAS_PREV) yn[j] = ((const u32x2*)(Y + (size_t)mbeg * D) + lane)[64 * j]; else yn[j] = (u32x2){0u, 0u}; }
    for (int m = mbeg; m < mend; ++m) {
        const int b = m >> 11;
        if (b != bcur) { bcur = b;
#pragma unroll
            for (int j = 0; j < 4; ++j) {
                if (HAS_PREV) ga[j] = ((const f32x4*)(ada_prev + (size_t)b * 3072 + 2048) + lane)[64 * j] * ((const f32x4*)gpost + lane)[64 * j]; else ga[j] = (f32x4){0.f, 0.f, 0.f, 0.f};
                if (MAKE_H) { hm[j] = ((const f32x4*)gpre + lane)[64 * j] * (((const f32x4*)(ada_cur + (size_t)b * 3072 + 1024) + lane)[64 * j] + 1.f); hs[j] = ((const f32x4*)(ada_cur + (size_t)b * 3072) + lane)[64 * j]; }
                else { hm[j] = (f32x4){0.f, 0.f, 0.f, 0.f}; hs[j] = hm[j]; } } }
        f32x4 v[4]; u32x2 yw[4];
#pragma unroll
        for (int j = 0; j < 4; ++j) { v[j] = vn[j]; yw[j] = yn[j]; }
        { const int mn = (m + 1 < mend) ? m + 1 : m;
#pragma unroll
          for (int j = 0; j < 4; ++j) { vn[j] = __builtin_nontemporal_load((const f32x4*)(xprev + (size_t)mn * D) + lane + 64 * j); if (HAS_PREV) yn[j] = ((const u32x2*)(Y + (size_t)mn * D) + lane)[64 * j]; } }
        if (HAS_PREV) {
            f32x4 y[4]; float ss = 0.f;
#pragma unroll
            for (int j = 0; j < 4; ++j) { y[j] = (f32x4){bf_lo(yw[j].x), bf_hi(yw[j].x), bf_lo(yw[j].y), bf_hi(yw[j].y)}; ss += (y[j].x * y[j].x + y[j].y * y[j].y) + (y[j].z * y[j].z + y[j].w * y[j].w); }
            const float rstd = rsqrtf(wave_sum(ss) * (1.f / D) + EPS);
            f32x4* xo = (f32x4*)(xout + (size_t)m * D) + lane;
#pragma unroll
            for (int j = 0; j < 4; ++j) { v[j] = v[j] + ga[j] * (y[j] * rstd); __builtin_nontemporal_store(v[j], xo + 64 * j); }
        }
        if (MAKE_H) {
            float ss = 0.f;
#pragma unroll
            for (int j = 0; j < 4; ++j) ss += (v[j].x * v[j].x + v[j].y * v[j].y) + (v[j].z * v[j].z + v[j].w * v[j].w);
            const float rstd = rsqrtf(wave_sum(ss) * (1.f / D) + EPS);
            u32x2* ho = (u32x2*)(H + (size_t)m * D) + lane;
#pragma unroll
            for (int j = 0; j < 4; ++j) { const f32x4 hv = (v[j] * rstd) * hm[j] + hs[j]; u32x2 w; w.x = pk_bf16(hv.x, hv.y); w.y = pk_bf16(hv.z, hv.w); ho[64 * j] = w; }
        }
    }
}

struct EpiU {
    static constexpr bool PERM = true, AFTER_DRAIN = false;
    unsigned char* ws;
    __device__ __forceinline__ void operator()(const f32x4 (&acc)[2][2][4][2], const pg8::Unit& u, int wr, int wc, int fr, int fq) const {
        const int pn = u.pn, mode = u.mode; const int row0 = u.pm * 256 + wr * 64 + fr;
        size_t boff; int ld = 1024, colt = pn * 256, op;
        if (mode == 0) {
            if (pn < 2) { boff = WS_PV; ld = 512; op = 0; }
            else if (pn < 4) { boff = WS_PG; ld = 512; colt = (pn - 2) * 256; op = 0; }
            else if (pn < 8) { boff = WS_Q; colt = (pn - 4) * 256; op = 0; }
            else if (pn < 12) { boff = WS_LF; colt = (pn - 8) * 256; op = 2; }
            else if (pn < 16) { boff = WS_V; colt = (pn - 12) * 256; op = 0; }
            else { boff = WS_HG; colt = (pn - 16) * 256; op = 0; }
        } else if (mode == 1) { boff = (pn < 4) ? WS_Q : WS_V; colt = (pn & 3) * 256; op = 3; }
        else if (mode == 2) { boff = WS_LF; op = 4; }
        else if (mode == 3) { boff = WS_LF; op = 5; }
        else { boff = WS_V; op = 0; }
        bf16_t* base = (bf16_t*)(ws + boff); const bf16_t* Gp = (const bf16_t*)(ws + (mode == 2 ? WS_V : WS_Q));
        const int col0 = colt + wc * 32 + 8 * fq;
#pragma unroll
        for (int ai = 0; ai < 2; ++ai) {
            u32x4 gq[4][2], tq[4][2];
#pragma unroll
            for (int m = 0; m < 4; ++m)
#pragma unroll
                for (int bj = 0; bj < 2; ++bj) { gq[m][bj] = (u32x4){0u, 0u, 0u, 0u}; tq[m][bj] = gq[m][bj]; }
            if (op >= 4) {
#pragma unroll
                for (int m = 0; m < 4; ++m)
#pragma unroll
                    for (int bj = 0; bj < 2; ++bj) gq[m][bj] = *(const u32x4*)(Gp + (size_t)(row0 + ai * 128 + m * 16) * ld + col0 + bj * 128);
                if (op == 5) {
#pragma unroll
                    for (int m = 0; m < 4; ++m)
#pragma unroll
                        for (int bj = 0; bj < 2; ++bj) tq[m][bj] = *(const u32x4*)(base + (size_t)(row0 + ai * 128 + m * 16) * ld + col0 + bj * 128); }
            }
            asm volatile("" ::: "memory");
#pragma unroll
            for (int m = 0; m < 4; ++m) { const size_t off = (size_t)(row0 + ai * 128 + m * 16) * ld + col0;
#pragma unroll
                for (int bj = 0; bj < 2; ++bj) { f32x4 v0 = acc[ai][bj][m][0], v1 = acc[ai][bj][m][1];
                    if (op == 1) {
#pragma unroll
                        for (int j = 0; j < 4; ++j) { v0[j] = silu_f(v0[j]); v1[j] = silu_f(v1[j]); }
                    } else if (op == 3) {
#pragma unroll
                        for (int j = 0; j < 4; ++j) { v0[j] = sigmoid_f(v0[j]); v1[j] = sigmoid_f(v1[j]); }
                    } else if (op >= 4) { const u32x4 g = gq[m][bj];
                        v0 = v0 * (f32x4){bf_lo(g.x), bf_hi(g.x), bf_lo(g.y), bf_hi(g.y)}; v1 = v1 * (f32x4){bf_lo(g.z), bf_hi(g.z), bf_lo(g.w), bf_hi(g.w)};
                        if (op == 5) { const u32x4 t = tq[m][bj];
                            v0 = v0 + (f32x4){bf_lo(t.x), bf_hi(t.x), bf_lo(t.y), bf_hi(t.y)}; v1 = v1 + (f32x4){bf_lo(t.z), bf_hi(t.z), bf_lo(t.w), bf_hi(t.w)}; } }
                    u32x4 w;
                    if (op == 2) { w.x = pk_f16(v0[0], v0[1]); w.y = pk_f16(v0[2], v0[3]); w.z = pk_f16(v1[0], v1[1]); w.w = pk_f16(v1[2], v1[3]); }
                    else { w.x = pk_bf16(v0[0], v0[1]); w.y = pk_bf16(v0[2], v0[3]); w.z = pk_bf16(v1[0], v1[1]); w.w = pk_bf16(v1[2], v1[3]); }
                    *(u32x4*)(base + off + bj * 128) = w; } }
        }
    }
};

constexpr int AP_STRIDE = 136;
template <int W>
__device__ __forceinline__ void pool_item(const bf16_t* PV, bf16_t* PG, const bf16_t* PoolWT_g, const float* pscale_g, int m0, int g, LAS unsigned char* lds) {
    int tid_l = threadIdx.x; asm volatile("" : "+v"(tid_l));
    const int tid = tid_l, lane = tid & 63, wv = tid >> 6, r = lane & 15, q = lane >> 4;
    const int pos0 = (m0 & (SEQ - 1)) + wv * 8;
    const bf16_t* src = PV + (size_t)(m0 + wv * 8) * 512 + g * 128 + 2 * lane;
    float r0[W + 7], r1[W + 7];
#pragma unroll
    for (int i = 0; i < W + 7; ++i) { const int pp = pos0 - (W - 1) + i; unsigned w = 0u; if (pp >= 0) w = *(const unsigned*)(src + (ptrdiff_t)(i - (W - 1)) * 512); r0[i] = bf_lo(w); r1[i] = bf_hi(w); }
    bf16x8 wf[4]; u32x2 gw[4];
#pragma unroll
    for (int ks = 0; ks < 4; ++ks) wf[ks] = *(const bf16x8*)(PoolWT_g + (16 * wv + r) * 128 + ks * 32 + q * 8);
#pragma unroll
    for (int mt = 0; mt < 4; ++mt) gw[mt] = *(const u32x2*)(PG + (size_t)(m0 + mt * 16 + r) * 512 + g * 128 + 16 * wv + q * 4);
    const f32x4 sc = *(const f32x4*)(pscale_g + 16 * wv + q * 4);
    float s0 = 0.f, s1 = 0.f;
#pragma unroll
    for (int i = 0; i < W - 1; ++i) { s0 += r0[i]; s1 += r1[i]; }
    LAS bf16_t* AP = (LAS bf16_t*)lds;
    __syncthreads();
#pragma unroll
    for (int i = 0; i < 8; ++i) { s0 += r0[W - 1 + i]; s1 += r1[W - 1 + i];
        const int pos = pos0 + i; const float inv = 1.f / (float)(pos + 1 < W ? pos + 1 : W);
        *(LAS unsigned*)(AP + (wv * 8 + i) * AP_STRIDE + 2 * lane) = pk_bf16(s0 * inv - r0[W - 1 + i], s1 * inv - r1[W - 1 + i]);
        s0 -= r0[i]; s1 -= r1[i]; }
    __syncthreads();
    f32x4 o[4];
#pragma unroll
    for (int mt = 0; mt < 4; ++mt) o[mt] = (f32x4){0.f, 0.f, 0.f, 0.f};
    bf16x8 af[16];
#pragma unroll
    for (int ks = 0; ks < 4; ++ks)
#pragma unroll
        for (int mt = 0; mt < 4; ++mt) af[ks * 4 + mt] = *(const LAS bf16x8*)(AP + (mt * 16 + r) * AP_STRIDE + ks * 32 + q * 8);
    __builtin_amdgcn_sched_barrier(0);
#pragma unroll
    for (int ks = 0; ks < 4; ++ks)
#pragma unroll
        for (int mt = 0; mt < 4; ++mt) o[mt] = MFMA16(wf[ks], af[ks * 4 + mt], o[mt]);
#pragma unroll
    for (int mt = 0; mt < 4; ++mt) { bf16_t* pp = PG + (size_t)(m0 + mt * 16 + r) * 512 + g * 128 + 16 * wv + q * 4;
        const f32x4 ov = o[mt] * sc * (f32x4){silu_f(bf_lo(gw[mt].x)), silu_f(bf_hi(gw[mt].x)), silu_f(bf_lo(gw[mt].y)), silu_f(bf_hi(gw[mt].y))};
        u32x2 w; w.x = pk_bf16(ov.x, ov.y); w.y = pk_bf16(ov.z, ov.w); *(u32x2*)pp = w; }
}

template <int W>
__device__ __forceinline__ void pool_tiles(const bf16_t* PV, bf16_t* PG, const bf16_t* PoolWT_g, const float* pscale_g, int g, int T0, int Tstep, LAS unsigned char* lds) {
    int tid_l = threadIdx.x; asm volatile("" : "+v"(tid_l));
    const int tid = tid_l, lane = tid & 63, wv = tid >> 6, r = lane & 15, q = lane >> 4;
    constexpr int NT = M / 64;
    if (T0 >= NT) return;
    bf16x8 wf[4];
#pragma unroll
    for (int ks = 0; ks < 4; ++ks) wf[ks] = *(const bf16x8*)(PoolWT_g + (16 * wv + r) * 128 + ks * 32 + q * 8);
    const f32x4 sc = *(const f32x4*)(pscale_g + 16 * wv + q * 4);
    unsigned raw[W + 7]; u32x2 gw[4];
    { const int m0 = T0 * 64, pos0 = (m0 & (SEQ - 1)) + wv * 8; const bf16_t* src = PV + (size_t)(m0 + wv * 8) * 512 + g * 128 + 2 * lane;
#pragma unroll
      for (int i = 0; i < W + 7; ++i) { raw[i] = 0u; if (pos0 - (W - 1) + i >= 0) raw[i] = *(const unsigned*)(src + (ptrdiff_t)(i - (W - 1)) * 512); }
#pragma unroll
      for (int mt = 0; mt < 4; ++mt) gw[mt] = *(const u32x2*)(PG + (size_t)(m0 + mt * 16 + r) * 512 + g * 128 + 16 * wv + q * 4); }
    LAS bf16_t* AP = (LAS bf16_t*)lds;
#pragma unroll 1
    for (int T = T0; T < NT; T += Tstep) {
        const int m0 = T * 64, pos0 = (m0 & (SEQ - 1)) + wv * 8;
        float r0[W + 7], r1[W + 7]; u32x2 gc[4];
#pragma unroll
        for (int i = 0; i < W + 7; ++i) { r0[i] = bf_lo(raw[i]); r1[i] = bf_hi(raw[i]); }
#pragma unroll
        for (int mt = 0; mt < 4; ++mt) gc[mt] = gw[mt];
        { const int Tn = (T + Tstep < NT) ? T + Tstep : T; const int mn = Tn * 64, posn = (mn & (SEQ - 1)) + wv * 8; const bf16_t* src = PV + (size_t)(mn + wv * 8) * 512 + g * 128 + 2 * lane;
#pragma unroll
          for (int i = 0; i < W + 7; ++i) { raw[i] = 0u; if (posn - (W - 1) + i >= 0) raw[i] = *(const unsigned*)(src + (ptrdiff_t)(i - (W - 1)) * 512); }
#pragma unroll
          for (int mt = 0; mt < 4; ++mt) gw[mt] = *(const u32x2*)(PG + (size_t)(mn + mt * 16 + r) * 512 + g * 128 + 16 * wv + q * 4); }
        float s0 = 0.f, s1 = 0.f;
#pragma unroll
        for (int i = 0; i < W - 1; ++i) { s0 += r0[i]; s1 += r1[i]; }
        LBAR();
#pragma unroll
        for (int i = 0; i < 8; ++i) { s0 += r0[W - 1 + i]; s1 += r1[W - 1 + i];
            const int pos = pos0 + i; const float inv = 1.f / (float)(pos + 1 < W ? pos + 1 : W);
            *(LAS unsigned*)(AP + (wv * 8 + i) * AP_STRIDE + 2 * lane) = pk_bf16(s0 * inv - r0[W - 1 + i], s1 * inv - r1[W - 1 + i]);
            s0 -= r0[i]; s1 -= r1[i]; }
        LBAR();
        f32x4 o[4];
#pragma unroll
        for (int mt = 0; mt < 4; ++mt) o[mt] = (f32x4){0.f, 0.f, 0.f, 0.f};
        bf16x8 af[16];
#pragma unroll
        for (int ks = 0; ks < 4; ++ks)
#pragma unroll
            for (int mt = 0; mt < 4; ++mt) af[ks * 4 + mt] = *(const LAS bf16x8*)(AP + (mt * 16 + r) * AP_STRIDE + ks * 32 + q * 8);
        __builtin_amdgcn_sched_barrier(0);
#pragma unroll
        for (int ks = 0; ks < 4; ++ks)
#pragma unroll
            for (int mt = 0; mt < 4; ++mt) o[mt] = MFMA16(wf[ks], af[ks * 4 + mt], o[mt]);
#pragma unroll
        for (int mt = 0; mt < 4; ++mt) { bf16_t* pp = PG + (size_t)(m0 + mt * 16 + r) * 512 + g * 128 + 16 * wv + q * 4;
            const f32x4 ov = o[mt] * sc * (f32x4){silu_f(bf_lo(gc[mt].x)), silu_f(bf_hi(gc[mt].x)), silu_f(bf_lo(gc[mt].y)), silu_f(bf_hi(gc[mt].y))};
            u32x2 w; w.x = pk_bf16(ov.x, ov.y); w.y = pk_bf16(ov.z, ov.w); *(u32x2*)pp = w; }
    }
    __syncthreads();
}

constexpr int HQ_STR = 136, HK_STR = 72;
__device__ __forceinline__ void prep_items(bf16_t* Qg, bf16_t* LFg, bf16_t* Pg, float* DECg, const float* lbl, int first, int step, int total, LAS unsigned char* lds) {
    int tid_l = threadIdx.x; asm volatile("" : "+v"(tid_l));
    const int tid = tid_l, lane = tid & 63, wv = __builtin_amdgcn_readfirstlane(tid >> 6), r = lane & 15, q = lane >> 4;
    LAS bf16_t* QT = (LAS bf16_t*)(lds); LAS bf16_t* KT = (LAS bf16_t*)(lds + 17408); LAS float* TOT = (LAS float*)(lds + 34816);
    unsigned q2[8], lf2[8], qn[8], lfn[8];
    if (first < total) { const int bh = first >> 5, n = first & 31; const size_t rb = ((size_t)(bh >> 3) * SEQ + n * 64 + wv * 8) * 1024 + (size_t)(bh & 7) * 128 + 2 * lane;
#pragma unroll
        for (int i = 0; i < 8; ++i) { qn[i] = *(const unsigned*)(Qg + rb + (size_t)i * 1024); lfn[i] = *(const unsigned*)(LFg + rb + (size_t)i * 1024); } }
#pragma unroll 1
    for (int item = first; item < total; item += step) {
        const int bh = item >> 5, n = item & 31;
        const size_t rb = ((size_t)(bh >> 3) * SEQ + n * 64 + wv * 8) * 1024 + (size_t)(bh & 7) * 128 + 2 * lane;
#pragma unroll
        for (int i = 0; i < 8; ++i) { q2[i] = qn[i]; lf2[i] = lfn[i]; }
        const f32x2 lbp = *(const f32x2*)(lbl + (bh & 7) * 128 + 2 * lane); const float lb0 = lbp.x, lb1 = lbp.y;
        { const int inext = (item + step < total) ? item + step : item; const int bh2 = inext >> 5, n2 = inext & 31; const size_t rb2 = ((size_t)(bh2 >> 3) * SEQ + n2 * 64 + wv * 8) * 1024 + (size_t)(bh2 & 7) * 128 + 2 * lane;
#pragma unroll
            for (int i = 0; i < 8; ++i) { qn[i] = *(const unsigned*)(Qg + rb2 + (size_t)i * 1024); lfn[i] = *(const unsigned*)(LFg + rb2 + (size_t)i * 1024); } }
        float f0[8], f1[8]; float run0 = 0.f, run1 = 0.f;
#pragma unroll
        for (int i = 0; i < 8; ++i) { const float z0 = h_lo(lf2[i]), z1 = h_hi(lf2[i]);
            f0[i] = fmaxf(lb0 + (1.f - lb0) * sigmoid_f(z0), 1e-30f); f1[i] = fmaxf(lb1 + (1.f - lb1) * sigmoid_f(z1), 1e-30f); run0 += flog(f0[i]); run1 += flog(f1[i]); }
        *(LAS f32x2*)(TOT + wv * 128 + 2 * lane) = (f32x2){run0, run1};
        LBAR();
        float pre0 = 0.f, pre1 = 0.f, last0 = 0.f, last1 = 0.f;
#pragma unroll
        for (int w = 0; w < 8; ++w) { const f32x2 t = *(const LAS f32x2*)(TOT + w * 128 + 2 * lane); last0 += t.x; last1 += t.y; if (w < wv) { pre0 += t.x; pre1 += t.y; } }
        if (wv == 0) *(f32x2*)(DECg + (size_t)item * 128 + 2 * lane) = (f32x2){fexp(last0), fexp(last1)};
        const float sc0 = fexp(fminf(-0.5f * last0, 60.f)), sc1 = fexp(fminf(-0.5f * last1, 60.f));
        float pf0 = fexp(pre0), pf1 = fexp(pre1), sf0 = fexp(last0 - pre0 - run0), sf1 = fexp(last1 - pre1 - run1);
        float kh0[8], kh1[8];
#pragma unroll
        for (int i = 7; i >= 0; --i) { kh0[i] = (1.f - f0[i]) * sf0; kh1[i] = (1.f - f1[i]) * sf1; sf0 *= f0[i]; sf1 *= f1[i]; }
#pragma unroll
        for (int i = 0; i < 8; ++i) { pf0 *= f0[i]; pf1 *= f1[i];
            const float qh0 = silu_f(bf_lo(q2[i])) * pf0, qh1 = silu_f(bf_hi(q2[i])) * pf1; const int t = wv * 8 + i;
            *(unsigned*)(Qg + rb + (size_t)i * 1024) = pk_bf16(qh0, qh1);
            *(unsigned*)(LFg + rb + (size_t)i * 1024) = pk_bf16(kh0[i], kh1[i]);
            *(LAS unsigned*)(QT + t * HQ_STR + 2 * lane) = pk_bf16(qh0 * sc0, qh1 * sc1);
            *(LAS unsigned*)(KT + t * HQ_STR + 2 * lane) = pk_bf16(kh0[i] * sc0, kh1[i] * sc1); }
        LBAR();
        const int ti = wv >> 1;
        { bf16x8 qf[4], kf[2][4];
#pragma unroll
          for (int ks = 0; ks < 4; ++ks) { qf[ks] = *(const LAS bf16x8*)(QT + (ti * 16 + r) * HQ_STR + ks * 32 + q * 8);
              kf[0][ks] = *(const LAS bf16x8*)(KT + ((2 * (wv & 1)) * 16 + r) * HQ_STR + ks * 32 + q * 8); kf[1][ks] = *(const LAS bf16x8*)(KT + ((2 * (wv & 1) + 1) * 16 + r) * HQ_STR + ks * 32 + q * 8); }
          __builtin_amdgcn_sched_barrier(0);
#pragma unroll
          for (int jj = 0; jj < 2; ++jj) { const int tj = 2 * (wv & 1) + jj; f32x4 sc = (f32x4){0.f, 0.f, 0.f, 0.f};
              if (tj <= ti) {
#pragma unroll
                  for (int ks = 0; ks < 4; ++ks) sc = MFMA16(kf[jj][ks], qf[ks], sc); }
              const int t = ti * 16 + r, s0 = tj * 16 + q * 4;
#pragma unroll
              for (int j = 0; j < 4; ++j) sc[j] = (s0 + j <= t) ? sc[j] : 0.f;
              u32x2 w; w.x = pk_bf16(sc[0], sc[1]); w.y = pk_bf16(sc[2], sc[3]);
              *(u32x2*)(Pg + (size_t)item * 4096 + t * 64 + s0) = w; } }
    }
    __syncthreads();
}

constexpr int SB_QH = 0, SB_KHT = 17408, SB_VT = 35840, SB_P = 54272, SB_DEC = 63488, SB_SSQ = 64000, SB_SIZE = 66048;
struct ScanRegs { unsigned q2[8], k2[8], v2[8]; u32x4 pr; f32x4 dc; u32x2 hg[4]; f32x4 o[4]; };
__device__ __forceinline__ void scan_load(ScanRegs& R, const bf16_t* Qg, const bf16_t* Kg, const bf16_t* Vg, const bf16_t* Pg, const float* DECg, int bh, int n, size_t mb, size_t cb, int tid, int lane, int wv) {
    R.pr = *(const u32x4*)(Pg + (size_t)(bh * 32 + n) * 4096 + tid * 8);
    R.dc = *(const f32x4*)(DECg + (size_t)(bh * 32 + n) * 128 + (tid & 31) * 4);
    const size_t rb = (mb + (size_t)n * 64 + wv * 8) * 1024 + cb + 2 * lane;
#pragma unroll
    for (int i = 0; i < 8; ++i) { R.q2[i] = *(const unsigned*)(Qg + rb + (size_t)i * 1024); R.k2[i] = *(const unsigned*)(Kg + rb + (size_t)i * 1024); R.v2[i] = *(const unsigned*)(Vg + rb + (size_t)i * 1024); }
    asm volatile("" ::: "memory");
}
__device__ __forceinline__ void scan_chunk(ScanRegs& X, ScanRegs& Y, f32x4 (&S)[8], const f32x4 g4, int n, const bf16_t* Qg, const bf16_t* Kg, const bf16_t* Vg, const bf16_t* Pg, const float* DECg, bf16_t* HGg,
                                           int bh, size_t mb, size_t cb, int tid, int lane, int wv, int r, int q, LAS unsigned char* lds, bool dry) {
    constexpr int NCH = SEQ / 64;
    LAS unsigned char* B = lds + (n & 1) * SB_SIZE;
    const size_t m0 = mb + (size_t)n * 64;
    if (n < NCH) {
        LAS bf16_t* QH = (LAS bf16_t*)(B + SB_QH); LAS bf16_t* KHT = (LAS bf16_t*)(B + SB_KHT); LAS bf16_t* VT = (LAS bf16_t*)(B + SB_VT); LAS bf16_t* Pm = (LAS bf16_t*)(B + SB_P);
#pragma unroll
        for (int i = 0; i < 8; ++i) *(LAS unsigned*)(QH + (wv * 8 + i) * HQ_STR + 2 * lane) = X.q2[i];
        { u32x4 lo, hi; const unsigned* k2 = X.k2;
          lo.x = (k2[0] & 0xffffu) | (k2[1] << 16); lo.y = (k2[2] & 0xffffu) | (k2[3] << 16); lo.z = (k2[4] & 0xffffu) | (k2[5] << 16); lo.w = (k2[6] & 0xffffu) | (k2[7] << 16);
          hi.x = (k2[0] >> 16) | (k2[1] & 0xffff0000u); hi.y = (k2[2] >> 16) | (k2[3] & 0xffff0000u); hi.z = (k2[4] >> 16) | (k2[5] & 0xffff0000u); hi.w = (k2[6] >> 16) | (k2[7] & 0xffff0000u);
          *(LAS u32x4*)(KHT + (2 * lane) * HK_STR + wv * 8) = lo; *(LAS u32x4*)(KHT + (2 * lane + 1) * HK_STR + wv * 8) = hi; }
        { u32x4 lo, hi; const unsigned* v2 = X.v2;
          lo.x = (v2[0] & 0xffffu) | (v2[1] << 16); lo.y = (v2[2] & 0xffffu) | (v2[3] << 16); lo.z = (v2[4] & 0xffffu) | (v2[5] << 16); lo.w = (v2[6] & 0xffffu) | (v2[7] << 16);
          hi.x = (v2[0] >> 16) | (v2[1] & 0xffff0000u); hi.y = (v2[2] >> 16) | (v2[3] & 0xffff0000u); hi.z = (v2[4] >> 16) | (v2[5] & 0xffff0000u); hi.w = (v2[6] >> 16) | (v2[7] & 0xffff0000u);
          *(LAS u32x4*)(VT + (2 * lane) * HK_STR + wv * 8) = lo; *(LAS u32x4*)(VT + (2 * lane + 1) * HK_STR + wv * 8) = hi; }
        *(LAS u32x4*)(Pm + (tid >> 3) * HK_STR + (tid & 7) * 8) = X.pr;
        if (tid < 32) *(LAS f32x4*)((LAS float*)(B + SB_DEC) + tid * 4) = X.dc;
#pragma unroll
        for (int mt = 0; mt < 4; ++mt) X.hg[mt] = *(const u32x2*)(HGg + (m0 + mt * 16 + r) * 1024 + cb + 16 * wv + q * 4);
        scan_load(X, Qg, Kg, Vg, Pg, DECg, bh, (n + 2 < NCH) ? n + 2 : NCH - 1, mb, cb, tid, lane, wv);
    }
    LBAR();
    {
        const LAS float* SSQ = (const LAS float*)(lds + ((n - 1) & 1) * SB_SIZE + SB_SSQ);
#pragma unroll
        for (int mt = 0; mt < 4; ++mt) { float tot = 0.f;
#pragma unroll
            for (int w = 0; w < 8; ++w) tot += SSQ[w * 64 + mt * 16 + r];
            const float rstd = rsqrtf(tot * (1.f / 128.f) + EPS);
            const f32x4 ov = Y.o[mt] * rstd * g4 * (f32x4){bf_lo(Y.hg[mt].x), bf_hi(Y.hg[mt].x), bf_lo(Y.hg[mt].y), bf_hi(Y.hg[mt].y)};
            u32x2 w; w.x = pk_bf16(ov.x, ov.y); w.y = pk_bf16(ov.z, ov.w);
            if (n > 0 && (!dry || rstd == 12345.678f)) *(u32x2*)(HGg + (m0 - 64 + mt * 16 + r) * 1024 + cb + 16 * wv + q * 4) = w; }
    }
    if (n < NCH) {
        const LAS bf16_t* QH = (const LAS bf16_t*)(B + SB_QH); const LAS bf16_t* KHT = (const LAS bf16_t*)(B + SB_KHT); const LAS bf16_t* VT = (const LAS bf16_t*)(B + SB_VT); const LAS bf16_t* Pm = (const LAS bf16_t*)(B + SB_P);
        const LAS float* DEC = (const LAS float*)(B + SB_DEC); LAS float* SSQ = (LAS float*)(B + SB_SSQ);
#define SCHED_FENCE() __builtin_amdgcn_sched_barrier(0)
#define QFRAG(a, mt) __builtin_bit_cast(bf16x8, (u32x4){(*(const LAS u32x2*)(QH + ((mt) * 16 + r) * HQ_STR + 32 * (a) + q * 4)).x, (*(const LAS u32x2*)(QH + ((mt) * 16 + r) * HQ_STR + 32 * (a) + q * 4)).y, \
                                                        (*(const LAS u32x2*)(QH + ((mt) * 16 + r) * HQ_STR + 32 * (a) + 16 + q * 4)).x, (*(const LAS u32x2*)(QH + ((mt) * 16 + r) * HQ_STR + 32 * (a) + 16 + q * 4)).y})
#define SFRAG(a) __builtin_bit_cast(bf16x8, (u32x4){pk_bf16(S[2 * (a)][0], S[2 * (a)][1]), pk_bf16(S[2 * (a)][2], S[2 * (a)][3]), pk_bf16(S[2 * (a) + 1][0], S[2 * (a) + 1][1]), pk_bf16(S[2 * (a) + 1][2], S[2 * (a) + 1][3])})
        f32x4 o[4];
#pragma unroll
        for (int mt = 0; mt < 4; ++mt) o[mt] = (f32x4){0.f, 0.f, 0.f, 0.f};
        bf16x8 qa[8], qb[8];
#pragma unroll
        for (int mt = 0; mt < 4; ++mt) { qa[mt] = QFRAG(0, mt); qa[4 + mt] = QFRAG(1, mt); }
        SCHED_FENCE();
#pragma unroll
        for (int mt = 0; mt < 4; ++mt) { qb[mt] = QFRAG(2, mt); qb[4 + mt] = QFRAG(3, mt); }
        { const bf16x8 s0 = SFRAG(0), s1 = SFRAG(1);
#pragma unroll
          for (int mt = 0; mt < 4; ++mt) o[mt] = MFMA16(s0, qa[mt], o[mt]);
#pragma unroll
          for (int mt = 0; mt < 4; ++mt) o[mt] = MFMA16(s1, qa[4 + mt], o[mt]); }
        SCHED_FENCE();
        bf16x8 vf[2], pf[6];
#pragma unroll
        for (int ks = 0; ks < 2; ++ks) vf[ks] = *(const LAS bf16x8*)(VT + (16 * wv + r) * HK_STR + ks * 32 + q * 8);
#pragma unroll
        for (int mt = 0; mt < 4; ++mt) pf[mt] = *(const LAS bf16x8*)(Pm + (mt * 16 + r) * HK_STR + q * 8);
        pf[4] = *(const LAS bf16x8*)(Pm + (2 * 16 + r) * HK_STR + 32 + q * 8); pf[5] = *(const LAS bf16x8*)(Pm + (3 * 16 + r) * HK_STR + 32 + q * 8);
        { const bf16x8 s2 = SFRAG(2), s3 = SFRAG(3);
#pragma unroll
          for (int mt = 0; mt < 4; ++mt) o[mt] = MFMA16(s2, qb[mt], o[mt]);
#pragma unroll
          for (int mt = 0; mt < 4; ++mt) o[mt] = MFMA16(s3, qb[4 + mt], o[mt]); }
        SCHED_FENCE();
        f32x4 deca[4], decb[4]; bf16x8 kfa[8], kfb[8];
#pragma unroll
        for (int kt = 0; kt < 4; ++kt) { deca[kt] = *(const LAS f32x4*)(DEC + kt * 16 + q * 4); kfa[2 * kt] = *(const LAS bf16x8*)(KHT + (kt * 16 + r) * HK_STR + q * 8); kfa[2 * kt + 1] = *(const LAS bf16x8*)(KHT + (kt * 16 + r) * HK_STR + 32 + q * 8); }
#pragma unroll
        for (int mt = 0; mt < 4; ++mt) o[mt] = MFMA16(vf[0], pf[mt], o[mt]);
        o[2] = MFMA16(vf[1], pf[4], o[2]); o[3] = MFMA16(vf[1], pf[5], o[3]);
        SCHED_FENCE();
#pragma unroll
        for (int kt = 4; kt < 8; ++kt) { decb[kt - 4] = *(const LAS f32x4*)(DEC + kt * 16 + q * 4); kfb[2 * (kt - 4)] = *(const LAS bf16x8*)(KHT + (kt * 16 + r) * HK_STR + q * 8); kfb[2 * (kt - 4) + 1] = *(const LAS bf16x8*)(KHT + (kt * 16 + r) * HK_STR + 32 + q * 8); }
#pragma unroll
        for (int kt = 0; kt < 4; ++kt) { S[kt] = S[kt] * deca[kt]; S[kt] = MFMA16(kfa[2 * kt], vf[0], S[kt]); S[kt] = MFMA16(kfa[2 * kt + 1], vf[1], S[kt]); }
        SCHED_FENCE();
#pragma unroll
        for (int kt = 4; kt < 8; ++kt) { S[kt] = S[kt] * decb[kt - 4]; S[kt] = MFMA16(kfb[2 * (kt - 4)], vf[0], S[kt]); S[kt] = MFMA16(kfb[2 * (kt - 4) + 1], vf[1], S[kt]); }
        float ss[4];
#pragma unroll
        for (int mt = 0; mt < 4; ++mt) { ss[mt] = (o[mt].x * o[mt].x + o[mt].y * o[mt].y) + (o[mt].z * o[mt].z + o[mt].w * o[mt].w); X.o[mt] = o[mt]; }
        float t16[4];
#pragma unroll
        for (int mt = 0; mt < 4; ++mt) t16[mt] = __shfl_xor(ss[mt], 16);
        SCHED_FENCE();
#pragma unroll
        for (int mt = 0; mt < 4; ++mt) ss[mt] += t16[mt];
#pragma unroll
        for (int mt = 0; mt < 4; ++mt) t16[mt] = __shfl_xor(ss[mt], 32);
        SCHED_FENCE();
#pragma unroll
        for (int mt = 0; mt < 4; ++mt) { ss[mt] += t16[mt]; if (q == 0) SSQ[wv * 64 + mt * 16 + r] = ss[mt]; }
#undef QFRAG
#undef SFRAG
    }
}
__device__ __forceinline__ void scan_item(const bf16_t* Qg, const bf16_t* Kg, const bf16_t* Vg, const bf16_t* Pg, const float* DECg, bf16_t* HGg, const float* gnorm, int bh, LAS unsigned char* lds, bool dry = false) {
    int tid_l = threadIdx.x; asm volatile("" : "+v"(tid_l));
    const int tid = tid_l, lane = tid & 63, wv = __builtin_amdgcn_readfirstlane(tid >> 6), r = lane & 15, q = lane >> 4;
    f32x4 S[8];
#pragma unroll
    for (int kt = 0; kt < 8; ++kt) S[kt] = (f32x4){0.f, 0.f, 0.f, 0.f};
    const f32x4 g4 = *(const f32x4*)(gnorm + 16 * wv + q * 4);
    const size_t cb = (size_t)(bh & 7) * 128, mb = (size_t)(bh >> 3) * SEQ;
    ScanRegs X, Y;
    X.dc = (f32x4){0.f, 0.f, 0.f, 0.f}; Y.dc = X.dc;
#pragma unroll
    for (int mt = 0; mt < 4; ++mt) { X.o[mt] = (f32x4){0.f, 0.f, 0.f, 0.f}; Y.o[mt] = X.o[mt]; X.hg[mt] = (u32x2){0u, 0u}; Y.hg[mt] = X.hg[mt]; }
    asm volatile("" ::: "memory");
    scan_load(X, Qg, Kg, Vg, Pg, DECg, bh, 0, mb, cb, tid, lane, wv);
    scan_load(Y, Qg, Kg, Vg, Pg, DECg, bh, 1, mb, cb, tid, lane, wv);
#pragma unroll 1
    for (int n = 0; n < SEQ / 64; n += 2) {
        scan_chunk(X, Y, S, g4, n, Qg, Kg, Vg, Pg, DECg, HGg, bh, mb, cb, tid, lane, wv, r, q, lds, dry);
        scan_chunk(Y, X, S, g4, n + 1, Qg, Kg, Vg, Pg, DECg, HGg, bh, mb, cb, tid, lane, wv, r, q, lds, dry);
    }
    scan_chunk(X, Y, S, g4, SEQ / 64, Qg, Kg, Vg, Pg, DECg, HGg, bh, mb, cb, tid, lane, wv, r, q, lds, dry);
    __syncthreads();
}

constexpr int NSEG = 4, CPS = (SEQ / 64) / NSEG;
struct Scan1Regs { unsigned q2[8], k2[8], v2[8]; u32x4 pr; f32x4 dc; };
__device__ __forceinline__ void scan1_load(Scan1Regs& R, const bf16_t* Qg, const bf16_t* Kg, const bf16_t* Vg, const bf16_t* Pg, const float* DECg, int bh, int n, size_t mb, size_t cb, int tid, int lane, int wv) {
    R.pr = *(const u32x4*)(Pg + (size_t)(bh * 32 + n) * 4096 + tid * 8);
    R.dc = *(const f32x4*)(DECg + (size_t)(bh * 32 + n) * 128 + (tid & 31) * 4);
    const size_t rb = (mb + (size_t)n * 64 + wv * 8) * 1024 + cb + 2 * lane;
#pragma unroll
    for (int i = 0; i < 8; ++i) { R.q2[i] = *(const unsigned*)(Qg + rb + (size_t)i * 1024); R.k2[i] = *(const unsigned*)(Kg + rb + (size_t)i * 1024); R.v2[i] = *(const unsigned*)(Vg + rb + (size_t)i * 1024); }
    asm volatile("" ::: "memory");
}
#define SCHED_FENCE() __builtin_amdgcn_sched_barrier(0)
#define QFRAG(a, mt) __builtin_bit_cast(bf16x8, (u32x4){(*(const LAS u32x2*)(QH + ((mt) * 16 + r) * HQ_STR + 32 * (a) + q * 4)).x, (*(const LAS u32x2*)(QH + ((mt) * 16 + r) * HQ_STR + 32 * (a) + q * 4)).y, \
                                                        (*(const LAS u32x2*)(QH + ((mt) * 16 + r) * HQ_STR + 32 * (a) + 16 + q * 4)).x, (*(const LAS u32x2*)(QH + ((mt) * 16 + r) * HQ_STR + 32 * (a) + 16 + q * 4)).y})
#define SFRAG(a) __builtin_bit_cast(bf16x8, (u32x4){pk_bf16(S[2 * (a)][0], S[2 * (a)][1]), pk_bf16(S[2 * (a)][2], S[2 * (a)][3]), pk_bf16(S[2 * (a) + 1][0], S[2 * (a) + 1][1]), pk_bf16(S[2 * (a) + 1][2], S[2 * (a) + 1][3])})
__device__ __forceinline__ void scan1_chunk(Scan1Regs& X, f32x4 (&S)[8], int n, int nlast, const bf16_t* Qg, const bf16_t* Kg, bf16_t* Vg, const bf16_t* Pg, const float* DECg,
                                            int bh, size_t mb, size_t cb, int tid, int lane, int wv, int r, int q, LAS unsigned char* lds) {
    LAS unsigned char* B = lds + (n & 1) * SB_SIZE;
    const size_t m0 = mb + (size_t)n * 64;
    LAS bf16_t* QH = (LAS bf16_t*)(B + SB_QH); LAS bf16_t* KHT = (LAS bf16_t*)(B + SB_KHT); LAS bf16_t* VT = (LAS bf16_t*)(B + SB_VT); LAS bf16_t* Pm = (LAS bf16_t*)(B + SB_P);
    const LAS float* DEC = (const LAS float*)(B + SB_DEC);
#pragma unroll
    for (int i = 0; i < 8; ++i) *(LAS unsigned*)(QH + (wv * 8 + i) * HQ_STR + 2 * lane) = X.q2[i];
    { u32x4 lo, hi; const unsigned* k2 = X.k2;
      lo.x = (k2[0] & 0xffffu) | (k2[1] << 16); lo.y = (k2[2] & 0xffffu) | (k2[3] << 16); lo.z = (k2[4] & 0xffffu) | (k2[5] << 16); lo.w = (k2[6] & 0xffffu) | (k2[7] << 16);
      hi.x = (k2[0] >> 16) | (k2[1] & 0xffff0000u); hi.y = (k2[2] >> 16) | (k2[3] & 0xffff0000u); hi.z = (k2[4] >> 16) | (k2[5] & 0xffff0000u); hi.w = (k2[6] >> 16) | (k2[7] & 0xffff0000u);
      *(LAS u32x4*)(KHT + (2 * lane) * HK_STR + wv * 8) = lo; *(LAS u32x4*)(KHT + (2 * lane + 1) * HK_STR + wv * 8) = hi; }
    { u32x4 lo, hi; const unsigned* v2 = X.v2;
      lo.x = (v2[0] & 0xffffu) | (v2[1] << 16); lo.y = (v2[2] & 0xffffu) | (v2[3] << 16); lo.z = (v2[4] & 0xffffu) | (v2[5] << 16); lo.w = (v2[6] & 0xffffu) | (v2[7] << 16);
      hi.x = (v2[0] >> 16) | (v2[1] & 0xffff0000u); hi.y = (v2[2] >> 16) | (v2[3] & 0xffff0000u); hi.z = (v2[4] >> 16) | (v2[5] & 0xffff0000u); hi.w = (v2[6] >> 16) | (v2[7] & 0xffff0000u);
      *(LAS u32x4*)(VT + (2 * lane) * HK_STR + wv * 8) = lo; *(LAS u32x4*)(VT + (2 * lane + 1) * HK_STR + wv * 8) = hi; }
    *(LAS u32x4*)(Pm + (tid >> 3) * HK_STR + (tid & 7) * 8) = X.pr;
    if (tid < 32) *(LAS f32x4*)((LAS float*)(B + SB_DEC) + tid * 4) = X.dc;
    scan1_load(X, Qg, Kg, Vg, Pg, DECg, bh, (n + 2 <= nlast) ? n + 2 : nlast, mb, cb, tid, lane, wv);
    LBAR();
    f32x4 o[4];
#pragma unroll
    for (int mt = 0; mt < 4; ++mt) o[mt] = (f32x4){0.f, 0.f, 0.f, 0.f};
    bf16x8 qa[8], qb[8];
#pragma unroll
    for (int mt = 0; mt < 4; ++mt) { qa[mt] = QFRAG(0, mt); qa[4 + mt] = QFRAG(1, mt); }
    SCHED_FENCE();
#pragma unroll
    for (int mt = 0; mt < 4; ++mt) { qb[mt] = QFRAG(2, mt); qb[4 + mt] = QFRAG(3, mt); }
    { const bf16x8 s0 = SFRAG(0), s1 = SFRAG(1);
#pragma unroll
      for (int mt = 0; mt < 4; ++mt) o[mt] = MFMA16(s0, qa[mt], o[mt]);
#pragma unroll
      for (int mt = 0; mt < 4; ++mt) o[mt] = MFMA16(s1, qa[4 + mt], o[mt]); }
    SCHED_FENCE();
    bf16x8 vf[2], pf[6];
#pragma unroll
    for (int ks = 0; ks < 2; ++ks) vf[ks] = *(const LAS bf16x8*)(VT + (16 * wv + r) * HK_STR + ks * 32 + q * 8);
#pragma unroll
    for (int mt = 0; mt < 4; ++mt) pf[mt] = *(const LAS bf16x8*)(Pm + (mt * 16 + r) * HK_STR + q * 8);
    pf[4] = *(const LAS bf16x8*)(Pm + (2 * 16 + r) * HK_STR + 32 + q * 8); pf[5] = *(const LAS bf16x8*)(Pm + (3 * 16 + r) * HK_STR + 32 + q * 8);
    { const bf16x8 s2 = SFRAG(2), s3 = SFRAG(3);
#pragma unroll
      for (int mt = 0; mt < 4; ++mt) o[mt] = MFMA16(s2, qb[mt], o[mt]);
#pragma unroll
      for (int mt = 0; mt < 4; ++mt) o[mt] = MFMA16(s3, qb[4 + mt], o[mt]); }
    SCHED_FENCE();
    f32x4 deca[4], decb[4]; bf16x8 kfa[8], kfb[8];
#pragma unroll
    for (int kt = 0; kt < 4; ++kt) { deca[kt] = *(const LAS f32x4*)(DEC + kt * 16 + q * 4); kfa[2 * kt] = *(const LAS bf16x8*)(KHT + (kt * 16 + r) * HK_STR + q * 8); kfa[2 * kt + 1] = *(const LAS bf16x8*)(KHT + (kt * 16 + r) * HK_STR + 32 + q * 8); }
#pragma unroll
    for (int mt = 0; mt < 4; ++mt) o[mt] = MFMA16(vf[0], pf[mt], o[mt]);
    o[2] = MFMA16(vf[1], pf[4], o[2]); o[3] = MFMA16(vf[1], pf[5], o[3]);
    SCHED_FENCE();
#pragma unroll
    for (int kt = 4; kt < 8; ++kt) { decb[kt - 4] = *(const LAS f32x4*)(DEC + kt * 16 + q * 4); kfb[2 * (kt - 4)] = *(const LAS bf16x8*)(KHT + (kt * 16 + r) * HK_STR + q * 8); kfb[2 * (kt - 4) + 1] = *(const LAS bf16x8*)(KHT + (kt * 16 + r) * HK_STR + 32 + q * 8); }
#pragma unroll
    for (int kt = 0; kt < 4; ++kt) { S[kt] = S[kt] * deca[kt]; S[kt] = MFMA16(kfa[2 * kt], vf[0], S[kt]); S[kt] = MFMA16(kfa[2 * kt + 1], vf[1], S[kt]); }
    SCHED_FENCE();
#pragma unroll
    for (int kt = 4; kt < 8; ++kt) { S[kt] = S[kt] * decb[kt - 4]; S[kt] = MFMA16(kfb[2 * (kt - 4)], vf[0], S[kt]); S[kt] = MFMA16(kfb[2 * (kt - 4) + 1], vf[1], S[kt]); }
#pragma unroll
    for (int mt = 0; mt < 4; ++mt) { u32x2 w; w.x = pk_bf16(o[mt].x, o[mt].y); w.y = pk_bf16(o[mt].z, o[mt].w);
        *(u32x2*)(Vg + (m0 + mt * 16 + r) * 1024 + cb + 16 * wv + q * 4) = w; }
}
__device__ __forceinline__ void scan1_item(const bf16_t* Qg, const bf16_t* Kg, bf16_t* Vg, const bf16_t* Pg, const float* DECg, float* SLOC, float* DSEG, int item, LAS unsigned char* lds) {
    int tid_l = threadIdx.x; asm volatile("" : "+v"(tid_l));
    const int tid = tid_l, lane = tid & 63, wv = __builtin_amdgcn_readfirstlane(tid >> 6), r = lane & 15, q = lane >> 4;
    const int bh = item >> 2, seg = item & 3, n0 = seg * CPS, nlast = n0 + CPS - 1;
    f32x4 S[8];
#pragma unroll
    for (int kt = 0; kt < 8; ++kt) S[kt] = (f32x4){0.f, 0.f, 0.f, 0.f};
    const size_t cb = (size_t)(bh & 7) * 128, mb = (size_t)(bh >> 3) * SEQ;
    Scan1Regs X, Y;
    asm volatile("" ::: "memory");
    scan1_load(X, Qg, Kg, Vg, Pg, DECg, bh, n0, mb, cb, tid, lane, wv);
    scan1_load(Y, Qg, Kg, Vg, Pg, DECg, bh, n0 + 1, mb, cb, tid, lane, wv);
#pragma unroll 1
    for (int n = n0; n <= nlast; n += 2) {
        scan1_chunk(X, S, n, nlast, Qg, Kg, Vg, Pg, DECg, bh, mb, cb, tid, lane, wv, r, q, lds);
        scan1_chunk(Y, S, n + 1, nlast, Qg, Kg, Vg, Pg, DECg, bh, mb, cb, tid, lane, wv, r, q, lds);
    }
    f32x4* sl = (f32x4*)SLOC + ((size_t)item * 8 + wv) * 8 * 64 + lane;
#pragma unroll
    for (int kt = 0; kt < 8; ++kt) sl[kt * 64] = S[kt];
    if (wv == 0 && r == 0) {
#pragma unroll
        for (int kt = 0; kt < 8; ++kt) { f32x4 cdv = (f32x4){1.f, 1.f, 1.f, 1.f};
            for (int n = n0; n <= nlast; ++n) cdv = cdv * *(const f32x4*)(DECg + (size_t)(bh * 32 + n) * 128 + kt * 16 + q * 4);
            *(f32x4*)(DSEG + (size_t)item * 128 + kt * 16 + q * 4) = cdv; } }
    __syncthreads();
}

constexpr int F_QH = 0, F_QT = 17408, F_KT = 34816, F_KHT = 52224, F_VT = 70656, F_P = 89088, F_TOT = 98304, F_DEC = 102400;
struct FRegs { unsigned q2[8], z2[8], v2[8]; };
__device__ __forceinline__ void f_load(FRegs& R, const bf16_t* Qg, const bf16_t* LFg, const bf16_t* Vg, int n, size_t mb, size_t cb, int lane, int wv) {
    const size_t rb = (mb + (size_t)n * 64 + wv * 8) * 1024 + cb + 2 * lane;
#pragma unroll
    for (int i = 0; i < 8; ++i) { R.q2[i] = *(const unsigned*)(Qg + rb + (size_t)i * 1024); R.z2[i] = *(const unsigned*)(LFg + rb + (size_t)i * 1024); R.v2[i] = *(const unsigned*)(Vg + rb + (size_t)i * 1024); }
    asm volatile("" ::: "memory");
}
__device__ __forceinline__ void f_chunk(FRegs& X, f32x4 (&S)[8], float& cd0, float& cd1, int n, int nlast, const float lb0, const float lb1, bf16_t* Qg, const bf16_t* LFg, bf16_t* Vg, float* DECg,
                                        int bh, size_t mb, size_t cb, int tid, int lane, int wv, int r, int q, LAS unsigned char* lds) {
    LAS bf16_t* QH = (LAS bf16_t*)(lds + F_QH); LAS bf16_t* QT = (LAS bf16_t*)(lds + F_QT); LAS bf16_t* KT = (LAS bf16_t*)(lds + F_KT);
    LAS bf16_t* KHT = (LAS bf16_t*)(lds + F_KHT); LAS bf16_t* VT = (LAS bf16_t*)(lds + F_VT); LAS bf16_t* Pm = (LAS bf16_t*)(lds + F_P);
    LAS float* TOT = (LAS float*)(lds + F_TOT); LAS float* DEC = (LAS float*)(lds + F_DEC);
    const size_t m0 = mb + (size_t)n * 64, rb = (m0 + wv * 8) * 1024 + cb + 2 * lane;
    float f0[8], f1[8]; float run0 = 0.f, run1 = 0.f;
#pragma unroll
    for (int i = 0; i < 8; ++i) { const float z0 = h_lo(X.z2[i]), z1 = h_hi(X.z2[i]);
        f0[i] = fmaxf(lb0 + (1.f - lb0) * sigmoid_f(z0), 1e-30f); f1[i] = fmaxf(lb1 + (1.f - lb1) * sigmoid_f(z1), 1e-30f); run0 += flog(f0[i]); run1 += flog(f1[i]); }
    *(LAS f32x2*)(TOT + wv * 128 + 2 * lane) = (f32x2){run0, run1};
    LBAR();
    float pre0 = 0.f, pre1 = 0.f, last0 = 0.f, last1 = 0.f;
#pragma unroll
    for (int w = 0; w < 8; ++w) { const f32x2 t = *(const LAS f32x2*)(TOT + w * 128 + 2 * lane); last0 += t.x; last1 += t.y; if (w < wv) { pre0 += t.x; pre1 += t.y; } }
    { const f32x2 dv = (f32x2){fexp(last0), fexp(last1)}; cd0 *= dv.x; cd1 *= dv.y;
      if (wv == 0) { *(LAS f32x2*)(DEC + 2 * lane) = dv; *(f32x2*)(DECg + (size_t)(bh * 32 + n) * 128 + 2 * lane) = dv; } }
    const float sc0 = fexp(fminf(-0.5f * last0, 60.f)), sc1 = fexp(fminf(-0.5f * last1, 60.f));
    float pf0 = fexp(pre0), pf1 = fexp(pre1), sf0 = fexp(last0 - pre0 - run0), sf1 = fexp(last1 - pre1 - run1);
    { float kh0[8], kh1[8];
#pragma unroll
      for (int i = 7; i >= 0; --i) { kh0[i] = (1.f - f0[i]) * sf0; kh1[i] = (1.f - f1[i]) * sf1; sf0 *= f0[i]; sf1 *= f1[i]; }
#pragma unroll
      for (int i = 0; i < 8; ++i) { pf0 *= f0[i]; pf1 *= f1[i];
          const float qh0 = silu_f(bf_lo(X.q2[i])) * pf0, qh1 = silu_f(bf_hi(X.q2[i])) * pf1; const int t = wv * 8 + i; const unsigned qp = pk_bf16(qh0, qh1);
          *(unsigned*)(Qg + rb + (size_t)i * 1024) = qp;
          *(LAS unsigned*)(QH + t * HQ_STR + 2 * lane) = qp;
          *(LAS unsigned*)(QT + t * HQ_STR + 2 * lane) = pk_bf16(qh0 * sc0, qh1 * sc1);
          *(LAS unsigned*)(KT + t * HQ_STR + 2 * lane) = pk_bf16(kh0[i] * sc0, kh1[i] * sc1); }
      u32x4 a, c; a.x = pk_bf16(kh0[0], kh0[1]); a.y = pk_bf16(kh0[2], kh0[3]); a.z = pk_bf16(kh0[4], kh0[5]); a.w = pk_bf16(kh0[6], kh0[7]);
      c.x = pk_bf16(kh1[0], kh1[1]); c.y = pk_bf16(kh1[2], kh1[3]); c.z = pk_bf16(kh1[4], kh1[5]); c.w = pk_bf16(kh1[6], kh1[7]);
      *(LAS u32x4*)(KHT + (2 * lane) * HK_STR + wv * 8) = a; *(LAS u32x4*)(KHT + (2 * lane + 1) * HK_STR + wv * 8) = c; }
    { u32x4 lo, hi; const unsigned* v2 = X.v2;
      lo.x = (v2[0] & 0xffffu) | (v2[1] << 16); lo.y = (v2[2] & 0xffffu) | (v2[3] << 16); lo.z = (v2[4] & 0xffffu) | (v2[5] << 16); lo.w = (v2[6] & 0xffffu) | (v2[7] << 16);
      hi.x = (v2[0] >> 16) | (v2[1] & 0xffff0000u); hi.y = (v2[2] >> 16) | (v2[3] & 0xffff0000u); hi.z = (v2[4] >> 16) | (v2[5] & 0xffff0000u); hi.w = (v2[6] >> 16) | (v2[7] & 0xffff0000u);
      *(LAS u32x4*)(VT + (2 * lane) * HK_STR + wv * 8) = lo; *(LAS u32x4*)(VT + (2 * lane + 1) * HK_STR + wv * 8) = hi; }
    f_load(X, Qg, LFg, Vg, (n + 2 <= nlast) ? n + 2 : nlast, mb, cb, lane, wv);
    LBAR();
    const int ti = wv >> 1;
    { bf16x8 qf[4], kf[2][4];
#pragma unroll
      for (int ks = 0; ks < 4; ++ks) { qf[ks] = *(const LAS bf16x8*)(QT + (ti * 16 + r) * HQ_STR + ks * 32 + q * 8);
          kf[0][ks] = *(const LAS bf16x8*)(KT + ((2 * (wv & 1)) * 16 + r) * HQ_STR + ks * 32 + q * 8); kf[1][ks] = *(const LAS bf16x8*)(KT + ((2 * (wv & 1) + 1) * 16 + r) * HQ_STR + ks * 32 + q * 8); }
      SCHED_FENCE();
#pragma unroll
      for (int jj = 0; jj < 2; ++jj) { const int tj = 2 * (wv & 1) + jj; f32x4 sc = (f32x4){0.f, 0.f, 0.f, 0.f};
          if (tj <= ti) {
#pragma unroll
              for (int ks = 0; ks < 4; ++ks) sc = MFMA16(kf[jj][ks], qf[ks], sc); }
          const int t = ti * 16 + r, s0 = tj * 16 + q * 4;
#pragma unroll
          for (int j = 0; j < 4; ++j) sc[j] = (s0 + j <= t) ? sc[j] : 0.f;
          u32x2 w; w.x = pk_bf16(sc[0], sc[1]); w.y = pk_bf16(sc[2], sc[3]);
          *(LAS u32x2*)(Pm + t * HK_STR + s0) = w; } }
    f32x4 o[4];
#pragma unroll
    for (int mt = 0; mt < 4; ++mt) o[mt] = (f32x4){0.f, 0.f, 0.f, 0.f};
    { bf16x8 qa[8], qb[8];
#pragma unroll
      for (int mt = 0; mt < 4; ++mt) { qa[mt] = QFRAG(0, mt); qa[4 + mt] = QFRAG(1, mt); }
      SCHED_FENCE();
#pragma unroll
      for (int mt = 0; mt < 4; ++mt) { qb[mt] = QFRAG(2, mt); qb[4 + mt] = QFRAG(3, mt); }
      { const bf16x8 s0 = SFRAG(0), s1 = SFRAG(1);
#pragma unroll
        for (int mt = 0; mt < 4; ++mt) o[mt] = MFMA16(s0, qa[mt], o[mt]);
#pragma unroll
        for (int mt = 0; mt < 4; ++mt) o[mt] = MFMA16(s1, qa[4 + mt], o[mt]); }
      SCHED_FENCE();
      { const bf16x8 s2 = SFRAG(2), s3 = SFRAG(3);
#pragma unroll
        for (int mt = 0; mt < 4; ++mt) o[mt] = MFMA16(s2, qb[mt], o[mt]);
#pragma unroll
        for (int mt = 0; mt < 4; ++mt) o[mt] = MFMA16(s3, qb[4 + mt], o[mt]); } }
    LBAR();
    bf16x8 vf[2], pf[6];
#pragma unroll
    for (int ks = 0; ks < 2; ++ks) vf[ks] = *(const LAS bf16x8*)(VT + (16 * wv + r) * HK_STR + ks * 32 + q * 8);
#pragma unroll
    for (int mt = 0; mt < 4; ++mt) pf[mt] = *(const LAS bf16x8*)(Pm + (mt * 16 + r) * HK_STR + q * 8);
    pf[4] = *(const LAS bf16x8*)(Pm + (2 * 16 + r) * HK_STR + 32 + q * 8); pf[5] = *(const LAS bf16x8*)(Pm + (3 * 16 + r) * HK_STR + 32 + q * 8);
    SCHED_FENCE();
    f32x4 deca[4], decb[4]; bf16x8 kfa[8], kfb[8];
#pragma unroll
    for (int kt = 0; kt < 4; ++kt) { deca[kt] = *(const LAS f32x4*)(DEC + kt * 16 + q * 4); kfa[2 * kt] = *(const LAS bf16x8*)(KHT + (kt * 16 + r) * HK_STR + q * 8); kfa[2 * kt + 1] = *(const LAS bf16x8*)(KHT + (kt * 16 + r) * HK_STR + 32 + q * 8); }
#pragma unroll
    for (int mt = 0; mt < 4; ++mt) o[mt] = MFMA16(vf[0], pf[mt], o[mt]);
    o[2] = MFMA16(vf[1], pf[4], o[2]); o[3] = MFMA16(vf[1], pf[5], o[3]);
    SCHED_FENCE();
#pragma unroll
    for (int kt = 4; kt < 8; ++kt) { decb[kt - 4] = *(const LAS f32x4*)(DEC + kt * 16 + q * 4); kfb[2 * (kt - 4)] = *(const LAS bf16x8*)(KHT + (kt * 16 + r) * HK_STR + q * 8); kfb[2 * (kt - 4) + 1] = *(const LAS bf16x8*)(KHT + (kt * 16 + r) * HK_STR + 32 + q * 8); }
#pragma unroll
    for (int kt = 0; kt < 4; ++kt) { S[kt] = S[kt] * deca[kt]; S[kt] = MFMA16(kfa[2 * kt], vf[0], S[kt]); S[kt] = MFMA16(kfa[2 * kt + 1], vf[1], S[kt]); }
    SCHED_FENCE();
#pragma unroll
    for (int kt = 4; kt < 8; ++kt) { S[kt] = S[kt] * decb[kt - 4]; S[kt] = MFMA16(kfb[2 * (kt - 4)], vf[0], S[kt]); S[kt] = MFMA16(kfb[2 * (kt - 4) + 1], vf[1], S[kt]); }
#pragma unroll
    for (int mt = 0; mt < 4; ++mt) { u32x2 w; w.x = pk_bf16(o[mt].x, o[mt].y); w.y = pk_bf16(o[mt].z, o[mt].w);
        *(u32x2*)(Vg + (m0 + mt * 16 + r) * 1024 + cb + 16 * wv + q * 4) = w; }
}
__device__ __forceinline__ void f_item(bf16_t* Qg, const bf16_t* LFg, bf16_t* Vg, float* DECg, float* SLOC, float* DSEG, const float* lbl, int item, LAS unsigned char* lds) {
    int tid_l = threadIdx.x; asm volatile("" : "+v"(tid_l));
    const int tid = tid_l, lane = tid & 63, wv = __builtin_amdgcn_readfirstlane(tid >> 6), r = lane & 15, q = lane >> 4;
    const int bh = item >> 2, seg = item & 3, n0 = seg * CPS, nlast = n0 + CPS - 1;
    f32x4 S[8];
#pragma unroll
    for (int kt = 0; kt < 8; ++kt) S[kt] = (f32x4){0.f, 0.f, 0.f, 0.f};
    const size_t cb = (size_t)(bh & 7) * 128, mb = (size_t)(bh >> 3) * SEQ;
    const f32x2 lbp = *(const f32x2*)(lbl + (bh & 7) * 128 + 2 * lane);
    FRegs X, Y; float cd0 = 1.f, cd1 = 1.f;
    asm volatile("" ::: "memory");
    f_load(X, Qg, LFg, Vg, n0, mb, cb, lane, wv);
    f_load(Y, Qg, LFg, Vg, n0 + 1, mb, cb, lane, wv);
#pragma unroll 1
    for (int n = n0; n <= nlast; n += 2) {
        f_chunk(X, S, cd0, cd1, n, nlast, lbp.x, lbp.y, Qg, LFg, Vg, DECg, bh, mb, cb, tid, lane, wv, r, q, lds);
        f_chunk(Y, S, cd0, cd1, n + 1, nlast, lbp.x, lbp.y, Qg, LFg, Vg, DECg, bh, mb, cb, tid, lane, wv, r, q, lds);
    }
    f32x4* sl = (f32x4*)SLOC + ((size_t)item * 8 + wv) * 8 * 64 + lane;
#pragma unroll
    for (int kt = 0; kt < 8; ++kt) sl[kt * 64] = S[kt];
    if (wv == 0) *(f32x2*)(DSEG + (size_t)item * 128 + 2 * lane) = (f32x2){cd0, cd1};
    __syncthreads();
}

struct Scan2Regs { unsigned q2[8]; f32x4 dc; u32x2 ol[4], hg[4], hgc[4]; f32x4 o[4]; };
__device__ __forceinline__ void scan2_load(Scan2Regs& R, const bf16_t* Qg, const bf16_t* OLg, const bf16_t* HGg, const float* DECg, int bh, int n, size_t mb, size_t cb, int tid, int lane, int wv, int r, int q) {
    R.dc = *(const f32x4*)(DECg + (size_t)(bh * 32 + n) * 128 + (tid & 31) * 4);
    const size_t rb = (mb + (size_t)n * 64 + wv * 8) * 1024 + cb + 2 * lane;
#pragma unroll
    for (int i = 0; i < 8; ++i) R.q2[i] = *(const unsigned*)(Qg + rb + (size_t)i * 1024);
#pragma unroll
    for (int mt = 0; mt < 4; ++mt) { const size_t ob = (mb + (size_t)n * 64 + mt * 16 + r) * 1024 + cb + 16 * wv + q * 4; R.ol[mt] = *(const u32x2*)(OLg + ob); R.hg[mt] = *(const u32x2*)(HGg + ob); }
    asm volatile("" ::: "memory");
}
__device__ __forceinline__ void scan2_chunk(Scan2Regs& X, Scan2Regs& Y, f32x4 (&S)[8], const f32x4 g4, int n, int n0, int nlast, const bf16_t* Qg, const bf16_t* OLg, bf16_t* HGg, const float* DECg,
                                            int bh, size_t mb, size_t cb, int tid, int lane, int wv, int r, int q, LAS unsigned char* lds) {
    LAS unsigned char* B = lds + (n & 1) * SB_SIZE;
    const size_t m0 = mb + (size_t)n * 64;
    u32x2 olx[4];
    if (n <= nlast) {
        LAS bf16_t* QH = (LAS bf16_t*)(B + SB_QH);
#pragma unroll
        for (int i = 0; i < 8; ++i) *(LAS unsigned*)(QH + (wv * 8 + i) * HQ_STR + 2 * lane) = X.q2[i];
        if (tid < 32) *(LAS f32x4*)((LAS float*)(B + SB_DEC) + tid * 4) = X.dc;
#pragma unroll
        for (int mt = 0; mt < 4; ++mt) { X.hgc[mt] = X.hg[mt]; olx[mt] = X.ol[mt]; }
        scan2_load(X, Qg, OLg, HGg, DECg, bh, (n + 2 <= nlast) ? n + 2 : nlast, mb, cb, tid, lane, wv, r, q);
    }
    LBAR();
    if (n > n0) {
        const LAS float* SSQ = (const LAS float*)(lds + ((n - 1) & 1) * SB_SIZE + SB_SSQ);
#pragma unroll
        for (int mt = 0; mt < 4; ++mt) { float tot = 0.f;
#pragma unroll
            for (int w = 0; w < 8; ++w) tot += SSQ[w * 64 + mt * 16 + r];
            const float rstd = rsqrtf(tot * (1.f / 128.f) + EPS);
            const f32x4 ov = Y.o[mt] * rstd * g4 * (f32x4){silu_f(bf_lo(Y.hgc[mt].x)), silu_f(bf_hi(Y.hgc[mt].x)), silu_f(bf_lo(Y.hgc[mt].y)), silu_f(bf_hi(Y.hgc[mt].y))};
            u32x2 w; w.x = pk_bf16(ov.x, ov.y); w.y = pk_bf16(ov.z, ov.w);
            *(u32x2*)(HGg + (m0 - 64 + mt * 16 + r) * 1024 + cb + 16 * wv + q * 4) = w; }
    }
    if (n <= nlast) {
        const LAS bf16_t* QH = (const LAS bf16_t*)(B + SB_QH); const LAS float* DEC = (const LAS float*)(B + SB_DEC); LAS float* SSQ = (LAS float*)(B + SB_SSQ);
        f32x4 o[4];
#pragma unroll
        for (int mt = 0; mt < 4; ++mt) o[mt] = (f32x4){bf_lo(olx[mt].x), bf_hi(olx[mt].x), bf_lo(olx[mt].y), bf_hi(olx[mt].y)};
        bf16x8 qa[8], qb[8];
#pragma unroll
        for (int mt = 0; mt < 4; ++mt) { qa[mt] = QFRAG(0, mt); qa[4 + mt] = QFRAG(1, mt); }
        SCHED_FENCE();
#pragma unroll
        for (int mt = 0; mt < 4; ++mt) { qb[mt] = QFRAG(2, mt); qb[4 + mt] = QFRAG(3, mt); }
        { const bf16x8 s0 = SFRAG(0), s1 = SFRAG(1);
#pragma unroll
          for (int mt = 0; mt < 4; ++mt) o[mt] = MFMA16(s0, qa[mt], o[mt]);
#pragma unroll
          for (int mt = 0; mt < 4; ++mt) o[mt] = MFMA16(s1, qa[4 + mt], o[mt]); }
        SCHED_FENCE();
        f32x4 dec[8];
#pragma unroll
        for (int kt = 0; kt < 8; ++kt) dec[kt] = *(const LAS f32x4*)(DEC + kt * 16 + q * 4);
        { const bf16x8 s2 = SFRAG(2), s3 = SFRAG(3);
#pragma unroll
          for (int mt = 0; mt < 4; ++mt) o[mt] = MFMA16(s2, qb[mt], o[mt]);
#pragma unroll
          for (int mt = 0; mt < 4; ++mt) o[mt] = MFMA16(s3, qb[4 + mt], o[mt]); }
        SCHED_FENCE();
#pragma unroll
        for (int kt = 0; kt < 8; ++kt) S[kt] = S[kt] * dec[kt];
        float ss[4], t16[4];
#pragma unroll
        for (int mt = 0; mt < 4; ++mt) { ss[mt] = (o[mt].x * o[mt].x + o[mt].y * o[mt].y) + (o[mt].z * o[mt].z + o[mt].w * o[mt].w); X.o[mt] = o[mt]; }
#pragma unroll
        for (int mt = 0; mt < 4; ++mt) t16[mt] = __shfl_xor(ss[mt], 16);
        SCHED_FENCE();
#pragma unroll
        for (int mt = 0; mt < 4; ++mt) ss[mt] += t16[mt];
#pragma unroll
        for (int mt = 0; mt < 4; ++mt) t16[mt] = __shfl_xor(ss[mt], 32);
        SCHED_FENCE();
#pragma unroll
        for (int mt = 0; mt < 4; ++mt) { ss[mt] += t16[mt]; if (q == 0) SSQ[wv * 64 + mt * 16 + r] = ss[mt]; }
    }
}
__device__ __forceinline__ void scan2_item(const bf16_t* Qg, const bf16_t* OLg, bf16_t* HGg, const float* DECg, const float* SLOC, const float* DSEG, const float* gnorm, int item, LAS unsigned char* lds) {
    int tid_l = threadIdx.x; asm volatile("" : "+v"(tid_l));
    const int tid = tid_l, lane = tid & 63, wv = __builtin_amdgcn_readfirstlane(tid >> 6), r = lane & 15, q = lane >> 4;
    const int bh = item >> 2, seg = item & 3, n0 = seg * CPS, nlast = n0 + CPS - 1;
    const f32x4 g4 = *(const f32x4*)(gnorm + 16 * wv + q * 4);
    const size_t cb = (size_t)(bh & 7) * 128, mb = (size_t)(bh >> 3) * SEQ;
    Scan2Regs X, Y;
#pragma unroll
    for (int mt = 0; mt < 4; ++mt) { X.o[mt] = (f32x4){0.f, 0.f, 0.f, 0.f}; Y.o[mt] = X.o[mt]; X.hgc[mt] = (u32x2){0u, 0u}; Y.hgc[mt] = X.hgc[mt]; }
    asm volatile("" ::: "memory");
    scan2_load(X, Qg, OLg, HGg, DECg, bh, n0, mb, cb, tid, lane, wv, r, q);
    scan2_load(Y, Qg, OLg, HGg, DECg, bh, n0 + 1, mb, cb, tid, lane, wv, r, q);
    f32x4 S[8];
#pragma unroll
    for (int kt = 0; kt < 8; ++kt) S[kt] = (f32x4){0.f, 0.f, 0.f, 0.f};
    { const f32x4* sl0 = (const f32x4*)SLOC + ((size_t)(bh * NSEG + 0) * 8 + wv) * 8 * 64 + lane; const f32x4* sl1 = sl0 + (size_t)8 * 8 * 64; const f32x4* sl2 = sl1 + (size_t)8 * 8 * 64;
      const float* d1 = DSEG + (size_t)(bh * NSEG + 1) * 128 + q * 4; const float* d2 = d1 + 128;
      if (seg == 1) {
#pragma unroll
          for (int kt = 0; kt < 8; ++kt) S[kt] = sl0[kt * 64];
      } else if (seg == 2) {
#pragma unroll
          for (int kt = 0; kt < 8; ++kt) S[kt] = sl0[kt * 64] * *(const f32x4*)(d1 + kt * 16) + sl1[kt * 64];
      } else if (seg == 3) {
#pragma unroll
          for (int kt = 0; kt < 8; ++kt) S[kt] = (sl0[kt * 64] * *(const f32x4*)(d1 + kt * 16) + sl1[kt * 64]) * *(const f32x4*)(d2 + kt * 16) + sl2[kt * 64];
      } }
    static_assert(NSEG == 4, "the segment fold above is written out for 4 segments");
#pragma unroll 1
    for (int n = n0; n <= nlast; n += 2) {
        scan2_chunk(X, Y, S, g4, n, n0, nlast, Qg, OLg, HGg, DECg, bh, mb, cb, tid, lane, wv, r, q, lds);
        scan2_chunk(Y, X, S, g4, n + 1, n0, nlast, Qg, OLg, HGg, DECg, bh, mb, cb, tid, lane, wv, r, q, lds);
    }
    scan2_chunk(X, Y, S, g4, nlast + 1, n0, nlast, Qg, OLg, HGg, DECg, bh, mb, cb, tid, lane, wv, r, q, lds);
    __syncthreads();
}
#undef QFRAG
#undef SFRAG

__global__ void __launch_bounds__(512, 2) fwd_megakernel(Params p) {
    extern __shared__ __attribute__((aligned(16))) unsigned char lds_raw[];
    LAS unsigned char* lds = (LAS unsigned char*)lds_raw;
#ifdef USE_CG_SYNC
    cg::grid_group grid = cg::this_grid();
#endif
    const int G = gridDim.x, blk = blockIdx.x;
    unsigned char* ws = p.ws;
    float* ADA = (float*)(ws + WS_ADA);
    bf16_t* H = (bf16_t*)(ws + WS_H); bf16_t* PV = (bf16_t*)(ws + WS_PV); bf16_t* PG = (bf16_t*)(ws + WS_PG); bf16_t* Q = (bf16_t*)(ws + WS_Q);
    bf16_t* LF = (bf16_t*)(ws + WS_LF); bf16_t* V = (bf16_t*)(ws + WS_V); bf16_t* HG = (bf16_t*)(ws + WS_HG);
    bf16_t* GATE = Q; bf16_t* MERGED = LF; bf16_t* Y = V;

    volatile LAS unsigned* stw = (volatile LAS unsigned*)(lds + LDS_BARW);
    unsigned* barw = (unsigned*)(ws + WS_BAR);
    if (threadIdx.x < 4) stw[threadIdx.x] = 0u;
    __syncthreads();
#ifdef USE_CG_SYNC
    if (blk == 0) for (int i = threadIdx.x; i < XCD_BAR_WORDS; i += 512) barw[i] = 0u;
    p0_prologue(p, lds);
    grid.sync();
    const XcdBarrier xb = xcd_barrier_post(barw, stw);
#else
    const XcdBarrier xb = xcd_barrier_post(barw, stw);
    p0_prologue(p, lds);
#ifdef DUP_P0
    __syncthreads(); p0_prologue(p, lds);
#endif
    xcd_barrier(xb);
#endif
#define GSYNC() xcd_barrier(xb)
#pragma unroll 1
    for (int l = 0; l < NL; ++l) {
#ifndef SKIP_P1
        if (l == 0) p1_rows<false, true>(p.x, nullptr, nullptr, nullptr, nullptr, p.g_pre, ADA, H);
        else p1_rows<true, true>(p.x, Y, ADA + (size_t)(l - 1) * NB * 3072, p.g_post + (size_t)(l - 1) * D, p.out, p.g_pre + (size_t)l * D, ADA + (size_t)l * NB * 3072, H);
#ifdef DUP_P1
        if (l == 0) p1_rows<false, true>(p.x, nullptr, nullptr, nullptr, nullptr, p.g_pre, ADA, H);
        else p1_rows<true, true>(p.x, Y, ADA + (size_t)(l - 1) * NB * 3072, p.g_post + (size_t)(l - 1) * D, p.out, p.g_pre + (size_t)l * D, ADA + (size_t)l * NB * 3072, H);
#endif
#endif
        GSYNC();
#pragma unroll 1
        for (int s = 0; s < 4; ++s) {
            const bf16_t* WinT = (const bf16_t*)(ws + WS_WIN) + (size_t)l * INW * D;
            pg8::Gemm g; g.M = M; g.N = D; g.K = D; g.A = nullptr; g.Bt = nullptr;
            pg8::StaticOrder S;
            if (s == 0) { g.N = NIN; S.init(M, NIN, G, blk); S.A0 = H; S.B0 = WinT; S.mode0 = 0; }
            else if (s == 1) { S.init(M, D, G, blk); S.dup = 3; S.A0 = H; S.B0 = WinT + (size_t)5120 * D; S.mode0 = 1;
                               S.A2 = HG; S.B2 = (const bf16_t*)(ws + WS_WHO) + (size_t)l * D * D; S.mode2 = 2; }
            else if (s == 2) { g.K = 512; S.init(M, D, G, blk); S.A0 = PG; S.B0 = (const bf16_t*)(ws + WS_WPO) + (size_t)l * D * 512; S.mode0 = 3; }
            else { S.init(M, D, G, blk); S.A0 = MERGED; S.B0 = (const bf16_t*)(ws + WS_WOUT) + (size_t)l * D * D; S.mode0 = 4; }
            EpiU E{ws};
#ifdef PROBE_G
            const unsigned long long tg0 = __builtin_amdgcn_s_memrealtime();
#endif
            pg8::gemm_phase<EpiU, pg8::StaticOrder, PG8_ALIGN_SEL, PG8_SP2_SEL>(lds, g, S, E);
#ifdef PROBE_G
            if ((PROBE_G >> s) & 1) probe_acc += __builtin_amdgcn_s_memrealtime() - tg0;
#endif
            if (s == 0) {
                GSYNC();
#ifdef PROBE_P3
                const unsigned long long tp0 = __builtin_amdgcn_s_memrealtime();
#endif
                bf16_t* Pg = (bf16_t*)(ws + WS_P); float* DECg = (float*)(ws + WS_DEC);
                float* SLOC = (float*)(ws + WS_P); float* DSEG = (float*)(ws + WS_DSEG);
                const bool own = (G == NB * 8 * NSEG);
                if (!own) prep_items(Q, LF, Pg, DECg, (const float*)(ws + WS_LB) + l * 1024, blk, G, 2048, lds);
                if ((G & 3) == 0) {
                    const int gq = blk & 3; const bf16_t* pw = (const bf16_t*)(ws + WS_POOLWT) + (size_t)(l * 4 + gq) * 16384; const float* ps = p.pool_scale + l * 512 + gq * 128;
                    __syncthreads();
                    if (gq == 0) pool_tiles<2>(PV, PG, pw, ps, gq, blk >> 2, G >> 2, lds); else if (gq == 1) pool_tiles<4>(PV, PG, pw, ps, gq, blk >> 2, G >> 2, lds);
                    else if (gq == 2) pool_tiles<8>(PV, PG, pw, ps, gq, blk >> 2, G >> 2, lds); else pool_tiles<16>(PV, PG, pw, ps, gq, blk >> 2, G >> 2, lds);
                } else for (int pi = blk; pi < 1024; pi += G) {
                    const int gq = pi & 3, m0 = (pi >> 2) * 64;
                    const bf16_t* pw = (const bf16_t*)(ws + WS_POOLWT) + (size_t)(l * 4 + gq) * 16384; const float* ps = p.pool_scale + l * 512 + gq * 128;
                    if (gq == 0) pool_item<2>(PV, PG, pw, ps, m0, gq, lds); else if (gq == 1) pool_item<4>(PV, PG, pw, ps, m0, gq, lds);
                    else if (gq == 2) pool_item<8>(PV, PG, pw, ps, m0, gq, lds); else pool_item<16>(PV, PG, pw, ps, m0, gq, lds);
                }
                if (own) { __syncthreads(); f_item(Q, LF, V, DECg, SLOC, DSEG, (const float*)(ws + WS_LB) + l * 1024, blk, lds); }
                if (!own) { GSYNC(); for (int it = blk; it < NB * 8 * NSEG; it += G) scan1_item(Q, LF, V, Pg, DECg, SLOC, DSEG, it, lds); }
                GSYNC();
                for (int it = blk; it < NB * 8 * NSEG; it += G) scan2_item(Q, V, HG, DECg, SLOC, DSEG, p.hgrn_norm_g + l * 128, it, lds);
                GSYNC();
            } else if (s >= 2) GSYNC();
        }
    }
#ifdef DUP_SYNC
    for (int i = 0; i < 16; ++i) GSYNC();
#endif
    p1_rows<true, false>(p.out, Y, ADA + (size_t)(NL - 1) * NB * 3072, p.g_post + (size_t)(NL - 1) * D, p.out, nullptr, nullptr, nullptr);
#if defined(PROBE_P3) || defined(PROBE_G)
    __syncthreads();
    if (blk == 0 && threadIdx.x == 0) p.out[0] = 25.f * floorf((float)probe_acc * 0.01f / 25.f + 0.5f);
#endif
}

extern "C" void kernel_launch(void* const* d_in, const int* in_sizes, int n_in, void* d_out, int out_size, void* d_ws, size_t ws_size, hipStream_t stream) {
    static int grid_blocks = 0;
    if (grid_blocks == 0) {
        if (n_in != 14 || out_size != M * D || ws_size < WS_END) { fprintf(stderr, "kernel_launch: unexpected problem (n_in %d out %d ws %zu)\n", n_in, out_size, ws_size); grid_blocks = -1; return; }
        int dev = 0, cus = 0, per_cu = 0;
        (void)hipGetDevice(&dev);
        (void)hipDeviceGetAttribute(&cus, hipDeviceAttributeMultiprocessorCount, dev);
        (void)hipFuncSetAttribute((const void*)fwd_megakernel, hipFuncAttributeMaxDynamicSharedMemorySize, LDS_BYTES);
        (void)hipOccupancyMaxActiveBlocksPerMultiprocessor(&per_cu, (const void*)fwd_megakernel, 512, LDS_BYTES);
        if (per_cu < 1) { fprintf(stderr, "kernel_launch: occupancy query says %d blocks per CU\n", per_cu); grid_blocks = -1; return; }
        grid_blocks = cus;
    }
    if (grid_blocks < 0) return;
    Params p{};
    p.x = (const float*)d_in[0]; p.c = (const float*)d_in[1]; p.w_ada = (const float*)d_in[2]; p.b_ada = (const float*)d_in[3]; p.g_pre = (const float*)d_in[4]; p.g_post = (const float*)d_in[5];
    p.w_in = (const float*)d_in[6]; p.pool_w = (const float*)d_in[7]; p.pool_scale = (const float*)d_in[8]; p.lb_logits = (const float*)d_in[9]; p.hgrn_norm_g = (const float*)d_in[10];
    p.w_pool_o = (const float*)d_in[11]; p.w_hgrn_o = (const float*)d_in[12]; p.w_out = (const float*)d_in[13];
    p.out = (float*)d_out; p.ws = (unsigned char*)d_ws;
#ifndef USE_CG_SYNC
    (void)hipMemsetAsync((unsigned char*)d_ws + WS_BAR, 0, XCD_BAR_WORDS * sizeof(unsigned), stream);
#endif
    void* args[] = {&p};
    hipError_t e = hipLaunchCooperativeKernel((const void*)fwd_megakernel, dim3(grid_blocks), dim3(512), args, LDS_BYTES, stream);
    if (e != hipSuccess) fprintf(stderr, "cooperative launch failed: %s (grid %d)\n", hipGetErrorString(e), grid_blocks);
}
```

```cpp
#ifndef PG8_ALIGN_SEL
#define PG8_ALIGN_SEL true
#endif
#ifndef PG8_SP2_SEL
#define PG8_SP2_SEL true
#endif
#include <hip/hip_runtime.h>
#include <hip/hip_cooperative_groups.h>
#include <cstdio>
#include <cstdint>
namespace cg = cooperative_groups;
#define LAS __attribute__((address_space(3)))
namespace pg8 {
#define PG8_LAS __attribute__((address_space(3)))
typedef unsigned short bf16_t;
typedef short bf16x8 __attribute__((ext_vector_type(8)));
typedef float f32x4 __attribute__((ext_vector_type(4)));
typedef unsigned u32x4 __attribute__((ext_vector_type(4)));
constexpr int BM = 256, BK = 64, HALF = 128, HTB = HALF * BK * 2  , STAGE_BYTES = 8 * HTB, NXCD = 8, WGM = 8;

__host__ __device__ __forceinline__ int lds_byte(int r, int c) { const int st = (r >> 4) * 2 + (c >> 5), rr = r & 15, cc = c & 31, ob = rr * 64 + cc * 2; return st * 1024 + (ob ^ (((ob >> 9) & 1) << 5)); }
__host__ __device__ __forceinline__ void stage_rc(int b, int& R, int& C) { const int st = b / 1024, sb = b % 1024, swz = sb ^ (((sb >> 9) & 1) << 5); R = (st >> 1) * 16 + swz / 64; C = (st & 1) * 32 + (swz % 64) / 2; }
__host__ __device__ __forceinline__ int perm32(int rho) { const int n = rho >> 4, i = rho & 15; return 8 * (i >> 2) + 4 * n + (i & 3); }

struct Unit { int pm, pn; const unsigned short* A; const unsigned short* Bt; int mode; };
struct Gemm { const bf16_t* A; const bf16_t* Bt; int M, N, K; };

struct StaticOrder {
    int nM, nN, nwg, G, c, dup;
    const unsigned short *A0, *B0, *A2, *B2; int mode0, mode2;
    __host__ __device__ void init(int M, int N, int G_, int c_) { nM = M / BM; nN = N / BM; nwg = nM * nN; G = G_; c = c_; dup = 0; A0 = B0 = A2 = B2 = nullptr; mode0 = mode2 = 0; }
    __host__ __device__ bool next(int i, Unit& u) const {
        if (dup > 0 && i >= dup) return false;
        const long L = (dup > 0) ? (long)c : (long)i * G + c; if (L >= nwg) return false;
        int wgid = (int)L; { const int q = nwg / NXCD, r = nwg % NXCD, xcd = wgid % NXCD, off = wgid / NXCD; wgid = (xcd < r ? xcd * (q + 1) : r * (q + 1) + (xcd - r) * q) + off; }
        const int nig = WGM * nN, gid = wgid / nig, fm = gid * WGM, gsz = (nM - fm) < WGM ? (nM - fm) : WGM;
        u.pm = fm + ((wgid % nig) % gsz); u.pn = (wgid % nig) / gsz + ((dup > 0 && i == 1) ? nN : 0);
        const bool third = (dup > 0 && i == 2);
        u.A = third ? A2 : A0; u.Bt = third ? B2 : B0; u.mode = third ? mode2 : mode0; return true;
    }
    __device__ __forceinline__ void a_ready(const Unit&) const {}
    __device__ __forceinline__ void done(const Unit&) const {}
};
__device__ __forceinline__ unsigned cvt_pk_bf16(float lo, float hi) { unsigned r; asm volatile("v_cvt_pk_bf16_f32 %0, %1, %2" : "=v"(r) : "v"(lo), "v"(hi)); return r; }
template <class Epi, class Sched, bool ALIGN_EPI = false, bool SP2 = false>
__device__ __forceinline__ void gemm_phase(PG8_LAS unsigned char* lds, const Gemm g, const Sched& S, const Epi& E) {
    int tid_l = threadIdx.x; asm volatile("" : "+v"(tid_l));
    const int tid = tid_l, wid = __builtin_amdgcn_readfirstlane(tid >> 6), lane = tid & 63, wr = wid >> 2, wc = wid & 3, fr = lane & 15, fq = lane >> 4;
    const int K = g.K, nt = K / BK;
    unsigned voffA[2], voffB[2];
#pragma unroll
    for (int i = 0; i < 2; ++i) { int R, C; stage_rc(tid * 16 + i * 8192, R, C); const int Rb = Epi::PERM ? ((R & ~31) + perm32(R & 31)) : R;
        voffA[i] = (unsigned)(R * K + C) * 2u; voffB[i] = (unsigned)(Rb * K + C) * 2u; }
    const size_t kstep = (size_t)(BK * 2);
    const size_t hstep = (size_t)HALF * K * 2;
    const size_t tstep = 2 * hstep;
    const unsigned ldsw = (unsigned)wid * 1024u;
    const int aoff = lds_byte(wr * 64 + fr, fq * 8), boff = lds_byte(wc * 32 + fr, fq * 8);
#define PG8_SA(b, h) (((b) * 2 + (h)) * HTB)
#define PG8_SB(b, h) ((4 + (b) * 2 + (h)) * HTB)
#define PG8_STAGE(bufoff, gbase, voff) do { _Pragma("unroll") for (int _i = 0; _i < 2; ++_i) \
        __builtin_amdgcn_global_load_lds((const unsigned*)((const char*)(gbase) + (voff)[_i]), (PG8_LAS unsigned*)(lds + (bufoff) + ldsw + _i * 8192), 16, 0, 0); } while (0)
#define PG8_LDA(dst, b, h) do { _Pragma("unroll") for (int m = 0; m < 4; ++m) _Pragma("unroll") for (int k = 0; k < 2; ++k) dst[m][k] = *(const PG8_LAS bf16x8*)(lds + PG8_SA(b, h) + aoff + m * 2048 + k * 1024); } while (0)
#define PG8_LDB(dst, b, h) do { _Pragma("unroll") for (int n = 0; n < 2; ++n) _Pragma("unroll") for (int k = 0; k < 2; ++k) dst[n][k] = *(const PG8_LAS bf16x8*)(lds + PG8_SB(b, h) + boff + n * 2048 + k * 1024); } while (0)
#define PG8_MMA(ai, bj, At, Bt) do { __builtin_amdgcn_s_setprio(1); _Pragma("unroll") for (int m = 0; m < 4; ++m) _Pragma("unroll") for (int n = 0; n < 2; ++n) _Pragma("unroll") for (int k = 0; k < 2; ++k) \
        acc[ai][bj][m][n] = __builtin_amdgcn_mfma_f32_16x16x32_bf16(Bt[n][k], At[m][k], acc[ai][bj][m][n], 0, 0, 0); __builtin_amdgcn_s_setprio(0); } while (0)
#define PG8_WAIT_V(n) asm volatile("s_waitcnt vmcnt(" #n ")" ::: "memory")
#define PG8_WAIT_L(n) asm volatile("s_waitcnt lgkmcnt(" #n ")" ::: "memory")
#define PG8_BAR __builtin_amdgcn_s_barrier()
#define PG8_SCHED __builtin_amdgcn_sched_barrier(0)
    Unit cur, nxt; int ui = 0;
    if (!S.next(0, cur)) return;
    f32x4 acc[2][2][4][2];
#pragma unroll
    for (int a = 0; a < 2; ++a)
#pragma unroll
        for (int b = 0; b < 2; ++b)
#pragma unroll
            for (int m = 0; m < 4; ++m)
#pragma unroll
                for (int n = 0; n < 2; ++n) acc[a][b][m][n] = (f32x4){0.f, 0.f, 0.f, 0.f};
    bf16x8 At[4][2], B0[2][2], B1[2][2];
    const char* cA = (const char*)cur.A + (size_t)cur.pm * tstep; const char* cB = (const char*)cur.Bt + (size_t)cur.pn * tstep;
    S.a_ready(cur);
    if constexpr (SP2) {
        PG8_STAGE(PG8_SB(0, 0), cB, voffB); PG8_STAGE(PG8_SB(0, 1), cB + hstep, voffB); PG8_STAGE(PG8_SA(0, 0), cA, voffA); PG8_STAGE(PG8_SA(0, 1), cA + hstep, voffA);
        if (wr == 1) PG8_BAR;
        PG8_WAIT_V(2); PG8_BAR;
        PG8_STAGE(PG8_SB(1, 0), cB + kstep, voffB); PG8_STAGE(PG8_SA(1, 0), cA + kstep, voffA); PG8_STAGE(PG8_SB(1, 1), cB + hstep + kstep, voffB);
        PG8_WAIT_V(6); PG8_BAR;
    } else {
        PG8_STAGE(PG8_SB(0, 0), cB, voffB); PG8_STAGE(PG8_SA(0, 0), cA, voffA); PG8_STAGE(PG8_SB(0, 1), cB + hstep, voffB); PG8_STAGE(PG8_SA(0, 1), cA + hstep, voffA);
        if (wr == 1) PG8_BAR;
        PG8_WAIT_V(4); PG8_BAR;
        PG8_STAGE(PG8_SB(1, 0), cB + kstep, voffB); PG8_STAGE(PG8_SA(1, 0), cA + kstep, voffA); PG8_STAGE(PG8_SB(1, 1), cB + hstep + kstep, voffB);
        PG8_WAIT_V(6); PG8_BAR;
    }
    for (;;) {
        const bool has_next = S.next(ui + 1, nxt);
        const char* nA = has_next ? (const char*)nxt.A + (size_t)nxt.pm * tstep : cA; const char* nB = has_next ? (const char*)nxt.Bt + (size_t)nxt.pn * tstep : cB;
        for (int t = 0; t < nt; t += 2) {
            const bool last = (t == nt - 2);
            const char* a1 = cA + (size_t)(t + 1) * kstep;
            const char* a2 = last ? nA : cA + (size_t)(t + 2) * kstep; const char* b2 = last ? nB : cB + (size_t)(t + 2) * kstep;
            const char* a3 = a2 + kstep; const char* b3 = b2 + kstep;
            if (last && has_next) S.a_ready(nxt);
            if constexpr (SP2) {
            PG8_LDB(B0, 0, 0); PG8_LDB(B1, 0, 1); PG8_SCHED; PG8_LDA(At, 0, 0); PG8_STAGE(PG8_SA(1, 1), a1 + hstep, voffA);
            PG8_WAIT_V(8); PG8_WAIT_L(0); PG8_BAR; PG8_MMA(0, 0, At, B0); PG8_MMA(0, 1, At, B1); PG8_BAR; PG8_SCHED;
            PG8_LDA(At, 0, 1); PG8_STAGE(PG8_SB(0, 0), b2, voffB); PG8_STAGE(PG8_SB(0, 1), b2 + hstep, voffB); PG8_STAGE(PG8_SA(0, 0), a2, voffA);
            PG8_WAIT_V(8); PG8_WAIT_L(0); PG8_BAR; PG8_MMA(1, 0, At, B0); PG8_MMA(1, 1, At, B1); PG8_BAR; PG8_SCHED;
            PG8_LDB(B0, 1, 0); PG8_LDB(B1, 1, 1); PG8_SCHED; PG8_LDA(At, 1, 0); PG8_STAGE(PG8_SA(0, 1), a2 + hstep, voffA);
            PG8_WAIT_V(8); PG8_WAIT_L(0); PG8_BAR; PG8_MMA(0, 0, At, B0); PG8_MMA(0, 1, At, B1); PG8_BAR; PG8_SCHED;
            PG8_LDA(At, 1, 1); PG8_STAGE(PG8_SB(1, 0), b3, voffB); PG8_STAGE(PG8_SB(1, 1), b3 + hstep, voffB); PG8_STAGE(PG8_SA(1, 0), a3, voffA);
            PG8_WAIT_V(8); PG8_WAIT_L(0); PG8_BAR; PG8_MMA(1, 0, At, B0); PG8_MMA(1, 1, At, B1); PG8_BAR; PG8_SCHED;
            } else {
            PG8_LDB(B0, 0, 0); PG8_SCHED; PG8_LDA(At, 0, 0); PG8_STAGE(PG8_SA(1, 1), a1 + hstep, voffA);
            PG8_WAIT_L(8); PG8_BAR; PG8_WAIT_L(0); PG8_MMA(0, 0, At, B0); PG8_BAR; PG8_SCHED;
            PG8_LDB(B1, 0, 1); PG8_STAGE(PG8_SB(0, 0), b2, voffB);
            PG8_BAR; PG8_WAIT_L(0); PG8_MMA(0, 1, At, B1); PG8_BAR;
            PG8_LDA(At, 0, 1); PG8_STAGE(PG8_SA(0, 0), a2, voffA);
            PG8_BAR; PG8_WAIT_L(0); PG8_MMA(1, 0, At, B0); PG8_BAR; PG8_SCHED;
            PG8_STAGE(PG8_SB(0, 1), b2 + hstep, voffB);
            PG8_WAIT_V(6); PG8_BAR; PG8_MMA(1, 1, At, B1); PG8_BAR;
            PG8_LDB(B0, 1, 0); PG8_SCHED; PG8_LDA(At, 1, 0); PG8_STAGE(PG8_SA(0, 1), a2 + hstep, voffA);
            PG8_WAIT_L(8); PG8_BAR; PG8_WAIT_L(0); PG8_MMA(0, 0, At, B0); PG8_BAR; PG8_SCHED;
            PG8_LDB(B1, 1, 1); PG8_STAGE(PG8_SB(1, 0), b3, voffB);
            PG8_BAR; PG8_WAIT_L(0); PG8_MMA(0, 1, At, B1); PG8_BAR;
            PG8_LDA(At, 1, 1); PG8_STAGE(PG8_SA(1, 0), a3, voffA);
            PG8_BAR; PG8_WAIT_L(0); PG8_MMA(1, 0, At, B0); PG8_BAR; PG8_SCHED;
            PG8_STAGE(PG8_SB(1, 1), b3 + hstep, voffB);
            PG8_WAIT_V(6); PG8_BAR; PG8_MMA(1, 1, At, B1); PG8_BAR;
            }
        }
        if constexpr (ALIGN_EPI) { if (wr == 0) PG8_BAR; }
        if constexpr (!Epi::AFTER_DRAIN) { E(acc, cur, wr, wc, fr, fq); S.done(cur); }
        if (!has_next) break;
#pragma unroll
        for (int a = 0; a < 2; ++a)
#pragma unroll
            for (int b = 0; b < 2; ++b)
#pragma unroll
                for (int m = 0; m < 4; ++m)
#pragma unroll
                    for (int n = 0; n < 2; ++n) acc[a][b][m][n] = (f32x4){0.f, 0.f, 0.f, 0.f};
        cur = nxt; cA = nA; cB = nB; ++ui;
        if constexpr (ALIGN_EPI) { if (wr == 1) PG8_BAR; }
    }
    PG8_WAIT_V(0);
    if constexpr (!ALIGN_EPI) { if (wr == 0) PG8_BAR; }
    PG8_BAR;
    if constexpr (Epi::AFTER_DRAIN) { E.fused(acc, cur, wr, wc, fr, fq, lds, wid, lane); S.done(cur); }
#undef PG8_SA
#undef PG8_SB
#undef PG8_STAGE
#undef PG8_LDA
#undef PG8_LDB
#undef PG8_MMA
#undef PG8_WAIT_V
#undef PG8_WAIT_L
#undef PG8_BAR
#undef PG8_SCHED
}
}
#define XB_TMO      128
#define XB_XCNT(j)  (256  + 64 * (j))
#define XB_XSUB(j)  (1280 + 64 * (j))
#define XB_XGEN(j)  (2304 + 64 * (j))
#define XB_TOP      3328
#define XB_TOPGEN   3392
#define XCD_BAR_WORDS 3456
#define XB_SPIN_CAP (1u << 18)

__device__ __forceinline__ unsigned xb_ld(unsigned* p)              { return __hip_atomic_load(p, __ATOMIC_RELAXED, __HIP_MEMORY_SCOPE_AGENT); }
__device__ __forceinline__ unsigned xb_add(unsigned* p, unsigned v) { return __hip_atomic_fetch_add(p, v, __ATOMIC_RELAXED, __HIP_MEMORY_SCOPE_AGENT); }
__device__ __forceinline__ unsigned xb_xcc_id() { return (unsigned)__builtin_amdgcn_s_getreg((3 << 11) | 20) & 0xFu; }
#define XB_SPIN(cond, bar) do { unsigned _sp = 0; while (cond) { __builtin_amdgcn_s_sleep(1); \
    if ((++_sp & 255u) == 0u) { if (xb_ld(&(bar)[XB_TMO])) break; if (_sp > XB_SPIN_CAP) { atomicAdd(&(bar)[XB_TMO], 1u); break; } } } } while (0)

struct XcdBarrier {
    unsigned* bar; unsigned x;
    volatile LAS unsigned* st;
};

__device__ __forceinline__ XcdBarrier xcd_barrier_post(unsigned* bar, volatile LAS unsigned* st) {
    XcdBarrier b; b.bar = bar; b.x = xb_xcc_id(); b.st = st;
    if (threadIdx.x == 0) (void)xb_add(&bar[XB_XCNT(b.x)], 1u);
    return b;
}
__device__ __forceinline__ void xcd_barrier_complete(unsigned* bar, unsigned x, unsigned& nloc, unsigned& nx) {
    const unsigned G = gridDim.x * gridDim.y * gridDim.z;
    unsigned sum, cnt, mine, sp = 0u;
    for (;;) {
        sum = 0u; cnt = 0u; mine = 0u;
#pragma unroll
        for (unsigned j = 0; j < 16; ++j) { const unsigned c = xb_ld(&bar[XB_XCNT(j)]); sum += c; cnt += (c > 0u) ? 1u : 0u; mine = (j == x) ? c : mine; }
        if (sum == G) break;
        __builtin_amdgcn_s_sleep(1);
        if ((++sp & 255u) == 0u) { if (xb_ld(&bar[XB_TMO])) break; if (sp > XB_SPIN_CAP) { atomicAdd(&bar[XB_TMO], 1u); break; } }
    }
    nloc = mine > 0u ? mine : 1u; nx = cnt > 0u ? cnt : 1u;
}

__device__ __forceinline__ void xcd_barrier(const XcdBarrier& b) {
    asm volatile("s_waitcnt vmcnt(0)" ::: "memory");
    __syncthreads();
    if (threadIdx.x == 0) {
        unsigned* bar = b.bar;
        __builtin_amdgcn_s_waitcnt(0);
        unsigned nloc = b.st[0], nx = b.st[1];
        if (nloc == 0u) { xcd_barrier_complete(bar, b.x, nloc, nx); b.st[0] = nloc; b.st[1] = nx; }
        const unsigned old = xb_add(&bar[XB_XSUB(b.x)], 1u);
        const unsigned gen = old / nloc;
        if (old + 1u == (gen + 1u) * nloc) {
            __builtin_amdgcn_fence(__ATOMIC_RELEASE, "agent");
            asm volatile("s_waitcnt vmcnt(0)" ::: "memory");
            const unsigned og = xb_add(&bar[XB_TOP], 1u);
            const unsigned tg = og / nx;
            if (og + 1u == (tg + 1u) * nx) xb_add(&bar[XB_TOPGEN], 1u);
            else XB_SPIN(xb_ld(&bar[XB_TOPGEN]) == tg, bar);
            __builtin_amdgcn_fence(__ATOMIC_ACQUIRE, "agent");
            xb_add(&bar[XB_XGEN(b.x)], 1u);
            asm volatile("s_waitcnt vmcnt(0)" ::: "memory");
        } else {
            XB_SPIN(xb_ld(&bar[XB_XGEN(b.x)]) == gen, bar);
            __builtin_amdgcn_fence(__ATOMIC_ACQUIRE, "agent");
            asm volatile("s_waitcnt vmcnt(0)" ::: "memory");
        }
    }
    __syncthreads();
}


constexpr int NB = 8, SEQ = 2048, D = 1024, M = NB * SEQ, NL = 2, INW = 7168, NIN = 5120;
constexpr float EPS = 1e-6f;
#define LAS __attribute__((address_space(3)))
typedef unsigned short bf16_t;
typedef short bf16x8 __attribute__((ext_vector_type(8)));
typedef float f32x4 __attribute__((ext_vector_type(4)));
typedef float f32x2 __attribute__((ext_vector_type(2)));
typedef unsigned u32x4 __attribute__((ext_vector_type(4)));
typedef unsigned u32x2 __attribute__((ext_vector_type(2)));
typedef __bf16 bf2_t __attribute__((ext_vector_type(2)));
typedef _Float16 h2_t __attribute__((ext_vector_type(2)));

constexpr size_t MiB = 1u << 20;
constexpr size_t WS_ADA = 0;
constexpr size_t WS_LB = 256 * 1024;
constexpr size_t WS_POOLWT = 512 * 1024;
constexpr size_t WS_WIN = 1 * MiB;
constexpr size_t WS_WPO = 29 * MiB;
constexpr size_t WS_WHO = 31 * MiB;
constexpr size_t WS_WOUT = 35 * MiB;
constexpr size_t WS_H = 40 * MiB;
constexpr size_t WS_PV = 72 * MiB;
constexpr size_t WS_PG = 88 * MiB;
constexpr size_t WS_Q = 104 * MiB;
constexpr size_t WS_LF = 136 * MiB;
constexpr size_t WS_V = 168 * MiB;
constexpr size_t WS_HG = 200 * MiB;
constexpr size_t WS_P = 232 * MiB;
constexpr size_t WS_DEC = 248 * MiB;
constexpr size_t WS_BAR = 250 * MiB;
constexpr size_t WS_DSEG = 251 * MiB;
constexpr size_t WS_END = 253 * MiB;
constexpr int LDS_BYTES = 147456, LDS_BARW = 147392;

__device__ __forceinline__ unsigned pk_bf16(float lo, float hi) { bf2_t r = __builtin_convertvector((f32x2){lo, hi}, bf2_t); return __builtin_bit_cast(unsigned, r); }
__device__ __forceinline__ unsigned pk_f16(float lo, float hi) { h2_t r = __builtin_convertvector((f32x2){lo, hi}, h2_t); return __builtin_bit_cast(unsigned, r); }
__device__ __forceinline__ float bf_lo(unsigned w) { return __uint_as_float(w << 16); }
__device__ __forceinline__ float bf_hi(unsigned w) { return __uint_as_float(w & 0xffff0000u); }
__device__ __forceinline__ float h_lo(unsigned w) { h2_t r = __builtin_bit_cast(h2_t, w); return (float)r.x; }
__device__ __forceinline__ float h_hi(unsigned w) { h2_t r = __builtin_bit_cast(h2_t, w); return (float)r.y; }
__device__ __forceinline__ float fexp(float x) { return __builtin_amdgcn_exp2f(x * 1.44269504088896f); }
__device__ __forceinline__ float flog(float x) { return __builtin_amdgcn_logf(x) * 0.693147180559945f; }
__device__ __forceinline__ float sigmoid_f(float x) { return __builtin_amdgcn_rcpf(1.f + fexp(-x)); }
__device__ __forceinline__ float silu_f(float x) { return x * sigmoid_f(x); }
__device__ __forceinline__ float dpp_f(float v, const int ctrl_unused) { return v; }
#define DPP_ADD(v, ctrl) ((v) + __builtin_bit_cast(float, __builtin_amdgcn_update_dpp(0, __builtin_bit_cast(int, (v)), (ctrl), 0xf, 0xf, true)))
__device__ __forceinline__ float wave_sum(float v) {
    v = DPP_ADD(v, 0xB1);
    v = DPP_ADD(v, 0x4E);
    v = DPP_ADD(v, 0x124);
    v = DPP_ADD(v, 0x128);
    return (__builtin_amdgcn_readlane(v, 0) + __builtin_amdgcn_readlane(v, 16)) + (__builtin_amdgcn_readlane(v, 32) + __builtin_amdgcn_readlane(v, 48));
}
#define LBAR() do { asm volatile("s_waitcnt lgkmcnt(0)" ::: "memory"); __builtin_amdgcn_s_barrier(); asm volatile("" ::: "memory"); } while (0)
#define MFMA16(a, b, c) __builtin_amdgcn_mfma_f32_16x16x32_bf16((a), (b), (c), 0, 0, 0)

__device__ __forceinline__ void p0_transpose_item(const float* W, int K, int N, bf16_t* WT, LAS float* scr, int item, int lane) {
    const int nblk = N / 32, kb = item / nblk, nb = item % nblk, k0 = 64 * kb, n0 = 32 * nb;
#pragma unroll
    for (int i = 0; i < 32; ++i) { const int kk = 2 * i + (lane >> 5); scr[kk * 33 + (lane & 31)] = __builtin_nontemporal_load(W + (size_t)(k0 + kk) * N + n0 + (lane & 31)); }
    asm volatile("s_waitcnt lgkmcnt(0)" ::: "memory");
    const int c = lane & 7;
#pragma unroll
    for (int j = 0; j < 4; ++j) { const int n = (lane >> 3) + 8 * j; const LAS float* s = scr + (8 * c) * 33 + n;
        u32x4 o; o.x = pk_bf16(s[0 * 33], s[1 * 33]); o.y = pk_bf16(s[2 * 33], s[3 * 33]); o.z = pk_bf16(s[4 * 33], s[5 * 33]); o.w = pk_bf16(s[6 * 33], s[7 * 33]);
        *(u32x4*)(WT + (size_t)(n0 + n) * K + k0 + 8 * c) = o; }
    asm volatile("s_waitcnt lgkmcnt(0)" ::: "memory");
}

struct Params {
    const float *x, *c, *w_ada, *b_ada, *g_pre, *g_post, *w_in, *pool_w, *pool_scale, *lb_logits, *hgrn_norm_g, *w_pool_o, *w_hgrn_o, *w_out;
    float* out; unsigned char* ws;
};

__device__ __forceinline__ void p0_prologue(const Params& p, LAS unsigned char* lds) {
    const int tid = threadIdx.x, lane = tid & 63, wave = tid >> 6, blk = blockIdx.x, G = gridDim.x;
    float* ADA = (float*)(p.ws + WS_ADA);
    LAS float* cact = (LAS float*)(lds + 73728);
    LAS float* red = (LAS float*)(lds + 73728 + 32768);
    for (int job = blk; job < 192; job += G) {
        for (int i = tid; i < NB * D; i += 512) cact[i] = silu_f(p.c[i]);
        __syncthreads();
        const int l = job / 96, j0 = (job % 96) * 32, j = tid & 31, ks = tid >> 5;
        const float* w = p.w_ada + ((size_t)l * D + ks * 64) * 3072 + j0 + j;
        float a0 = 0.f, a1 = 0.f, a2 = 0.f, a3 = 0.f, a4 = 0.f, a5 = 0.f, a6 = 0.f, a7 = 0.f;
#pragma unroll 32
        for (int d = 0; d < 64; ++d) { const float wv = __builtin_nontemporal_load(w + (size_t)d * 3072); const LAS float* cc = cact + ks * 64 + d;
            a0 += cc[0] * wv; a1 += cc[1024] * wv; a2 += cc[2048] * wv; a3 += cc[3072] * wv; a4 += cc[4096] * wv; a5 += cc[5120] * wv; a6 += cc[6144] * wv; a7 += cc[7168] * wv; }
        LAS float* rr = red + (ks * 8) * 32 + j;
        rr[0] = a0; rr[32] = a1; rr[64] = a2; rr[96] = a3; rr[128] = a4; rr[160] = a5; rr[192] = a6; rr[224] = a7;
        __syncthreads();
        if (tid < 256) { const int b = tid >> 5; float s = p.b_ada[l * 3072 + j0 + j];
#pragma unroll
            for (int k2 = 0; k2 < 16; ++k2) s += red[(k2 * 8 + b) * 32 + j];
            ADA[(size_t)(l * NB + b) * 3072 + j0 + j] = s; }
        __syncthreads();
    }
    if (blk == G - 1) { float* LB = (float*)(p.ws + WS_LB);
        for (int j = tid; j < 1024; j += 512) { const float l0 = p.lb_logits[j], l1 = p.lb_logits[1024 + j], mx = fmaxf(l0, l1), e0 = fexp(l0 - mx), e1 = fexp(l1 - mx);
            const float p0 = e0 / (e0 + e1), p1 = e1 / (e0 + e1); const float c1 = (p0 + p1) - p0;
            LB[j] = 0.f; LB[1024 + j] = fminf(fmaxf(c1, 0.f), 1.f); } }
    LAS float* scr = (LAS float*)(lds + wave * 8448);
    constexpr int I_IN = (D / 64) * (INW / 32), I_PO = (512 / 64) * (D / 32), I_HO = (D / 64) * (D / 32), I_OUT = I_HO, I_PW = 4 * 8, I_LAYER = I_IN + I_PO + I_HO + I_OUT + I_PW;
    bf16_t* WinT = (bf16_t*)(p.ws + WS_WIN); bf16_t* WpoT = (bf16_t*)(p.ws + WS_WPO); bf16_t* WhoT = (bf16_t*)(p.ws + WS_WHO); bf16_t* WoutT = (bf16_t*)(p.ws + WS_WOUT); bf16_t* PoolWT = (bf16_t*)(p.ws + WS_POOLWT);
    for (int it = blk * 8 + wave; it < NL * I_LAYER; it += G * 8) {
        int r = it; const int l = r / I_LAYER; r -= l * I_LAYER;
        if (r < I_IN) { p0_transpose_item(p.w_in + (size_t)l * D * INW, D, INW, WinT + (size_t)l * INW * D, scr, r, lane); continue; } r -= I_IN;
        if (r < I_PO) { p0_transpose_item(p.w_pool_o + (size_t)l * 512 * D, 512, D, WpoT + (size_t)l * D * 512, scr, r, lane); continue; } r -= I_PO;
        if (r < I_HO) { p0_transpose_item(p.w_hgrn_o + (size_t)l * D * D, D, D, WhoT + (size_t)l * D * D, scr, r, lane); continue; } r -= I_HO;
        if (r < I_OUT) { p0_transpose_item(p.w_out + (size_t)l * D * D, D, D, WoutT + (size_t)l * D * D, scr, r, lane); continue; } r -= I_OUT;
        { const int g = r >> 3; r &= 7; p0_transpose_item(p.pool_w + (size_t)(l * 4 + g) * 16384, 128, 128, PoolWT + (size_t)(l * 4 + g) * 16384, scr, r, lane); }
    }
}

template <bool HAS_PREV, bool MAKE_H>
__device__ __forceinline__ void p1_rows(const float* xprev, const bf16_t* Y, const float* ada_prev, const float* gpost, float* xout, const float* gpre, const float* ada_cur, bf16_t* H) {
    int tid_l = threadIdx.x; asm volatile("" : "+v"(tid_l));
    const int lane = tid_l & 63, wave = tid_l >> 6;
    const int NW = gridDim.x * 8, rpw = (M + NW - 1) / NW, gw = blockIdx.x * 8 + wave;
    const int mbeg = gw * rpw, mend = (mbeg + rpw < M) ? mbeg + rpw : M;
    if (mbeg >= mend) return;
    f32x4 ga[4], hm[4], hs[4];
    int bcur = -1;
    f32x4 vn[4]; u32x2 yn[4];
#pragma unroll
    for (int j = 0; j < 4; ++j) { vn[j] = __builtin_nontemporal_load((const f32x4*)(xprev + (size_t)mbeg * D) + lane + 64 * j); if (HAS_PREV) yn[j] = ((const u32x2*)(Y + (size_t)mbeg * D) + lane)[64 * j]; else yn[j] = (u32x2){0u, 0u}; }
    for (int m = mbeg; m < mend; ++m) {
        const int b = m >> 11;
        if (b != bcur) { bcur = b;
#pragma unroll
            for (int j = 0; j < 4; ++j) {
                if (HAS_PREV) ga[j] = ((const f32x4*)(ada_prev + (size_t)b * 3072 + 2048) + lane)[64 * j] * ((const f32x4*)gpost + lane)[64 * j]; else ga[j] = (f32x4){0.f, 0.f, 0.f, 0.f};
                if (MAKE_H) { hm[j] = ((const f32x4*)gpre + lane)[64 * j] * (((const f32x4*)(ada_cur + (size_t)b * 3072 + 1024) + lane)[64 * j] + 1.f); hs[j] = ((const f32x4*)(ada_cur + (size_t)b * 3072) + lane)[64 * j]; }
                else { hm[j] = (f32x4){0.f, 0.f, 0.f, 0.f}; hs[j] = hm[j]; } } }
        f32x4 v[4]; u32x2 yw[4];
#pragma unroll
        for (int j = 0; j < 4; ++j) { v[j] = vn[j]; yw[j] = yn[j]; }
        { const int mn = (m + 1 < mend) ? m + 1 : m;
#pragma unroll
          for (int j = 0; j < 4; ++j) { vn[j] = __builtin_nontemporal_load((const f32x4*)(xprev + (size_t)mn * D) + lane + 64 * j); if (HAS_PREV) yn[j] = ((const u32x2*)(Y + (size_t)mn * D) + lane)[64 * j]; } }
        if (HAS_PREV) {
            f32x4 y[4]; float ss = 0.f;
#pragma unroll
            for (int j = 0; j < 4; ++j) { y[j] = (f32x4){bf_lo(yw[j].x), bf_hi(yw[j].x), bf_lo(yw[j].y), bf_hi(yw[j].y)}; ss += (y[j].x * y[j].x + y[j].y * y[j].y) + (y[j].z * y[j].z + y[j].w * y[j].w); }
            const float rstd = rsqrtf(wave_sum(ss) * (1.f / D) + EPS);
            f32x4* xo = (f32x4*)(xout + (size_t)m * D) + lane;
#pragma unroll
            for (int j = 0; j < 4; ++j) { v[j] = v[j] + ga[j] * (y[j] * rstd); __builtin_nontemporal_store(v[j], xo + 64 * j); }
        }
        if (MAKE_H) {
            float ss = 0.f;
#pragma unroll
            for (int j = 0; j < 4; ++j) ss += (v[j].x * v[j].x + v[j].y * v[j].y) + (v[j].z * v[j].z + v[j].w * v[j].w);
            const float rstd = rsqrtf(wave_sum(ss) * (1.f / D) + EPS);
            u32x2* ho = (u32x2*)(H + (size_t)m * D) + lane;
#pragma unroll
            for (int j = 0; j < 4; ++j) { const f32x4 hv = (v[j] * rstd) * hm[j] + hs[j]; u32x2 w; w.x = pk_bf16(hv.x, hv.y); w.y = pk_bf16(hv.z, hv.w); ho[64 * j] = w; }
        }
    }
}

struct EpiU {
    static constexpr bool PERM = true, AFTER_DRAIN = false;
    unsigned char* ws;
    __device__ __forceinline__ void operator()(const f32x4 (&acc)[2][2][4][2], const pg8::Unit& u, int wr, int wc, int fr, int fq) const {
        const int pn = u.pn, mode = u.mode; const int row0 = u.pm * 256 + wr * 64 + fr;
        size_t boff; int ld = 1024, colt = pn * 256, op;
        if (mode == 0) {
            if (pn < 2) { boff = WS_PV; ld = 512; op = 0; }
            else if (pn < 4) { boff = WS_PG; ld = 512; colt = (pn - 2) * 256; op = 0; }
            else if (pn < 8) { boff = WS_Q; colt = (pn - 4) * 256; op = 0; }
            else if (pn < 12) { boff = WS_LF; colt = (pn - 8) * 256; op = 2; }
            else if (pn < 16) { boff = WS_V; colt = (pn - 12) * 256; op = 0; }
            else { boff = WS_HG; colt = (pn - 16) * 256; op = 0; }
        } else if (mode == 1) { boff = (pn < 4) ? WS_Q : WS_V; colt = (pn & 3) * 256; op = 3; }
        else if (mode == 2) { boff = WS_LF; op = 4; }
        else if (mode == 3) { boff = WS_LF; op = 5; }
        else { boff = WS_V; op = 0; }
        bf16_t* base = (bf16_t*)(ws + boff); const bf16_t* Gp = (const bf16_t*)(ws + (mode == 2 ? WS_V : WS_Q));
        const int col0 = colt + wc * 32 + 8 * fq;
#pragma unroll
        for (int ai = 0; ai < 2; ++ai) {
            u32x4 gq[4][2], tq[4][2];
#pragma unroll
            for (int m = 0; m < 4; ++m)
#pragma unroll
                for (int bj = 0; bj < 2; ++bj) { gq[m][bj] = (u32x4){0u, 0u, 0u, 0u}; tq[m][bj] = gq[m][bj]; }
            if (op >= 4) {
#pragma unroll
                for (int m = 0; m < 4; ++m)
#pragma unroll
                    for (int bj = 0; bj < 2; ++bj) gq[m][bj] = *(const u32x4*)(Gp + (size_t)(row0 + ai * 128 + m * 16) * ld + col0 + bj * 128);
                if (op == 5) {
#pragma unroll
                    for (int m = 0; m < 4; ++m)
#pragma unroll
                        for (int bj = 0; bj < 2; ++bj) tq[m][bj] = *(const u32x4*)(base + (size_t)(row0 + ai * 128 + m * 16) * ld + col0 + bj * 128); }
            }
            asm volatile("" ::: "memory");
#pragma unroll
            for (int m = 0; m < 4; ++m) { const size_t off = (size_t)(row0 + ai * 128 + m * 16) * ld + col0;
#pragma unroll
                for (int bj = 0; bj < 2; ++bj) { f32x4 v0 = acc[ai][bj][m][0], v1 = acc[ai][bj][m][1];
                    if (op == 1) {
#pragma unroll
                        for (int j = 0; j < 4; ++j) { v0[j] = silu_f(v0[j]); v1[j] = silu_f(v1[j]); }
                    } else if (op == 3) {
#pragma unroll
                        for (int j = 0; j < 4; ++j) { v0[j] = sigmoid_f(v0[j]); v1[j] = sigmoid_f(v1[j]); }
                    } else if (op >= 4) { const u32x4 g = gq[m][bj];
                        v0 = v0 * (f32x4){bf_lo(g.x), bf_hi(g.x), bf_lo(g.y), bf_hi(g.y)}; v1 = v1 * (f32x4){bf_lo(g.z), bf_hi(g.z), bf_lo(g.w), bf_hi(g.w)};
                        if (op == 5) { const u32x4 t = tq[m][bj];
                            v0 = v0 + (f32x4){bf_lo(t.x), bf_hi(t.x), bf_lo(t.y), bf_hi(t.y)}; v1 = v1 + (f32x4){bf_lo(t.z), bf_hi(t.z), bf_lo(t.w), bf_hi(t.w)}; } }
                    u32x4 w;
                    if (op == 2) { w.x = pk_f16(v0[0], v0[1]); w.y = pk_f16(v0[2], v0[3]); w.z = pk_f16(v1[0], v1[1]); w.w = pk_f16(v1[2], v1[3]); }
                    else { w.x = pk_bf16(v0[0], v0[1]); w.y = pk_bf16(v0[2], v0[3]); w.z = pk_bf16(v1[0], v1[1]); w.w = pk_bf16(v1[2], v1[3]); }
                    *(u32x4*)(base + off + bj * 128) = w; } }
        }
    }
};

constexpr int AP_STRIDE = 136;
template <int W>
__device__ __forceinline__ void pool_item(const bf16_t* PV, bf16_t* PG, const bf16_t* PoolWT_g, const float* pscale_g, int m0, int g, LAS unsigned char* lds) {
    int tid_l = threadIdx.x; asm volatile("" : "+v"(tid_l));
    const int tid = tid_l, lane = tid & 63, wv = tid >> 6, r = lane & 15, q = lane >> 4;
    const int pos0 = (m0 & (SEQ - 1)) + wv * 8;
    const bf16_t* src = PV + (size_t)(m0 + wv * 8) * 512 + g * 128 + 2 * lane;
    float r0[W + 7], r1[W + 7];
#pragma unroll
    for (int i = 0; i < W + 7; ++i) { const int pp = pos0 - (W - 1) + i; unsigned w = 0u; if (pp >= 0) w = *(const unsigned*)(src + (ptrdiff_t)(i - (W - 1)) * 512); r0[i] = bf_lo(w); r1[i] = bf_hi(w); }
    bf16x8 wf[4]; u32x2 gw[4];
#pragma unroll
    for (int ks = 0; ks < 4; ++ks) wf[ks] = *(const bf16x8*)(PoolWT_g + (16 * wv + r) * 128 + ks * 32 + q * 8);
#pragma unroll
    for (int mt = 0; mt < 4; ++mt) gw[mt] = *(const u32x2*)(PG + (size_t)(m0 + mt * 16 + r) * 512 + g * 128 + 16 * wv + q * 4);
    const f32x4 sc = *(const f32x4*)(pscale_g + 16 * wv + q * 4);
    float s0 = 0.f, s1 = 0.f;
#pragma unroll
    for (int i = 0; i < W - 1; ++i) { s0 += r0[i]; s1 += r1[i]; }
    LAS bf16_t* AP = (LAS bf16_t*)lds;
    __syncthreads();
#pragma unroll
    for (int i = 0; i < 8; ++i) { s0 += r0[W - 1 + i]; s1 += r1[W - 1 + i];
        const int pos = pos0 + i; const float inv = 1.f / (float)(pos + 1 < W ? pos + 1 : W);
        *(LAS unsigned*)(AP + (wv * 8 + i) * AP_STRIDE + 2 * lane) = pk_bf16(s0 * inv - r0[W - 1 + i], s1 * inv - r1[W - 1 + i]);
        s0 -= r0[i]; s1 -= r1[i]; }
    __syncthreads();
    f32x4 o[4];
#pragma unroll
    for (int mt = 0; mt < 4; ++mt) o[mt] = (f32x4){0.f, 0.f, 0.f, 0.f};
    bf16x8 af[16];
#pragma unroll
    for (int ks = 0; ks < 4; ++ks)
#pragma unroll
        for (int mt = 0; mt < 4; ++mt) af[ks * 4 + mt] = *(const LAS bf16x8*)(AP + (mt * 16 + r) * AP_STRIDE + ks * 32 + q * 8);
    __builtin_amdgcn_sched_barrier(0);
#pragma unroll
    for (int ks = 0; ks < 4; ++ks)
#pragma unroll
        for (int mt = 0; mt < 4; ++mt) o[mt] = MFMA16(wf[ks], af[ks * 4 + mt], o[mt]);
#pragma unroll
    for (int mt = 0; mt < 4; ++mt) { bf16_t* pp = PG + (size_t)(m0 + mt * 16 + r) * 512 + g * 128 + 16 * wv + q * 4;
        const f32x4 ov = o[mt] * sc * (f32x4){silu_f(bf_lo(gw[mt].x)), silu_f(bf_hi(gw[mt].x)), silu_f(bf_lo(gw[mt].y)), silu_f(bf_hi(gw[mt].y))};
        u32x2 w; w.x = pk_bf16(ov.x, ov.y); w.y = pk_bf16(ov.z, ov.w); *(u32x2*)pp = w; }
}

template <int W>
__device__ __forceinline__ void pool_tiles(const bf16_t* PV, bf16_t* PG, const bf16_t* PoolWT_g, const float* pscale_g, int g, int T0, int Tstep, LAS unsigned char* lds) {
    int tid_l = threadIdx.x; asm volatile("" : "+v"(tid_l));
    const int tid = tid_l, lane = tid & 63, wv = tid >> 6, r = lane & 15, q = lane >> 4;
    constexpr int NT = M / 64;
    if (T0 >= NT) return;
    bf16x8 wf[4];
#pragma unroll
    for (int ks = 0; ks < 4; ++ks) wf[ks] = *(const bf16x8*)(PoolWT_g + (16 * wv + r) * 128 + ks * 32 + q * 8);
    const f32x4 sc = *(const f32x4*)(pscale_g + 16 * wv + q * 4);
    unsigned raw[W + 7]; u32x2 gw[4];
    { const int m0 = T0 * 64, pos0 = (m0 & (SEQ - 1)) + wv * 8; const bf16_t* src = PV + (size_t)(m0 + wv * 8) * 512 + g * 128 + 2 * lane;
#pragma unroll
      for (int i = 0; i < W + 7; ++i) { raw[i] = 0u; if (pos0 - (W - 1) + i >= 0) raw[i] = *(const unsigned*)(src + (ptrdiff_t)(i - (W - 1)) * 512); }
#pragma unroll
      for (int mt = 0; mt < 4; ++mt) gw[mt] = *(const u32x2*)(PG + (size_t)(m0 + mt * 16 + r) * 512 + g * 128 + 16 * wv + q * 4); }
    LAS bf16_t* AP = (LAS bf16_t*)lds;
#pragma unroll 1
    for (int T = T0; T < NT; T += Tstep) {
        const int m0 = T * 64, pos0 = (m0 & (SEQ - 1)) + wv * 8;
        float r0[W + 7], r1[W + 7]; u32x2 gc[4];
#pragma unroll
        for (int i = 0; i < W + 7; ++i) { r0[i] = bf_lo(raw[i]); r1[i] = bf_hi(raw[i]); }
#pragma unroll
        for (int mt = 0; mt < 4; ++mt) gc[mt] = gw[mt];
        { const int Tn = (T + Tstep < NT) ? T + Tstep : T; const int mn = Tn * 64, posn = (mn & (SEQ - 1)) + wv * 8; const bf16_t* src = PV + (size_t)(mn + wv * 8) * 512 + g * 128 + 2 * lane;
#pragma unroll
          for (int i = 0; i < W + 7; ++i) { raw[i] = 0u; if (posn - (W - 1) + i >= 0) raw[i] = *(const unsigned*)(src + (ptrdiff_t)(i - (W - 1)) * 512); }
#pragma unroll
          for (int mt = 0; mt < 4; ++mt) gw[mt] = *(const u32x2*)(PG + (size_t)(mn + mt * 16 + r) * 512 + g * 128 + 16 * wv + q * 4); }
        float s0 = 0.f, s1 = 0.f;
#pragma unroll
        for (int i = 0; i < W - 1; ++i) { s0 += r0[i]; s1 += r1[i]; }
        LBAR();
#pragma unroll
        for (int i = 0; i < 8; ++i) { s0 += r0[W - 1 + i]; s1 += r1[W - 1 + i];
            const int pos = pos0 + i; const float inv = 1.f / (float)(pos + 1 < W ? pos + 1 : W);
            *(LAS unsigned*)(AP + (wv * 8 + i) * AP_STRIDE + 2 * lane) = pk_bf16(s0 * inv - r0[W - 1 + i], s1 * inv - r1[W - 1 + i]);
            s0 -= r0[i]; s1 -= r1[i]; }
        LBAR();
        f32x4 o[4];
#pragma unroll
        for (int mt = 0; mt < 4; ++mt) o[mt] = (f32x4){0.f, 0.f, 0.f, 0.f};
        bf16x8 af[16];
#pragma unroll
        for (int ks = 0; ks < 4; ++ks)
#pragma unroll
            for (int mt = 0; mt < 4; ++mt) af[ks * 4 + mt] = *(const LAS bf16x8*)(AP + (mt * 16 + r) * AP_STRIDE + ks * 32 + q * 8);
        __builtin_amdgcn_sched_barrier(0);
#pragma unroll
        for (int ks = 0; ks < 4; ++ks)
#pragma unroll
            for (int mt = 0; mt < 4; ++mt) o[mt] = MFMA16(wf[ks], af[ks * 4 + mt], o[mt]);
#pragma unroll
        for (int mt = 0; mt < 4; ++mt) { bf16_t* pp = PG + (size_t)(m0 + mt * 16 + r) * 512 + g * 128 + 16 * wv + q * 4;
            const f32x4 ov = o[mt] * sc * (f32x4){silu_f(bf_lo(gc[mt].x)), silu_f(bf_hi(gc[mt].x)), silu_f(bf_lo(gc[mt].y)), silu_f(bf_hi(gc[mt].y))};
            u32x2 w; w.x = pk_bf16(ov.x, ov.y); w.y = pk_bf16(ov.z, ov.w); *(u32x2*)pp = w; }
    }
    __syncthreads();
}

constexpr int HQ_STR = 136, HK_STR = 72;
__device__ __forceinline__ void prep_items(bf16_t* Qg, bf16_t* LFg, bf16_t* Pg, float* DECg, const float* lbl, int first, int step, int total, LAS unsigned char* lds) {
    int tid_l = threadIdx.x; asm volatile("" : "+v"(tid_l));
    const int tid = tid_l, lane = tid & 63, wv = __builtin_amdgcn_readfirstlane(tid >> 6), r = lane & 15, q = lane >> 4;
    LAS bf16_t* QT = (LAS bf16_t*)(lds); LAS bf16_t* KT = (LAS bf16_t*)(lds + 17408); LAS float* TOT = (LAS float*)(lds + 34816);
    unsigned q2[8], lf2[8], qn[8], lfn[8];
    if (first < total) { const int bh = first >> 5, n = first & 31; const size_t rb = ((size_t)(bh >> 3) * SEQ + n * 64 + wv * 8) * 1024 + (size_t)(bh & 7) * 128 + 2 * lane;
#pragma unroll
        for (int i = 0; i < 8; ++i) { qn[i] = *(const unsigned*)(Qg + rb + (size_t)i * 1024); lfn[i] = *(const unsigned*)(LFg + rb + (size_t)i * 1024); } }
#pragma unroll 1
    for (int item = first; item < total; item += step) {
        const int bh = item >> 5, n = item & 31;
        const size_t rb = ((size_t)(bh >> 3) * SEQ + n * 64 + wv * 8) * 1024 + (size_t)(bh & 7) * 128 + 2 * lane;
#pragma unroll
        for (int i = 0; i < 8; ++i) { q2[i] = qn[i]; lf2[i] = lfn[i]; }
        const f32x2 lbp = *(const f32x2*)(lbl + (bh & 7) * 128 + 2 * lane); const float lb0 = lbp.x, lb1 = lbp.y;
        { const int inext = (item + step < total) ? item + step : item; const int bh2 = inext >> 5, n2 = inext & 31; const size_t rb2 = ((size_t)(bh2 >> 3) * SEQ + n2 * 64 + wv * 8) * 1024 + (size_t)(bh2 & 7) * 128 + 2 * lane;
#pragma unroll
            for (int i = 0; i < 8; ++i) { qn[i] = *(const unsigned*)(Qg + rb2 + (size_t)i * 1024); lfn[i] = *(const unsigned*)(LFg + rb2 + (size_t)i * 1024); } }
        float f0[8], f1[8]; float run0 = 0.f, run1 = 0.f;
#pragma unroll
        for (int i = 0; i < 8; ++i) { const float z0 = h_lo(lf2[i]), z1 = h_hi(lf2[i]);
            f0[i] = fmaxf(lb0 + (1.f - lb0) * sigmoid_f(z0), 1e-30f); f1[i] = fmaxf(lb1 + (1.f - lb1) * sigmoid_f(z1), 1e-30f); run0 += flog(f0[i]); run1 += flog(f1[i]); }
        *(LAS f32x2*)(TOT + wv * 128 + 2 * lane) = (f32x2){run0, run1};
        LBAR();
        float pre0 = 0.f, pre1 = 0.f, last0 = 0.f, last1 = 0.f;
#pragma unroll
        for (int w = 0; w < 8; ++w) { const f32x2 t = *(const LAS f32x2*)(TOT + w * 128 + 2 * lane); last0 += t.x; last1 += t.y; if (w < wv) { pre0 += t.x; pre1 += t.y; } }
        if (wv == 0) *(f32x2*)(DECg + (size_t)item * 128 + 2 * lane) = (f32x2){fexp(last0), fexp(last1)};
        const float sc0 = fexp(fminf(-0.5f * last0, 60.f)), sc1 = fexp(fminf(-0.5f * last1, 60.f));
        float pf0 = fexp(pre0), pf1 = fexp(pre1), sf0 = fexp(last0 - pre0 - run0), sf1 = fexp(last1 - pre1 - run1);
        float kh0[8], kh1[8];
#pragma unroll
        for (int i = 7; i >= 0; --i) { kh0[i] = (1.f - f0[i]) * sf0; kh1[i] = (1.f - f1[i]) * sf1; sf0 *= f0[i]; sf1 *= f1[i]; }
#pragma unroll
        for (int i = 0; i < 8; ++i) { pf0 *= f0[i]; pf1 *= f1[i];
            const float qh0 = silu_f(bf_lo(q2[i])) * pf0, qh1 = silu_f(bf_hi(q2[i])) * pf1; const int t = wv * 8 + i;
            *(unsigned*)(Qg + rb + (size_t)i * 1024) = pk_bf16(qh0, qh1);
            *(unsigned*)(LFg + rb + (size_t)i * 1024) = pk_bf16(kh0[i], kh1[i]);
            *(LAS unsigned*)(QT + t * HQ_STR + 2 * lane) = pk_bf16(qh0 * sc0, qh1 * sc1);
            *(LAS unsigned*)(KT + t * HQ_STR + 2 * lane) = pk_bf16(kh0[i] * sc0, kh1[i] * sc1); }
        LBAR();
        const int ti = wv >> 1;
        { bf16x8 qf[4], kf[2][4];
#pragma unroll
          for (int ks = 0; ks < 4; ++ks) { qf[ks] = *(const LAS bf16x8*)(QT + (ti * 16 + r) * HQ_STR + ks * 32 + q * 8);
              kf[0][ks] = *(const LAS bf16x8*)(KT + ((2 * (wv & 1)) * 16 + r) * HQ_STR + ks * 32 + q * 8); kf[1][ks] = *(const LAS bf16x8*)(KT + ((2 * (wv & 1) + 1) * 16 + r) * HQ_STR + ks * 32 + q * 8); }
          __builtin_amdgcn_sched_barrier(0);
#pragma unroll
          for (int jj = 0; jj < 2; ++jj) { const int tj = 2 * (wv & 1) + jj; f32x4 sc = (f32x4){0.f, 0.f, 0.f, 0.f};
              if (tj <= ti) {
#pragma unroll
                  for (int ks = 0; ks < 4; ++ks) sc = MFMA16(kf[jj][ks], qf[ks], sc); }
              const int t = ti * 16 + r, s0 = tj * 16 + q * 4;
#pragma unroll
              for (int j = 0; j < 4; ++j) sc[j] = (s0 + j <= t) ? sc[j] : 0.f;
              u32x2 w; w.x = pk_bf16(sc[0], sc[1]); w.y = pk_bf16(sc[2], sc[3]);
              *(u32x2*)(Pg + (size_t)item * 4096 + t * 64 + s0) = w; } }
    }
    __syncthreads();
}

constexpr int SB_QH = 0, SB_KHT = 17408, SB_VT = 35840, SB_P = 54272, SB_DEC = 63488, SB_SSQ = 64000, SB_SIZE = 66048;
struct ScanRegs { unsigned q2[8], k2[8], v2[8]; u32x4 pr; f32x4 dc; u32x2 hg[4]; f32x4 o[4]; };
__device__ __forceinline__ void scan_load(ScanRegs& R, const bf16_t* Qg, const bf16_t* Kg, const bf16_t* Vg, const bf16_t* Pg, const float* DECg, int bh, int n, size_t mb, size_t cb, int tid, int lane, int wv) {
    R.pr = *(const u32x4*)(Pg + (size_t)(bh * 32 + n) * 4096 + tid * 8);
    R.dc = *(const f32x4*)(DECg + (size_t)(bh * 32 + n) * 128 + (tid & 31) * 4);
    const size_t rb = (mb + (size_t)n * 64 + wv * 8) * 1024 + cb + 2 * lane;
#pragma unroll
    for (int i = 0; i < 8; ++i) { R.q2[i] = *(const unsigned*)(Qg + rb + (size_t)i * 1024); R.k2[i] = *(const unsigned*)(Kg + rb + (size_t)i * 1024); R.v2[i] = *(const unsigned*)(Vg + rb + (size_t)i * 1024); }
    asm volatile("" ::: "memory");
}
__device__ __forceinline__ void scan_chunk(ScanRegs& X, ScanRegs& Y, f32x4 (&S)[8], const f32x4 g4, int n, const bf16_t* Qg, const bf16_t* Kg, const bf16_t* Vg, const bf16_t* Pg, const float* DECg, bf16_t* HGg,
                                           int bh, size_t mb, size_t cb, int tid, int lane, int wv, int r, int q, LAS unsigned char* lds, bool dry) {
    constexpr int NCH = SEQ / 64;
    LAS unsigned char* B = lds + (n & 1) * SB_SIZE;
    const size_t m0 = mb + (size_t)n * 64;
    if (n < NCH) {
        LAS bf16_t* QH = (LAS bf16_t*)(B + SB_QH); LAS bf16_t* KHT = (LAS bf16_t*)(B + SB_KHT); LAS bf16_t* VT = (LAS bf16_t*)(B + SB_VT); LAS bf16_t* Pm = (LAS bf16_t*)(B + SB_P);
#pragma unroll
        for (int i = 0; i < 8; ++i) *(LAS unsigned*)(QH + (wv * 8 + i) * HQ_STR + 2 * lane) = X.q2[i];
        { u32x4 lo, hi; const unsigned* k2 = X.k2;
          lo.x = (k2[0] & 0xffffu) | (k2[1] << 16); lo.y = (k2[2] & 0xffffu) | (k2[3] << 16); lo.z = (k2[4] & 0xffffu) | (k2[5] << 16); lo.w = (k2[6] & 0xffffu) | (k2[7] << 16);
          hi.x = (k2[0] >> 16) | (k2[1] & 0xffff0000u); hi.y = (k2[2] >> 16) | (k2[3] & 0xffff0000u); hi.z = (k2[4] >> 16) | (k2[5] & 0xffff0000u); hi.w = (k2[6] >> 16) | (k2[7] & 0xffff0000u);
          *(LAS u32x4*)(KHT + (2 * lane) * HK_STR + wv * 8) = lo; *(LAS u32x4*)(KHT + (2 * lane + 1) * HK_STR + wv * 8) = hi; }
        { u32x4 lo, hi; const unsigned* v2 = X.v2;
          lo.x = (v2[0] & 0xffffu) | (v2[1] << 16); lo.y = (v2[2] & 0xffffu) | (v2[3] << 16); lo.z = (v2[4] & 0xffffu) | (v2[5] << 16); lo.w = (v2[6] & 0xffffu) | (v2[7] << 16);
          hi.x = (v2[0] >> 16) | (v2[1] & 0xffff0000u); hi.y = (v2[2] >> 16) | (v2[3] & 0xffff0000u); hi.z = (v2[4] >> 16) | (v2[5] & 0xffff0000u); hi.w = (v2[6] >> 16) | (v2[7] & 0xffff0000u);
          *(LAS u32x4*)(VT + (2 * lane) * HK_STR + wv * 8) = lo; *(LAS u32x4*)(VT + (2 * lane + 1) * HK_STR + wv * 8) = hi; }
        *(LAS u32x4*)(Pm + (tid >> 3) * HK_STR + (tid & 7) * 8) = X.pr;
        if (tid < 32) *(LAS f32x4*)((LAS float*)(B + SB_DEC) + tid * 4) = X.dc;
#pragma unroll
        for (int mt = 0; mt < 4; ++mt) X.hg[mt] = *(const u32x2*)(HGg + (m0 + mt * 16 + r) * 1024 + cb + 16 * wv + q * 4);
        scan_load(X, Qg, Kg, Vg, Pg, DECg, bh, (n + 2 < NCH) ? n + 2 : NCH - 1, mb, cb, tid, lane, wv);
    }
    LBAR();
    {
        const LAS float* SSQ = (const LAS float*)(lds + ((n - 1) & 1) * SB_SIZE + SB_SSQ);
#pragma unroll
        for (int mt = 0; mt < 4; ++mt) { float tot = 0.f;
#pragma unroll
            for (int w = 0; w < 8; ++w) tot += SSQ[w * 64 + mt * 16 + r];
            const float rstd = rsqrtf(tot * (1.f / 128.f) + EPS);
            const f32x4 ov = Y.o[mt] * rstd * g4 * (f32x4){bf_lo(Y.hg[mt].x), bf_hi(Y.hg[mt].x), bf_lo(Y.hg[mt].y), bf_hi(Y.hg[mt].y)};
            u32x2 w; w.x = pk_bf16(ov.x, ov.y); w.y = pk_bf16(ov.z, ov.w);
            if (n > 0 && (!dry || rstd == 12345.678f)) *(u32x2*)(HGg + (m0 - 64 + mt * 16 + r) * 1024 + cb + 16 * wv + q * 4) = w; }
    }
    if (n < NCH) {
        const LAS bf16_t* QH = (const LAS bf16_t*)(B + SB_QH); const LAS bf16_t* KHT = (const LAS bf16_t*)(B + SB_KHT); const LAS bf16_t* VT = (const LAS bf16_t*)(B + SB_VT); const LAS bf16_t* Pm = (const LAS bf16_t*)(B + SB_P);
        const LAS float* DEC = (const LAS float*)(B + SB_DEC); LAS float* SSQ = (LAS float*)(B + SB_SSQ);
#define SCHED_FENCE() __builtin_amdgcn_sched_barrier(0)
#define QFRAG(a, mt) __builtin_bit_cast(bf16x8, (u32x4){(*(const LAS u32x2*)(QH + ((mt) * 16 + r) * HQ_STR + 32 * (a) + q * 4)).x, (*(const LAS u32x2*)(QH + ((mt) * 16 + r) * HQ_STR + 32 * (a) + q * 4)).y, \
                                                        (*(const LAS u32x2*)(QH + ((mt) * 16 + r) * HQ_STR + 32 * (a) + 16 + q * 4)).x, (*(const LAS u32x2*)(QH + ((mt) * 16 + r) * HQ_STR + 32 * (a) + 16 + q * 4)).y})
#define SFRAG(a) __builtin_bit_cast(bf16x8, (u32x4){pk_bf16(S[2 * (a)][0], S[2 * (a)][1]), pk_bf16(S[2 * (a)][2], S[2 * (a)][3]), pk_bf16(S[2 * (a) + 1][0], S[2 * (a) + 1][1]), pk_bf16(S[2 * (a) + 1][2], S[2 * (a) + 1][3])})
        f32x4 o[4];
#pragma unroll
        for (int mt = 0; mt < 4; ++mt) o[mt] = (f32x4){0.f, 0.f, 0.f, 0.f};
        bf16x8 qa[8], qb[8];
#pragma unroll
        for (int mt = 0; mt < 4; ++mt) { qa[mt] = QFRAG(0, mt); qa[4 + mt] = QFRAG(1, mt); }
        SCHED_FENCE();
#pragma unroll
        for (int mt = 0; mt < 4; ++mt) { qb[mt] = QFRAG(2, mt); qb[4 + mt] = QFRAG(3, mt); }
        { const bf16x8 s0 = SFRAG(0), s1 = SFRAG(1);
#pragma unroll
          for (int mt = 0; mt < 4; ++mt) o[mt] = MFMA16(s0, qa[mt], o[mt]);
#pragma unroll
          for (int mt = 0; mt < 4; ++mt) o[mt] = MFMA16(s1, qa[4 + mt], o[mt]); }
        SCHED_FENCE();
        bf16x8 vf[2], pf[6];
#pragma unroll
        for (int ks = 0; ks < 2; ++ks) vf[ks] = *(const LAS bf16x8*)(VT + (16 * wv + r) * HK_STR + ks * 32 + q * 8);
#pragma unroll
        for (int mt = 0; mt < 4; ++mt) pf[mt] = *(const LAS bf16x8*)(Pm + (mt * 16 + r) * HK_STR + q * 8);
        pf[4] = *(const LAS bf16x8*)(Pm + (2 * 16 + r) * HK_STR + 32 + q * 8); pf[5] = *(const LAS bf16x8*)(Pm + (3 * 16 + r) * HK_STR + 32 + q * 8);
        { const bf16x8 s2 = SFRAG(2), s3 = SFRAG(3);
#pragma unroll
          for (int mt = 0; mt < 4; ++mt) o[mt] = MFMA16(s2, qb[mt], o[mt]);
#pragma unroll
          for (int mt = 0; mt < 4; ++mt) o[mt] = MFMA16(s3, qb[4 + mt], o[mt]); }
        SCHED_FENCE();
        f32x4 deca[4], decb[4]; bf16x8 kfa[8], kfb[8];
#pragma unroll
        for (int kt = 0; kt < 4; ++kt) { deca[kt] = *(const LAS f32x4*)(DEC + kt * 16 + q * 4); kfa[2 * kt] = *(const LAS bf16x8*)(KHT + (kt * 16 + r) * HK_STR + q * 8); kfa[2 * kt + 1] = *(const LAS bf16x8*)(KHT + (kt * 16 + r) * HK_STR + 32 + q * 8); }
#pragma unroll
        for (int mt = 0; mt < 4; ++mt) o[mt] = MFMA16(vf[0], pf[mt], o[mt]);
        o[2] = MFMA16(vf[1], pf[4], o[2]); o[3] = MFMA16(vf[1], pf[5], o[3]);
        SCHED_FENCE();
#pragma unroll
        for (int kt = 4; kt < 8; ++kt) { decb[kt - 4] = *(const LAS f32x4*)(DEC + kt * 16 + q * 4); kfb[2 * (kt - 4)] = *(const LAS bf16x8*)(KHT + (kt * 16 + r) * HK_STR + q * 8); kfb[2 * (kt - 4) + 1] = *(const LAS bf16x8*)(KHT + (kt * 16 + r) * HK_STR + 32 + q * 8); }
#pragma unroll
        for (int kt = 0; kt < 4; ++kt) { S[kt] = S[kt] * deca[kt]; S[kt] = MFMA16(kfa[2 * kt], vf[0], S[kt]); S[kt] = MFMA16(kfa[2 * kt + 1], vf[1], S[kt]); }
        SCHED_FENCE();
#pragma unroll
        for (int kt = 4; kt < 8; ++kt) { S[kt] = S[kt] * decb[kt - 4]; S[kt] = MFMA16(kfb[2 * (kt - 4)], vf[0], S[kt]); S[kt] = MFMA16(kfb[2 * (kt - 4) + 1], vf[1], S[kt]); }
        float ss[4];
#pragma unroll
        for (int mt = 0; mt < 4; ++mt) { ss[mt] = (o[mt].x * o[mt].x + o[mt].y * o[mt].y) + (o[mt].z * o[mt].z + o[mt].w * o[mt].w); X.o[mt] = o[mt]; }
        float t16[4];
#pragma unroll
        for (int mt = 0; mt < 4; ++mt) t16[mt] = __shfl_xor(ss[mt], 16);
        SCHED_FENCE();
#pragma unroll
        for (int mt = 0; mt < 4; ++mt) ss[mt] += t16[mt];
#pragma unroll
        for (int mt = 0; mt < 4; ++mt) t16[mt] = __shfl_xor(ss[mt], 32);
        SCHED_FENCE();
#pragma unroll
        for (int mt = 0; mt < 4; ++mt) { ss[mt] += t16[mt]; if (q == 0) SSQ[wv * 64 + mt * 16 + r] = ss[mt]; }
#undef QFRAG
#undef SFRAG
    }
}
__device__ __forceinline__ void scan_item(const bf16_t* Qg, const bf16_t* Kg, const bf16_t* Vg, const bf16_t* Pg, const float* DECg, bf16_t* HGg, const float* gnorm, int bh, LAS unsigned char* lds, bool dry = false) {
    int tid_l = threadIdx.x; asm volatile("" : "+v"(tid_l));
    const int tid = tid_l, lane = tid & 63, wv = __builtin_amdgcn_readfirstlane(tid >> 6), r = lane & 15, q = lane >> 4;
    f32x4 S[8];
#pragma unroll
    for (int kt = 0; kt < 8; ++kt) S[kt] = (f32x4){0.f, 0.f, 0.f, 0.f};
    const f32x4 g4 = *(const f32x4*)(gnorm + 16 * wv + q * 4);
    const size_t cb = (size_t)(bh & 7) * 128, mb = (size_t)(bh >> 3) * SEQ;
    ScanRegs X, Y;
    X.dc = (f32x4){0.f, 0.f, 0.f, 0.f}; Y.dc = X.dc;
#pragma unroll
    for (int mt = 0; mt < 4; ++mt) { X.o[mt] = (f32x4){0.f, 0.f, 0.f, 0.f}; Y.o[mt] = X.o[mt]; X.hg[mt] = (u32x2){0u, 0u}; Y.hg[mt] = X.hg[mt]; }
    asm volatile("" ::: "memory");
    scan_load(X, Qg, Kg, Vg, Pg, DECg, bh, 0, mb, cb, tid, lane, wv);
    scan_load(Y, Qg, Kg, Vg, Pg, DECg, bh, 1, mb, cb, tid, lane, wv);
#pragma unroll 1
    for (int n = 0; n < SEQ / 64; n += 2) {
        scan_chunk(X, Y, S, g4, n, Qg, Kg, Vg, Pg, DECg, HGg, bh, mb, cb, tid, lane, wv, r, q, lds, dry);
        scan_chunk(Y, X, S, g4, n + 1, Qg, Kg, Vg, Pg, DECg, HGg, bh, mb, cb, tid, lane, wv, r, q, lds, dry);
    }
    scan_chunk(X, Y, S, g4, SEQ / 64, Qg, Kg, Vg, Pg, DECg, HGg, bh, mb, cb, tid, lane, wv, r, q, lds, dry);
    __syncthreads();
}

constexpr int NSEG = 4, CPS = (SEQ / 64) / NSEG;
struct Scan1Regs { unsigned q2[8], k2[8], v2[8]; u32x4 pr; f32x4 dc; };
__device__ __forceinline__ void scan1_load(Scan1Regs& R, const bf16_t* Qg, const bf16_t* Kg, const bf16_t* Vg, const bf16_t* Pg, const float* DECg, int bh, int n, size_t mb, size_t cb, int tid, int lane, int wv) {
    R.pr = *(const u32x4*)(Pg + (size_t)(bh * 32 + n) * 4096 + tid * 8);
    R.dc = *(const f32x4*)(DECg + (size_t)(bh * 32 + n) * 128 + (tid & 31) * 4);
    const size_t rb = (mb + (size_t)n * 64 + wv * 8) * 1024 + cb + 2 * lane;
#pragma unroll
    for (int i = 0; i < 8; ++i) { R.q2[i] = *(const unsigned*)(Qg + rb + (size_t)i * 1024); R.k2[i] = *(const unsigned*)(Kg + rb + (size_t)i * 1024); R.v2[i] = *(const unsigned*)(Vg + rb + (size_t)i * 1024); }
    asm volatile("" ::: "memory");
}
#define SCHED_FENCE() __builtin_amdgcn_sched_barrier(0)
#define QFRAG(a, mt) __builtin_bit_cast(bf16x8, (u32x4){(*(const LAS u32x2*)(QH + ((mt) * 16 + r) * HQ_STR + 32 * (a) + q * 4)).x, (*(const LAS u32x2*)(QH + ((mt) * 16 + r) * HQ_STR + 32 * (a) + q * 4)).y, \
                                                        (*(const LAS u32x2*)(QH + ((mt) * 16 + r) * HQ_STR + 32 * (a) + 16 + q * 4)).x, (*(const LAS u32x2*)(QH + ((mt) * 16 + r) * HQ_STR + 32 * (a) + 16 + q * 4)).y})
#define SFRAG(a) __builtin_bit_cast(bf16x8, (u32x4){pk_bf16(S[2 * (a)][0], S[2 * (a)][1]), pk_bf16(S[2 * (a)][2], S[2 * (a)][3]), pk_bf16(S[2 * (a) + 1][0], S[2 * (a) + 1][1]), pk_bf16(S[2 * (a) + 1][2], S[2 * (a) + 1][3])})
__device__ __forceinline__ void scan1_chunk(Scan1Regs& X, f32x4 (&S)[8], int n, int nlast, const bf16_t* Qg, const bf16_t* Kg, bf16_t* Vg, const bf16_t* Pg, const float* DECg,
                                            int bh, size_t mb, size_t cb, int tid, int lane, int wv, int r, int q, LAS unsigned char* lds) {
    LAS unsigned char* B = lds + (n & 1) * SB_SIZE;
    const size_t m0 = mb + (size_t)n * 64;
    LAS bf16_t* QH = (LAS bf16_t*)(B + SB_QH); LAS bf16_t* KHT = (LAS bf16_t*)(B + SB_KHT); LAS bf16_t* VT = (LAS bf16_t*)(B + SB_VT); LAS bf16_t* Pm = (LAS bf16_t*)(B + SB_P);
    const LAS float* DEC = (const LAS float*)(B + SB_DEC);
#pragma unroll
    for (int i = 0; i < 8; ++i) *(LAS unsigned*)(QH + (wv * 8 + i) * HQ_STR + 2 * lane) = X.q2[i];
    { u32x4 lo, hi; const unsigned* k2 = X.k2;
      lo.x = (k2[0] & 0xffffu) | (k2[1] << 16); lo.y = (k2[2] & 0xffffu) | (k2[3] << 16); lo.z = (k2[4] & 0xffffu) | (k2[5] << 16); lo.w = (k2[6] & 0xffffu) | (k2[7] << 16);
      hi.x = (k2[0] >> 16) | (k2[1] & 0xffff0000u); hi.y = (k2[2] >> 16) | (k2[3] & 0xffff0000u); hi.z = (k2[4] >> 16) | (k2[5] & 0xffff0000u); hi.w = (k2[6] >> 16) | (k2[7] & 0xffff0000u);
      *(LAS u32x4*)(KHT + (2 * lane) * HK_STR + wv * 8) = lo; *(LAS u32x4*)(KHT + (2 * lane + 1) * HK_STR + wv * 8) = hi; }
    { u32x4 lo, hi; const unsigned* v2 = X.v2;
      lo.x = (v2[0] & 0xffffu) | (v2[1] << 16); lo.y = (v2[2] & 0xffffu) | (v2[3] << 16); lo.z = (v2[4] & 0xffffu) | (v2[5] << 16); lo.w = (v2[6] & 0xffffu) | (v2[7] << 16);
      hi.x = (v2[0] >> 16) | (v2[1] & 0xffff0000u); hi.y = (v2[2] >> 16) | (v2[3] & 0xffff0000u); hi.z = (v2[4] >> 16) | (v2[5] & 0xffff0000u); hi.w = (v2[6] >> 16) | (v2[7] & 0xffff0000u);
      *(LAS u32x4*)(VT + (2 * lane) * HK_STR + wv * 8) = lo; *(LAS u32x4*)(VT + (2 * lane + 1) * HK_STR + wv * 8) = hi; }
    *(LAS u32x4*)(Pm + (tid >> 3) * HK_STR + (tid & 7) * 8) = X.pr;
    if (tid < 32) *(LAS f32x4*)((LAS float*)(B + SB_DEC) + tid * 4) = X.dc;
    scan1_load(X, Qg, Kg, Vg, Pg, DECg, bh, (n + 2 <= nlast) ? n + 2 : nlast, mb, cb, tid, lane, wv);
    LBAR();
    f32x4 o[4];
#pragma unroll
    for (int mt = 0; mt < 4; ++mt) o[mt] = (f32x4){0.f, 0.f, 0.f, 0.f};
    bf16x8 qa[8], qb[8];
#pragma unroll
    for (int mt = 0; mt < 4; ++mt) { qa[mt] = QFRAG(0, mt); qa[4 + mt] = QFRAG(1, mt); }
    SCHED_FENCE();
#pragma unroll
    for (int mt = 0; mt < 4; ++mt) { qb[mt] = QFRAG(2, mt); qb[4 + mt] = QFRAG(3, mt); }
    { const bf16x8 s0 = SFRAG(0), s1 = SFRAG(1);
#pragma unroll
      for (int mt = 0; mt < 4; ++mt) o[mt] = MFMA16(s0, qa[mt], o[mt]);
#pragma unroll
      for (int mt = 0; mt < 4; ++mt) o[mt] = MFMA16(s1, qa[4 + mt], o[mt]); }
    SCHED_FENCE();
    bf16x8 vf[2], pf[6];
#pragma unroll
    for (int ks = 0; ks < 2; ++ks) vf[ks] = *(const LAS bf16x8*)(VT + (16 * wv + r) * HK_STR + ks * 32 + q * 8);
#pragma unroll
    for (int mt = 0; mt < 4; ++mt) pf[mt] = *(const LAS bf16x8*)(Pm + (mt * 16 + r) * HK_STR + q * 8);
    pf[4] = *(const LAS bf16x8*)(Pm + (2 * 16 + r) * HK_STR + 32 + q * 8); pf[5] = *(const LAS bf16x8*)(Pm + (3 * 16 + r) * HK_STR + 32 + q * 8);
    { const bf16x8 s2 = SFRAG(2), s3 = SFRAG(3);
#pragma unroll
      for (int mt = 0; mt < 4; ++mt) o[mt] = MFMA16(s2, qb[mt], o[mt]);
#pragma unroll
      for (int mt = 0; mt < 4; ++mt) o[mt] = MFMA16(s3, qb[4 + mt], o[mt]); }
    SCHED_FENCE();
    f32x4 deca[4], decb[4]; bf16x8 kfa[8], kfb[8];
#pragma unroll
    for (int kt = 0; kt < 4; ++kt) { deca[kt] = *(const LAS f32x4*)(DEC + kt * 16 + q * 4); kfa[2 * kt] = *(const LAS bf16x8*)(KHT + (kt * 16 + r) * HK_STR + q * 8); kfa[2 * kt + 1] = *(const LAS bf16x8*)(KHT + (kt * 16 + r) * HK_STR + 32 + q * 8); }
#pragma unroll
    for (int mt = 0; mt < 4; ++mt) o[mt] = MFMA16(vf[0], pf[mt], o[mt]);
    o[2] = MFMA16(vf[1], pf[4], o[2]); o[3] = MFMA16(vf[1], pf[5], o[3]);
    SCHED_FENCE();
#pragma unroll
    for (int kt = 4; kt < 8; ++kt) { decb[kt - 4] = *(const LAS f32x4*)(DEC + kt * 16 + q * 4); kfb[2 * (kt - 4)] = *(const LAS bf16x8*)(KHT + (kt * 16 + r) * HK_STR + q * 8); kfb[2 * (kt - 4) + 1] = *(const LAS bf16x8*)(KHT + (kt * 16 + r) * HK_STR + 32 + q * 8); }
#pragma unroll
    for (int kt = 0; kt < 4; ++kt) { S[kt] = S[kt] * deca[kt]; S[kt] = MFMA16(kfa[2 * kt], vf[0], S[kt]); S[kt] = MFMA16(kfa[2 * kt + 1], vf[1], S[kt]); }
    SCHED_FENCE();
#pragma unroll
    for (int kt = 4; kt < 8; ++kt) { S[kt] = S[kt] * decb[kt - 4]; S[kt] = MFMA16(kfb[2 * (kt - 4)], vf[0], S[kt]); S[kt] = MFMA16(kfb[2 * (kt - 4) + 1], vf[1], S[kt]); }
#pragma unroll
    for (int mt = 0; mt < 4; ++mt) { u32x2 w; w.x = pk_bf16(o[mt].x, o[mt].y); w.y = pk_bf16(o[mt].z, o[mt].w);
        *(u32x2*)(Vg + (m0 + mt * 16 + r) * 1024 + cb + 16 * wv + q * 4) = w; }
}
__device__ __forceinline__ void scan1_item(const bf16_t* Qg, const bf16_t* Kg, bf16_t* Vg, const bf16_t* Pg, const float* DECg, float* SLOC, float* DSEG, int item, LAS unsigned char* lds) {
    int tid_l = threadIdx.x; asm volatile("" : "+v"(tid_l));
    const int tid = tid_l, lane = tid & 63, wv = __builtin_amdgcn_readfirstlane(tid >> 6), r = lane & 15, q = lane >> 4;
    const int bh = item >> 2, seg = item & 3, n0 = seg * CPS, nlast = n0 + CPS - 1;
    f32x4 S[8];
#pragma unroll
    for (int kt = 0; kt < 8; ++kt) S[kt] = (f32x4){0.f, 0.f, 0.f, 0.f};
    const size_t cb = (size_t)(bh & 7) * 128, mb = (size_t)(bh >> 3) * SEQ;
    Scan1Regs X, Y;
    asm volatile("" ::: "memory");
    scan1_load(X, Qg, Kg, Vg, Pg, DECg, bh, n0, mb, cb, tid, lane, wv);
    scan1_load(Y, Qg, Kg, Vg, Pg, DECg, bh, n0 + 1, mb, cb, tid, lane, wv);
#pragma unroll 1
    for (int n = n0; n <= nlast; n += 2) {
        scan1_chunk(X, S, n, nlast, Qg, Kg, Vg, Pg, DECg, bh, mb, cb, tid, lane, wv, r, q, lds);
        scan1_chunk(Y, S, n + 1, nlast, Qg, Kg, Vg, Pg, DECg, bh, mb, cb, tid, lane, wv, r, q, lds);
    }
    f32x4* sl = (f32x4*)SLOC + ((size_t)item * 8 + wv) * 8 * 64 + lane;
#pragma unroll
    for (int kt = 0; kt < 8; ++kt) sl[kt * 64] = S[kt];
    if (wv == 0 && r == 0) {
#pragma unroll
        for (int kt = 0; kt < 8; ++kt) { f32x4 cdv = (f32x4){1.f, 1.f, 1.f, 1.f};
            for (int n = n0; n <= nlast; ++n) cdv = cdv * *(const f32x4*)(DECg + (size_t)(bh * 32 + n) * 128 + kt * 16 + q * 4);
            *(f32x4*)(DSEG + (size_t)item * 128 + kt * 16 + q * 4) = cdv; } }
    __syncthreads();
}

constexpr int F_QH = 0, F_QT = 17408, F_KT = 34816, F_KHT = 52224, F_VT = 70656, F_P = 89088, F_TOT = 98304, F_DEC = 102400;
struct FRegs { unsigned q2[8], z2[8], v2[8]; };
__device__ __forceinline__ void f_load(FRegs& R, const bf16_t* Qg, const bf16_t* LFg, const bf16_t* Vg, int n, size_t mb, size_t cb, int lane, int wv) {
    const size_t rb = (mb + (size_t)n * 64 + wv * 8) * 1024 + cb + 2 * lane;
#pragma unroll
    for (int i = 0; i < 8; ++i) { R.q2[i] = *(const unsigned*)(Qg + rb + (size_t)i * 1024); R.z2[i] = *(const unsigned*)(LFg + rb + (size_t)i * 1024); R.v2[i] = *(const unsigned*)(Vg + rb + (size_t)i * 1024); }
    asm volatile("" ::: "memory");
}
__device__ __forceinline__ void f_chunk(FRegs& X, f32x4 (&S)[8], float& cd0, float& cd1, int n, int nlast, const float lb0, const float lb1, bf16_t* Qg, const bf16_t* LFg, bf16_t* Vg, float* DECg,
                                        int bh, size_t mb, size_t cb, int tid, int lane, int wv, int r, int q, LAS unsigned char* lds) {
    LAS bf16_t* QH = (LAS bf16_t*)(lds + F_QH); LAS bf16_t* QT = (LAS bf16_t*)(lds + F_QT); LAS bf16_t* KT = (LAS bf16_t*)(lds + F_KT);
    LAS bf16_t* KHT = (LAS bf16_t*)(lds + F_KHT); LAS bf16_t* VT = (LAS bf16_t*)(lds + F_VT); LAS bf16_t* Pm = (LAS bf16_t*)(lds + F_P);
    LAS float* TOT = (LAS float*)(lds + F_TOT); LAS float* DEC = (LAS float*)(lds + F_DEC);
    const size_t m0 = mb + (size_t)n * 64, rb = (m0 + wv * 8) * 1024 + cb + 2 * lane;
    float f0[8], f1[8]; float run0 = 0.f, run1 = 0.f;
#pragma unroll
    for (int i = 0; i < 8; ++i) { const float z0 = h_lo(X.z2[i]), z1 = h_hi(X.z2[i]);
        f0[i] = fmaxf(lb0 + (1.f - lb0) * sigmoid_f(z0), 1e-30f); f1[i] = fmaxf(lb1 + (1.f - lb1) * sigmoid_f(z1), 1e-30f); run0 += flog(f0[i]); run1 += flog(f1[i]); }
    *(LAS f32x2*)(TOT + wv * 128 + 2 * lane) = (f32x2){run0, run1};
    LBAR();
    float pre0 = 0.f, pre1 = 0.f, last0 = 0.f, last1 = 0.f;
#pragma unroll
    for (int w = 0; w < 8; ++w) { const f32x2 t = *(const LAS f32x2*)(TOT + w * 128 + 2 * lane); last0 += t.x; last1 += t.y; if (w < wv) { pre0 += t.x; pre1 += t.y; } }
    { const f32x2 dv = (f32x2){fexp(last0), fexp(last1)}; cd0 *= dv.x; cd1 *= dv.y;
      if (wv == 0) { *(LAS f32x2*)(DEC + 2 * lane) = dv; *(f32x2*)(DECg + (size_t)(bh * 32 + n) * 128 + 2 * lane) = dv; } }
    const float sc0 = fexp(fminf(-0.5f * last0, 60.f)), sc1 = fexp(fminf(-0.5f * last1, 60.f));
    float pf0 = fexp(pre0), pf1 = fexp(pre1), sf0 = fexp(last0 - pre0 - run0), sf1 = fexp(last1 - pre1 - run1);
    { float kh0[8], kh1[8];
#pragma unroll
      for (int i = 7; i >= 0; --i) { kh0[i] = (1.f - f0[i]) * sf0; kh1[i] = (1.f - f1[i]) * sf1; sf0 *= f0[i]; sf1 *= f1[i]; }
#pragma unroll
      for (int i = 0; i < 8; ++i) { pf0 *= f0[i]; pf1 *= f1[i];
          const float qh0 = silu_f(bf_lo(X.q2[i])) * pf0, qh1 = silu_f(bf_hi(X.q2[i])) * pf1; const int t = wv * 8 + i; const unsigned qp = pk_bf16(qh0, qh1);
          *(unsigned*)(Qg + rb + (size_t)i * 1024) = qp;
          *(LAS unsigned*)(QH + t * HQ_STR + 2 * lane) = qp;
          *(LAS unsigned*)(QT + t * HQ_STR + 2 * lane) = pk_bf16(qh0 * sc0, qh1 * sc1);
          *(LAS unsigned*)(KT + t * HQ_STR + 2 * lane) = pk_bf16(kh0[i] * sc0, kh1[i] * sc1); }
      u32x4 a, c; a.x = pk_bf16(kh0[0], kh0[1]); a.y = pk_bf16(kh0[2], kh0[3]); a.z = pk_bf16(kh0[4], kh0[5]); a.w = pk_bf16(kh0[6], kh0[7]);
      c.x = pk_bf16(kh1[0], kh1[1]); c.y = pk_bf16(kh1[2], kh1[3]); c.z = pk_bf16(kh1[4], kh1[5]); c.w = pk_bf16(kh1[6], kh1[7]);
      *(LAS u32x4*)(KHT + (2 * lane) * HK_STR + wv * 8) = a; *(LAS u32x4*)(KHT + (2 * lane + 1) * HK_STR + wv * 8) = c; }
    { u32x4 lo, hi; const unsigned* v2 = X.v2;
      lo.x = (v2[0] & 0xffffu) | (v2[1] << 16); lo.y = (v2[2] & 0xffffu) | (v2[3] << 16); lo.z = (v2[4] & 0xffffu) | (v2[5] << 16); lo.w = (v2[6] & 0xffffu) | (v2[7] << 16);
      hi.x = (v2[0] >> 16) | (v2[1] & 0xffff0000u); hi.y = (v2[2] >> 16) | (v2[3] & 0xffff0000u); hi.z = (v2[4] >> 16) | (v2[5] & 0xffff0000u); hi.w = (v2[6] >> 16) | (v2[7] & 0xffff0000u);
      *(LAS u32x4*)(VT + (2 * lane) * HK_STR + wv * 8) = lo; *(LAS u32x4*)(VT + (2 * lane + 1) * HK_STR + wv * 8) = hi; }
    f_load(X, Qg, LFg, Vg, (n + 2 <= nlast) ? n + 2 : nlast, mb, cb, lane, wv);
    LBAR();
    const int ti = wv >> 1;
    { bf16x8 qf[4], kf[2][4];
#pragma unroll
      for (int ks = 0; ks < 4; ++ks) { qf[ks] = *(const LAS bf16x8*)(QT + (ti * 16 + r) * HQ_STR + ks * 32 + q * 8);
          kf[0][ks] = *(const LAS bf16x8*)(KT + ((2 * (wv & 1)) * 16 + r) * HQ_STR + ks * 32 + q * 8); kf[1][ks] = *(const LAS bf16x8*)(KT + ((2 * (wv & 1) + 1) * 16 + r) * HQ_STR + ks * 32 + q * 8); }
      SCHED_FENCE();
#pragma unroll
      for (int jj = 0; jj < 2; ++jj) { const int tj = 2 * (wv & 1) + jj; f32x4 sc = (f32x4){0.f, 0.f, 0.f, 0.f};
          if (tj <= ti) {
#pragma unroll
              for (int ks = 0; ks < 4; ++ks) sc = MFMA16(kf[jj][ks], qf[ks], sc); }
          const int t = ti * 16 + r, s0 = tj * 16 + q * 4;
#pragma unroll
          for (int j = 0; j < 4; ++j) sc[j] = (s0 + j <= t) ? sc[j] : 0.f;
          u32x2 w; w.x = pk_bf16(sc[0], sc[1]); w.y = pk_bf16(sc[2], sc[3]);
          *(LAS u32x2*)(Pm + t * HK_STR + s0) = w; } }
    f32x4 o[4];
#pragma unroll
    for (int mt = 0; mt < 4; ++mt) o[mt] = (f32x4){0.f, 0.f, 0.f, 0.f};
    { bf16x8 qa[8], qb[8];
#pragma unroll
      for (int mt = 0; mt < 4; ++mt) { qa[mt] = QFRAG(0, mt); qa[4 + mt] = QFRAG(1, mt); }
      SCHED_FENCE();
#pragma unroll
      for (int mt = 0; mt < 4; ++mt) { qb[mt] = QFRAG(2, mt); qb[4 + mt] = QFRAG(3, mt); }
      { const bf16x8 s0 = SFRAG(0), s1 = SFRAG(1);
#pragma unroll
        for (int mt = 0; mt < 4; ++mt) o[mt] = MFMA16(s0, qa[mt], o[mt]);
#pragma unroll
        for (int mt = 0; mt < 4; ++mt) o[mt] = MFMA16(s1, qa[4 + mt], o[mt]); }
      SCHED_FENCE();
      { const bf16x8 s2 = SFRAG(2), s3 = SFRAG(3);
#pragma unroll
        for (int mt = 0; mt < 4; ++mt) o[mt] = MFMA16(s2, qb[mt], o[mt]);
#pragma unroll
        for (int mt = 0; mt < 4; ++mt) o[mt] = MFMA16(s3, qb[4 + mt], o[mt]); } }
    LBAR();
    bf16x8 vf[2], pf[6];
#pragma unroll
    for (int ks = 0; ks < 2; ++ks) vf[ks] = *(const LAS bf16x8*)(VT + (16 * wv + r) * HK_STR + ks * 32 + q * 8);
#pragma unroll
    for (int mt = 0; mt < 4; ++mt) pf[mt] = *(const LAS bf16x8*)(Pm + (mt * 16 + r) * HK_STR + q * 8);
    pf[4] = *(const LAS bf16x8*)(Pm + (2 * 16 + r) * HK_STR + 32 + q * 8); pf[5] = *(const LAS bf16x8*)(Pm + (3 * 16 + r) * HK_STR + 32 + q * 8);
    SCHED_FENCE();
    f32x4 deca[4], decb[4]; bf16x8 kfa[8], kfb[8];
#pragma unroll
    for (int kt = 0; kt < 4; ++kt) { deca[kt] = *(const LAS f32x4*)(DEC + kt * 16 + q * 4); kfa[2 * kt] = *(const LAS bf16x8*)(KHT + (kt * 16 + r) * HK_STR + q * 8); kfa[2 * kt + 1] = *(const LAS bf16x8*)(KHT + (kt * 16 + r) * HK_STR + 32 + q * 8); }
#pragma unroll
    for (int mt = 0; mt < 4; ++mt) o[mt] = MFMA16(vf[0], pf[mt], o[mt]);
    o[2] = MFMA16(vf[1], pf[4], o[2]); o[3] = MFMA16(vf[1], pf[5], o[3]);
    SCHED_FENCE();
#pragma unroll
    for (int kt = 4; kt < 8; ++kt) { decb[kt - 4] = *(const LAS f32x4*)(DEC + kt * 16 + q * 4); kfb[2 * (kt - 4)] = *(const LAS bf16x8*)(KHT + (kt * 16 + r) * HK_STR + q * 8); kfb[2 * (kt - 4) + 1] = *(const LAS bf16x8*)(KHT + (kt * 16 + r) * HK_STR + 32 + q * 8); }
#pragma unroll
    for (int kt = 0; kt < 4; ++kt) { S[kt] = S[kt] * deca[kt]; S[kt] = MFMA16(kfa[2 * kt], vf[0], S[kt]); S[kt] = MFMA16(kfa[2 * kt + 1], vf[1], S[kt]); }
    SCHED_FENCE();
#pragma unroll
    for (int kt = 4; kt < 8; ++kt) { S[kt] = S[kt] * decb[kt - 4]; S[kt] = MFMA16(kfb[2 * (kt - 4)], vf[0], S[kt]); S[kt] = MFMA16(kfb[2 * (kt - 4) + 1], vf[1], S[kt]); }
#pragma unroll
    for (int mt = 0; mt < 4; ++mt) { u32x2 w; w.x = pk_bf16(o[mt].x, o[mt].y); w.y = pk_bf16(o[mt].z, o[mt].w);
        *(u32x2*)(Vg + (m0 + mt * 16 + r) * 1024 + cb + 16 * wv + q * 4) = w; }
}
__device__ __forceinline__ void f_item(bf16_t* Qg, const bf16_t* LFg, bf16_t* Vg, float* DECg, float* SLOC, float* DSEG, const float* lbl, int item, LAS unsigned char* lds) {
    int tid_l = threadIdx.x; asm volatile("" : "+v"(tid_l));
    const int tid = tid_l, lane = tid & 63, wv = __builtin_amdgcn_readfirstlane(tid >> 6), r = lane & 15, q = lane >> 4;
    const int bh = item >> 2, seg = item & 3, n0 = seg * CPS, nlast = n0 + CPS - 1;
    f32x4 S[8];
#pragma unroll
    for (int kt = 0; kt < 8; ++kt) S[kt] = (f32x4){0.f, 0.f, 0.f, 0.f};
    const size_t cb = (size_t)(bh & 7) * 128, mb = (size_t)(bh >> 3) * SEQ;
    const f32x2 lbp = *(const f32x2*)(lbl + (bh & 7) * 128 + 2 * lane);
    FRegs X, Y; float cd0 = 1.f, cd1 = 1.f;
    asm volatile("" ::: "memory");
    f_load(X, Qg, LFg, Vg, n0, mb, cb, lane, wv);
    f_load(Y, Qg, LFg, Vg, n0 + 1, mb, cb, lane, wv);
#pragma unroll 1
    for (int n = n0; n <= nlast; n += 2) {
        f_chunk(X, S, cd0, cd1, n, nlast, lbp.x, lbp.y, Qg, LFg, Vg, DECg, bh, mb, cb, tid, lane, wv, r, q, lds);
        f_chunk(Y, S, cd0, cd1, n + 1, nlast, lbp.x, lbp.y, Qg, LFg, Vg, DECg, bh, mb, cb, tid, lane, wv, r, q, lds);
    }
    f32x4* sl = (f32x4*)SLOC + ((size_t)item * 8 + wv) * 8 * 64 + lane;
#pragma unroll
    for (int kt = 0; kt < 8; ++kt) sl[kt * 64] = S[kt];
    if (wv == 0) *(f32x2*)(DSEG + (size_t)item * 128 + 2 * lane) = (f32x2){cd0, cd1};
    __syncthreads();
}

struct Scan2Regs { unsigned q2[8]; f32x4 dc; u32x2 ol[4], hg[4], hgc[4]; f32x4 o[4]; };
__device__ __forceinline__ void scan2_load(Scan2Regs& R, const bf16_t* Qg, const bf16_t* OLg, const bf16_t* HGg, const float* DECg, int bh, int n, size_t mb, size_t cb, int tid, int lane, int wv, int r, int q) {
    R.dc = *(const f32x4*)(DECg + (size_t)(bh * 32 + n) * 128 + (tid & 31) * 4);
    const size_t rb = (mb + (size_t)n * 64 + wv * 8) * 1024 + cb + 2 * lane;
#pragma unroll
    for (int i = 0; i < 8; ++i) R.q2[i] = *(const unsigned*)(Qg + rb + (size_t)i * 1024);
#pragma unroll
    for (int mt = 0; mt < 4; ++mt) { const size_t ob = (mb + (size_t)n * 64 + mt * 16 + r) * 1024 + cb + 16 * wv + q * 4; R.ol[mt] = *(const u32x2*)(OLg + ob); R.hg[mt] = *(const u32x2*)(HGg + ob); }
    asm volatile("" ::: "memory");
}
__device__ __forceinline__ void scan2_chunk(Scan2Regs& X, Scan2Regs& Y, f32x4 (&S)[8], const f32x4 g4, int n, int n0, int nlast, const bf16_t* Qg, const bf16_t* OLg, bf16_t* HGg, const float* DECg,
                                            int bh, size_t mb, size_t cb, int tid, int lane, int wv, int r, int q, LAS unsigned char* lds) {
    LAS unsigned char* B = lds + (n & 1) * SB_SIZE;
    const size_t m0 = mb + (size_t)n * 64;
    u32x2 olx[4];
    if (n <= nlast) {
        LAS bf16_t* QH = (LAS bf16_t*)(B + SB_QH);
#pragma unroll
        for (int i = 0; i < 8; ++i) *(LAS unsigned*)(QH + (wv * 8 + i) * HQ_STR + 2 * lane) = X.q2[i];
        if (tid < 32) *(LAS f32x4*)((LAS float*)(B + SB_DEC) + tid * 4) = X.dc;
#pragma unroll
        for (int mt = 0; mt < 4; ++mt) { X.hgc[mt] = X.hg[mt]; olx[mt] = X.ol[mt]; }
        scan2_load(X, Qg, OLg, HGg, DECg, bh, (n + 2 <= nlast) ? n + 2 : nlast, mb, cb, tid, lane, wv, r, q);
    }
    LBAR();
    if (n > n0) {
        const LAS float* SSQ = (const LAS float*)(lds + ((n - 1) & 1) * SB_SIZE + SB_SSQ);
#pragma unroll
        for (int mt = 0; mt < 4; ++mt) { float tot = 0.f;
#pragma unroll
            for (int w = 0; w < 8; ++w) tot += SSQ[w * 64 + mt * 16 + r];
            const float rstd = rsqrtf(tot * (1.f / 128.f) + EPS);
            const f32x4 ov = Y.o[mt] * rstd * g4 * (f32x4){silu_f(bf_lo(Y.hgc[mt].x)), silu_f(bf_hi(Y.hgc[mt].x)), silu_f(bf_lo(Y.hgc[mt].y)), silu_f(bf_hi(Y.hgc[mt].y))};
            u32x2 w; w.x = pk_bf16(ov.x, ov.y); w.y = pk_bf16(ov.z, ov.w);
            *(u32x2*)(HGg + (m0 - 64 + mt * 16 + r) * 1024 + cb + 16 * wv + q * 4) = w; }
    }
    if (n <= nlast) {
        const LAS bf16_t* QH = (const LAS bf16_t*)(B + SB_QH); const LAS float* DEC = (const LAS float*)(B + SB_DEC); LAS float* SSQ = (LAS float*)(B + SB_SSQ);
        f32x4 o[4];
#pragma unroll
        for (int mt = 0; mt < 4; ++mt) o[mt] = (f32x4){bf_lo(olx[mt].x), bf_hi(olx[mt].x), bf_lo(olx[mt].y), bf_hi(olx[mt].y)};
        bf16x8 qa[8], qb[8];
#pragma unroll
        for (int mt = 0; mt < 4; ++mt) { qa[mt] = QFRAG(0, mt); qa[4 + mt] = QFRAG(1, mt); }
        SCHED_FENCE();
#pragma unroll
        for (int mt = 0; mt < 4; ++mt) { qb[mt] = QFRAG(2, mt); qb[4 + mt] = QFRAG(3, mt); }
        { const bf16x8 s0 = SFRAG(0), s1 = SFRAG(1);
#pragma unroll
          for (int mt = 0; mt < 4; ++mt) o[mt] = MFMA16(s0, qa[mt], o[mt]);
#pragma unroll
          for (int mt = 0; mt < 4; ++mt) o[mt] = MFMA16(s1, qa[4 + mt], o[mt]); }
        SCHED_FENCE();
        f32x4 dec[8];
#pragma unroll
        for (int kt = 0; kt < 8; ++kt) dec[kt] = *(const LAS f32x4*)(DEC + kt * 16 + q * 4);
        { const bf16x8 s2 = SFRAG(2), s3 = SFRAG(3);
#pragma unroll
          for (int mt = 0; mt < 4; ++mt) o[mt] = MFMA16(s2, qb[mt], o[mt]);
#pragma unroll
          for (int mt = 0; mt < 4; ++mt) o[mt] = MFMA16(s3, qb[4 + mt], o[mt]); }
        SCHED_FENCE();
#pragma unroll
        for (int kt = 0; kt < 8; ++kt) S[kt] = S[kt] * dec[kt];
        float ss[4], t16[4];
#pragma unroll
        for (int mt = 0; mt < 4; ++mt) { ss[mt] = (o[mt].x * o[mt].x + o[mt].y * o[mt].y) + (o[mt].z * o[mt].z + o[mt].w * o[mt].w); X.o[mt] = o[mt]; }
#pragma unroll
        for (int mt = 0; mt < 4; ++mt) t16[mt] = __shfl_xor(ss[mt], 16);
        SCHED_FENCE();
#pragma unroll
        for (int mt = 0; mt < 4; ++mt) ss[mt] += t16[mt];
#pragma unroll
        for (int mt = 0; mt < 4; ++mt) t16[mt] = __shfl_xor(ss[mt], 32);
        SCHED_FENCE();
#pragma unroll
        for (int mt = 0; mt < 4; ++mt) { ss[mt] += t16[mt]; if (q == 0) SSQ[wv * 64 + mt * 16 + r] = ss[mt]; }
    }
}
__device__ __forceinline__ void scan2_item(const bf16_t* Qg, const bf16_t* OLg, bf16_t* HGg, const float* DECg, const float* SLOC, const float* DSEG, const float* gnorm, int item, LAS unsigned char* lds) {
    int tid_l = threadIdx.x; asm volatile("" : "+v"(tid_l));
    const int tid = tid_l, lane = tid & 63, wv = __builtin_amdgcn_readfirstlane(tid >> 6), r = lane & 15, q = lane >> 4;
    const int bh = item >> 2, seg = item & 3, n0 = seg * CPS, nlast = n0 + CPS - 1;
    const f32x4 g4 = *(const f32x4*)(gnorm + 16 * wv + q * 4);
    const size_t cb = (size_t)(bh & 7) * 128, mb = (size_t)(bh >> 3) * SEQ;
    Scan2Regs X, Y;
#pragma unroll
    for (int mt = 0; mt < 4; ++mt) { X.o[mt] = (f32x4){0.f, 0.f, 0.f, 0.f}; Y.o[mt] = X.o[mt]; X.hgc[mt] = (u32x2){0u, 0u}; Y.hgc[mt] = X.hgc[mt]; }
    asm volatile("" ::: "memory");
    scan2_load(X, Qg, OLg, HGg, DECg, bh, n0, mb, cb, tid, lane, wv, r, q);
    scan2_load(Y, Qg, OLg, HGg, DECg, bh, n0 + 1, mb, cb, tid, lane, wv, r, q);
    f32x4 S[8];
#pragma unroll
    for (int kt = 0; kt < 8; ++kt) S[kt] = (f32x4){0.f, 0.f, 0.f, 0.f};
    { const f32x4* sl0 = (const f32x4*)SLOC + ((size_t)(bh * NSEG + 0) * 8 + wv) * 8 * 64 + lane; const f32x4* sl1 = sl0 + (size_t)8 * 8 * 64; const f32x4* sl2 = sl1 + (size_t)8 * 8 * 64;
      const float* d1 = DSEG + (size_t)(bh * NSEG + 1) * 128 + q * 4; const float* d2 = d1 + 128;
      if (seg == 1) {
#pragma unroll
          for (int kt = 0; kt < 8; ++kt) S[kt] = sl0[kt * 64];
      } else if (seg == 2) {
#pragma unroll
          for (int kt = 0; kt < 8; ++kt) S[kt] = sl0[kt * 64] * *(const f32x4*)(d1 + kt * 16) + sl1[kt * 64];
      } else if (seg == 3) {
#pragma unroll
          for (int kt = 0; kt < 8; ++kt) S[kt] = (sl0[kt * 64] * *(const f32x4*)(d1 + kt * 16) + sl1[kt * 64]) * *(const f32x4*)(d2 + kt * 16) + sl2[kt * 64];
      } }
    static_assert(NSEG == 4, "the segment fold above is written out for 4 segments");
#pragma unroll 1
    for (int n = n0; n <= nlast; n += 2) {
        scan2_chunk(X, Y, S, g4, n, n0, nlast, Qg, OLg, HGg, DECg, bh, mb, cb, tid, lane, wv, r, q, lds);
        scan2_chunk(Y, X, S, g4, n + 1, n0, nlast, Qg, OLg, HGg, DECg, bh, mb, cb, tid, lane, wv, r, q, lds);
    }
    scan2_chunk(X, Y, S, g4, nlast + 1, n0, nlast, Qg, OLg, HGg, DECg, bh, mb, cb, tid, lane, wv, r, q, lds);
    __syncthreads();
}
#undef QFRAG
#undef SFRAG

__global__ void __launch_bounds__(512, 2) fwd_megakernel(Params p) {
    extern __shared__ __attribute__((aligned(16))) unsigned char lds_raw[];
    LAS unsigned char* lds = (LAS unsigned char*)lds_raw;
#ifdef USE_CG_SYNC
    cg::grid_group grid = cg::this_grid();
#endif
    const int G = gridDim.x, blk = blockIdx.x;
    unsigned char* ws = p.ws;
    float* ADA = (float*)(ws + WS_ADA);
    bf16_t* H = (bf16_t*)(ws + WS_H); bf16_t* PV = (bf16_t*)(ws + WS_PV); bf16_t* PG = (bf16_t*)(ws + WS_PG); bf16_t* Q = (bf16_t*)(ws + WS_Q);
    bf16_t* LF = (bf16_t*)(ws + WS_LF); bf16_t* V = (bf16_t*)(ws + WS_V); bf16_t* HG = (bf16_t*)(ws + WS_HG);
    bf16_t* GATE = Q; bf16_t* MERGED = LF; bf16_t* Y = V;

    volatile LAS unsigned* stw = (volatile LAS unsigned*)(lds + LDS_BARW);
    unsigned* barw = (unsigned*)(ws + WS_BAR);
    if (threadIdx.x < 4) stw[threadIdx.x] = 0u;
    __syncthreads();
#ifdef USE_CG_SYNC
    if (blk == 0) for (int i = threadIdx.x; i < XCD_BAR_WORDS; i += 512) barw[i] = 0u;
    p0_prologue(p, lds);
    grid.sync();
    const XcdBarrier xb = xcd_barrier_post(barw, stw);
#else
    const XcdBarrier xb = xcd_barrier_post(barw, stw);
    p0_prologue(p, lds);
#ifdef DUP_P0
    __syncthreads(); p0_prologue(p, lds);
#endif
    xcd_barrier(xb);
#endif
#define GSYNC() xcd_barrier(xb)
#pragma unroll 1
    for (int l = 0; l < NL; ++l) {
#ifndef SKIP_P1
        if (l == 0) p1_rows<false, true>(p.x, nullptr, nullptr, nullptr, nullptr, p.g_pre, ADA, H);
        else p1_rows<true, true>(p.x, Y, ADA + (size_t)(l - 1) * NB * 3072, p.g_post + (size_t)(l - 1) * D, p.out, p.g_pre + (size_t)l * D, ADA + (size_t)l * NB * 3072, H);
#ifdef DUP_P1
        if (l == 0) p1_rows<false, true>(p.x, nullptr, nullptr, nullptr, nullptr, p.g_pre, ADA, H);
        else p1_rows<true, true>(p.x, Y, ADA + (size_t)(l - 1) * NB * 3072, p.g_post + (size_t)(l - 1) * D, p.out, p.g_pre + (size_t)l * D, ADA + (size_t)l * NB * 3072, H);
#endif
#endif
        GSYNC();
#pragma unroll 1
        for (int s = 0; s < 4; ++s) {
            const bf16_t* WinT = (const bf16_t*)(ws + WS_WIN) + (size_t)l * INW * D;
            pg8::Gemm g; g.M = M; g.N = D; g.K = D; g.A = nullptr; g.Bt = nullptr;
            pg8::StaticOrder S;
            if (s == 0) { g.N = NIN; S.init(M, NIN, G, blk); S.A0 = H; S.B0 = WinT; S.mode0 = 0; }
            else if (s == 1) { S.init(M, D, G, blk); S.dup = 3; S.A0 = H; S.B0 = WinT + (size_t)5120 * D; S.mode0 = 1;
                               S.A2 = HG; S.B2 = (const bf16_t*)(ws + WS_WHO) + (size_t)l * D * D; S.mode2 = 2; }
            else if (s == 2) { g.K = 512; S.init(M, D, G, blk); S.A0 = PG; S.B0 = (const bf16_t*)(ws + WS_WPO) + (size_t)l * D * 512; S.mode0 = 3; }
            else { S.init(M, D, G, blk); S.A0 = MERGED; S.B0 = (const bf16_t*)(ws + WS_WOUT) + (size_t)l * D * D; S.mode0 = 4; }
            EpiU E{ws};
#ifdef PROBE_G
            const unsigned long long tg0 = __builtin_amdgcn_s_memrealtime();
#endif
            pg8::gemm_phase<EpiU, pg8::StaticOrder, PG8_ALIGN_SEL, PG8_SP2_SEL>(lds, g, S, E);
#ifdef PROBE_G
            if ((PROBE_G >> s) & 1) probe_acc += __builtin_amdgcn_s_memrealtime() - tg0;
#endif
            if (s == 0) {
                GSYNC();
#ifdef PROBE_P3
                const unsigned long long tp0 = __builtin_amdgcn_s_memrealtime();
#endif
                bf16_t* Pg = (bf16_t*)(ws + WS_P); float* DECg = (float*)(ws + WS_DEC);
                float* SLOC = (float*)(ws + WS_P); float* DSEG = (float*)(ws + WS_DSEG);
                const bool own = (G == NB * 8 * NSEG);
                if (!own) prep_items(Q, LF, Pg, DECg, (const float*)(ws + WS_LB) + l * 1024, blk, G, 2048, lds);
                if ((G & 3) == 0) {
                    const int gq = blk & 3; const bf16_t* pw = (const bf16_t*)(ws + WS_POOLWT) + (size_t)(l * 4 + gq) * 16384; const float* ps = p.pool_scale + l * 512 + gq * 128;
                    __syncthreads();
                    if (gq == 0) pool_tiles<2>(PV, PG, pw, ps, gq, blk >> 2, G >> 2, lds); else if (gq == 1) pool_tiles<4>(PV, PG, pw, ps, gq, blk >> 2, G >> 2, lds);
                    else if (gq == 2) pool_tiles<8>(PV, PG, pw, ps, gq, blk >> 2, G >> 2, lds); else pool_tiles<16>(PV, PG, pw, ps, gq, blk >> 2, G >> 2, lds);
                } else for (int pi = blk; pi < 1024; pi += G) {
                    const int gq = pi & 3, m0 = (pi >> 2) * 64;
                    const bf16_t* pw = (const bf16_t*)(ws + WS_POOLWT) + (size_t)(l * 4 + gq) * 16384; const float* ps = p.pool_scale + l * 512 + gq * 128;
                    if (gq == 0) pool_item<2>(PV, PG, pw, ps, m0, gq, lds); else if (gq == 1) pool_item<4>(PV, PG, pw, ps, m0, gq, lds);
                    else if (gq == 2) pool_item<8>(PV, PG, pw, ps, m0, gq, lds); else pool_item<16>(PV, PG, pw, ps, m0, gq, lds);
                }
                if (own) { __syncthreads(); f_item(Q, LF, V, DECg, SLOC, DSEG, (const float*)(ws + WS_LB) + l * 1024, blk, lds); }
                if (!own) { GSYNC(); for (int it = blk; it < NB * 8 * NSEG; it += G) scan1_item(Q, LF, V, Pg, DECg, SLOC, DSEG, it, lds); }
                GSYNC();
                for (int it = blk; it < NB * 8 * NSEG; it += G) scan2_item(Q, V, HG, DECg, SLOC, DSEG, p.hgrn_norm_g + l * 128, it, lds);
                GSYNC();
            } else if (s >= 2) GSYNC();
        }
    }
#ifdef DUP_SYNC
    for (int i = 0; i < 16; ++i) GSYNC();
#endif
    p1_rows<true, false>(p.out, Y, ADA + (size_t)(NL - 1) * NB * 3072, p.g_post + (size_t)(NL - 1) * D, p.out, nullptr, nullptr, nullptr);
#if defined(PROBE_P3) || defined(PROBE_G)
    __syncthreads();
    if (blk == 0 && threadIdx.x == 0) p.out[0] = 25.f * floorf((float)probe_acc * 0.01f / 25.f + 0.5f);
#endif
}

extern "C" void kernel_launch(void* const* d_in, const int* in_sizes, int n_in, void* d_out, int out_size, void* d_ws, size_t ws_size, hipStream_t stream) {
    static int grid_blocks = 0;
    if (grid_blocks == 0) {
        if (n_in != 14 || out_size != M * D || ws_size < WS_END) { fprintf(stderr, "kernel_launch: unexpected problem (n_in %d out %d ws %zu)\n", n_in, out_size, ws_size); grid_blocks = -1; return; }
        int dev = 0, cus = 0, per_cu = 0;
        (void)hipGetDevice(&dev);
        (void)hipDeviceGetAttribute(&cus, hipDeviceAttributeMultiprocessorCount, dev);
        (void)hipFuncSetAttribute((const void*)fwd_megakernel, hipFuncAttributeMaxDynamicSharedMemorySize, LDS_BYTES);
        (void)hipOccupancyMaxActiveBlocksPerMultiprocessor(&per_cu, (const void*)fwd_megakernel, 512, LDS_BYTES);
        if (per_cu < 1) { fprintf(stderr, "kernel_launch: occupancy query says %d blocks per CU\n", per_cu); grid_blocks = -1; return; }
        grid_blocks = cus;
    }
    if (grid_blocks < 0) return;
    Params p{};
    p.x = (const float*)d_in[0]; p.c = (const float*)d_in[1]; p.w_ada = (const float*)d_in[2]; p.b_ada = (const float*)d_in[3]; p.g_pre = (const float*)d_in[4]; p.g_post = (const float*)d_in[5];
    p.w_in = (const float*)d_in[6]; p.pool_w = (const float*)d_in[7]; p.pool_scale = (const float*)d_in[8]; p.lb_logits = (const float*)d_in[9]; p.hgrn_norm_g = (const float*)d_in[10];
    p.w_pool_o = (const float*)d_in[11]; p.w_hgrn_o = (const float*)d_in[12]; p.w_out = (const float*)d_in[13];
    p.out = (float*)d_out; p.ws = (unsigned char*)d_ws;
#ifndef USE_CG_SYNC
    (void)hipMemsetAsync((unsigned char*)d_ws + WS_BAR, 0, XCD_BAR_WORDS * sizeof(unsigned), stream);
#endif
    void* args[] = {&p};
    hipError_t e = hipLaunchCooperativeKernel((const void*)fwd_megakernel, dim3(grid_blocks), dim3(512), args, LDS_BYTES, stream);
    if (e != hipSuccess) fprintf(stderr, "cooperative launch failed: %s (grid %d)\n", hipGetErrorString(e), grid_blocks);
}
```
